# Optimizing an MI355X kernel written in HIP

```python
import math
import jax, jax.numpy as jnp
from jax import lax
import numpy as np

D_MODEL = 2048
BATCH = 16
SEQ = 2048
DEPTH = 1

SWA_HEADS = 16
SWA_KV_HEADS = 2
SWA_HEAD_DIM = 64
WINDOW = 128
SWA_BLOCK = WINDOW
MLA_HEADS = 8
MLA_Q_RANK = 512
MLA_KV_RANK = 256
MLA_NOPE_DIM = 128
MLA_ROPE_DIM = 64
MLA_V_DIM = 128
MLA_QBLOCK = 128
ROPE_THETA = 10000.0
MAX_POS_OFFSET = 4096
N_BRANCH = 2
N_EXPERTS = 32
TOP_K = 4
D_EXPERT = D_MODEL
SWIGLU_LIMIT = 7.0
SWIGLU_ALPHA = 1.702
MOE_BLOCK = 256
EPS = 1e-6
NEG_INF = -1e30

IN_WIDTHS = (
    SWA_HEADS * SWA_HEAD_DIM,
    SWA_KV_HEADS * SWA_HEAD_DIM,
    SWA_KV_HEADS * SWA_HEAD_DIM,
    MLA_Q_RANK,
    MLA_KV_RANK,
    MLA_ROPE_DIM,
    N_BRANCH * D_MODEL,
)
IN_COLS = sum(IN_WIDTHS)

kernel_name = 'hybrid_swa_mla_gated_moe'


def rms_norm(x, g):
    xf = x.astype(jnp.float32)
    y = xf * lax.rsqrt(jnp.mean(xf * xf, axis=-1, keepdims=True) + EPS)
    return (y * g.astype(jnp.float32)).astype(x.dtype)


def rope(x, pos):
    d = x.shape[-1]
    half = d // 2
    inv_freq = jnp.power(ROPE_THETA, -jnp.arange(half, dtype=jnp.float32) * 2.0 / d)
    ang = pos.astype(jnp.float32)[..., None] * inv_freq
    cos = jnp.cos(ang)[:, :, None, :]
    sin = jnp.sin(ang)[:, :, None, :]
    xf = x.astype(jnp.float32)
    x1, x2 = xf[..., :half], xf[..., half:]
    return jnp.concatenate([x1 * cos - x2 * sin, x2 * cos + x1 * sin], axis=-1).astype(x.dtype)


def sliding_window_attention(q, k, v, sinks):
    B, S, Hq, Dh = q.shape
    Hkv = k.shape[2]
    G = Hq // Hkv
    nb = S // SWA_BLOCK
    qb = q.reshape(B, nb, SWA_BLOCK, Hkv, G, Dh)

    def band(t):
        prev = jnp.pad(t, ((0, 0), (SWA_BLOCK, 0), (0, 0), (0, 0)))[:, :S]
        return jnp.concatenate([prev.reshape(B, nb, SWA_BLOCK, Hkv, Dh),
                                t.reshape(B, nb, SWA_BLOCK, Hkv, Dh)], axis=2)

    kb, vb = band(k), band(v)
    s = jnp.einsum('bnqhgd,bnkhd->bnhgqk', qb, kb,
                   preferred_element_type=jnp.float32) * (Dh ** -0.5)
    blk = jnp.arange(nb)[:, None, None] * SWA_BLOCK
    q_abs = blk + jnp.arange(SWA_BLOCK)[None, :, None]
    k_abs = blk - SWA_BLOCK + jnp.arange(2 * SWA_BLOCK)[None, None, :]
    dist = q_abs - k_abs
    valid = (dist >= 0) & (dist < WINDOW) & (k_abs >= 0)
    s = jnp.where(valid[None, :, None, None], s, NEG_INF)
    sink = jnp.broadcast_to(
        sinks.astype(jnp.float32).reshape(Hkv, G)[None, None, :, :, None, None],
        s.shape[:-1] + (1,))
    p = jax.nn.softmax(jnp.concatenate([s, sink], axis=-1), axis=-1)[..., :-1]
    o = jnp.einsum('bnhgqk,bnkhd->bnqhgd', p.astype(v.dtype), vb)
    return o.reshape(B, S, Hq * Dh)


def mla_attention(q_nope, q_rope, k_nope, k_rope, v):
    B, S, H, _ = q_nope.shape
    dv = v.shape[-1]
    nb = S // MLA_QBLOCK
    scale = (MLA_NOPE_DIM + MLA_ROPE_DIM) ** -0.5
    k_pos = jnp.arange(S)

    def to_blocks(t):
        return jnp.moveaxis(t.reshape((B, nb, MLA_QBLOCK) + t.shape[2:]), 1, 0)

    def one_block(args):
        qn, qr, n = args
        s = (jnp.einsum('bqhd,bkhd->bhqk', qn, k_nope, preferred_element_type=jnp.float32)
             + jnp.einsum('bqhd,bkd->bhqk', qr, k_rope, preferred_element_type=jnp.float32)) * scale
        q_pos = n * MLA_QBLOCK + jnp.arange(MLA_QBLOCK)
        s = jnp.where((k_pos[None, :] <= q_pos[:, None])[None, None], s, NEG_INF)
        p = jax.nn.softmax(s, axis=-1)
        return jnp.einsum('bhqk,bkhd->bqhd', p.astype(v.dtype), v)

    o = lax.map(one_block, (to_blocks(q_nope), to_blocks(q_rope), jnp.arange(nb)))
    return jnp.moveaxis(o, 0, 1).reshape(B, S, H * dv)


def clamped_swiglu(gu):
    gate, up = gu[..., ::2], gu[..., 1::2]
    gate = jnp.minimum(gate, SWIGLU_LIMIT)
    up = jnp.clip(up, -SWIGLU_LIMIT, SWIGLU_LIMIT)
    return gate * jax.nn.sigmoid(SWIGLU_ALPHA * gate) * (up + 1.0)


def moe(xt, w_router, b_router, w_gate_up, b_gate_up, w_down, b_down):
    N, D = xt.shape
    logits = jnp.dot(xt, w_router, preferred_element_type=jnp.float32) + b_router.astype(jnp.float32)
    top_v, top_e = lax.top_k(logits, TOP_K)
    top_w = jax.nn.softmax(top_v, axis=-1)
    A = N * TOP_K
    flat_e = top_e.reshape(-1)
    flat_tok = jnp.repeat(jnp.arange(N, dtype=jnp.int32), TOP_K)
    order = jnp.argsort(flat_e, stable=True)
    se = flat_e[order]
    stok = flat_tok[order]
    counts = jnp.bincount(flat_e, length=N_EXPERTS)
    padded = (counts + MOE_BLOCK - 1) // MOE_BLOCK * MOE_BLOCK
    start = jnp.cumsum(counts) - counts
    pend = jnp.cumsum(padded)
    pstart = pend - padded
    dest = pstart[se] + jnp.arange(A) - start[se]
    n_blocks = -(-A // MOE_BLOCK) + N_EXPERTS
    P = n_blocks * MOE_BLOCK
    buf = jnp.zeros((P, D), xt.dtype).at[dest].set(xt[stok])
    block_e = jnp.minimum(
        jnp.searchsorted(pend, jnp.arange(n_blocks) * MOE_BLOCK, side='right'), N_EXPERTS - 1)

    def expert_block(args):
        xb, e = args
        gu = xb @ w_gate_up[e] + b_gate_up[e]
        return clamped_swiglu(gu) @ w_down[e] + b_down[e]

    ybuf = lax.map(expert_block, (buf.reshape(n_blocks, MOE_BLOCK, D), block_e)).reshape(P, D)
    y_assign = ybuf[dest] * top_w.reshape(-1)[order][:, None].astype(ybuf.dtype)
    return jax.ops.segment_sum(y_assign, stok, num_segments=N).astype(xt.dtype)


def setup_inputs(seed: int = 0) -> dict:
    key = jax.random.key(seed)
    ks = jax.random.split(key, 24)
    f32 = jnp.float32
    L, D = DEPTH, D_MODEL

    def nrm(k, shape, scale):
        return jax.random.normal(k, shape, f32) * scale

    def gain(k, shape):
        return 1.0 + 0.01 * jax.random.normal(k, shape, f32)

    x = nrm(ks[0], (BATCH, SEQ, D), 1.0)
    positions = (jnp.arange(SEQ, dtype=jnp.int32)[None, :]
                 + jax.random.randint(ks[1], (BATCH, 1), 0, MAX_POS_OFFSET, dtype=jnp.int32))
    return {
        'x': x,
        'positions': positions,
        'g_attn': gain(ks[2], (L, D)),
        'w_in': nrm(ks[3], (L, D, IN_COLS), D ** -0.5),
        'b_gate': nrm(ks[4], (L, N_BRANCH * D), 0.1),
        'sinks': nrm(ks[5], (L, SWA_HEADS), 1.0),
        'g_q': gain(ks[6], (L, MLA_Q_RANK)),
        'w_uq': nrm(ks[7], (L, MLA_Q_RANK, MLA_HEADS * (MLA_NOPE_DIM + MLA_ROPE_DIM)), MLA_Q_RANK ** -0.5),
        'g_kv': gain(ks[8], (L, MLA_KV_RANK)),
        'w_ukv': nrm(ks[9], (L, MLA_KV_RANK, MLA_HEADS * (MLA_NOPE_DIM + MLA_V_DIM)), MLA_KV_RANK ** -0.5),
        'w_o_swa': nrm(ks[10], (L, SWA_HEADS * SWA_HEAD_DIM, D), (SWA_HEADS * SWA_HEAD_DIM) ** -0.5),
        'w_o_mla': nrm(ks[11], (L, MLA_HEADS * MLA_V_DIM, D), (MLA_HEADS * MLA_V_DIM) ** -0.5),
        'w_out': nrm(ks[12], (L, D, D), D ** -0.5),
        'g_ffn': gain(ks[13], (L, D)),
        'w_router': nrm(ks[14], (L, D, N_EXPERTS), D ** -0.5),
        'b_router': nrm(ks[15], (L, N_EXPERTS), 0.01),
        'w_gate_up': nrm(ks[16], (L, N_EXPERTS, D, 2 * D_EXPERT), D ** -0.5),
        'b_gate_up': nrm(ks[17], (L, N_EXPERTS, 2 * D_EXPERT), 0.01),
        'w_down': nrm(ks[18], (L, N_EXPERTS, D_EXPERT, D), D_EXPERT ** -0.5),
        'b_down': nrm(ks[19], (L, N_EXPERTS, D), 0.01),
        'g_final': gain(ks[20], (D,)),
    }


def reference(x, positions, g_attn, w_in, b_gate, sinks, g_q, w_uq, g_kv, w_ukv,
              w_o_swa, w_o_mla, w_out, g_ffn, w_router, b_router, w_gate_up,
              b_gate_up, w_down, b_down, g_final):
    B, S, D = x.shape
    splits = [int(s) for s in np.cumsum(IN_WIDTHS)[:-1]]
    h = x
    for l in range(DEPTH):
        xn = rms_norm(h, g_attn[l])
        proj = xn @ w_in[l]
        q_a, k_a, v_a, dq, dkv, kr, gates = jnp.split(proj, splits, axis=-1)

        qa = rope(q_a.reshape(B, S, SWA_HEADS, SWA_HEAD_DIM), positions)
        ka = rope(k_a.reshape(B, S, SWA_KV_HEADS, SWA_HEAD_DIM), positions)
        va = v_a.reshape(B, S, SWA_KV_HEADS, SWA_HEAD_DIM)
        out_a = sliding_window_attention(qa, ka, va, sinks[l])

        c_q = rms_norm(dq, g_q[l])
        qb = (c_q @ w_uq[l]).reshape(B, S, MLA_HEADS, MLA_NOPE_DIM + MLA_ROPE_DIM)
        q_nope = qb[..., :MLA_NOPE_DIM]
        q_rope = rope(qb[..., MLA_NOPE_DIM:], positions)
        c_kv = rms_norm(dkv, g_kv[l])
        kvb = (c_kv @ w_ukv[l]).reshape(B, S, MLA_HEADS, MLA_NOPE_DIM + MLA_V_DIM)
        k_nope = kvb[..., :MLA_NOPE_DIM]
        vb = kvb[..., MLA_NOPE_DIM:]
        k_rope = rope(kr[:, :, None, :], positions)[:, :, 0, :]
        out_b = mla_attention(q_nope, q_rope, k_nope, k_rope, vb)

        g = jax.nn.sigmoid((gates + b_gate[l]).astype(jnp.float32)).reshape(B, S, N_BRANCH, D).astype(h.dtype)
        mixed = g[:, :, 0] * (out_a @ w_o_swa[l]) + g[:, :, 1] * (out_b @ w_o_mla[l])
        h = h + mixed @ w_out[l]

        hn = rms_norm(h, g_ffn[l]).reshape(B * S, D)
        h = h + moe(hn, w_router[l], b_router[l], w_gate_up[l], b_gate_up[l],
                    w_down[l], b_down[l]).reshape(B, S, D)
    return rms_norm(h, g_final)
```

```cpp
#include <hip/hip_runtime.h>
#include <cstdio>
#include <cstdint>

#ifndef MK_ONE_LAUNCH
#define MK_ONE_LAUNCH 1
#endif

#define LAS __attribute__((address_space(3)))
#define GAS __attribute__((address_space(1)))
typedef unsigned short bf16_t;
typedef short bf16x8 __attribute__((ext_vector_type(8)));
typedef short s16x4 __attribute__((ext_vector_type(4)));
typedef float f32x4 __attribute__((ext_vector_type(4)));
typedef float f32x16 __attribute__((ext_vector_type(16)));
typedef unsigned u32x4 __attribute__((ext_vector_type(4)));
typedef unsigned u32x2 __attribute__((ext_vector_type(2)));
typedef short v4i16_t __attribute__((ext_vector_type(4)));

constexpr int DM = 2048, BATCH = 16, SEQ = 2048, NTOK = BATCH * SEQ;
constexpr int NPROJ = 2304;
constexpr int PC_KA = 1024, PC_VA = 1152, PC_DQ = 1280, PC_DKV = 1792, PC_KR = 2048;
constexpr int NGATE = 4096, NIN_PHYS = 6400, NIN_LOG = 6208, NLOW = 2112;
constexpr int NEXP = 32, TOPK = 4, MAXTILES = 544, PROWS = MAXTILES * 256;
constexpr float EPS = 1e-6f;

constexpr size_t MiB = 1ull << 20;
constexpr size_t WS_CTL = 0, CTL_ZERO_BYTES = 1 * MiB;
constexpr size_t WS_CS = 1 * MiB, WS_WRT = 9 * MiB, WS_WIN = 10 * MiB, WS_WUQ = 36 * MiB, WS_WUKV = 38 * MiB, WS_WOA = 40 * MiB, WS_WOB = 45 * MiB, WS_WOUT = 50 * MiB;
constexpr size_t WS_WGU = 64 * MiB, WS_WD = 580 * MiB, WS_XN = 840 * MiB, WS_PROJ = 968 * MiB, WS_GATES = 1112 * MiB, WS_CQ = 1368 * MiB, WS_CKV = 1400 * MiB;
constexpr size_t WS_QB = 1416 * MiB, WS_KMLA = 1512 * MiB  , WS_VMLA = 1610 * MiB  ;
constexpr size_t WS_OUTA = 1676 * MiB, WS_OUTB = 1740 * MiB, WS_MIX = 1804 * MiB;
constexpr size_t WS_TOPE = 1932 * MiB, WS_TOPW = 1933 * MiB, WS_SLOT = 1934 * MiB, WS_ROWTOK = 1935 * MiB, WS_TILEE = 1936 * MiB, WS_CNT = 1937 * MiB;
constexpr size_t WS_ACT = 1940 * MiB, WS_YBUF = 2484 * MiB, WS_END = 3028 * MiB;
constexpr size_t WS_H = WS_OUTA;
constexpr size_t WS_XN8 = WS_YBUF  , WS_IDROW = 60 * MiB, WIN_GATES_OFF = 16 * MiB;
constexpr int LDPAD = 16;
constexpr int CW_NT = 16, CW_BAR = 4096;

constexpr int RING_BYTES = 131072, LDS_BYTES = 147456, MISC_OFF = LDS_BYTES - 256;
constexpr int NWAVES = 8, NTHREADS = 512;

__device__ __forceinline__ unsigned cvt_pk_bf16(float lo, float hi) { unsigned r; asm volatile("v_cvt_pk_bf16_f32 %0, %1, %2" : "=v"(r) : "v"(lo), "v"(hi)); return r; }
__device__ __forceinline__ unsigned cvt_pk_bf16_t(float lo, float hi) { unsigned r; asm volatile("s_nop 0\n\tv_cvt_pk_bf16_f32 %0, %1, %2" : "=v"(r) : "v"(lo), "v"(hi)); return r; }
__device__ __forceinline__ float bf_lo(unsigned w) { return __uint_as_float(w << 16); }
__device__ __forceinline__ float bf_hi(unsigned w) { return __uint_as_float(w & 0xffff0000u); }
__device__ __forceinline__ float wave_sum(float v) {
#pragma unroll
    for (int o = 1; o < 64; o <<= 1) v += __shfl_xor(v, o);
    return v;
}
__device__ __forceinline__ float fast_sigmoid(float x) { return __builtin_amdgcn_rcpf(1.0f + __builtin_amdgcn_exp2f(-1.4426950408889634f * x)); }
__device__ __forceinline__ const char* uni_ptr(const char* p) { const unsigned long long v = (unsigned long long)p; const unsigned lo = __builtin_amdgcn_readfirstlane((unsigned)v), hi = __builtin_amdgcn_readfirstlane((unsigned)(v >> 32)); return (const char*)(((unsigned long long)hi << 32) | lo); }
__device__ __forceinline__ void glds16_asm(const char* sbase, unsigned voff, unsigned lds_dst) {
    unsigned keep;
    asm volatile("s_mov_b32 %0, m0\n\ts_mov_b32 m0, %3\n\ts_nop 0\n\tglobal_load_lds_dwordx4 %1, %2\n\ts_mov_b32 m0, %0" : "=&s"(keep) : "v"(voff), "s"(sbase), "s"(lds_dst) : "memory");
}
#define LDS_WAIT() asm volatile("s_waitcnt lgkmcnt(0)" ::: "memory")

#define XB_TMO      128
#define XB_XCNT(j)  (256  + 64 * (j))
#define XB_XSUB(j)  (1280 + 64 * (j))
#define XB_XGEN(j)  (2304 + 64 * (j))
#define XB_TOP      3328
#define XB_TOPGEN   3392
#define XCD_BAR_WORDS 3456
#define XB_SPIN_CAP (1u << 18)
__device__ __forceinline__ unsigned xb_ld(unsigned* p)              { return __hip_atomic_load(p, __ATOMIC_RELAXED, __HIP_MEMORY_SCOPE_AGENT); }
__device__ __forceinline__ unsigned xb_add(unsigned* p, unsigned v) { return __hip_atomic_fetch_add(p, v, __ATOMIC_RELAXED, __HIP_MEMORY_SCOPE_AGENT); }
__device__ __forceinline__ unsigned xb_xcc_id() { return (unsigned)__builtin_amdgcn_s_getreg((3 << 11) | 20) & 0xFu; }
#define XB_SPIN(cond, bar) do { unsigned _sp = 0; while (cond) { __builtin_amdgcn_s_sleep(1); \
    if ((++_sp & 255u) == 0u) { if (xb_ld(&(bar)[XB_TMO])) break; if (_sp > XB_SPIN_CAP) { atomicAdd(&(bar)[XB_TMO], 1u); break; } } } } while (0)
struct XcdBarrier { unsigned* bar; unsigned x; volatile LAS unsigned* st; };
__device__ __forceinline__ XcdBarrier xcd_barrier_post(unsigned* bar, volatile LAS unsigned* st) {
    XcdBarrier b; b.bar = bar; b.x = xb_xcc_id(); b.st = st;
    if (threadIdx.x == 0) (void)xb_add(&bar[XB_XCNT(b.x)], 1u);
    return b;
}
__device__ __forceinline__ void xcd_barrier_complete(unsigned* bar, unsigned x, unsigned& nloc, unsigned& nx) {
    const unsigned G = gridDim.x * gridDim.y * gridDim.z;
    unsigned sum, cnt, mine, sp = 0u;
    for (;;) {
        sum = 0u; cnt = 0u; mine = 0u;
#pragma unroll
        for (unsigned j = 0; j < 16; ++j) { const unsigned c = xb_ld(&bar[XB_XCNT(j)]); sum += c; cnt += (c > 0u) ? 1u : 0u; mine = (j == x) ? c : mine; }
        if (sum == G) break;
        __builtin_amdgcn_s_sleep(1);
        if ((++sp & 255u) == 0u) { if (xb_ld(&bar[XB_TMO])) break; if (sp > XB_SPIN_CAP) { atomicAdd(&bar[XB_TMO], 1u); break; } }
    }
    nloc = mine > 0u ? mine : 1u; nx = cnt > 0u ? cnt : 1u;
}
__device__ __forceinline__ void xcd_barrier(const XcdBarrier& b) {
    asm volatile("s_waitcnt vmcnt(0)" ::: "memory");
    __syncthreads();
    if (threadIdx.x == 0) {
        unsigned* bar = b.bar;
        __builtin_amdgcn_s_waitcnt(0);
        unsigned nloc = b.st[0], nx = b.st[1];
        if (nloc == 0u) { xcd_barrier_complete(bar, b.x, nloc, nx); b.st[0] = nloc; b.st[1] = nx; }
        const unsigned old = xb_add(&bar[XB_XSUB(b.x)], 1u);
        const unsigned gen = old / nloc;
        if (old + 1u == (gen + 1u) * nloc) {
            __builtin_amdgcn_fence(__ATOMIC_RELEASE, "agent");
            asm volatile("s_waitcnt vmcnt(0)" ::: "memory");
            const unsigned og = xb_add(&bar[XB_TOP], 1u);
            const unsigned tg = og / nx;
            if (og + 1u == (tg + 1u) * nx) xb_add(&bar[XB_TOPGEN], 1u);
            else XB_SPIN(xb_ld(&bar[XB_TOPGEN]) == tg, bar);
            __builtin_amdgcn_fence(__ATOMIC_ACQUIRE, "agent");
            xb_add(&bar[XB_XGEN(b.x)], 1u);
            asm volatile("s_waitcnt vmcnt(0)" ::: "memory");
        } else {
            XB_SPIN(xb_ld(&bar[XB_XGEN(b.x)]) == gen, bar);
            __builtin_amdgcn_fence(__ATOMIC_ACQUIRE, "agent");
            asm volatile("s_waitcnt vmcnt(0)" ::: "memory");
        }
    }
    __syncthreads();
}

namespace pg8 {
constexpr int BM = 256, BK = 64, HALF = 128, HTB = HALF * BK * 2, STAGE_BYTES = 8 * HTB, NXCD = 8, WGM = 8;
__host__ __device__ __forceinline__ int lds_byte(int r, int c) { const int st = (r >> 4) * 2 + (c >> 5), rr = r & 15, cc = c & 31, ob = rr * 64 + cc * 2; return st * 1024 + (ob ^ (((ob >> 9) & 1) << 5)); }
__host__ __device__ __forceinline__ void stage_rc(int b, int& R, int& C) { const int st = b / 1024, sb = b % 1024, swz = sb ^ (((sb >> 9) & 1) << 5); R = (st >> 1) * 16 + swz / 64; C = (st & 1) * 32 + (swz % 64) / 2; }
__host__ __device__ __forceinline__ int perm32(int rho) { const int n = rho >> 4, i = rho & 15; return 8 * (i >> 2) + 4 * n + (i & 3); }
struct Unit { int pm, pn; };
struct Gemm { const bf16_t* A; const bf16_t* Bt; int lda, K; const int* tile_e; size_t estride; const int* rowtok; };
struct StaticOrder {
    int nM, nN, nwg, G, c;
    __device__ void init(int nM_, int nN_, int G_, int c_) { nM = nM_; nN = nN_; nwg = nM * nN; G = G_; c = c_; }
    __device__ bool next(int i, Unit& u) const {
        const long L = (long)i * G + c; if (L >= nwg) return false;
        int wgid = (int)L; { const int q = nwg / NXCD, r = nwg % NXCD, xcd = wgid % NXCD, off = wgid / NXCD; wgid = (xcd < r ? xcd * (q + 1) : r * (q + 1) + (xcd - r) * q) + off; }
        const int nig = WGM * nN, gid = wgid / nig, fm = gid * WGM, gsz = (nM - fm) < WGM ? (nM - fm) : WGM;
        u.pm = fm + ((wgid % nig) % gsz); u.pn = (wgid % nig) / gsz; return true;
    }
};
template <class Epi, bool GROUPED, bool GATHER, bool MIDHOOK = false>
__device__ __forceinline__ void gemm_phase(LAS unsigned char* lds, const Gemm g, const StaticOrder& S, const Epi& E) {
    int tid = threadIdx.x; asm volatile("" : "+v"(tid));
    const int wid = __builtin_amdgcn_readfirstlane(tid >> 6), lane = tid & 63, wr = wid >> 2, wc = wid & 3, fr = lane & 15, fq = lane >> 4;
    int K = g.K; asm volatile("" : "+s"(K));
    const int nt = K / BK, lda = g.lda;
    unsigned voffB[2];
#pragma unroll
    for (int i = 0; i < 2; ++i) { int R, C; stage_rc(tid * 16 + i * 8192, R, C); const int Rb = Epi::PERM ? ((R & ~31) + perm32(R & 31)) : R;
        (void)Rb; voffB[i] = (unsigned)(tid * 16 + i * 8192); }
    const size_t kstep = (size_t)(BK * 2);
    const size_t kstepB = 32768, hstepB = 16384, tstepB = (size_t)nt * 32768;
    const unsigned ldsw = (unsigned)wid * 1024u;
    const int aoff = lds_byte(wr * 64 + fr, fq * 8), boff = lds_byte(wc * 32 + fr, fq * 8);
#define PG8_SA(b, h) (((b) * 2 + (h)) * HTB)
#define PG8_SB(b, h) ((4 + (b) * 2 + (h)) * HTB)
#define PG8_STAGE(bufoff, gbase, voff) do { _Pragma("unroll") for (int _i = 0; _i < 2; ++_i) \
        __builtin_amdgcn_global_load_lds((const unsigned*)((const char*)(gbase) + (voff)[_i]), (LAS unsigned*)(lds + (bufoff) + ldsw + _i * 8192), 16, 0, 0); } while (0)
#define PG8_LDA(dst, b, h) do { _Pragma("unroll") for (int m = 0; m < 4; ++m) _Pragma("unroll") for (int k = 0; k < 2; ++k) dst[m][k] = *(const LAS bf16x8*)(lds + PG8_SA(b, h) + aoff + m * 2048 + k * 1024); } while (0)
#define PG8_LDB(dst, b, h) do { _Pragma("unroll") for (int n = 0; n < 2; ++n) _Pragma("unroll") for (int k = 0; k < 2; ++k) dst[n][k] = *(const LAS bf16x8*)(lds + PG8_SB(b, h) + boff + n * 2048 + k * 1024); } while (0)
#define PG8_MMA(ai, bj, At, Bt) do { __builtin_amdgcn_s_setprio(1); _Pragma("unroll") for (int m = 0; m < 4; ++m) _Pragma("unroll") for (int n = 0; n < 2; ++n) _Pragma("unroll") for (int k = 0; k < 2; ++k) \
        acc[ai][bj][m][n] = __builtin_amdgcn_mfma_f32_16x16x32_bf16(Bt[n][k], At[m][k], acc[ai][bj][m][n], 0, 0, 0); __builtin_amdgcn_s_setprio(0); } while (0)
#ifdef DBG_SAFE_GEMM
#define PG8_WAIT_V(n) asm volatile("s_waitcnt vmcnt(0)" ::: "memory")
#else
#define PG8_WAIT_V(n) asm volatile("s_waitcnt vmcnt(" #n ")" ::: "memory")
#endif
#define PG8_WAIT_L(n) asm volatile("s_waitcnt lgkmcnt(" #n ")" ::: "memory")
#define PG8_BAR __builtin_amdgcn_s_barrier()
#define PG8_SCHED __builtin_amdgcn_sched_barrier(0)
#define PG8_AOFF(vo, u) do { int _t = tid; asm volatile("" : "+v"(_t));     \
        _Pragma("unroll") for (int _i = 0; _i < 2; ++_i) { int _R, _C; stage_rc(_t * 16 + _i * 8192, _R, _C); \
        _Pragma("unroll") for (int _h = 0; _h < 2; ++_h) { \
        const int _r = (u).pm * BM + _h * HALF + _R; (vo)[_h][_i] = (unsigned)(g.rowtok[_r] * lda + _C) * 2u; } } } while (0)
#define PG8_STGA(bufoff, aptr, gptr, h, vo) do { if constexpr (GATHER) PG8_STAGE(bufoff, gptr, (vo)[h]); else PG8_STAGE(bufoff, (aptr) + (h) * hstepA, voffA); } while (0)
#define PF8_AOFF_LDS(vo, rt) do { int _t = tid; asm volatile("" : "+v"(_t)); \
        _Pragma("unroll") for (int _i = 0; _i < 2; ++_i) { const int _p = _t + 512 * _i, _R = _p >> 3, _C = ((_p & 7) ^ sw8(_R)) << 4; \
        _Pragma("unroll") for (int _h = 0; _h < 2; ++_h) (vo)[_h][_i] = (unsigned)((rt)[_h * HALF + _R] * lda + _C); } } while (0)
    Unit cur, nxt; int ui = 0;
    if (!S.next(0, cur)) return;
    f32x4 acc[2][2][4][2];
#pragma unroll
    for (int a = 0; a < 2; ++a)
#pragma unroll
        for (int b = 0; b < 2; ++b)
#pragma unroll
            for (int m = 0; m < 4; ++m)
#pragma unroll
                for (int n = 0; n < 2; ++n) acc[a][b][m][n] = (f32x4){0.f, 0.f, 0.f, 0.f};
    bf16x8 At[4][2], B0[2][2], B1[2][2];
    unsigned voC[2][2], voffA[2];
    LAS u32x4* const gslot = (LAS u32x4*)(lds + STAGE_BYTES) + tid;
    const size_t hstepA = (size_t)HALF * lda * 2, tstepA = 2 * hstepA;
    if constexpr (GATHER) { PG8_AOFF(voC, cur); voffA[0] = 0; voffA[1] = 0; }
    else {
#pragma unroll
        for (int i = 0; i < 2; ++i) { int R, C; stage_rc(tid * 16 + i * 8192, R, C); voffA[i] = (unsigned)(R * lda + C) * 2u; }
#pragma unroll
        for (int h = 0; h < 2; ++h)
#pragma unroll
            for (int i = 0; i < 2; ++i) voC[h][i] = 0;
    }
    const char* const Abase = (const char*)g.A;
    const char* cA = GATHER ? Abase : Abase + (size_t)cur.pm * tstepA;
    const char* cB = (const char*)g.Bt + (GROUPED ? (size_t)g.tile_e[cur.pm] * g.estride * 2 : (size_t)0) + (size_t)cur.pn * tstepB;
    PG8_STAGE(PG8_SB(0, 0), cB, voffB); PG8_STAGE(PG8_SB(0, 1), cB + hstepB, voffB); PG8_STGA(PG8_SA(0, 0), cA, Abase, 0, voC); PG8_STGA(PG8_SA(0, 1), cA, Abase, 1, voC);
    if (wr == 1) PG8_BAR;
    PG8_WAIT_V(2); PG8_BAR;
    PG8_STAGE(PG8_SB(1, 0), cB + kstepB, voffB); PG8_STGA(PG8_SA(1, 0), cA + kstep, Abase + kstep, 0, voC); PG8_STAGE(PG8_SB(1, 1), cB + hstepB + kstepB, voffB);
    PG8_WAIT_V(6); PG8_BAR;
    for (;;) {
        const bool has_next = S.next(ui + 1, nxt);
        const char* nB = cB; const char* nA = cA;
        if (has_next) { nB = (const char*)g.Bt + (GROUPED ? (size_t)g.tile_e[nxt.pm] * g.estride * 2 : (size_t)0) + (size_t)nxt.pn * tstepB;
            if constexpr (GATHER) { unsigned vt[2][2]; PG8_AOFF(vt, nxt); *gslot = (u32x4){vt[0][0], vt[0][1], vt[1][0], vt[1][1]}; } else nA = Abase + (size_t)nxt.pm * tstepA; }
        else if constexpr (GATHER) *gslot = (u32x4){voC[0][0], voC[0][1], voC[1][0], voC[1][1]};
#pragma unroll 1
        for (int t = 0; t < nt; t += 2) {
            const bool last = (t == nt - 2);
            const char* a1 = cA + (size_t)(t + 1) * kstep;
            const char* a2 = last ? nA : cA + (size_t)(t + 2) * kstep; const char* b2 = last ? nB : cB + (size_t)(t + 2) * kstepB;
            const char* a3 = a2 + kstep; const char* b3 = b2 + kstepB;
            if constexpr (MIDHOOK) { if (t == nt / 2) { int ln_ = lane; asm volatile("" : "+v"(ln_)); E.mid(acc, cur, wr, wc, ln_ & 15, ln_ >> 4); } }
            PG8_LDB(B0, 0, 0); PG8_LDB(B1, 0, 1); PG8_SCHED; PG8_LDA(At, 0, 0); PG8_STGA(PG8_SA(1, 1), a1, a1, 1, voC);
            if constexpr (GATHER) { if (last) { const u32x4 q = *gslot; voC[0][0] = q.x; voC[0][1] = q.y; voC[1][0] = q.z; voC[1][1] = q.w; } }
            PG8_WAIT_V(8); PG8_WAIT_L(0); PG8_BAR; PG8_MMA(0, 0, At, B0); PG8_MMA(0, 1, At, B1); PG8_BAR; PG8_SCHED;
            PG8_LDA(At, 0, 1); PG8_STAGE(PG8_SB(0, 0), b2, voffB); PG8_STAGE(PG8_SB(0, 1), b2 + hstepB, voffB); PG8_STGA(PG8_SA(0, 0), a2, a2, 0, voC);
            PG8_WAIT_V(8); PG8_WAIT_L(0); PG8_BAR; PG8_MMA(1, 0, At, B0); PG8_MMA(1, 1, At, B1); PG8_BAR; PG8_SCHED;
            PG8_LDB(B0, 1, 0); PG8_LDB(B1, 1, 1); PG8_SCHED; PG8_LDA(At, 1, 0); PG8_STGA(PG8_SA(0, 1), a2, a2, 1, voC);
            PG8_WAIT_V(8); PG8_WAIT_L(0); PG8_BAR; PG8_MMA(0, 0, At, B0); PG8_MMA(0, 1, At, B1); PG8_BAR; PG8_SCHED;
            PG8_LDA(At, 1, 1); PG8_STAGE(PG8_SB(1, 0), b3, voffB); PG8_STAGE(PG8_SB(1, 1), b3 + hstepB, voffB); PG8_STGA(PG8_SA(1, 0), a3, a3, 0, voC);
            PG8_WAIT_V(8); PG8_WAIT_L(0); PG8_BAR; PG8_MMA(1, 0, At, B0); PG8_MMA(1, 1, At, B1); PG8_BAR; PG8_SCHED;
        }
        if (wr == 0) PG8_BAR;
        { int ln_ = lane; asm volatile("" : "+v"(ln_)); E(acc, cur, wr, wc, ln_ & 15, ln_ >> 4); }
        if (!has_next) break;
#pragma unroll
        for (int a = 0; a < 2; ++a)
#pragma unroll
            for (int b = 0; b < 2; ++b)
#pragma unroll
                for (int m = 0; m < 4; ++m)
#pragma unroll
                    for (int n = 0; n < 2; ++n) acc[a][b][m][n] = (f32x4){0.f, 0.f, 0.f, 0.f};
        cur = nxt; cB = nB; cA = nA; ++ui;
        if (wr == 1) PG8_BAR;
    }
    PG8_WAIT_V(0);
    PG8_BAR;
#undef PG8_SA
#undef PG8_SB
#undef PG8_STAGE
#undef PG8_LDA
#undef PG8_LDB
#undef PG8_MMA
#undef PG8_WAIT_V
#undef PG8_WAIT_L
#undef PG8_BAR
#undef PG8_SCHED
#undef PG8_AOFF
#undef PG8_STGA
}

struct GemmO { const bf16_t* A; const bf16_t* Bt; int M, N, K; };
template <class Epi, class Sched, bool ALIGN_EPI = false, bool SP2 = false>
__device__ __forceinline__ void gemm_phase_orig(LAS unsigned char* lds, const GemmO g, const Sched& S, const Epi& E) {
    const int tid = threadIdx.x, wid = __builtin_amdgcn_readfirstlane(tid >> 6), lane = tid & 63, wr = wid >> 2, wc = wid & 3, fr = lane & 15, fq = lane >> 4;
    const int K = g.K, nt = K / BK;
    unsigned voffA[2], voffB[2];
#pragma unroll
    for (int i = 0; i < 2; ++i) { int R, C; stage_rc(tid * 16 + i * 8192, R, C); const int Rb = Epi::PERM ? ((R & ~31) + perm32(R & 31)) : R;
        voffA[i] = (unsigned)(R * K + C) * 2u; voffB[i] = (unsigned)(Rb * K + C) * 2u; }
    const size_t kstep = (size_t)(BK * 2);
    const size_t hstep = (size_t)HALF * K * 2;
    const size_t tstep = 2 * hstep;
    const unsigned ldsw = (unsigned)wid * 1024u;
    const int aoff = lds_byte(wr * 64 + fr, fq * 8), boff = lds_byte(wc * 32 + fr, fq * 8);
#define PG8_SA(b, h) (((b) * 2 + (h)) * HTB)
#define PG8_SB(b, h) ((4 + (b) * 2 + (h)) * HTB)
#define PG8_STAGE(bufoff, gbase, voff) do { _Pragma("unroll") for (int _i = 0; _i < 2; ++_i) \
        __builtin_amdgcn_global_load_lds((const unsigned*)((const char*)(gbase) + (voff)[_i]), (LAS unsigned*)(lds + (bufoff) + ldsw + _i * 8192), 16, 0, 0); } while (0)
#define PG8_LDA(dst, b, h) do { _Pragma("unroll") for (int m = 0; m < 4; ++m) _Pragma("unroll") for (int k = 0; k < 2; ++k) dst[m][k] = *(const LAS bf16x8*)(lds + PG8_SA(b, h) + aoff + m * 2048 + k * 1024); } while (0)
#define PG8_LDB(dst, b, h) do { _Pragma("unroll") for (int n = 0; n < 2; ++n) _Pragma("unroll") for (int k = 0; k < 2; ++k) dst[n][k] = *(const LAS bf16x8*)(lds + PG8_SB(b, h) + boff + n * 2048 + k * 1024); } while (0)
#define PG8_MMA(ai, bj, At, Bt) do { __builtin_amdgcn_s_setprio(1); _Pragma("unroll") for (int m = 0; m < 4; ++m) _Pragma("unroll") for (int n = 0; n < 2; ++n) _Pragma("unroll") for (int k = 0; k < 2; ++k) \
        acc[ai][bj][m][n] = __builtin_amdgcn_mfma_f32_16x16x32_bf16(Bt[n][k], At[m][k], acc[ai][bj][m][n], 0, 0, 0); __builtin_amdgcn_s_setprio(0); } while (0)
#define PG8_WAIT_V(n) asm volatile("s_waitcnt vmcnt(" #n ")" ::: "memory")
#define PG8_WAIT_L(n) asm volatile("s_waitcnt lgkmcnt(" #n ")" ::: "memory")
#define PG8_BAR __builtin_amdgcn_s_barrier()
#define PG8_SCHED __builtin_amdgcn_sched_barrier(0)
    Unit cur, nxt; int ui = 0;
    if (!S.next(0, cur)) return;
    f32x4 acc[2][2][4][2];
#pragma unroll
    for (int a = 0; a < 2; ++a)
#pragma unroll
        for (int b = 0; b < 2; ++b)
#pragma unroll
            for (int m = 0; m < 4; ++m)
#pragma unroll
                for (int n = 0; n < 2; ++n) acc[a][b][m][n] = (f32x4){0.f, 0.f, 0.f, 0.f};
    bf16x8 At[4][2], B0[2][2], B1[2][2];
    const char* cA = (const char*)g.A + (size_t)cur.pm * tstep; const char* cB = (const char*)g.Bt + (size_t)cur.pn * tstep;

    if constexpr (SP2) {
        PG8_STAGE(PG8_SB(0, 0), cB, voffB); PG8_STAGE(PG8_SB(0, 1), cB + hstep, voffB); PG8_STAGE(PG8_SA(0, 0), cA, voffA); PG8_STAGE(PG8_SA(0, 1), cA + hstep, voffA);
        if (wr == 1) PG8_BAR;
        PG8_WAIT_V(2); PG8_BAR;
        PG8_STAGE(PG8_SB(1, 0), cB + kstep, voffB); PG8_STAGE(PG8_SA(1, 0), cA + kstep, voffA); PG8_STAGE(PG8_SB(1, 1), cB + hstep + kstep, voffB);
        PG8_WAIT_V(6); PG8_BAR;
    } else {
        PG8_STAGE(PG8_SB(0, 0), cB, voffB); PG8_STAGE(PG8_SA(0, 0), cA, voffA); PG8_STAGE(PG8_SB(0, 1), cB + hstep, voffB); PG8_STAGE(PG8_SA(0, 1), cA + hstep, voffA);
        if (wr == 1) PG8_BAR;
        PG8_WAIT_V(4); PG8_BAR;
        PG8_STAGE(PG8_SB(1, 0), cB + kstep, voffB); PG8_STAGE(PG8_SA(1, 0), cA + kstep, voffA); PG8_STAGE(PG8_SB(1, 1), cB + hstep + kstep, voffB);
        PG8_WAIT_V(6); PG8_BAR;
    }
    for (;;) {
        const bool has_next = S.next(ui + 1, nxt);
        const char* nA = has_next ? (const char*)g.A + (size_t)nxt.pm * tstep : cA; const char* nB = has_next ? (const char*)g.Bt + (size_t)nxt.pn * tstep : cB;
        for (int t = 0; t < nt; t += 2) {
            const bool last = (t == nt - 2);
            const char* a1 = cA + (size_t)(t + 1) * kstep;
            const char* a2 = last ? nA : cA + (size_t)(t + 2) * kstep; const char* b2 = last ? nB : cB + (size_t)(t + 2) * kstep;
            const char* a3 = a2 + kstep; const char* b3 = b2 + kstep;

            if constexpr (SP2) {
            PG8_LDB(B0, 0, 0); PG8_LDB(B1, 0, 1); PG8_SCHED; PG8_LDA(At, 0, 0); PG8_STAGE(PG8_SA(1, 1), a1 + hstep, voffA);
            PG8_WAIT_V(8); PG8_WAIT_L(0); PG8_BAR; PG8_MMA(0, 0, At, B0); PG8_MMA(0, 1, At, B1); PG8_BAR; PG8_SCHED;
            PG8_LDA(At, 0, 1); PG8_STAGE(PG8_SB(0, 0), b2, voffB); PG8_STAGE(PG8_SB(0, 1), b2 + hstep, voffB); PG8_STAGE(PG8_SA(0, 0), a2, voffA);
            PG8_WAIT_V(8); PG8_WAIT_L(0); PG8_BAR; PG8_MMA(1, 0, At, B0); PG8_MMA(1, 1, At, B1); PG8_BAR; PG8_SCHED;
            PG8_LDB(B0, 1, 0); PG8_LDB(B1, 1, 1); PG8_SCHED; PG8_LDA(At, 1, 0); PG8_STAGE(PG8_SA(0, 1), a2 + hstep, voffA);
            PG8_WAIT_V(8); PG8_WAIT_L(0); PG8_BAR; PG8_MMA(0, 0, At, B0); PG8_MMA(0, 1, At, B1); PG8_BAR; PG8_SCHED;
            PG8_LDA(At, 1, 1); PG8_STAGE(PG8_SB(1, 0), b3, voffB); PG8_STAGE(PG8_SB(1, 1), b3 + hstep, voffB); PG8_STAGE(PG8_SA(1, 0), a3, voffA);
            PG8_WAIT_V(8); PG8_WAIT_L(0); PG8_BAR; PG8_MMA(1, 0, At, B0); PG8_MMA(1, 1, At, B1); PG8_BAR; PG8_SCHED;
            } else {
            PG8_LDB(B0, 0, 0); PG8_SCHED; PG8_LDA(At, 0, 0); PG8_STAGE(PG8_SA(1, 1), a1 + hstep, voffA);
            PG8_WAIT_L(8); PG8_BAR; PG8_WAIT_L(0); PG8_MMA(0, 0, At, B0); PG8_BAR; PG8_SCHED;
            PG8_LDB(B1, 0, 1); PG8_STAGE(PG8_SB(0, 0), b2, voffB);
            PG8_BAR; PG8_WAIT_L(0); PG8_MMA(0, 1, At, B1); PG8_BAR;
            PG8_LDA(At, 0, 1); PG8_STAGE(PG8_SA(0, 0), a2, voffA);
            PG8_BAR; PG8_WAIT_L(0); PG8_MMA(1, 0, At, B0); PG8_BAR; PG8_SCHED;
            PG8_STAGE(PG8_SB(0, 1), b2 + hstep, voffB);
            PG8_WAIT_V(6); PG8_BAR; PG8_MMA(1, 1, At, B1); PG8_BAR;
            PG8_LDB(B0, 1, 0); PG8_SCHED; PG8_LDA(At, 1, 0); PG8_STAGE(PG8_SA(0, 1), a2 + hstep, voffA);
            PG8_WAIT_L(8); PG8_BAR; PG8_WAIT_L(0); PG8_MMA(0, 0, At, B0); PG8_BAR; PG8_SCHED;
            PG8_LDB(B1, 1, 1); PG8_STAGE(PG8_SB(1, 0), b3, voffB);
            PG8_BAR; PG8_WAIT_L(0); PG8_MMA(0, 1, At, B1); PG8_BAR;
            PG8_LDA(At, 1, 1); PG8_STAGE(PG8_SA(1, 0), a3, voffA);
            PG8_BAR; PG8_WAIT_L(0); PG8_MMA(1, 0, At, B0); PG8_BAR; PG8_SCHED;
            PG8_STAGE(PG8_SB(1, 1), b3 + hstep, voffB);
            PG8_WAIT_V(6); PG8_BAR; PG8_MMA(1, 1, At, B1); PG8_BAR;
            }
        }
        if constexpr (ALIGN_EPI) { if (wr == 0) PG8_BAR; }
        E(acc, cur, wr, wc, fr, fq);
        if (!has_next) break;
#pragma unroll
        for (int a = 0; a < 2; ++a)
#pragma unroll
            for (int b = 0; b < 2; ++b)
#pragma unroll
                for (int m = 0; m < 4; ++m)
#pragma unroll
                    for (int n = 0; n < 2; ++n) acc[a][b][m][n] = (f32x4){0.f, 0.f, 0.f, 0.f};
        cur = nxt; cA = nA; cB = nB; ++ui;
        if constexpr (ALIGN_EPI) { if (wr == 1) PG8_BAR; }
    }
    PG8_WAIT_V(0);
    if constexpr (!ALIGN_EPI) { if (wr == 0) PG8_BAR; }
    PG8_BAR;
#undef PG8_SA
#undef PG8_SB
#undef PG8_STAGE
#undef PG8_LDA
#undef PG8_LDB
#undef PG8_MMA
#undef PG8_WAIT_V
#undef PG8_WAIT_L
#undef PG8_BAR
#undef PG8_SCHED
}

typedef const f32x4 (&AccRef)[2][2][4][2];
__device__ __forceinline__ u32x4 pack8(f32x4 v0, f32x4 v1) { u32x4 w; w.x = cvt_pk_bf16(v0[0], v0[1]); w.y = cvt_pk_bf16(v0[2], v0[3]); w.z = cvt_pk_bf16(v1[0], v1[1]); w.w = cvt_pk_bf16(v1[2], v1[3]); return w; }

struct EpiProj { static constexpr bool PERM = true;
    bf16_t* proj; bf16_t* gates; const float* b_gate;
    __device__ __forceinline__ void operator()(AccRef acc, const Unit& u, int wr, int wc, int fr, int fq) const {
        const int row0 = u.pm * BM + wr * 64 + fr;
        if (u.pn < 9) {
            const int col0 = u.pn * BM + wc * 64 + 16 * fq;
#pragma unroll
            for (int ai = 0; ai < 2; ++ai)
#pragma unroll
                for (int m = 0; m < 4; ++m) { bf16_t* rowp = proj + (size_t)(row0 + ai * HALF + m * 16) * NPROJ + col0;
#pragma unroll
                    for (int bj = 0; bj < 2; ++bj) *(u32x4*)(rowp + bj * 8) = pack8(acc[ai][bj][m][0], acc[ai][bj][m][1]); }
        } else {
            const int col0 = (u.pn - 9) * BM + wc * 64 + 16 * fq;
            f32x4 bv[2][2];
#pragma unroll
            for (int bj = 0; bj < 2; ++bj)
#pragma unroll
                for (int n = 0; n < 2; ++n) bv[bj][n] = *(const f32x4*)(b_gate + col0 + bj * 8 + 4 * n);
#pragma unroll
            for (int ai = 0; ai < 2; ++ai)
#pragma unroll
                for (int m = 0; m < 4; ++m) { bf16_t* rowp = gates + (size_t)(row0 + ai * HALF + m * 16) * NGATE + col0;
#pragma unroll
                    for (int bj = 0; bj < 2; ++bj) { f32x4 v0 = acc[ai][bj][m][0] + bv[bj][0], v1 = acc[ai][bj][m][1] + bv[bj][1];
#pragma unroll
                        for (int j = 0; j < 4; ++j) { v0[j] = fast_sigmoid(v0[j]); v1[j] = fast_sigmoid(v1[j]); }
                        u32x4 w; w.x = cvt_pk_bf16_t(v0[0], v0[1]); w.y = cvt_pk_bf16_t(v0[2], v0[3]); w.z = cvt_pk_bf16_t(v1[0], v1[1]); w.w = cvt_pk_bf16_t(v1[2], v1[3]);
                        *(u32x4*)(rowp + bj * 8) = w; } }
        }
    }
};
template <bool BIAS> struct EpiBf16 { static constexpr bool PERM = true;
    bf16_t* O; int ldc; const float* bias; const int* tile_e; int bstride; float scl;
    __device__ __forceinline__ void operator()(AccRef acc, const Unit& u, int wr, int wc, int fr, int fq) const {
        const int row0 = u.pm * BM + wr * 64 + fr, col0 = u.pn * BM + wc * 64 + 16 * fq;
        f32x4 bv[2][2];
#pragma unroll
        for (int bj = 0; bj < 2; ++bj)
#pragma unroll
            for (int n = 0; n < 2; ++n) bv[bj][n] = (f32x4){0.f, 0.f, 0.f, 0.f};
        if constexpr (BIAS) { const float* bp = bias + (size_t)tile_e[u.pm] * bstride + col0;
#pragma unroll
            for (int bj = 0; bj < 2; ++bj)
#pragma unroll
                for (int n = 0; n < 2; ++n) bv[bj][n] = *(const f32x4*)(bp + bj * 8 + 4 * n); }
#pragma unroll
        for (int ai = 0; ai < 2; ++ai)
#pragma unroll
            for (int m = 0; m < 4; ++m) { bf16_t* rowp = O + (size_t)(row0 + ai * HALF + m * 16) * ldc + col0;
#pragma unroll
                for (int bj = 0; bj < 2; ++bj) *(u32x4*)(rowp + bj * 8) = pack8((acc[ai][bj][m][0] + bv[bj][0]) * scl, (acc[ai][bj][m][1] + bv[bj][1]) * scl); }
    }
};
struct EpiKV { static constexpr bool PERM = true;
    bf16_t* kmla; bf16_t* vmla;
    __device__ __forceinline__ void operator()(AccRef acc, const Unit& u, int wr, int wc, int fr, int fq) const {
        const int row0 = u.pm * BM + wr * 64 + fr, c0 = wc * 32 + 8 * fq;
#pragma unroll
        for (int ai = 0; ai < 2; ++ai)
#pragma unroll
            for (int m = 0; m < 4; ++m) { const size_t row = (size_t)(row0 + ai * HALF + m * 16);
                const size_t hrow = ((row >> 11) * 8 + u.pn) * 2048 + (row & 2047);
                *(u32x4*)(kmla + hrow * 192 + c0) = pack8(acc[ai][0][m][0], acc[ai][0][m][1]);
                *(u32x4*)(vmla + hrow * 128 + c0) = pack8(acc[ai][1][m][0], acc[ai][1][m][1]); }
    }
};
template <bool ADD> struct EpiGateMix { static constexpr bool PERM = true;
    bf16_t* O; const unsigned char* gates; int goff;
    __device__ __forceinline__ void operator()(AccRef acc, const Unit& u, int wr, int wc, int fr, int fq) const {
        const int row0 = u.pm * BM + wr * 64 + fr, col0 = u.pn * BM + wc * 32 + 8 * fq;
        constexpr float I255 = 1.0f / 255.0f;
#pragma unroll
        for (int ai = 0; ai < 2; ++ai) {
            u32x2 gw[4][2]; u32x4 pw[4][2];
#pragma unroll
            for (int m = 0; m < 4; ++m)
#pragma unroll
                for (int bj = 0; bj < 2; ++bj) { const size_t row = (size_t)(row0 + ai * HALF + m * 16);
                    gw[m][bj] = *(const u32x2*)(gates + row * NGATE + goff + col0 + bj * HALF);
                    if constexpr (ADD) pw[m][bj] = *(const u32x4*)(O + row * DM + col0 + bj * HALF); }
            asm volatile("s_waitcnt vmcnt(0)" ::: "memory");
#pragma unroll
            for (int m = 0; m < 4; ++m)
#pragma unroll
                for (int bj = 0; bj < 2; ++bj) { const size_t row = (size_t)(row0 + ai * HALF + m * 16); const u32x2 g2 = gw[m][bj];
                    f32x4 v0 = acc[ai][bj][m][0], v1 = acc[ai][bj][m][1];
                    v0[0] *= (float)(g2.x & 0xffu) * I255; v0[1] *= (float)((g2.x >> 8) & 0xffu) * I255; v0[2] *= (float)((g2.x >> 16) & 0xffu) * I255; v0[3] *= (float)(g2.x >> 24) * I255;
                    v1[0] *= (float)(g2.y & 0xffu) * I255; v1[1] *= (float)((g2.y >> 8) & 0xffu) * I255; v1[2] *= (float)((g2.y >> 16) & 0xffu) * I255; v1[3] *= (float)(g2.y >> 24) * I255;
                    if constexpr (ADD) { const u32x4 p4 = pw[m][bj];
                        v0[0] += bf_lo(p4.x); v0[1] += bf_hi(p4.x); v0[2] += bf_lo(p4.y); v0[3] += bf_hi(p4.y);
                        v1[0] += bf_lo(p4.z); v1[1] += bf_hi(p4.z); v1[2] += bf_lo(p4.w); v1[3] += bf_hi(p4.w); }
                    *(u32x4*)(O + row * DM + col0 + bj * HALF) = pack8(v0, v1); }
            asm volatile("" ::: "memory");
        }
    }
};
struct EpiGateMerge { static constexpr bool PERM = true;
    unsigned char* O; const unsigned char* gates;
    template <bool FINAL, class AccT> __device__ __forceinline__ void scale(AccT& acc, const Unit& u, int wr, int wc, int fr, int fq) const {
        const int row0 = u.pm * BM + wr * 64 + fr, col0 = u.pn * BM + wc * 64 + 16 * fq;
#pragma unroll
        for (int ai = 0; ai < 2; ++ai) {
            u32x2 ga[4][2], gb[4][2];
#pragma unroll
            for (int m = 0; m < 4; ++m)
#pragma unroll
                for (int bj = 0; bj < 2; ++bj) { const size_t row = (size_t)(row0 + ai * HALF + m * 16);
                    if constexpr (!FINAL) ga[m][bj] = *(const u32x2*)(gates + row * NGATE + col0 + bj * 8);
                    gb[m][bj] = *(const u32x2*)(gates + row * NGATE + DM + col0 + bj * 8); }
            asm volatile("s_waitcnt vmcnt(0)" ::: "memory");
#pragma unroll
            for (int m = 0; m < 4; ++m)
#pragma unroll
                for (int bj = 0; bj < 2; ++bj) { const size_t row = (size_t)(row0 + ai * HALF + m * 16);
                    float f[8];
#pragma unroll
                    for (int j = 0; j < 8; ++j) { const unsigned wb = j < 4 ? gb[m][bj].x : gb[m][bj].y; const float b = fmaxf((float)((wb >> (8 * (j & 3))) & 0xffu), 1.0f);
                        if constexpr (FINAL) f[j] = b * (1.0f / 255.0f);
                        else { const unsigned wa = j < 4 ? ga[m][bj].x : ga[m][bj].y; f[j] = (float)((wa >> (8 * (j & 3))) & 0xffu) * __builtin_amdgcn_rcpf(b); } }
                    f32x4 v0 = acc[ai][bj][m][0], v1 = acc[ai][bj][m][1];
                    v0[0] *= f[0]; v0[1] *= f[1]; v0[2] *= f[2]; v0[3] *= f[3]; v1[0] *= f[4]; v1[1] *= f[5]; v1[2] *= f[6]; v1[3] *= f[7];
                    if constexpr (FINAL) { int w0 = __builtin_amdgcn_cvt_pk_fp8_f32(v0[0] * 16.0f, v0[1] * 16.0f, 0, false); w0 = __builtin_amdgcn_cvt_pk_fp8_f32(v0[2] * 16.0f, v0[3] * 16.0f, w0, true);
                        int w1 = __builtin_amdgcn_cvt_pk_fp8_f32(v1[0] * 16.0f, v1[1] * 16.0f, 0, false); w1 = __builtin_amdgcn_cvt_pk_fp8_f32(v1[2] * 16.0f, v1[3] * 16.0f, w1, true);
                        *(u32x2*)(O + row * DM + col0 + bj * 8) = (u32x2){(unsigned)w0, (unsigned)w1}; }
                    else { acc[ai][bj][m][0] = v0; acc[ai][bj][m][1] = v1; } }
            asm volatile("" ::: "memory");
        }
    }
    __device__ __forceinline__ void mid(f32x4 (&acc)[2][2][4][2], const Unit& u, int wr, int wc, int fr, int fq) const { scale<false>(acc, u, wr, wc, fr, fq); }
    __device__ __forceinline__ void operator()(AccRef acc, const Unit& u, int wr, int wc, int fr, int fq) const { scale<true>(acc, u, wr, wc, fr, fq); }
};
struct EpiResF32 { static constexpr bool PERM = false;
    const float* x; float* out;
    __device__ __forceinline__ void operator()(AccRef acc, const Unit& u, int wr, int wc, int fr, int fq) const {
        const int row0 = u.pm * BM + wr * 64 + fr, col0 = u.pn * BM + wc * 32 + 4 * fq;
#pragma unroll
        for (int ai = 0; ai < 2; ++ai) {
            f32x4 xv[4][2][2];
#pragma unroll
            for (int m = 0; m < 4; ++m) { const size_t off = (size_t)(row0 + ai * HALF + m * 16) * DM + col0;
#pragma unroll
                for (int bj = 0; bj < 2; ++bj)
#pragma unroll
                    for (int n = 0; n < 2; ++n) xv[m][bj][n] = *(const f32x4*)(x + off + bj * HALF + n * 16); }
            asm volatile("s_waitcnt vmcnt(0)" ::: "memory");
#pragma unroll
            for (int m = 0; m < 4; ++m) { const size_t off = (size_t)(row0 + ai * HALF + m * 16) * DM + col0;
#pragma unroll
                for (int bj = 0; bj < 2; ++bj)
#pragma unroll
                    for (int n = 0; n < 2; ++n) *(f32x4*)(out + off + bj * HALF + n * 16) = xv[m][bj][n] + acc[ai][bj][m][n]; }
            asm volatile("" ::: "memory");
        }
    }
};
struct EpiResBf16 { static constexpr bool PERM = true;
    const float* x; bf16_t* out;
    __device__ __forceinline__ void operator()(AccRef acc, const Unit& u, int wr, int wc, int fr, int fq) const {
        const int row0 = u.pm * BM + wr * 64 + fr, col0 = u.pn * BM + wc * 64 + 16 * fq;
#pragma unroll
        for (int ai = 0; ai < 2; ++ai) {
            f32x4 xv[4][2][2];
#pragma unroll
            for (int m = 0; m < 4; ++m) { const size_t off = (size_t)(row0 + ai * HALF + m * 16) * DM + col0;
#pragma unroll
                for (int bj = 0; bj < 2; ++bj)
#pragma unroll
                    for (int n = 0; n < 2; ++n) xv[m][bj][n] = *(const f32x4*)(x + off + bj * 8 + n * 4); }
            asm volatile("s_waitcnt vmcnt(0)" ::: "memory");
#pragma unroll
            for (int m = 0; m < 4; ++m) { const size_t off = (size_t)(row0 + ai * HALF + m * 16) * DM + col0;
#pragma unroll
                for (int bj = 0; bj < 2; ++bj) *(u32x4*)(out + off + bj * 8) = pack8(xv[m][bj][0] + acc[ai][bj][m][0], xv[m][bj][1] + acc[ai][bj][m][1]); }
            asm volatile("" ::: "memory");
        }
    }
};
struct EpiSwiglu { static constexpr bool PERM = true;
    bf16_t* act; const float* bgu; const int* tile_e;
    __device__ __forceinline__ void operator()(AccRef acc, const Unit& u, int wr, int wc, int fr, int fq) const {
        const int row0 = u.pm * BM + wr * 64 + fr, p0 = u.pn * BM + wc * 32 + 8 * fq;
        const float* bp = bgu + (size_t)tile_e[u.pm] * (2 * DM) + p0;
        f32x4 bg[2], bu[2];
#pragma unroll
        for (int bj = 0; bj < 2; ++bj) { const f32x4 a = *(const f32x4*)(bp + bj * HALF), b = *(const f32x4*)(bp + bj * HALF + 4);
            bg[bj] = (f32x4){a[0], a[2], b[0], b[2]}; bu[bj] = (f32x4){a[1], a[3], b[1], b[3]}; }
#pragma unroll
        for (int ai = 0; ai < 2; ++ai)
#pragma unroll
            for (int m = 0; m < 4; ++m) { bf16_t* rowp = act + (size_t)(row0 + ai * HALF + m * 16) * DM + (p0 >> 1);
#pragma unroll
                for (int bj = 0; bj < 2; ++bj) { const f32x4 gt = acc[ai][bj][m][0] + bg[bj], up = acc[ai][bj][m][1] + bu[bj]; float o[4];
#pragma unroll
                    for (int j = 0; j < 4; ++j) { const float gg = fminf(gt[j], 7.0f), uu = fminf(fmaxf(up[j], -7.0f), 7.0f); o[j] = gg * fast_sigmoid(1.702f * gg) * (uu + 1.0f); }
                    u32x2 w; w.x = cvt_pk_bf16(o[0], o[1]); w.y = cvt_pk_bf16(o[2], o[3]);
                    *(u32x2*)(rowp + bj * (HALF / 2)) = w; } }
    }
};

typedef int v8i32 __attribute__((ext_vector_type(8)));
__host__ __device__ __forceinline__ int sw8(int row) { return ((row >> 1) & 7) ^ ((((row >> 2) ^ (row >> 3)) & 1) << 1); }
__host__ __device__ __forceinline__ int img8(int row, int c) { return row * 128 + ((c ^ sw8(row)) << 4); }
struct Gemm8 { const unsigned char* A; const unsigned char* Bt; int lda, K; const int* tile_e; size_t estride; const int* rowtok; };
typedef const f32x4 (&AccRef8)[2][2][4][2];
template <class Epi, bool MIDHOOK = false>
__device__ __forceinline__ void gemm_phase_f8(LAS unsigned char* lds, const Gemm8 g, const StaticOrder& S, const Epi& E) {
    int tid = threadIdx.x; asm volatile("" : "+v"(tid));
    const int wid = __builtin_amdgcn_readfirstlane(tid >> 6), lane = tid & 63, wr = wid >> 2, wc = wid & 3, r15 = lane & 15, kq = lane >> 4;
    int K = g.K; asm volatile("" : "+s"(K));
    const int nt = K / 128, lda = g.lda;
    unsigned voffB[2];
#pragma unroll
    for (int i = 0; i < 2; ++i) voffB[i] = (unsigned)(tid * 16 + i * 8192);
    const size_t kstep = 128;
    const size_t kstepB = 32768, hstepB = 16384, tstepB = (size_t)nt * 32768;
    const unsigned ldsw = (unsigned)wid * 1024u;
    const int sw = sw8(r15);
    int aadr[2], badr[2];
#pragma unroll
    for (int x = 0; x < 2; ++x) { const int c = 2 * kq + x; aadr[x] = (wr * 64 + r15) * 128 + ((c ^ sw) << 4); badr[x] = (wc * 32 + r15) * 128 + ((c ^ sw) << 4); }
#define PF8_SA(b, h) (((b) * 2 + (h)) * HTB)
#define PF8_SB(b, h) ((4 + (b) * 2 + (h)) * HTB)
#define PF8_STAGE(bufoff, gbase, voff) do { _Pragma("unroll") for (int _i = 0; _i < 2; ++_i) \
        __builtin_amdgcn_global_load_lds((const unsigned*)((const char*)(gbase) + (voff)[_i]), (LAS unsigned*)(lds + (bufoff) + ldsw + _i * 8192), 16, 0, 0); } while (0)
#define PF8_LD(dst, off) do { const u32x4 _a = *(const LAS u32x4*)(lds + (off)[0]), _b = *(const LAS u32x4*)(lds + (off)[1]); \
        dst = (v8i32){(int)_a.x, (int)_a.y, (int)_a.z, (int)_a.w, (int)_b.x, (int)_b.y, (int)_b.z, (int)_b.w}; } while (0)
#define PF8_LDA(dst, b, h) do { _Pragma("unroll") for (int tb = 0; tb < 4; ++tb) { const int _o[2] = {PF8_SA(b, h) + aadr[0] + tb * 2048, PF8_SA(b, h) + aadr[1] + tb * 2048}; PF8_LD(dst[tb], _o); } } while (0)
#define PF8_LDB(dst, b, h) do { _Pragma("unroll") for (int pb = 0; pb < 2; ++pb) { const int _o[2] = {PF8_SB(b, h) + badr[0] + pb * 2048, PF8_SB(b, h) + badr[1] + pb * 2048}; PF8_LD(dst[pb], _o); } } while (0)
#define PF8_MMA(ai, bj, At, Bt) do { __builtin_amdgcn_s_setprio(1); _Pragma("unroll") for (int tb = 0; tb < 4; ++tb) _Pragma("unroll") for (int pb = 0; pb < 2; ++pb) \
        acc[ai][bj][tb][pb] = __builtin_amdgcn_mfma_scale_f32_16x16x128_f8f6f4(Bt[pb], At[tb], acc[ai][bj][tb][pb], 0, 0, 0, 0, 0, 0); __builtin_amdgcn_s_setprio(0); } while (0)
#define PF8_WAIT_V(n) asm volatile("s_waitcnt vmcnt(" #n ")" ::: "memory")
#define PF8_WAIT_L(n) asm volatile("s_waitcnt lgkmcnt(" #n ")" ::: "memory")
#define PF8_BAR __builtin_amdgcn_s_barrier()
#define PF8_SCHED __builtin_amdgcn_sched_barrier(0)
#define PF8_AOFF(vo, u) do { int _t = tid; asm volatile("" : "+v"(_t)); \
        _Pragma("unroll") for (int _i = 0; _i < 2; ++_i) { const int _p = _t + 512 * _i, _R = _p >> 3, _C = ((_p & 7) ^ sw8(_R)) << 4; \
        _Pragma("unroll") for (int _h = 0; _h < 2; ++_h) { const int _r = (u).pm * BM + _h * HALF + _R; (vo)[_h][_i] = (unsigned)(g.rowtok[_r] * lda + _C); } } } while (0)
    Unit cur, nxt; int ui = 0;
    LAS int* const te_l = (LAS int*)(lds + STAGE_BYTES + 2048);
    if (g.tile_e) { for (int i = tid; i < S.nM; i += NTHREADS) te_l[i] = g.tile_e[i]; }
    __syncthreads();
    if (!S.next(0, cur)) return;
    f32x4 acc[2][2][4][2];
#pragma unroll
    for (int a = 0; a < 2; ++a)
#pragma unroll
        for (int b = 0; b < 2; ++b)
#pragma unroll
            for (int m = 0; m < 4; ++m)
#pragma unroll
                for (int r = 0; r < 2; ++r) acc[a][b][m][r] = (f32x4){0.f, 0.f, 0.f, 0.f};
    v8i32 At[4], B0[2], B1[2];
    unsigned voC[2][2];
    LAS u32x4* const gslot = (LAS u32x4*)(lds + STAGE_BYTES) + tid;
    PF8_AOFF(voC, cur);
    const char* const Abase = (const char*)g.A;
    const char* cB = (const char*)g.Bt + (g.tile_e ? (size_t)g.tile_e[cur.pm] * g.estride : (size_t)0) + (size_t)cur.pn * tstepB;
    PF8_STAGE(PF8_SB(0, 0), cB, voffB); PF8_STAGE(PF8_SB(0, 1), cB + hstepB, voffB); PF8_STAGE(PF8_SA(0, 0), Abase, voC[0]); PF8_STAGE(PF8_SA(0, 1), Abase, voC[1]);
    if (wr == 1) PF8_BAR;
    PF8_WAIT_V(2); PF8_BAR;
    PF8_STAGE(PF8_SB(1, 0), cB + kstepB, voffB); PF8_STAGE(PF8_SA(1, 0), Abase + kstep, voC[0]); PF8_STAGE(PF8_SB(1, 1), cB + hstepB + kstepB, voffB);
    PF8_WAIT_V(6); PF8_BAR;
    for (;;) {
        const bool has_next = S.next(ui + 1, nxt);
        const char* nB = cB;
        if (has_next) { const int npm = __builtin_amdgcn_readfirstlane(nxt.pm);
            nB = (const char*)g.Bt + (g.tile_e ? (size_t)te_l[npm] * g.estride : (size_t)0) + (size_t)nxt.pn * tstepB;
            if (wid == 0) glds16_asm((const char*)(g.rowtok + (size_t)npm * BM), (unsigned)(lane * 16), (unsigned)(size_t)(lds + STAGE_BYTES + ((ui + 1) & 1) * 1024)); }
#pragma unroll 1
        for (int t = 0; t < nt; t += 2) {
            const bool last = (t == nt - 2);
            if constexpr (MIDHOOK) { if (t == nt / 2) { int ln_ = lane; asm volatile("" : "+v"(ln_)); E.mid(acc, cur, wr, wc, ln_ & 15, ln_ >> 4); } }
            const char* a1 = Abase + (size_t)(t + 1) * kstep;
            const char* a2 = last ? Abase : Abase + (size_t)(t + 2) * kstep; const char* b2 = last ? nB : cB + (size_t)(t + 2) * kstepB;
            const char* a3 = a2 + kstep; const char* b3 = b2 + kstepB;
            PF8_LDB(B0, 0, 0); PF8_LDB(B1, 0, 1); PF8_SCHED; PF8_LDA(At, 0, 0); PF8_STAGE(PF8_SA(1, 1), a1, voC[1]);
            if (last && has_next) { const LAS int* rt = (const LAS int*)(lds + STAGE_BYTES + ((ui + 1) & 1) * 1024); PF8_AOFF_LDS(voC, rt); }
            PF8_WAIT_V(8); PF8_WAIT_L(0); PF8_BAR; PF8_MMA(0, 0, At, B0); PF8_MMA(0, 1, At, B1); PF8_BAR; PF8_SCHED;
            PF8_LDA(At, 0, 1); PF8_STAGE(PF8_SB(0, 0), b2, voffB); PF8_STAGE(PF8_SB(0, 1), b2 + hstepB, voffB); PF8_STAGE(PF8_SA(0, 0), a2, voC[0]);
            PF8_WAIT_V(8); PF8_WAIT_L(0); PF8_BAR; PF8_MMA(1, 0, At, B0); PF8_MMA(1, 1, At, B1); PF8_BAR; PF8_SCHED;
            PF8_LDB(B0, 1, 0); PF8_LDB(B1, 1, 1); PF8_SCHED; PF8_LDA(At, 1, 0); PF8_STAGE(PF8_SA(0, 1), a2, voC[1]);
            PF8_WAIT_V(8); PF8_WAIT_L(0); PF8_BAR; PF8_MMA(0, 0, At, B0); PF8_MMA(0, 1, At, B1); PF8_BAR; PF8_SCHED;
            PF8_LDA(At, 1, 1); PF8_STAGE(PF8_SB(1, 0), b3, voffB); PF8_STAGE(PF8_SB(1, 1), b3 + hstepB, voffB); PF8_STAGE(PF8_SA(1, 0), a3, voC[0]);
            PF8_WAIT_V(8); PF8_WAIT_L(0); PF8_BAR; PF8_MMA(1, 0, At, B0); PF8_MMA(1, 1, At, B1); PF8_BAR; PF8_SCHED;
        }
        if (wr == 0) PF8_BAR;
        { int ln_ = lane; asm volatile("" : "+v"(ln_)); E(acc, cur, wr, wc, ln_ & 15, ln_ >> 4); }
        if (!has_next) break;
#pragma unroll
        for (int a = 0; a < 2; ++a)
#pragma unroll
            for (int b = 0; b < 2; ++b)
#pragma unroll
                for (int m = 0; m < 4; ++m)
#pragma unroll
                    for (int r = 0; r < 2; ++r) acc[a][b][m][r] = (f32x4){0.f, 0.f, 0.f, 0.f};
        cur = nxt; cB = nB; ++ui;
        if (wr == 1) PF8_BAR;
    }
    PF8_WAIT_V(0);
    PF8_BAR;
#undef PF8_SA
#undef PF8_SB
#undef PF8_STAGE
#undef PF8_LD
#undef PF8_LDA
#undef PF8_LDB
#undef PF8_MMA
#undef PF8_WAIT_V
#undef PF8_WAIT_L
#undef PF8_BAR
#undef PF8_SCHED
#undef PF8_AOFF
}
struct EpiSwiglu8 {
    unsigned char* act; const float* bgu; const int* tile_e;
    __device__ __forceinline__ void operator()(AccRef8 acc, const Unit& u, int wr, int wc, int t15, int q) const {
        const int row0 = u.pm * BM + wr * 64 + t15;
        const float* bp = bgu + (size_t)tile_e[u.pm] * (2 * DM);
        const int ja = u.pn * 128 + 32 * wc + 8 * q;
        const f32x4 b0 = *(const f32x4*)(bp + 2 * ja), b1 = *(const f32x4*)(bp + 2 * ja + 4), b2 = *(const f32x4*)(bp + 2 * ja + 8), b3 = *(const f32x4*)(bp + 2 * ja + 12);
        const float bg[8] = {b0[0], b0[2], b1[0], b1[2], b2[0], b2[2], b3[0], b3[2]}, bu[8] = {b0[1], b0[3], b1[1], b1[3], b2[1], b2[3], b3[1], b3[3]};
#pragma unroll
        for (int ai = 0; ai < 2; ++ai)
#pragma unroll
            for (int tb = 0; tb < 4; ++tb) { float o[8];
#pragma unroll
                for (int bj = 0; bj < 2; ++bj)
#pragma unroll
                    for (int j = 0; j < 4; j += 2) {
                        typedef float f32x2_ __attribute__((ext_vector_type(2)));
                        const f32x2_ a0 = {acc[ai][bj][tb][0][j], acc[ai][bj][tb][0][j + 1]}, a1 = {acc[ai][bj][tb][1][j], acc[ai][bj][tb][1][j + 1]};
                        const f32x2_ bg2 = {bg[4 * bj + j], bg[4 * bj + j + 1]}, bu2 = {bu[4 * bj + j], bu[4 * bj + j + 1]};
                        f32x2_ gt = a0 * 0.015625f + bg2, up = a1 * 0.015625f + bu2;
                        gt[0] = fminf(gt[0], 7.0f); gt[1] = fminf(gt[1], 7.0f); up[0] = fminf(fmaxf(up[0], -7.0f), 7.0f); up[1] = fminf(fmaxf(up[1], -7.0f), 7.0f);
                        f32x2_ e = gt * (-1.702f * 1.4426950408889634f); e[0] = __builtin_amdgcn_exp2f(e[0]); e[1] = __builtin_amdgcn_exp2f(e[1]);
                        f32x2_ d = e + 1.0f; d[0] = __builtin_amdgcn_rcpf(d[0]); d[1] = __builtin_amdgcn_rcpf(d[1]);
                        const f32x2_ r = gt * d * (up + 1.0f); o[4 * bj + j] = r[0]; o[4 * bj + j + 1] = r[1]; }
                int w0 = __builtin_amdgcn_cvt_pk_fp8_f32(o[0], o[1], 0, false); w0 = __builtin_amdgcn_cvt_pk_fp8_f32(o[2], o[3], w0, true);
                int w1 = __builtin_amdgcn_cvt_pk_fp8_f32(o[4], o[5], 0, false); w1 = __builtin_amdgcn_cvt_pk_fp8_f32(o[6], o[7], w1, true);
                *(u32x2*)(act + (size_t)(row0 + ai * HALF + tb * 16) * DM + ja) = (u32x2){(unsigned)w0, (unsigned)w1}; }
    }
};
struct EpiDown8 {
    unsigned char* y; const float* bd; const int* tile_e;
    __device__ __forceinline__ void operator()(AccRef8 acc, const Unit& u, int wr, int wc, int t15, int q) const {
        const int row0 = u.pm * BM + wr * 64 + t15;
        const float* bp = bd + (size_t)tile_e[u.pm] * DM;
        const int c0 = u.pn * BM + 64 * wc + 16 * q;
        f32x4 bb[2][2];
#pragma unroll
        for (int bj = 0; bj < 2; ++bj)
#pragma unroll
            for (int pb = 0; pb < 2; ++pb) bb[bj][pb] = *(const f32x4*)(bp + c0 + 8 * bj + 4 * pb);
#pragma unroll
        for (int ai = 0; ai < 2; ++ai)
#pragma unroll
            for (int tb = 0; tb < 4; ++tb) { int w4[4];
#pragma unroll
                for (int bj = 0; bj < 2; ++bj)
#pragma unroll
                    for (int pb = 0; pb < 2; ++pb) { const f32x4 o = acc[ai][bj][tb][pb] * 0.015625f + bb[bj][pb];
                        const int x = __builtin_amdgcn_cvt_pk_fp8_f32(o[0], o[1], 0, false); w4[2 * bj + pb] = __builtin_amdgcn_cvt_pk_fp8_f32(o[2], o[3], x, true); }
                *(u32x4*)(y + (size_t)(row0 + ai * HALF + tb * 16) * DM + c0) = (u32x4){(unsigned)w4[0], (unsigned)w4[1], (unsigned)w4[2], (unsigned)w4[3]}; }
    }
};
struct EpiGateMerge8 {
    unsigned char* O; const unsigned char* gates;
    template <bool FINAL, class AccT> __device__ __forceinline__ void scale(AccT& acc, const Unit& u, int wr, int wc, int t15, int q) const {
        const int row0 = u.pm * BM + wr * 64 + t15, c0 = u.pn * BM + 64 * wc + 16 * q;
#pragma unroll
        for (int ai = 0; ai < 2; ++ai) {
            u32x4 ga[4], gb[4];
#pragma unroll
            for (int tb = 0; tb < 4; ++tb) { const size_t row = (size_t)(row0 + ai * HALF + tb * 16);
                if constexpr (!FINAL) ga[tb] = *(const u32x4*)(gates + row * NGATE + c0);
                gb[tb] = *(const u32x4*)(gates + row * NGATE + DM + c0); }
            asm volatile("s_waitcnt vmcnt(0)" ::: "memory");
#pragma unroll
            for (int tb = 0; tb < 4; ++tb) { const size_t row = (size_t)(row0 + ai * HALF + tb * 16); int w4[4];
#pragma unroll
                for (int bj = 0; bj < 2; ++bj)
#pragma unroll
                    for (int pb = 0; pb < 2; ++pb) { const unsigned wb = gb[tb][2 * bj + pb]; f32x4 v = acc[ai][bj][tb][pb];
#pragma unroll
                        for (int j = 0; j < 4; ++j) { const float b = fmaxf((float)((wb >> (8 * j)) & 0xffu), 1.0f);
                            if constexpr (FINAL) v[j] *= b * (1.0f / (255.0f * 64.0f));
                            else { const unsigned wa = ga[tb][2 * bj + pb]; v[j] *= (float)((wa >> (8 * j)) & 0xffu) * __builtin_amdgcn_rcpf(b); } }
                        if constexpr (FINAL) { const int x = __builtin_amdgcn_cvt_pk_fp8_f32(v[0], v[1], 0, false); w4[2 * bj + pb] = __builtin_amdgcn_cvt_pk_fp8_f32(v[2], v[3], x, true); }
                        else acc[ai][bj][tb][pb] = v; }
                if constexpr (FINAL) *(u32x4*)(O + row * DM + c0) = (u32x4){(unsigned)w4[0], (unsigned)w4[1], (unsigned)w4[2], (unsigned)w4[3]}; }
            asm volatile("" ::: "memory");
        }
    }
    __device__ __forceinline__ void mid(f32x4 (&acc)[2][2][4][2], const Unit& u, int wr, int wc, int t15, int q) const { scale<false>(acc, u, wr, wc, t15, q); }
    __device__ __forceinline__ void operator()(AccRef8 acc, const Unit& u, int wr, int wc, int t15, int q) const { scale<true>(acc, u, wr, wc, t15, q); }
};
struct EpiProj8 {
    bf16_t* proj; float* ssqp;
    __device__ __forceinline__ void operator()(AccRef8 acc, const Unit& u, int wr, int wc, int t15, int q) const {
        const int row0 = u.pm * BM + wr * 64 + t15, c0 = u.pn * BM + 64 * wc + 16 * q;
        const bool lat = (u.pn >= 5) && (u.pn <= 7);
#pragma unroll
        for (int ai = 0; ai < 2; ++ai)
#pragma unroll
            for (int tb = 0; tb < 4; ++tb) { const size_t row = (size_t)(row0 + ai * HALF + tb * 16); bf16_t* rowp = proj + row * NPROJ + c0;
#pragma unroll
                for (int bj = 0; bj < 2; ++bj) *(u32x4*)(rowp + 8 * bj) = pack8(acc[ai][bj][tb][0] * 0.015625f, acc[ai][bj][tb][1] * 0.015625f);
                if (lat) { f32x4 sq = {0.f, 0.f, 0.f, 0.f};
#pragma unroll
                    for (int bj = 0; bj < 2; ++bj)
#pragma unroll
                        for (int pb = 0; pb < 2; ++pb) { const f32x4 v = acc[ai][bj][tb][pb] * 0.015625f; sq += v * v; }
                    float ss = (sq[0] + sq[1]) + (sq[2] + sq[3]);
                    ss += __shfl_xor(ss, 16); ss += __shfl_xor(ss, 32);
                    if (q == 0) ssqp[row * 12 + 4 * (u.pn - 5) + wc] = ss; } }
    }
};
struct EpiRes8 {
    const float* x; bf16_t* out; float* ssqh;
    __device__ __forceinline__ void operator()(AccRef8 acc, const Unit& u, int wr, int wc, int t15, int q) const {
        const int row0 = u.pm * BM + wr * 64 + t15, c0 = u.pn * BM + 64 * wc + 16 * q;
#pragma unroll
        for (int ai = 0; ai < 2; ++ai) {
            f32x4 xv[4][2][2];
#pragma unroll
            for (int tb = 0; tb < 4; ++tb) { const size_t off = (size_t)(row0 + ai * HALF + tb * 16) * DM + c0;
#pragma unroll
                for (int bj = 0; bj < 2; ++bj)
#pragma unroll
                    for (int pb = 0; pb < 2; ++pb) xv[tb][bj][pb] = *(const f32x4*)(x + off + 8 * bj + 4 * pb); }
            asm volatile("s_waitcnt vmcnt(0)" ::: "memory");
#pragma unroll
            for (int tb = 0; tb < 4; ++tb) { const size_t row = (size_t)(row0 + ai * HALF + tb * 16), off = row * DM + c0; f32x4 sq = {0.f, 0.f, 0.f, 0.f};
#pragma unroll
                for (int bj = 0; bj < 2; ++bj) { const f32x4 h0 = xv[tb][bj][0] + acc[ai][bj][tb][0] * (1.0f / 1024.0f), h1 = xv[tb][bj][1] + acc[ai][bj][tb][1] * (1.0f / 1024.0f);
                    *(u32x4*)(out + off + 8 * bj) = pack8(h0, h1); sq += h0 * h0 + h1 * h1; }
                float ss = (sq[0] + sq[1]) + (sq[2] + sq[3]); ss += __shfl_xor(ss, 16); ss += __shfl_xor(ss, 32);
                if (q == 0) ssqh[row * 32 + 4 * u.pn + wc] = ss; }
            asm volatile("" ::: "memory");
        }
    }
};
struct EpiGates8 {
    unsigned char* gates; const float* b_gate;
    __device__ __forceinline__ void operator()(AccRef8 acc, const Unit& u, int wr, int wc, int t15, int q) const {
        const int row0 = u.pm * BM + wr * 64 + t15;
        const int c0 = u.pn * BM + 64 * wc + 16 * q;
        f32x4 bb[2][2];
#pragma unroll
        for (int bj = 0; bj < 2; ++bj)
#pragma unroll
            for (int pb = 0; pb < 2; ++pb) bb[bj][pb] = *(const f32x4*)(b_gate + c0 + 8 * bj + 4 * pb);
#pragma unroll
        for (int ai = 0; ai < 2; ++ai)
#pragma unroll
            for (int tb = 0; tb < 4; ++tb) { unsigned qq[4];
#pragma unroll
                for (int bj = 0; bj < 2; ++bj)
#pragma unroll
                    for (int pb = 0; pb < 2; ++pb) { float o[4];
#pragma unroll
                        for (int j = 0; j < 4; j += 2) {
                            typedef float f32x2_ __attribute__((ext_vector_type(2)));
                            const f32x2_ a = {acc[ai][bj][tb][pb][j], acc[ai][bj][tb][pb][j + 1]}, b2 = {bb[bj][pb][j], bb[bj][pb][j + 1]};
                            f32x2_ e = (a * 0.015625f + b2) * -1.4426950408889634f; e[0] = __builtin_amdgcn_exp2f(e[0]); e[1] = __builtin_amdgcn_exp2f(e[1]);
                            f32x2_ d = e + 1.0f; d[0] = __builtin_amdgcn_rcpf(d[0]); d[1] = __builtin_amdgcn_rcpf(d[1]);
                            const f32x2_ r = d * 255.0f + 0.5f; o[j] = r[0]; o[j + 1] = r[1]; }
                        qq[2 * bj + pb] = (unsigned)o[0] | ((unsigned)o[1] << 8) | ((unsigned)o[2] << 16) | ((unsigned)o[3] << 24); }
                *(u32x4*)(gates + (size_t)(row0 + ai * HALF + tb * 16) * NGATE + c0) = (u32x4){qq[0], qq[1], qq[2], qq[3]}; }
    }
};
}

struct Args { const void* in[21]; float* out; unsigned char* ws; int ph_lo, ph_hi; };

struct Frame {
    LAS unsigned char* lds; unsigned char* ws; unsigned* ctl;
    int tid, lane, wave, G, bx;
    const float *x, *g_attn, *w_in, *b_gate, *sinks, *g_q, *w_uq, *g_kv, *w_ukv, *w_o_swa, *w_o_mla, *w_out, *g_ffn, *w_router, *b_router, *w_gate_up, *b_gate_up, *w_down, *b_down, *g_final;
    const int* positions; float* out;
};

template <int MODE> __device__ __forceinline__ int rowmap(int n) {
    if (MODE == 1) return n < NLOW ? n : n + (NPROJ - NLOW);
    if (MODE == 2) { const int j = n >> 1, t = n & 1; return 8 * (j >> 2) + 4 * t + (j & 3); }
    return n;
}
__device__ __forceinline__ int perm32_inv(int x) { return 16 * ((x >> 2) & 1) + 4 * (x >> 3) + (x & 3); }
__host__ __device__ __forceinline__ int wide_map(int c) { return 128 * ((c >> 3) & 1) + 32 * (c >> 6) + 8 * ((c >> 4) & 3) + (c & 7); }
template <int MODE, bool PERM, bool WIDE = false> __device__ __forceinline__ void p0_convert_item(const float* W, int K, int N, bf16_t* WB, int item, int lane, int ldw = 0, int nkt_img = 0, int kt_off = 0, const float* kgain = nullptr) {
    if (ldw == 0) ldw = N;
    const int nblk = (N + 255) / 256, kb = item / nblk, nb = item % nblk, k0 = 32 * kb, n = 256 * nb + 4 * lane;
    if (n >= N) return;
    const f32x4* src = (const f32x4*)(W + (size_t)k0 * ldw + n);
    f32x4 v[32];
#pragma unroll
    for (int r = 0; r < 32; ++r) v[r] = src[(size_t)r * (ldw / 4)];
    if (kgain) {
#pragma unroll
        for (int r = 0; r < 32; ++r) v[r] = v[r] * kgain[k0 + r]; }
    const int nkt = nkt_img ? nkt_img : K / 64;
#pragma unroll
    for (int cmp = 0; cmp < 4; ++cmp) {
        const int p0_ = rowmap<MODE>(n + cmp), p = WIDE ? (p0_ & ~255) + wide_map(p0_ & 255) : p0_, q = p & 127, R = PERM ? ((q & ~31) + perm32_inv(q & 31)) : q;
        char* tile = (char*)WB + ((size_t)(p >> 8) * nkt + kt_off + (kb >> 1)) * 32768 + ((p >> 7) & 1) * 16384;
#pragma unroll
        for (int g8 = 0; g8 < 4; ++g8) { u32x4 o;
            o.x = cvt_pk_bf16(v[8 * g8 + 0][cmp], v[8 * g8 + 1][cmp]); o.y = cvt_pk_bf16(v[8 * g8 + 2][cmp], v[8 * g8 + 3][cmp]);
            o.z = cvt_pk_bf16(v[8 * g8 + 4][cmp], v[8 * g8 + 5][cmp]); o.w = cvt_pk_bf16(v[8 * g8 + 6][cmp], v[8 * g8 + 7][cmp]);
            *(u32x4*)(tile + pg8::lds_byte(R, 32 * (kb & 1) + 8 * g8)) = o; }
    }
}
template <bool GU> __device__ __forceinline__ void p0_convert_item_f8(const float* W, int K, int N, unsigned char* WB, int item, int lane, int ldw = 0, int nkt_img = 0, int kt_off = 0) {
    if (ldw == 0) ldw = N;
    const int nblk = (N + 255) / 256, kb = item / nblk, nb = item % nblk, k0 = 32 * kb, n = 256 * nb + 4 * lane;
    if (n >= N) return;
    const f32x4* src = (const f32x4*)(W + (size_t)k0 * ldw + n);
    f32x4 v[32];
#pragma unroll
    for (int r = 0; r < 32; ++r) v[r] = src[(size_t)r * (ldw / 4)];
    const int nkt = nkt_img ? nkt_img : K / 128, kt = kt_off + (k0 >> 7), c0 = (k0 & 127) >> 4;
#pragma unroll
    for (int cmp = 0; cmp < 4; ++cmp) {
        const int nl = n + cmp, j = (nl & 255) >> 1, t = nl & 1;
        const int P = (nl & ~255) + (GU ? 128 * ((j >> 2) & 1) + 32 * (j >> 5) + 16 * t + 4 * ((j >> 3) & 3) + (j & 3) : 128 * ((nl >> 3) & 1) + 32 * ((nl >> 6) & 3) + 16 * ((nl >> 2) & 1) + 4 * ((nl >> 4) & 3) + (nl & 3));
        const int q = P & 127, row = q;
        unsigned char* tile = WB + ((size_t)(P >> 8) * nkt + kt) * 32768 + ((P >> 7) & 1) * 16384;
#pragma unroll
        for (int g = 0; g < 2; ++g) { int w[4];
#pragma unroll
            for (int d = 0; d < 4; ++d) { int x = __builtin_amdgcn_cvt_pk_fp8_f32(v[16 * g + 4 * d + 0][cmp] * 64.0f, v[16 * g + 4 * d + 1][cmp] * 64.0f, 0, false);
                w[d] = __builtin_amdgcn_cvt_pk_fp8_f32(v[16 * g + 4 * d + 2][cmp] * 64.0f, v[16 * g + 4 * d + 3][cmp] * 64.0f, x, true); }
            *(u32x4*)(tile + pg8::img8(row, c0 + g)) = (u32x4){(unsigned)w[0], (unsigned)w[1], (unsigned)w[2], (unsigned)w[3]}; }
    }
}
__device__ __forceinline__ void p0_moe_convert_block(Frame& F) {
    constexpr int NI_GU = NEXP * 16 * 16, NI_D = NEXP * 16 * 8, NIT = NI_GU + NI_D;
    const int lane = F.lane, w = F.wave, tid = F.tid;
    unsigned char* WGU = (unsigned char*)(F.ws + WS_WGU); unsigned char* WD = (unsigned char*)(F.ws + WS_WD);
#define MC_SRC(it, srcp, ldw_, dstp, gu_, gk_) do { int r_ = (it); const float* W_; int N_; unsigned char* D_; \
        if (r_ < NI_GU) { const int e_ = r_ >> 8, rem_ = r_ & 255, kt_ = rem_ >> 4, pn_ = rem_ & 15; W_ = F.w_gate_up + (size_t)e_ * DM * 2 * DM + (size_t)(128 * kt_) * (2 * DM) + 256 * pn_; N_ = 2 * DM; \
            D_ = WGU + (size_t)e_ * 2 * DM * DM + ((size_t)pn_ * 16 + kt_) * 32768; gu_ = true; gk_ = F.g_ffn + 128 * kt_ + 16 * w; }     \
        else { r_ -= NI_GU; const int e_ = r_ >> 7, rem_ = r_ & 127, kt_ = rem_ >> 3, pn_ = rem_ & 7; W_ = F.w_down + (size_t)e_ * DM * DM + (size_t)(128 * kt_) * DM + 256 * pn_; N_ = DM; \
            D_ = WD + (size_t)e_ * DM * DM + ((size_t)pn_ * 16 + kt_) * 32768; gu_ = false; } \
        srcp = (const f32x4*)(W_ + (size_t)(16 * w) * N_ + 4 * lane); ldw_ = N_ / 4; dstp = D_; } while (0)
#define MC_LOAD(v, srcp, ldw_) do { _Pragma("unroll") for (int r = 0; r < 16; ++r) v[r] = srcp[(size_t)r * ldw_]; } while (0)
#define MC_STEP(v, buf, dstp, gu_, gk_) do { float gs_[16]; _Pragma("unroll") for (int r = 0; r < 16; ++r) gs_[r] = gu_ ? gk_[r] * 64.0f : 64.0f; \
        _Pragma("unroll") for (int cmp = 0; cmp < 4; ++cmp) { const int nl = 4 * lane + cmp, j = nl >> 1, t = nl & 1, P = gu_ ? 128 * ((j >> 2) & 1) + 32 * (j >> 5) + 16 * t + 4 * ((j >> 3) & 3) + (j & 3) : 128 * ((nl >> 3) & 1) + 32 * ((nl >> 6) & 3) + 16 * ((nl >> 2) & 1) + 4 * ((nl >> 4) & 3) + (nl & 3); \
            const int q = P & 127, row = q; int wq[4]; \
            _Pragma("unroll") for (int d = 0; d < 4; ++d) { const int x = __builtin_amdgcn_cvt_pk_fp8_f32(v[4 * d + 0][cmp] * gs_[4 * d + 0], v[4 * d + 1][cmp] * gs_[4 * d + 1], 0, false); \
                wq[d] = __builtin_amdgcn_cvt_pk_fp8_f32(v[4 * d + 2][cmp] * gs_[4 * d + 2], v[4 * d + 3][cmp] * gs_[4 * d + 3], x, true); } \
            *(LAS u32x4*)((buf) + ((P >> 7) & 1) * 16384 + pg8::img8(row, w)) = (u32x4){(unsigned)wq[0], (unsigned)wq[1], (unsigned)wq[2], (unsigned)wq[3]}; } \
        __syncthreads(); \
        _Pragma("unroll") for (int q4 = 0; q4 < 4; ++q4) *(u32x4*)((dstp) + tid * 16 + q4 * 8192) = *(const LAS u32x4*)((buf) + tid * 16 + q4 * 8192); } while (0)
    f32x4 va[16], vb[16];
    const f32x4* sa; const f32x4* sb; int la = 0, lb = 0; unsigned char* da = nullptr; unsigned char* db = nullptr; bool ga = false, gb = false; const float* gka = F.g_ffn; const float* gkb = F.g_ffn;
    int it = F.bx;
    if (it < NIT) { MC_SRC(it, sa, la, da, ga, gka); MC_LOAD(va, sa, la); }
    __syncthreads();
    for (; it < NIT; it += 2 * F.G) {
        const int it1 = it + F.G, it2 = it + 2 * F.G;
        if (it1 < NIT) { MC_SRC(it1, sb, lb, db, gb, gkb); MC_LOAD(vb, sb, lb); }
        MC_STEP(va, F.lds, da, ga, gka);
        if (it1 < NIT) {
            if (it2 < NIT) { MC_SRC(it2, sa, la, da, ga, gka); MC_LOAD(va, sa, la); }
            MC_STEP(vb, F.lds + 32768, db, gb, gkb);
        }
    }
    __syncthreads();
#undef MC_SRC
#undef MC_LOAD
#undef MC_STEP
}
__device__ __forceinline__ void p0_prologue(Frame& F) {
    const int gw = F.bx * NWAVES + F.wave, NGW = F.G * NWAVES;
    bf16_t* WIN = (bf16_t*)(F.ws + WS_WIN); bf16_t* WUQ = (bf16_t*)(F.ws + WS_WUQ); bf16_t* WUKV = (bf16_t*)(F.ws + WS_WUKV);
    bf16_t* WOA = (bf16_t*)(F.ws + WS_WOA); bf16_t* WOB = (bf16_t*)(F.ws + WS_WOB); bf16_t* WOUT = (bf16_t*)(F.ws + WS_WOUT);
    bf16_t* WGU = (bf16_t*)(F.ws + WS_WGU); bf16_t* WD = (bf16_t*)(F.ws + WS_WD);
    constexpr int I_IN = (DM / 32) * ((NLOW + 255) / 256), I_ING = (DM / 32) * (NGATE / 256), I_UQ = (512 / 32) * (1536 / 256), I_UKV = (256 / 32) * (2048 / 256), I_OA = (1024 / 32) * (DM / 256), I_OUT = (DM / 32) * (DM / 256);
    constexpr int I_GU1 = (DM / 32) * (2 * DM / 256), I_D1 = (DM / 32) * (DM / 256);
    (void)WGU; (void)WD; (void)I_GU1; (void)I_D1;
    constexpr int NITEMS = I_IN + I_ING + I_UQ + I_UKV + 2 * I_OA + I_OUT;
    for (int it = gw; it < NITEMS; it += NGW) {
        int r = it;
        if (r < I_IN) { p0_convert_item_f8<false>(F.w_in, DM, NLOW, (unsigned char*)WIN, r, F.lane, NIN_LOG); continue; } r -= I_IN;
        if (r < I_ING) { p0_convert_item_f8<false>(F.w_in + NLOW, DM, NGATE, (unsigned char*)WIN + WIN_GATES_OFF, r, F.lane, NIN_LOG); continue; } r -= I_ING;
        if (r < I_UQ) { p0_convert_item<0, true, true>(F.w_uq, 512, 1536, WUQ, r, F.lane, 0, 0, 0, F.g_q); continue; } r -= I_UQ;
        if (r < I_UKV) { p0_convert_item<0, true>(F.w_ukv, 256, 2048, WUKV, r, F.lane, 0, 0, 0, F.g_kv); continue; } r -= I_UKV;
        if (r < I_OA) { p0_convert_item_f8<false>(F.w_o_swa, 1024, DM, (unsigned char*)WOA, r, F.lane, 0, 16, 0); continue; } r -= I_OA;
        if (r < I_OA) { (void)WOB; p0_convert_item_f8<false>(F.w_o_mla, 1024, DM, (unsigned char*)WOA, r, F.lane, 0, 16, 8); continue; } r -= I_OA;
        { p0_convert_item_f8<false>(F.w_out, DM, DM, (unsigned char*)WOUT, r, F.lane); }
    }
    p0_moe_convert_block(F);
    { constexpr int NPAD = NPROJ - NLOW, nz = (DM / 128) * NPAD * 8;
      for (int i = F.bx * NTHREADS + F.tid; i < nz; i += F.G * NTHREADS) { const int c = i & 7, col = (i >> 3) % NPAD, kt = (i >> 3) / NPAD, p0_ = NLOW + col, nl = p0_ & 255;
          const int P = (p0_ & ~255) + 128 * ((nl >> 3) & 1) + 32 * ((nl >> 6) & 3) + 16 * ((nl >> 2) & 1) + 4 * ((nl >> 4) & 3) + (nl & 3), q = P & 127;
          *(u32x4*)((unsigned char*)WIN + ((size_t)(P >> 8) * (DM / 128) + kt) * 32768 + ((P >> 7) & 1) * 16384 + pg8::img8(q, c)) = (u32x4){0u, 0u, 0u, 0u}; } }
    { int* idr = (int*)(F.ws + WS_IDROW); for (int i = F.bx * NTHREADS + F.tid; i < PROWS; i += F.G * NTHREADS) idr[i] = i; }
    { bf16_t* wrh = (bf16_t*)(F.ws + WS_WRT); bf16_t* wrl = wrh + NEXP * DM;
      for (int i = F.bx * NTHREADS + F.tid; i < DM * NEXP; i += F.G * NTHREADS) { const int d = i >> 5, e = i & 31; const float wv = F.w_router[i] * F.g_ffn[d];
          const unsigned hb = cvt_pk_bf16(wv, 0.f) & 0xffffu; const unsigned lb = cvt_pk_bf16(wv - bf_lo(hb), 0.f) & 0xffffu; wrh[e * DM + d] = (bf16_t)hb; wrl[e * DM + d] = (bf16_t)lb; } }
    float* CS = (float*)(F.ws + WS_CS);
#ifndef P0B_REP
#define P0B_REP 1
#endif
    for (int rep_ = 0; rep_ < P0B_REP; ++rep_)
    for (int m = gw; m < NTOK; m += NGW) {
        const f32x4* xr = (const f32x4*)(F.x + (size_t)m * DM) + F.lane; const f32x4* gr = (const f32x4*)F.g_attn + F.lane;
        f32x4 v[8]; float s = 0.f;
#pragma unroll
        for (int j = 0; j < 8; ++j) { v[j] = xr[64 * j]; s += (v[j].x * v[j].x + v[j].y * v[j].y) + (v[j].z * v[j].z + v[j].w * v[j].w); }
        const float rstd = 1.0f / sqrtf(wave_sum(s) * (1.0f / DM) + EPS);
#pragma unroll
        for (int j = 0; j < 8; ++j) { const f32x4 gg = gr[64 * j]; const float y0 = v[j].x * rstd * gg.x, y1 = v[j].y * rstd * gg.y, y2 = v[j].z * rstd * gg.z, y3 = v[j].w * rstd * gg.w;
            int w8 = __builtin_amdgcn_cvt_pk_fp8_f32(y0, y1, 0, false); w8 = __builtin_amdgcn_cvt_pk_fp8_f32(y2, y3, w8, true); ((unsigned*)(F.ws + WS_XN8 + (size_t)m * DM))[F.lane + 64 * j] = (unsigned)w8; }
        { const int i = F.lane & 31; const float inv_freq = powf(10000.0f, -(float)i * 2.0f / 64.0f); const float ang = (float)F.positions[m] * inv_freq;
          CS[(size_t)m * 64 + F.lane] = (F.lane < 32) ? cosf(ang) : sinf(ang); }
    }
}

__device__ __forceinline__ void rope4(u32x2& a, u32x2& b, f32x4 c, f32x4 s) {
    const float x1[4] = {bf_lo(a.x), bf_hi(a.x), bf_lo(a.y), bf_hi(a.y)}, x2[4] = {bf_lo(b.x), bf_hi(b.x), bf_lo(b.y), bf_hi(b.y)};
    float o1[4], o2[4];
#pragma unroll
    for (int j = 0; j < 4; ++j) { o1[j] = x1[j] * c[j] - x2[j] * s[j]; o2[j] = x2[j] * c[j] + x1[j] * s[j]; }
    a.x = cvt_pk_bf16(o1[0], o1[1]); a.y = cvt_pk_bf16(o1[2], o1[3]); b.x = cvt_pk_bf16(o2[0], o2[1]); b.y = cvt_pk_bf16(o2[2], o2[3]);
}
namespace pg8 {
__device__ __forceinline__ float row_rstd_q(const float* ssqp, size_t row) { const f32x4 a = *(const f32x4*)(ssqp + row * 12), b = *(const f32x4*)(ssqp + row * 12 + 4);
    return 1.0f / sqrtf((((a[0] + a[1]) + (a[2] + a[3])) + ((b[0] + b[1]) + (b[2] + b[3]))) * (1.0f / 512.0f) + EPS); }
__device__ __forceinline__ float row_rstd_kv(const float* ssqp, size_t row) { const f32x4 a = *(const f32x4*)(ssqp + row * 12 + 8);
    return 1.0f / sqrtf(((a[0] + a[1]) + (a[2] + a[3])) * (1.0f / 256.0f) + EPS); }
struct EpiQn { static constexpr bool PERM = true;
    bf16_t* O; const float* ssqp; float scl;
    __device__ __forceinline__ void operator()(AccRef acc, const Unit& u, int wr, int wc, int fr, int fq) const {
        const int row0 = u.pm * BM + wr * 64 + fr, col0 = u.pn * BM + wc * 64 + 16 * fq;
#pragma unroll
        for (int ai = 0; ai < 2; ++ai)
#pragma unroll
            for (int m = 0; m < 4; ++m) { const size_t row = (size_t)(row0 + ai * HALF + m * 16); const float sc = row_rstd_q(ssqp, row) * scl; bf16_t* rowp = O + row * 1536 + col0;
#pragma unroll
                for (int bj = 0; bj < 2; ++bj) *(u32x4*)(rowp + bj * 8) = pack8(acc[ai][bj][m][0] * sc, acc[ai][bj][m][1] * sc); }
    }
};
struct EpiKVn { static constexpr bool PERM = true;
    bf16_t* kmla; bf16_t* vmla; const float* ssqp; const bf16_t* proj; const float* cs;
    __device__ __forceinline__ void operator()(AccRef acc, const Unit& u, int wr, int wc, int fr, int fq) const {
        const int row0 = u.pm * BM + wr * 64 + fr, c0 = wc * 32 + 8 * fq;
#pragma unroll
        for (int ai = 0; ai < 2; ++ai)
#pragma unroll
            for (int m = 0; m < 4; ++m) { const size_t row = (size_t)(row0 + ai * HALF + m * 16); const float sc = row_rstd_kv(ssqp, row);
                const size_t hrow = ((row >> 11) * 8 + u.pn) * 2048 + (row & 2047);
                *(u32x4*)(kmla + hrow * 192 + c0) = pack8(acc[ai][0][m][0] * sc, acc[ai][0][m][1] * sc);
                *(u32x4*)(vmla + hrow * 128 + c0) = pack8(acc[ai][1][m][0] * sc, acc[ai][1][m][1] * sc); }
        const int tid_ = (wr * 4 + wc) * 64 + fq * 16 + fr;
#pragma unroll
        for (int it = 0; it < 4; ++it) { const int idx = tid_ + 512 * it, i0 = 4 * (idx & 7); const size_t row = (size_t)(u.pm * BM + (idx >> 3));
            const bf16_t* pr = proj + row * NPROJ + PC_KR;
            u32x2 a = *(const u32x2*)(pr + i0), b = *(const u32x2*)(pr + 32 + i0);
            const f32x4 c = *(const f32x4*)(cs + row * 64 + i0), sn = *(const f32x4*)(cs + row * 64 + 32 + i0);
            rope4(a, b, c, sn);
            bf16_t* kp = kmla + (((row >> 11) * 8 + u.pn) * 2048 + (row & 2047)) * 192 + 128 + i0;
            *(u32x2*)kp = a; *(u32x2*)(kp + 32) = b; }
    }
};
}
__device__ __forceinline__ void p2_postproj(Frame& F) {
    const int gw = F.bx * NWAVES + F.wave, NGW = F.G * NWAVES, lane = F.lane;
    bf16_t* PROJ = (bf16_t*)(F.ws + WS_PROJ); const float* CS = (const float*)(F.ws + WS_CS);
    bf16_t* CQ = (bf16_t*)(F.ws + WS_CQ); bf16_t* CKV = (bf16_t*)(F.ws + WS_CKV); bf16_t* KMLA = (bf16_t*)(F.ws + WS_KMLA);
    constexpr int R2 = 4;
    const int hd = lane >> 3, i0 = 4 * (lane & 7); const int base = (hd < 2) ? PC_KA + hd * 64 : PC_KR;
    const f32x4 gq0 = *(const f32x4*)(F.g_q + 8 * lane), gq1 = *(const f32x4*)(F.g_q + 8 * lane + 4), gk0 = *(const f32x4*)(F.g_kv + 4 * lane);
    for (int m0 = gw; m0 < NTOK; m0 += R2 * NGW) {
        f32x4 rc[R2], rs[R2]; u32x2 ra[R2], rb[R2], wkv[R2]; u32x4 wq[R2];
#pragma unroll
        for (int j = 0; j < R2; ++j) { const int m = m0 + j * NGW; if (m < NTOK) { bf16_t* pr = PROJ + (size_t)m * NPROJ;
            if (lane < 24) { rc[j] = *(const f32x4*)(CS + (size_t)m * 64 + i0); rs[j] = *(const f32x4*)(CS + (size_t)m * 64 + 32 + i0);
                ra[j] = *(u32x2*)(pr + base + i0); rb[j] = *(u32x2*)(pr + base + 32 + i0); }
            wq[j] = *(const u32x4*)(pr + PC_DQ + 8 * lane); wkv[j] = *(const u32x2*)(pr + PC_DKV + 4 * lane); } }
#pragma unroll
        for (int j = 0; j < R2; ++j) { const int m = m0 + j * NGW; if (m < NTOK) { bf16_t* pr = PROJ + (size_t)m * NPROJ;
            if (lane < 24) { u32x2 a = ra[j], b = rb[j];
                rope4(a, b, rc[j], rs[j]);
                if (hd < 2) { *(u32x2*)(pr + base + i0) = a; *(u32x2*)(pr + base + 32 + i0) = b; }
                else { bf16_t* kp = KMLA + ((size_t)(m >> 11) * (8 * 2048) + (m & 2047)) * 192 + 128 + i0;
#pragma unroll
                    for (int hh = 0; hh < 8; ++hh) { *(u32x2*)(kp + (size_t)hh * (2048 * 192)) = a; *(u32x2*)(kp + (size_t)hh * (2048 * 192) + 32) = b; } } }
            { const u32x4 w = wq[j];
              float v[8] = {bf_lo(w.x), bf_hi(w.x), bf_lo(w.y), bf_hi(w.y), bf_lo(w.z), bf_hi(w.z), bf_lo(w.w), bf_hi(w.w)}; float sq = 0.f;
#pragma unroll
              for (int t = 0; t < 8; ++t) sq += v[t] * v[t];
              const float rstd = 1.0f / sqrtf(wave_sum(sq) * (1.0f / 512.0f) + EPS);
              u32x4 o; o.x = cvt_pk_bf16(v[0] * rstd * gq0[0], v[1] * rstd * gq0[1]); o.y = cvt_pk_bf16(v[2] * rstd * gq0[2], v[3] * rstd * gq0[3]);
              o.z = cvt_pk_bf16(v[4] * rstd * gq1[0], v[5] * rstd * gq1[1]); o.w = cvt_pk_bf16(v[6] * rstd * gq1[2], v[7] * rstd * gq1[3]);
              *(u32x4*)(CQ + (size_t)m * 512 + 8 * lane) = o; }
            { const u32x2 w = wkv[j];
              float v[4] = {bf_lo(w.x), bf_hi(w.x), bf_lo(w.y), bf_hi(w.y)}; float sq = (v[0] * v[0] + v[1] * v[1]) + (v[2] * v[2] + v[3] * v[3]);
              const float rstd = 1.0f / sqrtf(wave_sum(sq) * (1.0f / 256.0f) + EPS);
              u32x2 o; o.x = cvt_pk_bf16(v[0] * rstd * gk0[0], v[1] * rstd * gk0[1]); o.y = cvt_pk_bf16(v[2] * rstd * gk0[2], v[3] * rstd * gk0[3]);
              *(u32x2*)(CKV + (size_t)m * 256 + 4 * lane) = o; } } }
    }
}

__device__ __forceinline__ int crow(int r, int hi) { return (r & 3) + 8 * (r >> 2) + 4 * hi; }
__device__ __forceinline__ bf16x8 tr2(const LAS unsigned char* p0, const LAS unsigned char* p1) {
    const v4i16_t a = __builtin_amdgcn_ds_read_tr16_b64_v4i16((LAS v4i16_t*)p0), b = __builtin_amdgcn_ds_read_tr16_b64_v4i16((LAS v4i16_t*)p1);
    bf16x8 r; r[0] = a[0]; r[1] = a[1]; r[2] = a[2]; r[3] = a[3]; r[4] = b[0]; r[5] = b[1]; r[6] = b[2]; r[7] = b[3]; return r;
}
__device__ __forceinline__ void rope_frag(bf16x8& f1, bf16x8& f2, const float* cs, int i0, float scl = 1.0f) {
    const f32x4 c0 = *(const f32x4*)(cs + i0) * scl, c1 = *(const f32x4*)(cs + i0 + 4) * scl, s0 = *(const f32x4*)(cs + 32 + i0) * scl, s1 = *(const f32x4*)(cs + 32 + i0 + 4) * scl;
    u32x4 a = __builtin_bit_cast(u32x4, f1), b = __builtin_bit_cast(u32x4, f2);
    u32x2 a0 = {a.x, a.y}, b0 = {b.x, b.y}, a1 = {a.z, a.w}, b1 = {b.z, b.w};
    rope4(a0, b0, c0, s0); rope4(a1, b1, c1, s1);
    f1 = __builtin_bit_cast(bf16x8, (u32x4){a0.x, a0.y, a1.x, a1.y}); f2 = __builtin_bit_cast(bf16x8, (u32x4){b0.x, b0.y, b1.x, b1.y});
}
__device__ __forceinline__ bf16x8 pack_p(const f32x16& p, int s2) {
    u32x4 w;
    asm volatile("s_nop 0\n\tv_cvt_pk_bf16_f32 %0, %4, %5\n\tv_cvt_pk_bf16_f32 %1, %6, %7\n\tv_cvt_pk_bf16_f32 %2, %8, %9\n\tv_cvt_pk_bf16_f32 %3, %10, %11"
                 : "=&v"(w.x), "=&v"(w.y), "=&v"(w.z), "=&v"(w.w)
                 : "v"(p[8 * s2 + 0]), "v"(p[8 * s2 + 1]), "v"(p[8 * s2 + 2]), "v"(p[8 * s2 + 3]), "v"(p[8 * s2 + 4]), "v"(p[8 * s2 + 5]), "v"(p[8 * s2 + 6]), "v"(p[8 * s2 + 7]));
    return __builtin_bit_cast(bf16x8, w);
}

constexpr int SWA_KRS = 144;
constexpr int SWA_LDS_K = 0, SWA_LDS_V = 256 * SWA_KRS;
__device__ __forceinline__ void swa_phase(Frame& F) {
    const bf16_t* PROJ = (const bf16_t*)(F.ws + WS_PROJ); const float* CS = (const float*)(F.ws + WS_CS); bf16_t* OUTA = (bf16_t*)(F.ws + WS_OUTA);
    LAS unsigned char* Kl = F.lds + SWA_LDS_K; LAS unsigned char* Vl = F.lds + SWA_LDS_V;
    int lane = F.lane; asm volatile("" : "+v"(lane));
    const int w = F.wave, l31 = lane & 31, h = lane >> 5;
    const int vq = (lane & 15) >> 2, vp = lane & 3, vg = (lane >> 4) & 1;
    const int vlane = (4 * h + vq) * 64 + (16 * vg + 4 * vp) * 2;
    for (int u = F.bx; u < BATCH * 16 * 2; u += F.G) {
        const int kvh = u & 1, nb = (u >> 1) & 15, b = u >> 5;
        const int tok0 = b * SEQ + nb * 128;
        __syncthreads();
#pragma unroll
        for (int j = 0; j < 4; ++j) { const int id = F.tid + 512 * j, row = id >> 3, ch = id & 7;
            u32x4 kv = (u32x4){0u, 0u, 0u, 0u}, vv = (u32x4){0u, 0u, 0u, 0u};
            if (nb > 0 || row >= 128) { const size_t tok = (size_t)(tok0 - 128 + row); const bf16_t* src = PROJ + tok * NPROJ + kvh * 64 + ch * 8;
                vv = *(const u32x4*)(src + PC_VA);
                const u32x4 ko = *(const u32x4*)(src + PC_KA), kp = *(const u32x4*)(src + PC_KA + ((ch & 4) ? -32 : 32));
                const float* cs = CS + tok * 64 + 8 * (ch & 3);
                const f32x4 c0 = *(const f32x4*)cs, c1 = *(const f32x4*)(cs + 4), s0 = *(const f32x4*)(cs + 32), s1 = *(const f32x4*)(cs + 36);
                const float sg = (ch & 4) ? 1.0f : -1.0f;
                const unsigned kow[4] = {ko.x, ko.y, ko.z, ko.w}, kpw[4] = {kp.x, kp.y, kp.z, kp.w}; unsigned ow[4];
#pragma unroll
                for (int e = 0; e < 4; ++e) { const float cl = e < 2 ? c0[2 * e] : c1[2 * e - 4], ch_ = e < 2 ? c0[2 * e + 1] : c1[2 * e - 3], sl = e < 2 ? s0[2 * e] : s1[2 * e - 4], sh = e < 2 ? s0[2 * e + 1] : s1[2 * e - 3];
                    ow[e] = cvt_pk_bf16(bf_lo(kow[e]) * cl + sg * bf_lo(kpw[e]) * sl, bf_hi(kow[e]) * ch_ + sg * bf_hi(kpw[e]) * sh); }
                kv = (u32x4){ow[0], ow[1], ow[2], ow[3]}; }
            *(LAS u32x4*)(Kl + row * SWA_KRS + ch * 16) = kv;
            *(LAS u32x4*)(Vl + ((row >> 3) * 2 + (ch >> 2)) * 512 + (row & 7) * 64 + (ch & 3) * 16) = vv; }
        __syncthreads();
        const int hq = kvh * 8 + w; const float sink = F.sinks[hq];
        for (int i = 0; i < 4; ++i) {
            const size_t row0 = (size_t)tok0 + 32 * i;
            bf16x8 Qf[4];
            { const char* qp = (const char*)PROJ + (row0 * NPROJ + hq * 64) * 2; const unsigned qo = (unsigned)(l31 * (NPROJ * 2) + 16 * h);
#pragma unroll
              for (int ks = 0; ks < 4; ++ks) Qf[ks] = *(const bf16x8*)(qp + qo + 32 * ks);
              const float* cs = (const float*)((const char*)CS + row0 * 256 + (unsigned)(l31 * 256));
              rope_frag(Qf[0], Qf[2], cs, 8 * h, 0.125f * 1.4426950408889634f); rope_frag(Qf[1], Qf[3], cs, 16 + 8 * h, 0.125f * 1.4426950408889634f); }
            f32x16 O[2];
#pragma unroll
            for (int db = 0; db < 2; ++db)
#pragma unroll
                for (int r = 0; r < 16; ++r) O[db][r] = 0.f;
            const float sinkl = sink * 1.4426950408889634f;
            float mrun = sinkl, lrun = 0.f;
            const int tcmp = l31 - 4 * h;
#pragma unroll 1
            for (int kb = 0; kb < 5; ++kb) {
                if (nb == 0 && i + kb < 4) continue;
                const int kk0 = 32 * (i + kb);
                f32x16 Sx;
#pragma unroll
                for (int r = 0; r < 16; ++r) Sx[r] = 0.f;
                const LAS unsigned char* kp = Kl + kk0 * SWA_KRS + l31 * SWA_KRS + 16 * h;
#pragma unroll
                for (int ks = 0; ks < 4; ++ks) Sx = __builtin_amdgcn_mfma_f32_32x32x16_bf16(*(const LAS bf16x8*)(kp + 32 * ks), Qf[ks], Sx, 0, 0, 0);
                const LAS unsigned char* vb = Vl + (kk0 >> 3) * 1024 + vlane;
                bf16x8 vf[4];
#pragma unroll
                for (int db = 0; db < 2; ++db) { vf[2 * db] = tr2(vb + db * 512, vb + db * 512 + 1024); vf[2 * db + 1] = tr2(vb + db * 512 + 2048, vb + db * 512 + 3072); }
                __builtin_amdgcn_sched_barrier(0);
                if (kb == 0) {
#pragma unroll
                    for (int r = 0; r < 16; ++r) if (!((r & 3) + 8 * (r >> 2) > tcmp)) Sx[r] = -1e30f;
                } else if (kb == 4) {
#pragma unroll
                    for (int r = 0; r < 16; ++r) if ((r & 3) + 8 * (r >> 2) > tcmp) Sx[r] = -1e30f;
                }
                float mx = Sx[0];
#pragma unroll
                for (int r = 1; r < 16; ++r) mx = fmaxf(mx, Sx[r]);
                mx = fmaxf(mx, __shfl_xor(mx, 32));
                if (__builtin_amdgcn_ballot_w64(mx > mrun + 8.f) != 0) {
                    const float mn = fmaxf(mrun, mx);
                    const float alpha = __builtin_amdgcn_exp2f(mrun - mn);
                    mrun = mn; lrun *= alpha;
#pragma unroll
                    for (int db = 0; db < 2; ++db)
#pragma unroll
                        for (int r = 0; r < 16; ++r) O[db][r] *= alpha;
                }
                float ps = 0.f;
#pragma unroll
                for (int r = 0; r < 16; ++r) { const float p = __builtin_amdgcn_exp2f(Sx[r] - mrun); Sx[r] = p; ps += p; }
                lrun += ps;
                const bf16x8 P0 = pack_p(Sx, 0), P1 = pack_p(Sx, 1);
                __builtin_amdgcn_sched_barrier(0);
#pragma unroll
                for (int db = 0; db < 2; ++db) {
                    O[db] = __builtin_amdgcn_mfma_f32_32x32x16_bf16(vf[2 * db], P0, O[db], 0, 0, 0);
                    O[db] = __builtin_amdgcn_mfma_f32_32x32x16_bf16(vf[2 * db + 1], P1, O[db], 0, 0, 0);
                }
            }
            const float ltot = lrun + __shfl_xor(lrun, 32) + __builtin_amdgcn_exp2f(sinkl - mrun);
            const float inv = 1.0f / ltot;
            char* op = (char*)OUTA + (row0 * 2048 + hq * 64); const unsigned oo = (unsigned)(l31 * 2048 + 4 * h);
            const float inv16 = inv * 16.0f;
#pragma unroll
            for (int db = 0; db < 2; ++db)
#pragma unroll
                for (int g4 = 0; g4 < 4; ++g4) { int wv = __builtin_amdgcn_cvt_pk_fp8_f32(O[db][4 * g4] * inv16, O[db][4 * g4 + 1] * inv16, 0, false); wv = __builtin_amdgcn_cvt_pk_fp8_f32(O[db][4 * g4 + 2] * inv16, O[db][4 * g4 + 3] * inv16, wv, true);
                    *(unsigned*)(op + oo + 32 * db + 8 * g4) = (unsigned)wv; }
        }
    }
    __syncthreads();
}

constexpr int MLA_KRS = 400, MLA_KB = 64 * MLA_KRS, MLA_VB = 64 * 256, MLA_BUF = MLA_KB + MLA_VB;
typedef float f32x2m __attribute__((ext_vector_type(2)));
__device__ __forceinline__ void mla_phase(Frame& F) {
    const char* QBc = (const char*)(F.ws + WS_QB); const char* KMLA = (const char*)(F.ws + WS_KMLA); const char* VMLA = (const char*)(F.ws + WS_VMLA);
    const char* CSc = (const char*)(F.ws + WS_CS); char* OUTBc = (char*)(F.ws + WS_OUTA) + 1024;
    int lane = F.lane; asm volatile("" : "+v"(lane));
    const int w = F.wave, l31 = lane & 31, h = lane >> 5;
    const int vq = (lane & 15) >> 2, vp = lane & 3, vg = (lane >> 4) & 1;
    const int vlane = (4 * h + vq) * 64 + (16 * vg + 4 * vp) * 2;
    const int klane = l31 * MLA_KRS + 16 * h;
    constexpr float C2 = 0.07216878364870322f * 1.4426950408889634f;
    for (int it0 = F.bx; it0 < BATCH * 8 * 4; it0 += F.G) {
        const int it = (F.G == 256) ? ((it0 & 7) * 64 + ((it0 >> 3) & 31) + 32 * (it0 >> 8)) : it0;
        const int pr = it & 3, hh = (it >> 2) & 7, b = it >> 5;
        for (int half = 0; half < 2; ++half) {
            const int qb = half ? pr : (7 - pr);
            const int nkt = 4 * (qb + 1);
            const size_t row0 = (size_t)b * SEQ + 256 * qb + 32 * w;
            const int qpos = 256 * qb + 32 * w + l31;
            bf16x8 Qf[12];
            { const char* qp = QBc + (row0 * 1536 + hh * 192) * 2; const unsigned qo = (unsigned)(l31 * 3072 + 16 * h);
#pragma unroll
              for (int ks = 0; ks < 12; ++ks) Qf[ks] = *(const bf16x8*)(qp + qo + 32 * ks);
              const float* cs = (const float*)(CSc + row0 * 256 + (unsigned)(l31 * 256));
              rope_frag(Qf[8], Qf[10], cs, 8 * h); rope_frag(Qf[9], Qf[11], cs, 16 + 8 * h); }
            f32x16 O[4];
#pragma unroll
            for (int db = 0; db < 4; ++db)
#pragma unroll
                for (int r = 0; r < 16; ++r) O[db][r] = 0.f;
            float mrun = -1e30f, lrun = 0.f;
            const size_t hrow0 = ((size_t)b * 8 + hh) * SEQ;
#define MLA_DMAK(kt, bufp) do { const char* kb_ = KMLA + (hrow0 + 64 * (kt)) * 384; \
              _Pragma("unroll") for (int j = 0; j < 4; ++j) { const int q = w + 8 * j; \
                if (q < 25) { const int s_ = 64 * q + lane, row = s_ / 25, ch = s_ - 25 * row; const unsigned off = (unsigned)(row * 384 + ch * 16); \
                    glds16_asm(kb_, off, (unsigned)(size_t)((bufp) + q * 1024)); } } } while (0)
#define MLA_DMAV(kt, bufp) do { const char* vb_ = VMLA + (hrow0 + 64 * (kt)) * 256; \
              _Pragma("unroll") for (int j = 0; j < 2; ++j) { const int q = w + 8 * j; \
                const int s_ = 64 * q + lane, sub = s_ >> 5, row = (sub >> 2) * 8 + ((s_ >> 2) & 7), ch = (sub & 3) * 4 + (s_ & 3); const unsigned off = (unsigned)(row * 256 + ch * 16); \
                glds16_asm(vb_, off, (unsigned)(size_t)((bufp) + q * 1024)); } } while (0)
#define MLA_SB() __builtin_amdgcn_sched_barrier(0)
#define MLA_LDK(p) (*(const LAS bf16x8*)(p))
#define MLA_E(SP, r) do { const float p_ = __builtin_amdgcn_exp2f(SP[r] - mrun); SP[r] = p_; ps += p_; } while (0)
#define MLA_E2(SP, r) do { f32x2m t_ = (f32x2m){SP[r], SP[(r) + 1]} - mrun; t_[0] = __builtin_amdgcn_exp2f(t_[0]); t_[1] = __builtin_amdgcn_exp2f(t_[1]); SP[r] = t_[0]; SP[(r) + 1] = t_[1]; ps2 += t_; } while (0)
#define MLA_QKM(SN, f, ks) SN = __builtin_amdgcn_mfma_f32_32x32x16_bf16(f, Qf[ks], SN, 0, 0, 0)
#define MLA_PEND_PLAIN(SP, vbp) do { float ps = 0.f; \
                _Pragma("unroll") for (int r = 0; r < 16; ++r) MLA_E(SP, r); \
                lrun += ps; \
                const bf16x8 P0 = pack_p(SP, 0), P1 = pack_p(SP, 1); \
                const LAS unsigned char* vb = (vbp); \
                _Pragma("unroll") for (int db = 0; db < 4; ++db) { \
                    O[db] = __builtin_amdgcn_mfma_f32_32x32x16_bf16(tr2(vb + db * 512, vb + db * 512 + 4 * 512), P0, O[db], 0, 0, 0); \
                    O[db] = __builtin_amdgcn_mfma_f32_32x32x16_bf16(tr2(vb + db * 512 + 8 * 512, vb + db * 512 + 12 * 512), P1, O[db], 0, 0, 0); } } while (0)
#define MLA_STAGE(SN, SP, kpp, vbp, NIDX) do { const int n_ = (NIDX); \
                if (n_ <= nlast + 1) {                                    \
                    const LAS unsigned char* kp = (kpp); const LAS unsigned char* vb = (vbp); \
                    bf16x8 kfA[4], kfB[4], vf[8], P0, P1; f32x2m ps2 = {0.f, 0.f}; \
                    _Pragma("unroll") for (int j = 0; j < 4; ++j) kfA[j] = MLA_LDK(kp + 32 * j); \
                    _Pragma("unroll") for (int j = 0; j < 4; ++j) kfB[j] = MLA_LDK(kp + 32 * (4 + j)); \
                    _Pragma("unroll") for (int r = 0; r < 16; ++r) SN[r] = 0.f; \
                    MLA_SB(); \
                    MLA_E2(SP, 0); MLA_SB(); \
                    MLA_QKM(SN, kfA[0], 0); MLA_E2(SP, 2); MLA_SB(); \
                    MLA_QKM(SN, kfA[1], 1); MLA_SB(); \
                    MLA_QKM(SN, kfA[2], 2); MLA_E2(SP, 4); MLA_SB(); \
                    MLA_QKM(SN, kfA[3], 3); MLA_SB(); \
                    _Pragma("unroll") for (int j = 0; j < 4; ++j) kfA[j] = MLA_LDK(kp + 32 * (8 + j)); \
                    MLA_SB(); \
                    MLA_QKM(SN, kfB[0], 4); MLA_E2(SP, 6); MLA_SB(); \
                    MLA_QKM(SN, kfB[1], 5); P0 = pack_p(SP, 0); MLA_SB(); \
                    MLA_QKM(SN, kfB[2], 6); MLA_E2(SP, 8); MLA_SB(); \
                    MLA_QKM(SN, kfB[3], 7); MLA_E2(SP, 10); MLA_SB(); \
                    _Pragma("unroll") for (int db = 0; db < 2; ++db) { vf[2 * db] = tr2(vb + db * 512, vb + db * 512 + 4 * 512); vf[2 * db + 1] = tr2(vb + db * 512 + 8 * 512, vb + db * 512 + 12 * 512); } \
                    MLA_SB(); \
                    MLA_QKM(SN, kfA[0], 8); MLA_E2(SP, 12); MLA_SB(); \
                    MLA_QKM(SN, kfA[1], 9); MLA_SB(); \
                    MLA_QKM(SN, kfA[2], 10); MLA_E2(SP, 14); MLA_SB(); \
                    MLA_QKM(SN, kfA[3], 11); lrun += ps2[0] + ps2[1]; P1 = pack_p(SP, 1); MLA_SB(); \
                    _Pragma("unroll") for (int db = 2; db < 4; ++db) { vf[2 * db] = tr2(vb + db * 512, vb + db * 512 + 4 * 512); vf[2 * db + 1] = tr2(vb + db * 512 + 8 * 512, vb + db * 512 + 12 * 512); } \
                    MLA_SB(); \
                    if (n_ >= nlast) {                                    \
                        _Pragma("unroll") for (int r = 0; r < 16; ++r) { const int key = 32 * n_ + crow(r, h); if (key > qpos) SN[r] = -1e30f; } \
                    } \
                    float mx; \
                    O[0] = __builtin_amdgcn_mfma_f32_32x32x16_bf16(vf[0], P0, O[0], 0, 0, 0); MLA_SB(); \
                    O[0] = __builtin_amdgcn_mfma_f32_32x32x16_bf16(vf[1], P1, O[0], 0, 0, 0); MLA_SB(); \
                    O[1] = __builtin_amdgcn_mfma_f32_32x32x16_bf16(vf[2], P0, O[1], 0, 0, 0); mx = fmaxf(fmaxf(SN[0], SN[1]), SN[2]); MLA_SB(); \
                    O[1] = __builtin_amdgcn_mfma_f32_32x32x16_bf16(vf[3], P1, O[1], 0, 0, 0); mx = fmaxf(fmaxf(mx, SN[3]), SN[4]); mx = fmaxf(fmaxf(mx, SN[5]), SN[6]); MLA_SB(); \
                    O[2] = __builtin_amdgcn_mfma_f32_32x32x16_bf16(vf[4], P0, O[2], 0, 0, 0); mx = fmaxf(fmaxf(mx, SN[7]), SN[8]); mx = fmaxf(fmaxf(mx, SN[9]), SN[10]); MLA_SB(); \
                    O[2] = __builtin_amdgcn_mfma_f32_32x32x16_bf16(vf[5], P1, O[2], 0, 0, 0); mx = fmaxf(fmaxf(mx, SN[11]), SN[12]); mx = fmaxf(fmaxf(mx, SN[13]), SN[14]); MLA_SB(); \
                    O[3] = __builtin_amdgcn_mfma_f32_32x32x16_bf16(vf[6], P0, O[3], 0, 0, 0); mx = fmaxf(mx, SN[15]); MLA_SB(); \
                    O[3] = __builtin_amdgcn_mfma_f32_32x32x16_bf16(vf[7], P1, O[3], 0, 0, 0); MLA_SB(); \
                    mx = fmaxf(mx, __shfl_xor(mx, 32)); \
                      \
                    if (__builtin_amdgcn_ballot_w64(mx > mrun + 8.f) != 0) { \
                        const float mn = fmaxf(mrun, mx); \
                        const float alpha = __builtin_amdgcn_exp2f(mrun - mn); \
                        mrun = mn; lrun *= alpha; \
                        _Pragma("unroll") for (int db = 0; db < 4; ++db) _Pragma("unroll") for (int r = 0; r < 16; ++r) O[db][r] *= alpha; \
                    } \
                } } while (0)
#define MLA_KB_(i) (F.lds + (i) * MLA_KB)
#define MLA_VB_(i) (F.lds + 3 * MLA_KB + (i) * MLA_VB)
#define MLA_TILE(KT, BI) do { const int kt_ = (KT); \
                  \
                if (kt_ + 1 < nkt) asm volatile("s_waitcnt vmcnt(3) lgkmcnt(0)" ::: "memory"); else asm volatile("s_waitcnt vmcnt(0) lgkmcnt(0)" ::: "memory"); \
                __builtin_amdgcn_s_barrier(); asm volatile("" ::: "memory");     \
                  \
                  \
                if (w < 4) { if (kt_ + 1 < nkt) MLA_DMAV(kt_ + 1, MLA_VB_(((BI) + 1) % 3)); if (kt_ + 2 < nkt) MLA_DMAK(kt_ + 2, MLA_KB_(((BI) + 2) % 3)); } \
                  \
                const LAS unsigned char* vprev = (kt_ == 0) ? (MLA_VB_(BI) + vlane) : (MLA_VB_(((BI) + 2) % 3) + 16 * 512 + vlane); \
                MLA_STAGE(Sa, Sb, MLA_KB_(BI) + klane, vprev, 2 * kt_); \
                if (w >= 4) { if (kt_ + 1 < nkt) MLA_DMAV(kt_ + 1, MLA_VB_(((BI) + 1) % 3)); if (kt_ + 2 < nkt) MLA_DMAK(kt_ + 2, MLA_KB_(((BI) + 2) % 3)); } \
                MLA_STAGE(Sb, Sa, MLA_KB_(BI) + 32 * MLA_KRS + klane, MLA_VB_(BI) + vlane, 2 * kt_ + 1); \
                } while (0)
            const int nlast = 8 * qb + w;
            f32x16 Sa, Sb;
#pragma unroll
            for (int r = 0; r < 16; ++r) { Sa[r] = 0.f; Sb[r] = -__builtin_inff(); }
            __syncthreads();
            MLA_DMAK(0, MLA_KB_(0)); MLA_DMAV(0, MLA_VB_(0));
            if (nkt > 1) MLA_DMAK(1, MLA_KB_(1));
#pragma unroll 1
            for (int kt = 0; kt < nkt; kt += 3) {
                MLA_TILE(kt, 0);
                if (kt + 1 < nkt) MLA_TILE(kt + 1, 1);
                if (kt + 2 < nkt) MLA_TILE(kt + 2, 2);
            }
            if (w == 7) { MLA_PEND_PLAIN(Sb, MLA_VB_((nkt - 1) % 3) + 16 * 512 + vlane); }
#undef MLA_TILE
#undef MLA_STAGE
#undef MLA_PEND_PLAIN
#undef MLA_DMAK
#undef MLA_DMAV
            const float ltot = lrun + __shfl_xor(lrun, 32);
            const float inv = 1.0f / ltot;
            char* op = OUTBc + (row0 * 2048 + hh * 128); const unsigned oo = (unsigned)(l31 * 2048 + 4 * h);
            const float inv16 = inv * 16.0f;
#pragma unroll
            for (int db = 0; db < 4; ++db)
#pragma unroll
                for (int g4 = 0; g4 < 4; ++g4) { int wv = __builtin_amdgcn_cvt_pk_fp8_f32(O[db][4 * g4] * inv16, O[db][4 * g4 + 1] * inv16, 0, false); wv = __builtin_amdgcn_cvt_pk_fp8_f32(O[db][4 * g4 + 2] * inv16, O[db][4 * g4 + 3] * inv16, wv, true);
                    *(unsigned*)(op + oo + 32 * db + 8 * g4) = (unsigned)wv; }
        }
    }
    __syncthreads();
}

__device__ __forceinline__ void p7_router(Frame& F) {
    const char* Hc = (const char*)(F.ws + WS_H);
    const bf16_t* WRH = (const bf16_t*)(F.ws + WS_WRT); const bf16_t* WRL = WRH + NEXP * DM;
    int* TOPE = (int*)(F.ws + WS_TOPE); float* TOPW = (float*)(F.ws + WS_TOPW); int* CNT = (int*)(F.ws + WS_CNT);
    const float* SSQH = (const float*)(F.ws + WS_CKV); unsigned char* HN8 = (unsigned char*)(F.ws + WS_XN);
    constexpr int A_BYTES = 32 * 4096, LG_OFF = A_BYTES, HIST_OFF = LG_OFF + 32 * 33 * 4, RS_OFF = HIST_OFF + 128;
    LAS float* red = (LAS float*)F.lds; LAS float* lg = (LAS float*)(F.lds + LG_OFF); LAS int* hist = (LAS int*)(F.lds + HIST_OFF); LAS float* rsl = (LAS float*)(F.lds + RS_OFF);
    int lane = F.lane; asm volatile("" : "+v"(lane));
    const int w = F.wave, l31 = lane & 31, h = lane >> 5;
    bf16x8 bh[16];
#pragma unroll
    for (int ks = 0; ks < 16; ++ks) { const size_t bo = (size_t)l31 * DM + 256 * w + 16 * ks + 8 * h; bh[ks] = *(const bf16x8*)(WRH + bo); }
    for (int c = F.bx; c < NTOK / 128; c += F.G) {
        __syncthreads();
        if (F.tid < NEXP) hist[F.tid] = 0;
        for (int tt = 0; tt < 4; ++tt) {
            const int r0 = 128 * c + 32 * tt;
            __syncthreads();
            { const char* hb = Hc + (size_t)r0 * 4096;
#pragma unroll
              for (int j = 0; j < 16; ++j) { const int p = w + 8 * j, s_ = 64 * p + lane, row = s_ >> 8, pos = s_ & 255;
                  glds16_asm(hb, (unsigned)(row * 4096 + ((pos ^ (row & 15)) << 4)), (unsigned)(size_t)(F.lds + p * 1024)); } }
            if (F.tid < 32) { const float* sp = SSQH + (size_t)(r0 + F.tid) * 32; float ssum = 0.f;
#pragma unroll
                for (int q4 = 0; q4 < 8; ++q4) { const f32x4 v = *(const f32x4*)(sp + 4 * q4); ssum += (v[0] + v[1]) + (v[2] + v[3]); }
                const float rs = 1.0f / sqrtf(ssum * (1.0f / DM) + EPS); rsl[F.tid] = rs; }
            asm volatile("s_waitcnt vmcnt(0)" ::: "memory");
            __syncthreads();
            f32x16 acc;
#pragma unroll
            for (int r = 0; r < 16; ++r) acc[r] = 0.f;
#pragma unroll
            for (int ks = 0; ks < 16; ++ks) { const int ch = 32 * w + 2 * ks + h;
                const bf16x8 ah = *(const LAS bf16x8*)(F.lds + l31 * 4096 + ((ch ^ (l31 & 15)) << 4));
                const bf16x8 blk = *(const bf16x8*)(WRL + (size_t)l31 * DM + 256 * w + 16 * ks + 8 * h);
                acc = __builtin_amdgcn_mfma_f32_32x32x16_bf16(ah, bh[ks], acc, 0, 0, 0);
                acc = __builtin_amdgcn_mfma_f32_32x32x16_bf16(ah, blk, acc, 0, 0, 0); }
#pragma unroll 4
            for (int j = 0; j < 16; ++j) { const int s_ = F.tid + 512 * j, row = s_ >> 8, g = (s_ & 255) ^ (row & 15); const float rs = rsl[row];
                const u32x4 hw = *(const LAS u32x4*)(F.lds + s_ * 16);
                int y0 = __builtin_amdgcn_cvt_pk_fp8_f32(bf_lo(hw.x) * rs, bf_hi(hw.x) * rs, 0, false); y0 = __builtin_amdgcn_cvt_pk_fp8_f32(bf_lo(hw.y) * rs, bf_hi(hw.y) * rs, y0, true);
                int y1 = __builtin_amdgcn_cvt_pk_fp8_f32(bf_lo(hw.z) * rs, bf_hi(hw.z) * rs, 0, false); y1 = __builtin_amdgcn_cvt_pk_fp8_f32(bf_lo(hw.w) * rs, bf_hi(hw.w) * rs, y1, true);
                *(u32x2*)(HN8 + (size_t)(r0 + row) * DM + g * 8) = (u32x2){(unsigned)y0, (unsigned)y1}; }
            __syncthreads();
#pragma unroll
            for (int r = 0; r < 16; ++r) red[(w * 32 + crow(r, h)) * 32 + l31] = acc[r];
            __syncthreads();
#pragma unroll
            for (int q = 0; q < 2; ++q) { const int idx = F.tid + 512 * q, row = idx >> 5, e = idx & 31; float sum = 0.f;
#pragma unroll
                for (int ww = 0; ww < 8; ++ww) sum += red[(ww * 32 + row) * 32 + e];
                lg[row * 33 + e] = sum * rsl[row] + F.b_router[e]; }
            __syncthreads();
#pragma unroll
            for (int rr = 0; rr < 4; ++rr) {
                float lv = (lane < 32) ? lg[(4 * w + rr) * 33 + l31] : -1e30f; float tv[4]; int te[4];
#pragma unroll
                for (int k = 0; k < 4; ++k) {
                    float bv = lv; int bi = lane;
#pragma unroll
                    for (int o = 1; o < 64; o <<= 1) { const float ov = __shfl_xor(bv, o); const int oi = __shfl_xor(bi, o); if (ov > bv || (ov == bv && oi < bi)) { bv = ov; bi = oi; } }
                    tv[k] = bv; te[k] = bi; if (lane == bi) lv = -3e38f;
                }
                const float e1 = __expf(tv[1] - tv[0]), e2 = __expf(tv[2] - tv[0]), e3 = __expf(tv[3] - tv[0]); const float inv = 1.0f / (1.0f + e1 + e2 + e3);
                if (lane == 0) { const int row = r0 + 4 * w + rr;
                    *(int4*)(TOPE + (size_t)row * 4) = make_int4(te[0], te[1], te[2], te[3]);
                    *(float4*)(TOPW + (size_t)row * 4) = make_float4(inv, e1 * inv, e2 * inv, e3 * inv);
                    atomicAdd((int*)hist + te[0], 1); atomicAdd((int*)hist + te[1], 1); atomicAdd((int*)hist + te[2], 1); atomicAdd((int*)hist + te[3], 1); }
            }
        }
        __syncthreads();
        if (F.tid < NEXP) CNT[c * NEXP + F.tid] = hist[F.tid];
    }
    __syncthreads();
}

__device__ __forceinline__ void p8_slots(Frame& F) {
    const int* CNT = (const int*)(F.ws + WS_CNT); const int* TOPE = (const int*)(F.ws + WS_TOPE);
    int* SLOT = (int*)(F.ws + WS_SLOT); int* ROWTOK = (int*)(F.ws + WS_ROWTOK); int* TILEE = (int*)(F.ws + WS_TILEE);
    LAS int* red_all = (LAS int*)F.lds;
    LAS int* red_pre = red_all + 512;
    LAS int* tot = red_pre + 512;
    LAS int* pre = tot + 32;
    LAS int* pstart = pre + 32;
    LAS int* le = pstart + 64;
    LAS int* ls = le + 512;
    constexpr int NCH = NTOK / 128;
    for (int c = F.bx; c < NCH; c += F.G) {
        __syncthreads();
        { const int e = F.tid & 31, part = F.tid >> 5; int sa = 0, sp = 0;
          for (int cc = part; cc < NCH; cc += 16) { const int v = CNT[cc * NEXP + e]; sa += v; if (cc < c) sp += v; }
          red_all[part * 32 + e] = sa; red_pre[part * 32 + e] = sp; }
        le[F.tid] = TOPE[(size_t)c * 512 + F.tid];
        __syncthreads();
        if (F.tid < 32) { int sa = 0, sp = 0;
#pragma unroll
            for (int p = 0; p < 16; ++p) { sa += red_all[p * 32 + F.tid]; sp += red_pre[p * 32 + F.tid]; }
            tot[F.tid] = sa; pre[F.tid] = sp; }
        __syncthreads();
        if (F.tid == 0) { int a = 0; for (int e = 0; e < NEXP; ++e) { pstart[e] = a; a += (tot[e] + 255) / 256 * 256; } pstart[32] = a; }
        __syncthreads();
        if (F.tid < 32) { const int e = F.tid; int run = pstart[e] + pre[e];
            for (int a = 0; a < 512; ++a) { if (le[a] == e) { ls[a] = run; ++run; } } }
        __syncthreads();
        { const int a = F.tid, token = 128 * c + (a >> 2), slot = ls[a]; SLOT[(size_t)c * 512 + a] = slot; ROWTOK[slot] = token; }
        if (c < NEXP) { const int e = c; for (int r = pstart[e] + tot[e] + F.tid; r < pstart[e + 1]; r += NTHREADS) ROWTOK[r] = 0; }
        if (c == 0) { const int ntl = pstart[32] / 256;
            for (int t = F.tid; t < ntl; t += NTHREADS) { int e = 0; for (int q = 1; q < NEXP; ++q) if (t * 256 >= pstart[q]) e = q; TILEE[t] = e; }
            if (F.tid == 0) F.ctl[CW_NT] = (unsigned)ntl; }
    }
    __syncthreads();
}

__device__ __forceinline__ void p11_final(Frame& F) {
    const int gw = F.bx * NWAVES + F.wave, NGW = F.G * NWAVES, lane = F.lane;
    const bf16_t* YB = (const bf16_t*)(F.ws + WS_YBUF); const int* SLOT = (const int*)(F.ws + WS_SLOT); const float* TOPW = (const float*)(F.ws + WS_TOPW);
#ifdef DBG_DUMP
    for (int m = gw; m < NTOK; m += NGW) {
        const bf16_t* src = (const bf16_t*)(F.ws + DBG_DUMP_OFF) + (size_t)((m + DBG_DUMP_SHIFT) % NTOK) * DBG_DUMP_PITCH + DBG_DUMP_COL;
        #ifdef DBG_TWICE
        const bf16_t* src2 = (const bf16_t*)(F.ws + WS_ACT) + (size_t)m * DBG_DUMP_PITCH + DBG_DUMP_COL;
        for (int d = lane; d < DM; d += 64) F.out[(size_t)m * DM + d] = (bf_lo((unsigned)src[d]) - bf_lo((unsigned)src2[d])) * 1000.f + 1.0f;
#else
        for (int d = lane; d < DM; d += 64) F.out[(size_t)m * DM + d] = (d < DBG_DUMP_N) ? bf_lo((unsigned)src[d]) : 0.f;
#endif
    }
    return;
#endif
    constexpr int R11 = 2;
    typedef float f32x2_ __attribute__((ext_vector_type(2)));
    int4 sl[R11]; float4 tw[R11];
#pragma unroll
    for (int q = 0; q < R11; ++q) { const int m = gw + q * NGW; sl[q] = make_int4(0, 0, 0, 0); tw[q] = make_float4(0.f, 0.f, 0.f, 0.f);
        if (m < NTOK) { sl[q] = *(const int4*)(SLOT + (size_t)m * 4); tw[q] = *(const float4*)(TOPW + (size_t)m * 4); } }
    for (int m0 = gw; m0 < NTOK; m0 += R11 * NGW) {
        u32x2 hw[R11][8]; unsigned ya[R11][8], yb[R11][8], yc[R11][8], yd[R11][8];
#pragma unroll
        for (int q = 0; q < R11; ++q) { const int m = m0 + q * NGW; if (m < NTOK) {
            const u32x2* hb = (const u32x2*)((const bf16_t*)(F.ws + WS_H) + (size_t)m * DM) + lane;
            const unsigned* y0 = (const unsigned*)((const unsigned char*)YB + (size_t)sl[q].x * DM) + lane; const unsigned* y1 = (const unsigned*)((const unsigned char*)YB + (size_t)sl[q].y * DM) + lane;
            const unsigned* y2 = (const unsigned*)((const unsigned char*)YB + (size_t)sl[q].z * DM) + lane; const unsigned* y3 = (const unsigned*)((const unsigned char*)YB + (size_t)sl[q].w * DM) + lane;
#pragma unroll
            for (int j = 0; j < 8; ++j) { hw[q][j] = hb[64 * j]; ya[q][j] = y0[64 * j]; yb[q][j] = y1[64 * j]; yc[q][j] = y2[64 * j]; yd[q][j] = y3[64 * j]; } } }
        float4 twc[R11];
#pragma unroll
        for (int q = 0; q < R11; ++q) { twc[q] = tw[q]; const int mn = m0 + (R11 + q) * NGW;
            if (mn < NTOK) { sl[q] = *(const int4*)(SLOT + (size_t)mn * 4); tw[q] = *(const float4*)(TOPW + (size_t)mn * 4); } }
#pragma unroll
        for (int q = 0; q < R11; ++q) { const int m = m0 + q * NGW; if (m < NTOK) {
            f32x4* hr = (f32x4*)(F.out + (size_t)m * DM) + lane;
            f32x4 v[8]; float s = 0.f;
#pragma unroll
            for (int j = 0; j < 8; ++j) { v[j] = (f32x4){bf_lo(hw[q][j].x), bf_hi(hw[q][j].x), bf_lo(hw[q][j].y), bf_hi(hw[q][j].y)};
                const unsigned a = ya[q][j], b = yb[q][j], c = yc[q][j], d = yd[q][j];
                const f32x2_ a0 = __builtin_amdgcn_cvt_pk_f32_fp8((int)a, false), a1 = __builtin_amdgcn_cvt_pk_f32_fp8((int)a, true), b0 = __builtin_amdgcn_cvt_pk_f32_fp8((int)b, false), b1 = __builtin_amdgcn_cvt_pk_f32_fp8((int)b, true);
                const f32x2_ c0 = __builtin_amdgcn_cvt_pk_f32_fp8((int)c, false), c1 = __builtin_amdgcn_cvt_pk_f32_fp8((int)c, true), d0 = __builtin_amdgcn_cvt_pk_f32_fp8((int)d, false), d1 = __builtin_amdgcn_cvt_pk_f32_fp8((int)d, true);
                v[j].x += twc[q].x * a0[0] + twc[q].y * b0[0] + twc[q].z * c0[0] + twc[q].w * d0[0];
                v[j].y += twc[q].x * a0[1] + twc[q].y * b0[1] + twc[q].z * c0[1] + twc[q].w * d0[1];
                v[j].z += twc[q].x * a1[0] + twc[q].y * b1[0] + twc[q].z * c1[0] + twc[q].w * d1[0];
                v[j].w += twc[q].x * a1[1] + twc[q].y * b1[1] + twc[q].z * c1[1] + twc[q].w * d1[1];
                s += (v[j].x * v[j].x + v[j].y * v[j].y) + (v[j].z * v[j].z + v[j].w * v[j].w); }
            const float rstd = 1.0f / sqrtf(wave_sum(s) * (1.0f / DM) + EPS);
#pragma unroll
            for (int j = 0; j < 8; ++j) { const f32x4 gg = ((const f32x4*)F.g_final)[lane + 64 * j]; hr[64 * j] = v[j] * rstd * gg; } } }
    }
}

__global__ void __launch_bounds__(NTHREADS, 2) fwd_kernel(Args args) {
    __shared__ __attribute__((aligned(16))) unsigned char lds_raw[LDS_BYTES];
    Frame F;
    F.lds = (LAS unsigned char*)lds_raw; F.ws = args.ws; F.ctl = (unsigned*)(args.ws + WS_CTL);
    F.tid = threadIdx.x; F.lane = F.tid & 63; F.wave = __builtin_amdgcn_readfirstlane(F.tid >> 6); F.G = gridDim.x; F.bx = blockIdx.x;
    F.x = (const float*)args.in[0]; F.positions = (const int*)args.in[1]; F.g_attn = (const float*)args.in[2]; F.w_in = (const float*)args.in[3]; F.b_gate = (const float*)args.in[4];
    F.sinks = (const float*)args.in[5]; F.g_q = (const float*)args.in[6]; F.w_uq = (const float*)args.in[7]; F.g_kv = (const float*)args.in[8]; F.w_ukv = (const float*)args.in[9];
    F.w_o_swa = (const float*)args.in[10]; F.w_o_mla = (const float*)args.in[11]; F.w_out = (const float*)args.in[12]; F.g_ffn = (const float*)args.in[13]; F.w_router = (const float*)args.in[14];
    F.b_router = (const float*)args.in[15]; F.w_gate_up = (const float*)args.in[16]; F.b_gate_up = (const float*)args.in[17]; F.w_down = (const float*)args.in[18]; F.b_down = (const float*)args.in[19];
    F.g_final = (const float*)args.in[20]; F.out = args.out;
    volatile LAS unsigned* MISC = (volatile LAS unsigned*)(F.lds + MISC_OFF);
#ifdef DBG_ZERO_LDS
    for (int u = F.tid; u < RING_BYTES / 4; u += NTHREADS) ((LAS unsigned*)(F.lds))[u] = 0u;
#endif
    for (int u = F.tid; u < (LDS_BYTES - MISC_OFF) / 4; u += NTHREADS) ((LAS unsigned*)(F.lds + MISC_OFF))[u] = 0u;
    __syncthreads();
    const int lo = args.ph_lo, hi = args.ph_hi;
    const bool multi = (hi - lo) > 1;
    XcdBarrier bar; bar.bar = F.ctl + CW_BAR; bar.x = 0; bar.st = nullptr;
    if (multi) bar = xcd_barrier_post(F.ctl + CW_BAR, MISC + 8);
#ifndef PHMASK
#ifdef DBG_NOMOE
#define PHMASK 0x87F
#else
#define PHMASK 0xFFF
#endif
#endif
#define IN(k) (((PHMASK >> (k)) & 1) && lo <= (k) && (k) < hi)
#define SEAM(k) do { if (IN(k) && IN((k) + 1)) xcd_barrier(bar); } while (0)
    unsigned char* ws = args.ws;
    bf16_t* XN = (bf16_t*)(ws + WS_XN); bf16_t* PROJ = (bf16_t*)(ws + WS_PROJ); unsigned char* GATES = (unsigned char*)(ws + WS_GATES);
    const int* TILEE = (const int*)(ws + WS_TILEE); const int* ROWTOK = (const int*)(ws + WS_ROWTOK);

#ifndef REPMASK
#define REPMASK 0
#endif
#define NREP(k) (((REPMASK >> (k)) & 1) + 1)
    if (IN(0)) { for (int rep = 0; rep < NREP(0); ++rep) p0_prologue(F); SEAM(0); }
    if (IN(1)) {
        { pg8::Gemm8 g{(const unsigned char*)(ws + WS_XN8), (const unsigned char*)(ws + WS_WIN), DM, DM, nullptr, 0, (const int*)(ws + WS_IDROW)}; pg8::StaticOrder S; S.init(NTOK / 256, NPROJ / 256, F.G, F.bx);
          pg8::EpiProj8 E{PROJ, (float*)(ws + WS_CQ)};
          for (int rep = 0; rep < NREP(1); ++rep) pg8::gemm_phase_f8<pg8::EpiProj8>(F.lds, g, S, E); }
        { pg8::Gemm8 g{(const unsigned char*)(ws + WS_XN8), (const unsigned char*)(ws + WS_WIN + WIN_GATES_OFF), DM, DM, nullptr, 0, (const int*)(ws + WS_IDROW)}; pg8::StaticOrder S; S.init(NTOK / 256, NGATE / 256, F.G, F.bx);
          pg8::EpiGates8 E{GATES, F.b_gate};
          for (int rep = 0; rep < NREP(1); ++rep) pg8::gemm_phase_f8<pg8::EpiGates8>(F.lds, g, S, E); }
        SEAM(1);
    }
#ifdef DBG_TWICE
    if (IN(2)) {
        pg8::Gemm g{XN, (const bf16_t*)(ws + WS_WIN), DM, DM, nullptr, 0, nullptr}; pg8::StaticOrder S; S.init(NTOK / 256, NIN_PHYS / 256, F.G, F.bx);
        pg8::EpiProj E{(bf16_t*)(ws + WS_YBUF), (bf16_t*)(ws + WS_ACT), F.b_gate};
        pg8::gemm_phase<pg8::EpiProj, false, false>(F.lds, g, S, E);
    }
#else
#endif
    if (IN(3)) {
#ifndef P3_SKIP_GEMM
        { pg8::Gemm g{PROJ + PC_DQ, (const bf16_t*)(ws + WS_WUQ), NPROJ, 512, nullptr, 0, nullptr}; pg8::StaticOrder S; S.init(NTOK / 256, 1536 / 256, F.G, F.bx);
          pg8::EpiQn E{(bf16_t*)(ws + WS_QB), (const float*)(ws + WS_CQ), 0.07216878364870322f * 1.4426950408889634f};
          for (int rep = 0; rep < NREP(12); ++rep) pg8::gemm_phase<pg8::EpiQn, false, false>(F.lds, g, S, E); }
        { pg8::Gemm g{PROJ + PC_DKV, (const bf16_t*)(ws + WS_WUKV), NPROJ, 256, nullptr, 0, nullptr}; pg8::StaticOrder S; S.init(NTOK / 256, 2048 / 256, F.G, F.bx);
          pg8::EpiKVn E{(bf16_t*)(ws + WS_KMLA), (bf16_t*)(ws + WS_VMLA), (const float*)(ws + WS_CQ), PROJ, (const float*)(ws + WS_CS)};
          for (int rep = 0; rep < NREP(12); ++rep) pg8::gemm_phase<pg8::EpiKVn, false, false>(F.lds, g, S, E); }
#endif
#ifndef P3_SKIP_SWA
        for (int rep = 0; rep < NREP(3); ++rep) swa_phase(F);
#endif
        SEAM(3);
    }
    if (IN(4)) { for (int rep = 0; rep < NREP(4); ++rep) mla_phase(F); SEAM(4); }
    if (IN(5)) {
        pg8::Gemm8 g{(const unsigned char*)(ws + WS_OUTA), (const unsigned char*)(ws + WS_WOA), DM, DM, nullptr, 0, (const int*)(ws + WS_IDROW)}; pg8::StaticOrder S; S.init(NTOK / 256, DM / 256, F.G, F.bx);
        pg8::EpiGateMerge8 E{(unsigned char*)(ws + WS_MIX), GATES};
        for (int rep = 0; rep < NREP(5); ++rep) pg8::gemm_phase_f8<pg8::EpiGateMerge8, true>(F.lds, g, S, E);
        SEAM(5);
    }
    if (IN(6)) {
        pg8::Gemm8 g{(const unsigned char*)(ws + WS_MIX), (const unsigned char*)(ws + WS_WOUT), DM, DM, nullptr, 0, (const int*)(ws + WS_IDROW)}; pg8::StaticOrder S; S.init(NTOK / 256, DM / 256, F.G, F.bx);
        pg8::EpiRes8 E{F.x, (bf16_t*)(ws + WS_H), (float*)(ws + WS_CKV)};
        for (int rep = 0; rep < NREP(6); ++rep) pg8::gemm_phase_f8<pg8::EpiRes8>(F.lds, g, S, E);
        SEAM(6);
    }
    if (IN(7)) { for (int rep = 0; rep < NREP(7); ++rep) p7_router(F); SEAM(7); }
    if (IN(8)) { p8_slots(F); SEAM(8); }
    if (IN(9)) {
        const int ntl = (int)__hip_atomic_load(F.ctl + CW_NT, __ATOMIC_RELAXED, __HIP_MEMORY_SCOPE_AGENT);
        pg8::Gemm8 g{(const unsigned char*)XN, (const unsigned char*)(ws + WS_WGU), DM, DM, TILEE, (size_t)2 * DM * DM, ROWTOK}; pg8::StaticOrder S; S.init(ntl, 2 * DM / 256, F.G, F.bx);
        pg8::EpiSwiglu8 E{(unsigned char*)(ws + WS_ACT), F.b_gate_up, TILEE};
        for (int rep = 0; rep < NREP(9); ++rep) pg8::gemm_phase_f8<pg8::EpiSwiglu8>(F.lds, g, S, E);
        SEAM(9);
    }
#ifdef DBG_TWICE
    if (IN(10)) {
        const int gw = F.bx * NWAVES + F.wave, NGW = F.G * NWAVES; unsigned cnt = 0;
        for (int m = gw; m < NTOK; m += NGW) {
            const bf16_t* s1 = (const bf16_t*)(ws + DBG_CMP_OFF1) + (size_t)m * DBG_CMP_PITCH; const bf16_t* s2 = (const bf16_t*)(ws + DBG_CMP_OFF2) + (size_t)m * DBG_CMP_PITCH;
            for (int d = F.lane; d < 2048; d += 64) cnt += (s1[d] != s2[d]) ? 1u : 0u;
        }
        if (cnt) atomicAdd(F.ctl + 32, cnt);
    }
    if (IN(11)) {
        const unsigned c = __hip_atomic_load(F.ctl + 32, __ATOMIC_RELAXED, __HIP_MEMORY_SCOPE_AGENT);
        const float v = c == 0 ? 1.0f : (c < 1000u ? 2.0f : (c < 100000u ? 3.0f : (c < 10000000u ? 4.0f : 5.0f)));
        for (size_t i = (size_t)F.bx * NTHREADS + F.tid; i < (size_t)NTOK * DM; i += (size_t)F.G * NTHREADS) F.out[i] = v;
        return;
    }
#endif
    if (IN(10)) {
        const int ntl = (int)__hip_atomic_load(F.ctl + CW_NT, __ATOMIC_RELAXED, __HIP_MEMORY_SCOPE_AGENT);
        pg8::Gemm8 g{(const unsigned char*)(ws + WS_ACT), (const unsigned char*)(ws + WS_WD), DM, DM, TILEE, (size_t)DM * DM, (const int*)(ws + WS_IDROW)}; pg8::StaticOrder S; S.init(ntl, DM / 256, F.G, F.bx);
        pg8::EpiDown8 E{(unsigned char*)(ws + WS_YBUF), F.b_down, TILEE};
        for (int rep = 0; rep < NREP(10); ++rep) pg8::gemm_phase_f8<pg8::EpiDown8>(F.lds, g, S, E);
        SEAM(10);
    }
    if (IN(11)) { p11_final(F); }
#undef IN
#undef SEAM
}

extern "C" void kernel_launch(void* const* d_in, const int* in_sizes, int n_in, void* d_out, int out_size, void* d_ws, size_t ws_size, hipStream_t stream) {
    static int grid = 0;
    if (grid == 0) {
        if (n_in != 21 || out_size != NTOK * DM || ws_size < WS_END) { fprintf(stderr, "kernel_launch: unexpected problem (n_in %d, out %d, ws %zu)\n", n_in, out_size, ws_size); grid = -1; return; }
        int dev = 0, cus = 0, per_cu = 0;
        if (hipGetDevice(&dev) != hipSuccess || hipDeviceGetAttribute(&cus, hipDeviceAttributeMultiprocessorCount, dev) != hipSuccess) { grid = -1; return; }
        if (hipOccupancyMaxActiveBlocksPerMultiprocessor(&per_cu, (const void*)fwd_kernel, NTHREADS, 0) != hipSuccess || per_cu < 1) { fprintf(stderr, "kernel_launch: occupancy query says %d\n", per_cu); }
        (void)hipGetLastError();
        grid = cus;
    }
    if (grid < 0) return;
    if (hipMemsetAsync((char*)d_ws + WS_CTL, 0, CTL_ZERO_BYTES, stream) != hipSuccess) return;
    Args a{};
    for (int i = 0; i < 21; ++i) a.in[i] = d_in[i];
    a.out = (float*)d_out; a.ws = (unsigned char*)d_ws;
#if MK_ONE_LAUNCH
    a.ph_lo = 0; a.ph_hi = 12;
    hipLaunchKernelGGL(fwd_kernel, dim3(grid), dim3(NTHREADS), 0, stream, a);
#else
    for (int p = 0; p < 12; ++p) { a.ph_lo = p; a.ph_hi = p + 1; hipLaunchKernelGGL(fwd_kernel, dim3(grid), dim3(NTHREADS), 0, stream, a); }
#endif
}
```

```cpp
#include <hip/hip_runtime.h>
#include <cstdio>
#include <cstdint>

#ifndef MK_ONE_LAUNCH
#define MK_ONE_LAUNCH 1
#endif

#define LAS __attribute__((address_space(3)))
#define GAS __attribute__((address_space(1)))
typedef unsigned short bf16_t;
typedef short bf16x8 __attribute__((ext_vector_type(8)));
typedef short s16x4 __attribute__((ext_vector_type(4)));
typedef float f32x4 __attribute__((ext_vector_type(4)));
typedef float f32x16 __attribute__((ext_vector_type(16)));
typedef unsigned u32x4 __attribute__((ext_vector_type(4)));
typedef unsigned u32x2 __attribute__((ext_vector_type(2)));
typedef short v4i16_t __attribute__((ext_vector_type(4)));

constexpr int DM = 2048, BATCH = 16, SEQ = 2048, NTOK = BATCH * SEQ;
constexpr int NPROJ = 2304;
constexpr int PC_KA = 1024, PC_VA = 1152, PC_DQ = 1280, PC_DKV = 1792, PC_KR = 2048;
constexpr int NGATE = 4096, NIN_PHYS = 6400, NIN_LOG = 6208, NLOW = 2112;
constexpr int NEXP = 32, TOPK = 4, MAXTILES = 544, PROWS = MAXTILES * 256;
constexpr float EPS = 1e-6f;

constexpr size_t MiB = 1ull << 20;
constexpr size_t WS_CTL = 0, CTL_ZERO_BYTES = 1 * MiB;
constexpr size_t WS_CS = 1 * MiB, WS_WRT = 9 * MiB, WS_WIN = 10 * MiB, WS_WUQ = 36 * MiB, WS_WUKV = 38 * MiB, WS_WOA = 40 * MiB, WS_WOB = 45 * MiB, WS_WOUT = 50 * MiB;
constexpr size_t WS_WGU = 64 * MiB, WS_WD = 580 * MiB, WS_XN = 840 * MiB, WS_PROJ = 968 * MiB, WS_GATES = 1112 * MiB, WS_CQ = 1368 * MiB, WS_CKV = 1400 * MiB;
constexpr size_t WS_QB = 1416 * MiB, WS_KMLA = 1512 * MiB  , WS_VMLA = 1610 * MiB  ;
constexpr size_t WS_OUTA = 1676 * MiB, WS_OUTB = 1740 * MiB, WS_MIX = 1804 * MiB;
constexpr size_t WS_TOPE = 1932 * MiB, WS_TOPW = 1933 * MiB, WS_SLOT = 1934 * MiB, WS_ROWTOK = 1935 * MiB, WS_TILEE = 1936 * MiB, WS_CNT = 1937 * MiB;
constexpr size_t WS_ACT = 1940 * MiB, WS_YBUF = 2484 * MiB, WS_END = 3028 * MiB;
constexpr size_t WS_H = WS_OUTA;
constexpr size_t WS_XN8 = WS_YBUF  , WS_IDROW = 60 * MiB, WIN_GATES_OFF = 16 * MiB;
constexpr int LDPAD = 16;
constexpr int CW_NT = 16, CW_BAR = 4096;

constexpr int RING_BYTES = 131072, LDS_BYTES = 147456, MISC_OFF = LDS_BYTES - 256;
constexpr int NWAVES = 8, NTHREADS = 512;

__device__ __forceinline__ unsigned cvt_pk_bf16(float lo, float hi) { unsigned r; asm volatile("v_cvt_pk_bf16_f32 %0, %1, %2" : "=v"(r) : "v"(lo), "v"(hi)); return r; }
__device__ __forceinline__ unsigned cvt_pk_bf16_t(float lo, float hi) { unsigned r; asm volatile("s_nop 0\n\tv_cvt_pk_bf16_f32 %0, %1, %2" : "=v"(r) : "v"(lo), "v"(hi)); return r; }
__device__ __forceinline__ float bf_lo(unsigned w) { return __uint_as_float(w << 16); }
__device__ __forceinline__ float bf_hi(unsigned w) { return __uint_as_float(w & 0xffff0000u); }
__device__ __forceinline__ float wave_sum(float v) {
#pragma unroll
    for (int o = 1; o < 64; o <<= 1) v += __shfl_xor(v, o);
    return v;
}
__device__ __forceinline__ float fast_sigmoid(float x) { return __builtin_amdgcn_rcpf(1.0f + __builtin_amdgcn_exp2f(-1.4426950408889634f * x)); }
__device__ __forceinline__ const char* uni_ptr(const char* p) { const unsigned long long v = (unsigned long long)p; const unsigned lo = __builtin_amdgcn_readfirstlane((unsigned)v), hi = __builtin_amdgcn_readfirstlane((unsigned)(v >> 32)); return (const char*)(((unsigned long long)hi << 32) | lo); }
__device__ __forceinline__ void glds16_asm(const char* sbase, unsigned voff, unsigned lds_dst) {
    unsigned keep;
    asm volatile("s_mov_b32 %0, m0\n\ts_mov_b32 m0, %3\n\ts_nop 0\n\tglobal_load_lds_dwordx4 %1, %2\n\ts_mov_b32 m0, %0" : "=&s"(keep) : "v"(voff), "s"(sbase), "s"(lds_dst) : "memory");
}
#define LDS_WAIT() asm volatile("s_waitcnt lgkmcnt(0)" ::: "memory")

#define XB_TMO      128
#define XB_XCNT(j)  (256  + 64 * (j))
#define XB_XSUB(j)  (1280 + 64 * (j))
#define XB_XGEN(j)  (2304 + 64 * (j))
#define XB_TOP      3328
#define XB_TOPGEN   3392
#define XCD_BAR_WORDS 3456
#define XB_SPIN_CAP (1u << 18)
__device__ __forceinline__ unsigned xb_ld(unsigned* p)              { return __hip_atomic_load(p, __ATOMIC_RELAXED, __HIP_MEMORY_SCOPE_AGENT); }
__device__ __forceinline__ unsigned xb_add(unsigned* p, unsigned v) { return __hip_atomic_fetch_add(p, v, __ATOMIC_RELAXED, __HIP_MEMORY_SCOPE_AGENT); }
__device__ __forceinline__ unsigned xb_xcc_id() { return (unsigned)__builtin_amdgcn_s_getreg((3 << 11) | 20) & 0xFu; }
#define XB_SPIN(cond, bar) do { unsigned _sp = 0; while (cond) { __builtin_amdgcn_s_sleep(1); \
    if ((++_sp & 255u) == 0u) { if (xb_ld(&(bar)[XB_TMO])) break; if (_sp > XB_SPIN_CAP) { atomicAdd(&(bar)[XB_TMO], 1u); break; } } } } while (0)
struct XcdBarrier { unsigned* bar; unsigned x; volatile LAS unsigned* st; };
__device__ __forceinline__ XcdBarrier xcd_barrier_post(unsigned* bar, volatile LAS unsigned* st) {
    XcdBarrier b; b.bar = bar; b.x = xb_xcc_id(); b.st = st;
    if (threadIdx.x == 0) (void)xb_add(&bar[XB_XCNT(b.x)], 1u);
    return b;
}
__device__ __forceinline__ void xcd_barrier_complete(unsigned* bar, unsigned x, unsigned& nloc, unsigned& nx) {
    const unsigned G = gridDim.x * gridDim.y * gridDim.z;
    unsigned sum, cnt, mine, sp = 0u;
    for (;;) {
        sum = 0u; cnt = 0u; mine = 0u;
#pragma unroll
        for (unsigned j = 0; j < 16; ++j) { const unsigned c = xb_ld(&bar[XB_XCNT(j)]); sum += c; cnt += (c > 0u) ? 1u : 0u; mine = (j == x) ? c : mine; }
        if (sum == G) break;
        __builtin_amdgcn_s_sleep(1);
        if ((++sp & 255u) == 0u) { if (xb_ld(&bar[XB_TMO])) break; if (sp > XB_SPIN_CAP) { atomicAdd(&bar[XB_TMO], 1u); break; } }
    }
    nloc = mine > 0u ? mine : 1u; nx = cnt > 0u ? cnt : 1u;
}
__device__ __forceinline__ void xcd_barrier(const XcdBarrier& b) {
    asm volatile("s_waitcnt vmcnt(0)" ::: "memory");
    __syncthreads();
    if (threadIdx.x == 0) {
        unsigned* bar = b.bar;
        __builtin_amdgcn_s_waitcnt(0);
        unsigned nloc = b.st[0], nx = b.st[1];
        if (nloc == 0u) { xcd_barrier_complete(bar, b.x, nloc, nx); b.st[0] = nloc; b.st[1] = nx; }
        const unsigned old = xb_add(&bar[XB_XSUB(b.x)], 1u);
        const unsigned gen = old / nloc;
        if (old + 1u == (gen + 1u) * nloc) {
            __builtin_amdgcn_fence(__ATOMIC_RELEASE, "agent");
            asm volatile("s_waitcnt vmcnt(0)" ::: "memory");
            const unsigned og = xb_add(&bar[XB_TOP], 1u);
            const unsigned tg = og / nx;
            if (og + 1u == (tg + 1u) * nx) xb_add(&bar[XB_TOPGEN], 1u);
            else XB_SPIN(xb_ld(&bar[XB_TOPGEN]) == tg, bar);
            __builtin_amdgcn_fence(__ATOMIC_ACQUIRE, "agent");
            xb_add(&bar[XB_XGEN(b.x)], 1u);
            asm volatile("s_waitcnt vmcnt(0)" ::: "memory");
        } else {
            XB_SPIN(xb_ld(&bar[XB_XGEN(b.x)]) == gen, bar);
            __builtin_amdgcn_fence(__ATOMIC_ACQUIRE, "agent");
            asm volatile("s_waitcnt vmcnt(0)" ::: "memory");
        }
    }
    __syncthreads();
}

namespace pg8 {
constexpr int BM = 256, BK = 64, HALF = 128, HTB = HALF * BK * 2, STAGE_BYTES = 8 * HTB, NXCD = 8, WGM = 8;
__host__ __device__ __forceinline__ int lds_byte(int r, int c) { const int st = (r >> 4) * 2 + (c >> 5), rr = r & 15, cc = c & 31, ob = rr * 64 + cc * 2; return st * 1024 + (ob ^ (((ob >> 9) & 1) << 5)); }
__host__ __device__ __forceinline__ void stage_rc(int b, int& R, int& C) { const int st = b / 1024, sb = b % 1024, swz = sb ^ (((sb >> 9) & 1) << 5); R = (st >> 1) * 16 + swz / 64; C = (st & 1) * 32 + (swz % 64) / 2; }
__host__ __device__ __forceinline__ int perm32(int rho) { const int n = rho >> 4, i = rho & 15; return 8 * (i >> 2) + 4 * n + (i & 3); }
struct Unit { int pm, pn; };
struct Gemm { const bf16_t* A; const bf16_t* Bt; int lda, K; const int* tile_e; size_t estride; const int* rowtok; };
struct StaticOrder {
    int nM, nN, nwg, G, c;
    __device__ void init(int nM_, int nN_, int G_, int c_) { nM = nM_; nN = nN_; nwg = nM * nN; G = G_; c = c_; }
    __device__ bool next(int i, Unit& u) const {
        const long L = (long)i * G + c; if (L >= nwg) return false;
        int wgid = (int)L; { const int q = nwg / NXCD, r = nwg % NXCD, xcd = wgid % NXCD, off = wgid / NXCD; wgid = (xcd < r ? xcd * (q + 1) : r * (q + 1) + (xcd - r) * q) + off; }
        const int nig = WGM * nN, gid = wgid / nig, fm = gid * WGM, gsz = (nM - fm) < WGM ? (nM - fm) : WGM;
        u.pm = fm + ((wgid % nig) % gsz); u.pn = (wgid % nig) / gsz; return true;
    }
};
template <class Epi, bool GROUPED, bool GATHER, bool MIDHOOK = false>
__device__ __forceinline__ void gemm_phase(LAS unsigned char* lds, const Gemm g, const StaticOrder& S, const Epi& E) {
    int tid = threadIdx.x; asm volatile("" : "+v"(tid));
    const int wid = __builtin_amdgcn_readfirstlane(tid >> 6), lane = tid & 63, wr = wid >> 2, wc = wid & 3, fr = lane & 15, fq = lane >> 4;
    int K = g.K; asm volatile("" : "+s"(K));
    const int nt = K / BK, lda = g.lda;
    unsigned voffB[2];
#pragma unroll
    for (int i = 0; i < 2; ++i) { int R, C; stage_rc(tid * 16 + i * 8192, R, C); const int Rb = Epi::PERM ? ((R & ~31) + perm32(R & 31)) : R;
        (void)Rb; voffB[i] = (unsigned)(tid * 16 + i * 8192); }
    const size_t kstep = (size_t)(BK * 2);
    const size_t kstepB = 32768, hstepB = 16384, tstepB = (size_t)nt * 32768;
    const unsigned ldsw = (unsigned)wid * 1024u;
    const int aoff = lds_byte(wr * 64 + fr, fq * 8), boff = lds_byte(wc * 32 + fr, fq * 8);
#define PG8_SA(b, h) (((b) * 2 + (h)) * HTB)
#define PG8_SB(b, h) ((4 + (b) * 2 + (h)) * HTB)
#define PG8_STAGE(bufoff, gbase, voff) do { _Pragma("unroll") for (int _i = 0; _i < 2; ++_i) \
        __builtin_amdgcn_global_load_lds((const unsigned*)((const char*)(gbase) + (voff)[_i]), (LAS unsigned*)(lds + (bufoff) + ldsw + _i * 8192), 16, 0, 0); } while (0)
#define PG8_LDA(dst, b, h) do { _Pragma("unroll") for (int m = 0; m < 4; ++m) _Pragma("unroll") for (int k = 0; k < 2; ++k) dst[m][k] = *(const LAS bf16x8*)(lds + PG8_SA(b, h) + aoff + m * 2048 + k * 1024); } while (0)
#define PG8_LDB(dst, b, h) do { _Pragma("unroll") for (int n = 0; n < 2; ++n) _Pragma("unroll") for (int k = 0; k < 2; ++k) dst[n][k] = *(const LAS bf16x8*)(lds + PG8_SB(b, h) + boff + n * 2048 + k * 1024); } while (0)
#define PG8_MMA(ai, bj, At, Bt) do { __builtin_amdgcn_s_setprio(1); _Pragma("unroll") for (int m = 0; m < 4; ++m) _Pragma("unroll") for (int n = 0; n < 2; ++n) _Pragma("unroll") for (int k = 0; k < 2; ++k) \
        acc[ai][bj][m][n] = __builtin_amdgcn_mfma_f32_16x16x32_bf16(Bt[n][k], At[m][k], acc[ai][bj][m][n], 0, 0, 0); __builtin_amdgcn_s_setprio(0); } while (0)
#ifdef DBG_SAFE_GEMM
#define PG8_WAIT_V(n) asm volatile("s_waitcnt vmcnt(0)" ::: "memory")
#else
#define PG8_WAIT_V(n) asm volatile("s_waitcnt vmcnt(" #n ")" ::: "memory")
#endif
#define PG8_WAIT_L(n) asm volatile("s_waitcnt lgkmcnt(" #n ")" ::: "memory")
#define PG8_BAR __builtin_amdgcn_s_barrier()
#define PG8_SCHED __builtin_amdgcn_sched_barrier(0)
#define PG8_AOFF(vo, u) do { int _t = tid; asm volatile("" : "+v"(_t));     \
        _Pragma("unroll") for (int _i = 0; _i < 2; ++_i) { int _R, _C; stage_rc(_t * 16 + _i * 8192, _R, _C); \
        _Pragma("unroll") for (int _h = 0; _h < 2; ++_h) { \
        const int _r = (u).pm * BM + _h * HALF + _R; (vo)[_h][_i] = (unsigned)(g.rowtok[_r] * lda + _C) * 2u; } } } while (0)
#define PG8_STGA(bufoff, aptr, gptr, h, vo) do { if constexpr (GATHER) PG8_STAGE(bufoff, gptr, (vo)[h]); else PG8_STAGE(bufoff, (aptr) + (h) * hstepA, voffA); } while (0)
    Unit cur, nxt; int ui = 0;
    if (!S.next(0, cur)) return;
    f32x4 acc[2][2][4][2];
#pragma unroll
    for (int a = 0; a < 2; ++a)
#pragma unroll
        for (int b = 0; b < 2; ++b)
#pragma unroll
            for (int m = 0; m < 4; ++m)
#pragma unroll
                for (int n = 0; n < 2; ++n) acc[a][b][m][n] = (f32x4){0.f, 0.f, 0.f, 0.f};
    bf16x8 At[4][2], B0[2][2], B1[2][2];
    unsigned voC[2][2], voffA[2];
    LAS u32x4* const gslot = (LAS u32x4*)(lds + STAGE_BYTES) + tid;
    const size_t hstepA = (size_t)HALF * lda * 2, tstepA = 2 * hstepA;
    if constexpr (GATHER) { PG8_AOFF(voC, cur); voffA[0] = 0; voffA[1] = 0; }
    else {
#pragma unroll
        for (int i = 0; i < 2; ++i) { int R, C; stage_rc(tid * 16 + i * 8192, R, C); voffA[i] = (unsigned)(R * lda + C) * 2u; }
#pragma unroll
        for (int h = 0; h < 2; ++h)
#pragma unroll
            for (int i = 0; i < 2; ++i) voC[h][i] = 0;
    }
    const char* const Abase = (const char*)g.A;
    const char* cA = GATHER ? Abase : Abase + (size_t)cur.pm * tstepA;
    const char* cB = (const char*)g.Bt + (GROUPED ? (size_t)g.tile_e[cur.pm] * g.estride * 2 : (size_t)0) + (size_t)cur.pn * tstepB;
    PG8_STAGE(PG8_SB(0, 0), cB, voffB); PG8_STAGE(PG8_SB(0, 1), cB + hstepB, voffB); PG8_STGA(PG8_SA(0, 0), cA, Abase, 0, voC); PG8_STGA(PG8_SA(0, 1), cA, Abase, 1, voC);
    if (wr == 1) PG8_BAR;
    PG8_WAIT_V(2); PG8_BAR;
    PG8_STAGE(PG8_SB(1, 0), cB + kstepB, voffB); PG8_STGA(PG8_SA(1, 0), cA + kstep, Abase + kstep, 0, voC); PG8_STAGE(PG8_SB(1, 1), cB + hstepB + kstepB, voffB);
    PG8_WAIT_V(6); PG8_BAR;
    for (;;) {
        const bool has_next = S.next(ui + 1, nxt);
        const char* nB = cB; const char* nA = cA;
        if (has_next) { nB = (const char*)g.Bt + (GROUPED ? (size_t)g.tile_e[nxt.pm] * g.estride * 2 : (size_t)0) + (size_t)nxt.pn * tstepB;
            if constexpr (GATHER) { unsigned vt[2][2]; PG8_AOFF(vt, nxt); *gslot = (u32x4){vt[0][0], vt[0][1], vt[1][0], vt[1][1]}; } else nA = Abase + (size_t)nxt.pm * tstepA; }
        else if constexpr (GATHER) *gslot = (u32x4){voC[0][0], voC[0][1], voC[1][0], voC[1][1]};
#pragma unroll 1
        for (int t = 0; t < nt; t += 2) {
            const bool last = (t == nt - 2);
            const char* a1 = cA + (size_t)(t + 1) * kstep;
            const char* a2 = last ? nA : cA + (size_t)(t + 2) * kstep; const char* b2 = last ? nB : cB + (size_t)(t + 2) * kstepB;
            const char* a3 = a2 + kstep; const char* b3 = b2 + kstepB;
            if constexpr (MIDHOOK) { if (t == nt / 2) { int ln_ = lane; asm volatile("" : "+v"(ln_)); E.mid(acc, cur, wr, wc, ln_ & 15, ln_ >> 4); } }
            PG8_LDB(B0, 0, 0); PG8_LDB(B1, 0, 1); PG8_SCHED; PG8_LDA(At, 0, 0); PG8_STGA(PG8_SA(1, 1), a1, a1, 1, voC);
            if constexpr (GATHER) { if (last) { const u32x4 q = *gslot; voC[0][0] = q.x; voC[0][1] = q.y; voC[1][0] = q.z; voC[1][1] = q.w; } }
            PG8_WAIT_V(8); PG8_WAIT_L(0); PG8_BAR; PG8_MMA(0, 0, At, B0); PG8_MMA(0, 1, At, B1); PG8_BAR; PG8_SCHED;
            PG8_LDA(At, 0, 1); PG8_STAGE(PG8_SB(0, 0), b2, voffB); PG8_STAGE(PG8_SB(0, 1), b2 + hstepB, voffB); PG8_STGA(PG8_SA(0, 0), a2, a2, 0, voC);
            PG8_WAIT_V(8); PG8_WAIT_L(0); PG8_BAR; PG8_MMA(1, 0, At, B0); PG8_MMA(1, 1, At, B1); PG8_BAR; PG8_SCHED;
            PG8_LDB(B0, 1, 0); PG8_LDB(B1, 1, 1); PG8_SCHED; PG8_LDA(At, 1, 0); PG8_STGA(PG8_SA(0, 1), a2, a2, 1, voC);
            PG8_WAIT_V(8); PG8_WAIT_L(0); PG8_BAR; PG8_MMA(0, 0, At, B0); PG8_MMA(0, 1, At, B1); PG8_BAR; PG8_SCHED;
            PG8_LDA(At, 1, 1); PG8_STAGE(PG8_SB(1, 0), b3, voffB); PG8_STAGE(PG8_SB(1, 1), b3 + hstepB, voffB); PG8_STGA(PG8_SA(1, 0), a3, a3, 0, voC);
            PG8_WAIT_V(8); PG8_WAIT_L(0); PG8_BAR; PG8_MMA(1, 0, At, B0); PG8_MMA(1, 1, At, B1); PG8_BAR; PG8_SCHED;
        }
        if (wr == 0) PG8_BAR;
        { int ln_ = lane; asm volatile("" : "+v"(ln_)); E(acc, cur, wr, wc, ln_ & 15, ln_ >> 4); }
        if (!has_next) break;
#pragma unroll
        for (int a = 0; a < 2; ++a)
#pragma unroll
            for (int b = 0; b < 2; ++b)
#pragma unroll
                for (int m = 0; m < 4; ++m)
#pragma unroll
                    for (int n = 0; n < 2; ++n) acc[a][b][m][n] = (f32x4){0.f, 0.f, 0.f, 0.f};
        cur = nxt; cB = nB; cA = nA; ++ui;
        if (wr == 1) PG8_BAR;
    }
    PG8_WAIT_V(0);
    PG8_BAR;
#undef PG8_SA
#undef PG8_SB
#undef PG8_STAGE
#undef PG8_LDA
#undef PG8_LDB
#undef PG8_MMA
#undef PG8_WAIT_V
#undef PG8_WAIT_L
#undef PG8_BAR
#undef PG8_SCHED
#undef PG8_AOFF
#undef PG8_STGA
}

struct GemmO { const bf16_t* A; const bf16_t* Bt; int M, N, K; };
template <class Epi, class Sched, bool ALIGN_EPI = false, bool SP2 = false>
__device__ __forceinline__ void gemm_phase_orig(LAS unsigned char* lds, const GemmO g, const Sched& S, const Epi& E) {
    const int tid = threadIdx.x, wid = __builtin_amdgcn_readfirstlane(tid >> 6), lane = tid & 63, wr = wid >> 2, wc = wid & 3, fr = lane & 15, fq = lane >> 4;
    const int K = g.K, nt = K / BK;
    unsigned voffA[2], voffB[2];
#pragma unroll
    for (int i = 0; i < 2; ++i) { int R, C; stage_rc(tid * 16 + i * 8192, R, C); const int Rb = Epi::PERM ? ((R & ~31) + perm32(R & 31)) : R;
        voffA[i] = (unsigned)(R * K + C) * 2u; voffB[i] = (unsigned)(Rb * K + C) * 2u; }
    const size_t kstep = (size_t)(BK * 2);
    const size_t hstep = (size_t)HALF * K * 2;
    const size_t tstep = 2 * hstep;
    const unsigned ldsw = (unsigned)wid * 1024u;
    const int aoff = lds_byte(wr * 64 + fr, fq * 8), boff = lds_byte(wc * 32 + fr, fq * 8);
#define PG8_SA(b, h) (((b) * 2 + (h)) * HTB)
#define PG8_SB(b, h) ((4 + (b) * 2 + (h)) * HTB)
#define PG8_STAGE(bufoff, gbase, voff) do { _Pragma("unroll") for (int _i = 0; _i < 2; ++_i) \
        __builtin_amdgcn_global_load_lds((const unsigned*)((const char*)(gbase) + (voff)[_i]), (LAS unsigned*)(lds + (bufoff) + ldsw + _i * 8192), 16, 0, 0); } while (0)
#define PG8_LDA(dst, b, h) do { _Pragma("unroll") for (int m = 0; m < 4; ++m) _Pragma("unroll") for (int k = 0; k < 2; ++k) dst[m][k] = *(const LAS bf16x8*)(lds + PG8_SA(b, h) + aoff + m * 2048 + k * 1024); } while (0)
#define PG8_LDB(dst, b, h) do { _Pragma("unroll") for (int n = 0; n < 2; ++n) _Pragma("unroll") for (int k = 0; k < 2; ++k) dst[n][k] = *(const LAS bf16x8*)(lds + PG8_SB(b, h) + boff + n * 2048 + k * 1024); } while (0)
#define PG8_MMA(ai, bj, At, Bt) do { __builtin_amdgcn_s_setprio(1); _Pragma("unroll") for (int m = 0; m < 4; ++m) _Pragma("unroll") for (int n = 0; n < 2; ++n) _Pragma("unroll") for (int k = 0; k < 2; ++k) \
        acc[ai][bj][m][n] = __builtin_amdgcn_mfma_f32_16x16x32_bf16(Bt[n][k], At[m][k], acc[ai][bj][m][n], 0, 0, 0); __builtin_amdgcn_s_setprio(0); } while (0)
#define PG8_WAIT_V(n) asm volatile("s_waitcnt vmcnt(" #n ")" ::: "memory")
#define PG8_WAIT_L(n) asm volatile("s_waitcnt lgkmcnt(" #n ")" ::: "memory")
#define PG8_BAR __builtin_amdgcn_s_barrier()
#define PG8_SCHED __builtin_amdgcn_sched_barrier(0)
    Unit cur, nxt; int ui = 0;
    if (!S.next(0, cur)) return;
    f32x4 acc[2][2][4][2];
#pragma unroll
    for (int a = 0; a < 2; ++a)
#pragma unroll
        for (int b = 0; b < 2; ++b)
#pragma unroll
            for (int m = 0; m < 4; ++m)
#pragma unroll
                for (int n = 0; n < 2; ++n) acc[a][b][m][n] = (f32x4){0.f, 0.f, 0.f, 0.f};
    bf16x8 At[4][2], B0[2][2], B1[2][2];
    const char* cA = (const char*)g.A + (size_t)cur.pm * tstep; const char* cB = (const char*)g.Bt + (size_t)cur.pn * tstep;

    if constexpr (SP2) {
        PG8_STAGE(PG8_SB(0, 0), cB, voffB); PG8_STAGE(PG8_SB(0, 1), cB + hstep, voffB); PG8_STAGE(PG8_SA(0, 0), cA, voffA); PG8_STAGE(PG8_SA(0, 1), cA + hstep, voffA);
        if (wr == 1) PG8_BAR;
        PG8_WAIT_V(2); PG8_BAR;
        PG8_STAGE(PG8_SB(1, 0), cB + kstep, voffB); PG8_STAGE(PG8_SA(1, 0), cA + kstep, voffA); PG8_STAGE(PG8_SB(1, 1), cB + hstep + kstep, voffB);
        PG8_WAIT_V(6); PG8_BAR;
    } else {
        PG8_STAGE(PG8_SB(0, 0), cB, voffB); PG8_STAGE(PG8_SA(0, 0), cA, voffA); PG8_STAGE(PG8_SB(0, 1), cB + hstep, voffB); PG8_STAGE(PG8_SA(0, 1), cA + hstep, voffA);
        if (wr == 1) PG8_BAR;
        PG8_WAIT_V(4); PG8_BAR;
        PG8_STAGE(PG8_SB(1, 0), cB + kstep, voffB); PG8_STAGE(PG8_SA(1, 0), cA + kstep, voffA); PG8_STAGE(PG8_SB(1, 1), cB + hstep + kstep, voffB);
        PG8_WAIT_V(6); PG8_BAR;
    }
    for (;;) {
        const bool has_next = S.next(ui + 1, nxt);
        const char* nA = has_next ? (const char*)g.A + (size_t)nxt.pm * tstep : cA; const char* nB = has_next ? (const char*)g.Bt + (size_t)nxt.pn * tstep : cB;
        for (int t = 0; t < nt; t += 2) {
            const bool last = (t == nt - 2);
            const char* a1 = cA + (size_t)(t + 1) * kstep;
            const char* a2 = last ? nA : cA + (size_t)(t + 2) * kstep; const char* b2 = last ? nB : cB + (size_t)(t + 2) * kstep;
            const char* a3 = a2 + kstep; const char* b3 = b2 + kstep;

            if constexpr (SP2) {
            PG8_LDB(B0, 0, 0); PG8_LDB(B1, 0, 1); PG8_SCHED; PG8_LDA(At, 0, 0); PG8_STAGE(PG8_SA(1, 1), a1 + hstep, voffA);
            PG8_WAIT_V(8); PG8_WAIT_L(0); PG8_BAR; PG8_MMA(0, 0, At, B0); PG8_MMA(0, 1, At, B1); PG8_BAR; PG8_SCHED;
            PG8_LDA(At, 0, 1); PG8_STAGE(PG8_SB(0, 0), b2, voffB); PG8_STAGE(PG8_SB(0, 1), b2 + hstep, voffB); PG8_STAGE(PG8_SA(0, 0), a2, voffA);
            PG8_WAIT_V(8); PG8_WAIT_L(0); PG8_BAR; PG8_MMA(1, 0, At, B0); PG8_MMA(1, 1, At, B1); PG8_BAR; PG8_SCHED;
            PG8_LDB(B0, 1, 0); PG8_LDB(B1, 1, 1); PG8_SCHED; PG8_LDA(At, 1, 0); PG8_STAGE(PG8_SA(0, 1), a2 + hstep, voffA);
            PG8_WAIT_V(8); PG8_WAIT_L(0); PG8_BAR; PG8_MMA(0, 0, At, B0); PG8_MMA(0, 1, At, B1); PG8_BAR; PG8_SCHED;
            PG8_LDA(At, 1, 1); PG8_STAGE(PG8_SB(1, 0), b3, voffB); PG8_STAGE(PG8_SB(1, 1), b3 + hstep, voffB); PG8_STAGE(PG8_SA(1, 0), a3, voffA);
            PG8_WAIT_V(8); PG8_WAIT_L(0); PG8_BAR; PG8_MMA(1, 0, At, B0); PG8_MMA(1, 1, At, B1); PG8_BAR; PG8_SCHED;
            } else {
            PG8_LDB(B0, 0, 0); PG8_SCHED; PG8_LDA(At, 0, 0); PG8_STAGE(PG8_SA(1, 1), a1 + hstep, voffA);
            PG8_WAIT_L(8); PG8_BAR; PG8_WAIT_L(0); PG8_MMA(0, 0, At, B0); PG8_BAR; PG8_SCHED;
            PG8_LDB(B1, 0, 1); PG8_STAGE(PG8_SB(0, 0), b2, voffB);
            PG8_BAR; PG8_WAIT_L(0); PG8_MMA(0, 1, At, B1); PG8_BAR;
            PG8_LDA(At, 0, 1); PG8_STAGE(PG8_SA(0, 0), a2, voffA);
            PG8_BAR; PG8_WAIT_L(0); PG8_MMA(1, 0, At, B0); PG8_BAR; PG8_SCHED;
            PG8_STAGE(PG8_SB(0, 1), b2 + hstep, voffB);
            PG8_WAIT_V(6); PG8_BAR; PG8_MMA(1, 1, At, B1); PG8_BAR;
            PG8_LDB(B0, 1, 0); PG8_SCHED; PG8_LDA(At, 1, 0); PG8_STAGE(PG8_SA(0, 1), a2 + hstep, voffA);
            PG8_WAIT_L(8); PG8_BAR; PG8_WAIT_L(0); PG8_MMA(0, 0, At, B0); PG8_BAR; PG8_SCHED;
            PG8_LDB(B1, 1, 1); PG8_STAGE(PG8_SB(1, 0), b3, voffB);
            PG8_BAR; PG8_WAIT_L(0); PG8_MMA(0, 1, At, B1); PG8_BAR;
            PG8_LDA(At, 1, 1); PG8_STAGE(PG8_SA(1, 0), a3, voffA);
            PG8_BAR; PG8_WAIT_L(0); PG8_MMA(1, 0, At, B0); PG8_BAR; PG8_SCHED;
            PG8_STAGE(PG8_SB(1, 1), b3 + hstep, voffB);
            PG8_WAIT_V(6); PG8_BAR; PG8_MMA(1, 1, At, B1); PG8_BAR;
            }
        }
        if constexpr (ALIGN_EPI) { if (wr == 0) PG8_BAR; }
        E(acc, cur, wr, wc, fr, fq);
        if (!has_next) break;
#pragma unroll
        for (int a = 0; a < 2; ++a)
#pragma unroll
            for (int b = 0; b < 2; ++b)
#pragma unroll
                for (int m = 0; m < 4; ++m)
#pragma unroll
                    for (int n = 0; n < 2; ++n) acc[a][b][m][n] = (f32x4){0.f, 0.f, 0.f, 0.f};
        cur = nxt; cA = nA; cB = nB; ++ui;
        if constexpr (ALIGN_EPI) { if (wr == 1) PG8_BAR; }
    }
    PG8_WAIT_V(0);
    if constexpr (!ALIGN_EPI) { if (wr == 0) PG8_BAR; }
    PG8_BAR;
#undef PG8_SA
#undef PG8_SB
#undef PG8_STAGE
#undef PG8_LDA
#undef PG8_LDB
#undef PG8_MMA
#undef PG8_WAIT_V
#undef PG8_WAIT_L
#undef PG8_BAR
#undef PG8_SCHED
}

typedef const f32x4 (&AccRef)[2][2][4][2];
__device__ __forceinline__ u32x4 pack8(f32x4 v0, f32x4 v1) { u32x4 w; w.x = cvt_pk_bf16(v0[0], v0[1]); w.y = cvt_pk_bf16(v0[2], v0[3]); w.z = cvt_pk_bf16(v1[0], v1[1]); w.w = cvt_pk_bf16(v1[2], v1[3]); return w; }

struct EpiProj { static constexpr bool PERM = true;
    bf16_t* proj; bf16_t* gates; const float* b_gate;
    __device__ __forceinline__ void operator()(AccRef acc, const Unit& u, int wr, int wc, int fr, int fq) const {
        const int row0 = u.pm * BM + wr * 64 + fr;
        if (u.pn < 9) {
            const int col0 = u.pn * BM + wc * 64 + 16 * fq;
#pragma unroll
            for (int ai = 0; ai < 2; ++ai)
#pragma unroll
                for (int m = 0; m < 4; ++m) { bf16_t* rowp = proj + (size_t)(row0 + ai * HALF + m * 16) * NPROJ + col0;
#pragma unroll
                    for (int bj = 0; bj < 2; ++bj) *(u32x4*)(rowp + bj * 8) = pack8(acc[ai][bj][m][0], acc[ai][bj][m][1]); }
        } else {
            const int col0 = (u.pn - 9) * BM + wc * 64 + 16 * fq;
            f32x4 bv[2][2];
#pragma unroll
            for (int bj = 0; bj < 2; ++bj)
#pragma unroll
                for (int n = 0; n < 2; ++n) bv[bj][n] = *(const f32x4*)(b_gate + col0 + bj * 8 + 4 * n);
#pragma unroll
            for (int ai = 0; ai < 2; ++ai)
#pragma unroll
                for (int m = 0; m < 4; ++m) { bf16_t* rowp = gates + (size_t)(row0 + ai * HALF + m * 16) * NGATE + col0;
#pragma unroll
                    for (int bj = 0; bj < 2; ++bj) { f32x4 v0 = acc[ai][bj][m][0] + bv[bj][0], v1 = acc[ai][bj][m][1] + bv[bj][1];
#pragma unroll
                        for (int j = 0; j < 4; ++j) { v0[j] = fast_sigmoid(v0[j]); v1[j] = fast_sigmoid(v1[j]); }
                        u32x4 w; w.x = cvt_pk_bf16_t(v0[0], v0[1]); w.y = cvt_pk_bf16_t(v0[2], v0[3]); w.z = cvt_pk_bf16_t(v1[0], v1[1]); w.w = cvt_pk_bf16_t(v1[2], v1[3]);
                        *(u32x4*)(rowp + bj * 8) = w; } }
        }
    }
};
template <bool BIAS> struct EpiBf16 { static constexpr bool PERM = true;
    bf16_t* O; int ldc; const float* bias; const int* tile_e; int bstride; float scl;
    __device__ __forceinline__ void operator()(AccRef acc, const Unit& u, int wr, int wc, int fr, int fq) const {
        const int row0 = u.pm * BM + wr * 64 + fr, col0 = u.pn * BM + wc * 64 + 16 * fq;
        f32x4 bv[2][2];
#pragma unroll
        for (int bj = 0; bj < 2; ++bj)
#pragma unroll
            for (int n = 0; n < 2; ++n) bv[bj][n] = (f32x4){0.f, 0.f, 0.f, 0.f};
        if constexpr (BIAS) { const float* bp = bias + (size_t)tile_e[u.pm] * bstride + col0;
#pragma unroll
            for (int bj = 0; bj < 2; ++bj)
#pragma unroll
                for (int n = 0; n < 2; ++n) bv[bj][n] = *(const f32x4*)(bp + bj * 8 + 4 * n); }
#pragma unroll
        for (int ai = 0; ai < 2; ++ai)
#pragma unroll
            for (int m = 0; m < 4; ++m) { bf16_t* rowp = O + (size_t)(row0 + ai * HALF + m * 16) * ldc + col0;
#pragma unroll
                for (int bj = 0; bj < 2; ++bj) *(u32x4*)(rowp + bj * 8) = pack8((acc[ai][bj][m][0] + bv[bj][0]) * scl, (acc[ai][bj][m][1] + bv[bj][1]) * scl); }
    }
};
struct EpiKV { static constexpr bool PERM = true;
    bf16_t* kmla; bf16_t* vmla;
    __device__ __forceinline__ void operator()(AccRef acc, const Unit& u, int wr, int wc, int fr, int fq) const {
        const int row0 = u.pm * BM + wr * 64 + fr, c0 = wc * 32 + 8 * fq;
#pragma unroll
        for (int ai = 0; ai < 2; ++ai)
#pragma unroll
            for (int m = 0; m < 4; ++m) { const size_t row = (size_t)(row0 + ai * HALF + m * 16);
                const size_t hrow = ((row >> 11) * 8 + u.pn) * 2048 + (row & 2047);
                *(u32x4*)(kmla + hrow * 192 + c0) = pack8(acc[ai][0][m][0], acc[ai][0][m][1]);
                *(u32x4*)(vmla + hrow * 128 + c0) = pack8(acc[ai][1][m][0], acc[ai][1][m][1]); }
    }
};
template <bool ADD> struct EpiGateMix { static constexpr bool PERM = true;
    bf16_t* O; const unsigned char* gates; int goff;
    __device__ __forceinline__ void operator()(AccRef acc, const Unit& u, int wr, int wc, int fr, int fq) const {
        const int row0 = u.pm * BM + wr * 64 + fr, col0 = u.pn * BM + wc * 32 + 8 * fq;
        constexpr float I255 = 1.0f / 255.0f;
#pragma unroll
        for (int ai = 0; ai < 2; ++ai) {
            u32x2 gw[4][2]; u32x4 pw[4][2];
#pragma unroll
            for (int m = 0; m < 4; ++m)
#pragma unroll
                for (int bj = 0; bj < 2; ++bj) { const size_t row = (size_t)(row0 + ai * HALF + m * 16);
                    gw[m][bj] = *(const u32x2*)(gates + row * NGATE + goff + col0 + bj * HALF);
                    if constexpr (ADD) pw[m][bj] = *(const u32x4*)(O + row * DM + col0 + bj * HALF); }
            asm volatile("s_waitcnt vmcnt(0)" ::: "memory");
#pragma unroll
            for (int m = 0; m < 4; ++m)
#pragma unroll
                for (int bj = 0; bj < 2; ++bj) { const size_t row = (size_t)(row0 + ai * HALF + m * 16); const u32x2 g2 = gw[m][bj];
                    f32x4 v0 = acc[ai][bj][m][0], v1 = acc[ai][bj][m][1];
                    v0[0] *= (float)(g2.x & 0xffu) * I255; v0[1] *= (float)((g2.x >> 8) & 0xffu) * I255; v0[2] *= (float)((g2.x >> 16) & 0xffu) * I255; v0[3] *= (float)(g2.x >> 24) * I255;
                    v1[0] *= (float)(g2.y & 0xffu) * I255; v1[1] *= (float)((g2.y >> 8) & 0xffu) * I255; v1[2] *= (float)((g2.y >> 16) & 0xffu) * I255; v1[3] *= (float)(g2.y >> 24) * I255;
                    if constexpr (ADD) { const u32x4 p4 = pw[m][bj];
                        v0[0] += bf_lo(p4.x); v0[1] += bf_hi(p4.x); v0[2] += bf_lo(p4.y); v0[3] += bf_hi(p4.y);
                        v1[0] += bf_lo(p4.z); v1[1] += bf_hi(p4.z); v1[2] += bf_lo(p4.w); v1[3] += bf_hi(p4.w); }
                    *(u32x4*)(O + row * DM + col0 + bj * HALF) = pack8(v0, v1); }
            asm volatile("" ::: "memory");
        }
    }
};
struct EpiGateMerge { static constexpr bool PERM = true;
    unsigned char* O; const unsigned char* gates;
    template <bool FINAL, class AccT> __device__ __forceinline__ void scale(AccT& acc, const Unit& u, int wr, int wc, int fr, int fq) const {
        const int row0 = u.pm * BM + wr * 64 + fr, col0 = u.pn * BM + wc * 64 + 16 * fq;
#pragma unroll
        for (int ai = 0; ai < 2; ++ai) {
            u32x2 ga[4][2], gb[4][2];
#pragma unroll
            for (int m = 0; m < 4; ++m)
#pragma unroll
                for (int bj = 0; bj < 2; ++bj) { const size_t row = (size_t)(row0 + ai * HALF + m * 16);
                    if constexpr (!FINAL) ga[m][bj] = *(const u32x2*)(gates + row * NGATE + col0 + bj * 8);
                    gb[m][bj] = *(const u32x2*)(gates + row * NGATE + DM + col0 + bj * 8); }
            asm volatile("s_waitcnt vmcnt(0)" ::: "memory");
#pragma unroll
            for (int m = 0; m < 4; ++m)
#pragma unroll
                for (int bj = 0; bj < 2; ++bj) { const size_t row = (size_t)(row0 + ai * HALF + m * 16);
                    float f[8];
#pragma unroll
                    for (int j = 0; j < 8; ++j) { const unsigned wb = j < 4 ? gb[m][bj].x : gb[m][bj].y; const float b = fmaxf((float)((wb >> (8 * (j & 3))) & 0xffu), 1.0f);
                        if constexpr (FINAL) f[j] = b * (1.0f / 255.0f);
                        else { const unsigned wa = j < 4 ? ga[m][bj].x : ga[m][bj].y; f[j] = (float)((wa >> (8 * (j & 3))) & 0xffu) * __builtin_amdgcn_rcpf(b); } }
                    f32x4 v0 = acc[ai][bj][m][0], v1 = acc[ai][bj][m][1];
                    v0[0] *= f[0]; v0[1] *= f[1]; v0[2] *= f[2]; v0[3] *= f[3]; v1[0] *= f[4]; v1[1] *= f[5]; v1[2] *= f[6]; v1[3] *= f[7];
                    if constexpr (FINAL) { int w0 = __builtin_amdgcn_cvt_pk_fp8_f32(v0[0] * 16.0f, v0[1] * 16.0f, 0, false); w0 = __builtin_amdgcn_cvt_pk_fp8_f32(v0[2] * 16.0f, v0[3] * 16.0f, w0, true);
                        int w1 = __builtin_amdgcn_cvt_pk_fp8_f32(v1[0] * 16.0f, v1[1] * 16.0f, 0, false); w1 = __builtin_amdgcn_cvt_pk_fp8_f32(v1[2] * 16.0f, v1[3] * 16.0f, w1, true);
                        *(u32x2*)(O + row * DM + col0 + bj * 8) = (u32x2){(unsigned)w0, (unsigned)w1}; }
                    else { acc[ai][bj][m][0] = v0; acc[ai][bj][m][1] = v1; } }
            asm volatile("" ::: "memory");
        }
    }
    __device__ __forceinline__ void mid(f32x4 (&acc)[2][2][4][2], const Unit& u, int wr, int wc, int fr, int fq) const { scale<false>(acc, u, wr, wc, fr, fq); }
    __device__ __forceinline__ void operator()(AccRef acc, const Unit& u, int wr, int wc, int fr, int fq) const { scale<true>(acc, u, wr, wc, fr, fq); }
};
struct EpiResF32 { static constexpr bool PERM = false;
    const float* x; float* out;
    __device__ __forceinline__ void operator()(AccRef acc, const Unit& u, int wr, int wc, int fr, int fq) const {
        const int row0 = u.pm * BM + wr * 64 + fr, col0 = u.pn * BM + wc * 32 + 4 * fq;
#pragma unroll
        for (int ai = 0; ai < 2; ++ai) {
            f32x4 xv[4][2][2];
#pragma unroll
            for (int m = 0; m < 4; ++m) { const size_t off = (size_t)(row0 + ai * HALF + m * 16) * DM + col0;
#pragma unroll
                for (int bj = 0; bj < 2; ++bj)
#pragma unroll
                    for (int n = 0; n < 2; ++n) xv[m][bj][n] = *(const f32x4*)(x + off + bj * HALF + n * 16); }
            asm volatile("s_waitcnt vmcnt(0)" ::: "memory");
#pragma unroll
            for (int m = 0; m < 4; ++m) { const size_t off = (size_t)(row0 + ai * HALF + m * 16) * DM + col0;
#pragma unroll
                for (int bj = 0; bj < 2; ++bj)
#pragma unroll
                    for (int n = 0; n < 2; ++n) *(f32x4*)(out + off + bj * HALF + n * 16) = xv[m][bj][n] + acc[ai][bj][m][n]; }
            asm volatile("" ::: "memory");
        }
    }
};
struct EpiResBf16 { static constexpr bool PERM = true;
    const float* x; bf16_t* out;
    __device__ __forceinline__ void operator()(AccRef acc, const Unit& u, int wr, int wc, int fr, int fq) const {
        const int row0 = u.pm * BM + wr * 64 + fr, col0 = u.pn * BM + wc * 64 + 16 * fq;
#pragma unroll
        for (int ai = 0; ai < 2; ++ai) {
            f32x4 xv[4][2][2];
#pragma unroll
            for (int m = 0; m < 4; ++m) { const size_t off = (size_t)(row0 + ai * HALF + m * 16) * DM + col0;
#pragma unroll
                for (int bj = 0; bj < 2; ++bj)
#pragma unroll
                    for (int n = 0; n < 2; ++n) xv[m][bj][n] = *(const f32x4*)(x + off + bj * 8 + n * 4); }
            asm volatile("s_waitcnt vmcnt(0)" ::: "memory");
#pragma unroll
            for (int m = 0; m < 4; ++m) { const size_t off = (size_t)(row0 + ai * HALF + m * 16) * DM + col0;
#pragma unroll
                for (int bj = 0; bj < 2; ++bj) *(u32x4*)(out + off + bj * 8) = pack8(xv[m][bj][0] + acc[ai][bj][m][0], xv[m][bj][1] + acc[ai][bj][m][1]); }
            asm volatile("" ::: "memory");
        }
    }
};
struct EpiSwiglu { static constexpr bool PERM = true;
    bf16_t* act; const float* bgu; const int* tile_e;
    __device__ __forceinline__ void operator()(AccRef acc, const Unit& u, int wr, int wc, int fr, int fq) const {
        const int row0 = u.pm * BM + wr * 64 + fr, p0 = u.pn * BM + wc * 32 + 8 * fq;
        const float* bp = bgu + (size_t)tile_e[u.pm] * (2 * DM) + p0;
        f32x4 bg[2], bu[2];
#pragma unroll
        for (int bj = 0; bj < 2; ++bj) { const f32x4 a = *(const f32x4*)(bp + bj * HALF), b = *(const f32x4*)(bp + bj * HALF + 4);
            bg[bj] = (f32x4){a[0], a[2], b[0], b[2]}; bu[bj] = (f32x4){a[1], a[3], b[1], b[3]}; }
#pragma unroll
        for (int ai = 0; ai < 2; ++ai)
#pragma unroll
            for (int m = 0; m < 4; ++m) { bf16_t* rowp = act + (size_t)(row0 + ai * HALF + m * 16) * DM + (p0 >> 1);
#pragma unroll
                for (int bj = 0; bj < 2; ++bj) { const f32x4 gt = acc[ai][bj][m][0] + bg[bj], up = acc[ai][bj][m][1] + bu[bj]; float o[4];
#pragma unroll
                    for (int j = 0; j < 4; ++j) { const float gg = fminf(gt[j], 7.0f), uu = fminf(fmaxf(up[j], -7.0f), 7.0f); o[j] = gg * fast_sigmoid(1.702f * gg) * (uu + 1.0f); }
                    u32x2 w; w.x = cvt_pk_bf16(o[0], o[1]); w.y = cvt_pk_bf16(o[2], o[3]);
                    *(u32x2*)(rowp + bj * (HALF / 2)) = w; } }
    }
};

typedef int v8i32 __attribute__((ext_vector_type(8)));
__host__ __device__ __forceinline__ int sw8(int row) { return ((row >> 1) & 7) ^ ((((row >> 2) ^ (row >> 3)) & 1) << 1); }
__host__ __device__ __forceinline__ int img8(int row, int c) { return row * 128 + ((c ^ sw8(row)) << 4); }
struct Gemm8 { const unsigned char* A; const unsigned char* Bt; int lda, K; const int* tile_e; size_t estride; const int* rowtok; };
typedef const f32x4 (&AccRef8)[2][2][4][2];
template <class Epi, bool MIDHOOK = false>
__device__ __forceinline__ void gemm_phase_f8(LAS unsigned char* lds, const Gemm8 g, const StaticOrder& S, const Epi& E) {
    int tid = threadIdx.x; asm volatile("" : "+v"(tid));
    const int wid = __builtin_amdgcn_readfirstlane(tid >> 6), lane = tid & 63, wr = wid >> 2, wc = wid & 3, r15 = lane & 15, kq = lane >> 4;
    int K = g.K; asm volatile("" : "+s"(K));
    const int nt = K / 128, lda = g.lda;
    unsigned voffB[2];
#pragma unroll
    for (int i = 0; i < 2; ++i) voffB[i] = (unsigned)(tid * 16 + i * 8192);
    const size_t kstep = 128;
    const size_t kstepB = 32768, hstepB = 16384, tstepB = (size_t)nt * 32768;
    const unsigned ldsw = (unsigned)wid * 1024u;
    const int sw = sw8(r15);
    int aadr[2], badr[2];
#pragma unroll
    for (int x = 0; x < 2; ++x) { const int c = 2 * kq + x; aadr[x] = (wr * 64 + r15) * 128 + ((c ^ sw) << 4); badr[x] = (wc * 32 + r15) * 128 + ((c ^ sw) << 4); }
#define PF8_SA(b, h) (((b) * 2 + (h)) * HTB)
#define PF8_SB(b, h) ((4 + (b) * 2 + (h)) * HTB)
#define PF8_STAGE(bufoff, gbase, voff) do { _Pragma("unroll") for (int _i = 0; _i < 2; ++_i) \
        __builtin_amdgcn_global_load_lds((const unsigned*)((const char*)(gbase) + (voff)[_i]), (LAS unsigned*)(lds + (bufoff) + ldsw + _i * 8192), 16, 0, 0); } while (0)
#define PF8_LD(dst, off) do { const u32x4 _a = *(const LAS u32x4*)(lds + (off)[0]), _b = *(const LAS u32x4*)(lds + (off)[1]); \
        dst = (v8i32){(int)_a.x, (int)_a.y, (int)_a.z, (int)_a.w, (int)_b.x, (int)_b.y, (int)_b.z, (int)_b.w}; } while (0)
#define PF8_LDA(dst, b, h) do { _Pragma("unroll") for (int tb = 0; tb < 4; ++tb) { const int _o[2] = {PF8_SA(b, h) + aadr[0] + tb * 2048, PF8_SA(b, h) + aadr[1] + tb * 2048}; PF8_LD(dst[tb], _o); } } while (0)
#define PF8_LDB(dst, b, h) do { _Pragma("unroll") for (int pb = 0; pb < 2; ++pb) { const int _o[2] = {PF8_SB(b, h) + badr[0] + pb * 2048, PF8_SB(b, h) + badr[1] + pb * 2048}; PF8_LD(dst[pb], _o); } } while (0)
#define PF8_MMA(ai, bj, At, Bt) do { __builtin_amdgcn_s_setprio(1); _Pragma("unroll") for (int tb = 0; tb < 4; ++tb) _Pragma("unroll") for (int pb = 0; pb < 2; ++pb) \
        acc[ai][bj][tb][pb] = __builtin_amdgcn_mfma_scale_f32_16x16x128_f8f6f4(Bt[pb], At[tb], acc[ai][bj][tb][pb], 0, 0, 0, 0, 0, 0); __builtin_amdgcn_s_setprio(0); } while (0)
#define PF8_WAIT_V(n) asm volatile("s_waitcnt vmcnt(" #n ")" ::: "memory")
#define PF8_WAIT_L(n) asm volatile("s_waitcnt lgkmcnt(" #n ")" ::: "memory")
#define PF8_BAR __builtin_amdgcn_s_barrier()
#define PF8_SCHED __builtin_amdgcn_sched_barrier(0)
#define PF8_AOFF(vo, u) do { int _t = tid; asm volatile("" : "+v"(_t)); \
        _Pragma("unroll") for (int _i = 0; _i < 2; ++_i) { const int _p = _t + 512 * _i, _R = _p >> 3, _C = ((_p & 7) ^ sw8(_R)) << 4; \
        _Pragma("unroll") for (int _h = 0; _h < 2; ++_h) { const int _r = (u).pm * BM + _h * HALF + _R; (vo)[_h][_i] = (unsigned)(g.rowtok[_r] * lda + _C); } } } while (0)
    Unit cur, nxt; int ui = 0;
    if (!S.next(0, cur)) return;
    f32x4 acc[2][2][4][2];
#pragma unroll
    for (int a = 0; a < 2; ++a)
#pragma unroll
        for (int b = 0; b < 2; ++b)
#pragma unroll
            for (int m = 0; m < 4; ++m)
#pragma unroll
                for (int r = 0; r < 2; ++r) acc[a][b][m][r] = (f32x4){0.f, 0.f, 0.f, 0.f};
    v8i32 At[4], B0[2], B1[2];
    unsigned voC[2][2];
    LAS u32x4* const gslot = (LAS u32x4*)(lds + STAGE_BYTES) + tid;
    PF8_AOFF(voC, cur);
    const char* const Abase = (const char*)g.A;
    const char* cB = (const char*)g.Bt + (g.tile_e ? (size_t)g.tile_e[cur.pm] * g.estride : (size_t)0) + (size_t)cur.pn * tstepB;
    PF8_STAGE(PF8_SB(0, 0), cB, voffB); PF8_STAGE(PF8_SB(0, 1), cB + hstepB, voffB); PF8_STAGE(PF8_SA(0, 0), Abase, voC[0]); PF8_STAGE(PF8_SA(0, 1), Abase, voC[1]);
    if (wr == 1) PF8_BAR;
    PF8_WAIT_V(2); PF8_BAR;
    PF8_STAGE(PF8_SB(1, 0), cB + kstepB, voffB); PF8_STAGE(PF8_SA(1, 0), Abase + kstep, voC[0]); PF8_STAGE(PF8_SB(1, 1), cB + hstepB + kstepB, voffB);
    PF8_WAIT_V(6); PF8_BAR;
    for (;;) {
        const bool has_next = S.next(ui + 1, nxt);
        const char* nB = cB;
        if (has_next) { nB = (const char*)g.Bt + (g.tile_e ? (size_t)g.tile_e[nxt.pm] * g.estride : (size_t)0) + (size_t)nxt.pn * tstepB;
            unsigned vt[2][2]; PF8_AOFF(vt, nxt); *gslot = (u32x4){vt[0][0], vt[0][1], vt[1][0], vt[1][1]}; }
        else *gslot = (u32x4){voC[0][0], voC[0][1], voC[1][0], voC[1][1]};
#pragma unroll 1
        for (int t = 0; t < nt; t += 2) {
            const bool last = (t == nt - 2);
            if constexpr (MIDHOOK) { if (t == nt / 2) { int ln_ = lane; asm volatile("" : "+v"(ln_)); E.mid(acc, cur, wr, wc, ln_ & 15, ln_ >> 4); } }
            const char* a1 = Abase + (size_t)(t + 1) * kstep;
            const char* a2 = last ? Abase : Abase + (size_t)(t + 2) * kstep; const char* b2 = last ? nB : cB + (size_t)(t + 2) * kstepB;
            const char* a3 = a2 + kstep; const char* b3 = b2 + kstepB;
            PF8_LDB(B0, 0, 0); PF8_LDB(B1, 0, 1); PF8_SCHED; PF8_LDA(At, 0, 0); PF8_STAGE(PF8_SA(1, 1), a1, voC[1]);
            if (last) { const u32x4 q = *gslot; voC[0][0] = q.x; voC[0][1] = q.y; voC[1][0] = q.z; voC[1][1] = q.w; }
            PF8_WAIT_V(8); PF8_WAIT_L(0); PF8_BAR; PF8_MMA(0, 0, At, B0); PF8_MMA(0, 1, At, B1); PF8_BAR; PF8_SCHED;
            PF8_LDA(At, 0, 1); PF8_STAGE(PF8_SB(0, 0), b2, voffB); PF8_STAGE(PF8_SB(0, 1), b2 + hstepB, voffB); PF8_STAGE(PF8_SA(0, 0), a2, voC[0]);
            PF8_WAIT_V(8); PF8_WAIT_L(0); PF8_BAR; PF8_MMA(1, 0, At, B0); PF8_MMA(1, 1, At, B1); PF8_BAR; PF8_SCHED;
            PF8_LDB(B0, 1, 0); PF8_LDB(B1, 1, 1); PF8_SCHED; PF8_LDA(At, 1, 0); PF8_STAGE(PF8_SA(0, 1), a2, voC[1]);
            PF8_WAIT_V(8); PF8_WAIT_L(0); PF8_BAR; PF8_MMA(0, 0, At, B0); PF8_MMA(0, 1, At, B1); PF8_BAR; PF8_SCHED;
            PF8_LDA(At, 1, 1); PF8_STAGE(PF8_SB(1, 0), b3, voffB); PF8_STAGE(PF8_SB(1, 1), b3 + hstepB, voffB); PF8_STAGE(PF8_SA(1, 0), a3, voC[0]);
            PF8_WAIT_V(8); PF8_WAIT_L(0); PF8_BAR; PF8_MMA(1, 0, At, B0); PF8_MMA(1, 1, At, B1); PF8_BAR; PF8_SCHED;
        }
        if (wr == 0) PF8_BAR;
        { int ln_ = lane; asm volatile("" : "+v"(ln_)); E(acc, cur, wr, wc, ln_ & 15, ln_ >> 4); }
        if (!has_next) break;
#pragma unroll
        for (int a = 0; a < 2; ++a)
#pragma unroll
            for (int b = 0; b < 2; ++b)
#pragma unroll
                for (int m = 0; m < 4; ++m)
#pragma unroll
                    for (int r = 0; r < 2; ++r) acc[a][b][m][r] = (f32x4){0.f, 0.f, 0.f, 0.f};
        cur = nxt; cB = nB; ++ui;
        if (wr == 1) PF8_BAR;
    }
    PF8_WAIT_V(0);
    PF8_BAR;
#undef PF8_SA
#undef PF8_SB
#undef PF8_STAGE
#undef PF8_LD
#undef PF8_LDA
#undef PF8_LDB
#undef PF8_MMA
#undef PF8_WAIT_V
#undef PF8_WAIT_L
#undef PF8_BAR
#undef PF8_SCHED
#undef PF8_AOFF
}
struct EpiSwiglu8 {
    unsigned char* act; const float* bgu; const int* tile_e;
    __device__ __forceinline__ void operator()(AccRef8 acc, const Unit& u, int wr, int wc, int t15, int q) const {
        const int row0 = u.pm * BM + wr * 64 + t15;
        const float* bp = bgu + (size_t)tile_e[u.pm] * (2 * DM);
        const int ja = u.pn * 128 + 32 * wc + 8 * q;
        const f32x4 b0 = *(const f32x4*)(bp + 2 * ja), b1 = *(const f32x4*)(bp + 2 * ja + 4), b2 = *(const f32x4*)(bp + 2 * ja + 8), b3 = *(const f32x4*)(bp + 2 * ja + 12);
        const float bg[8] = {b0[0], b0[2], b1[0], b1[2], b2[0], b2[2], b3[0], b3[2]}, bu[8] = {b0[1], b0[3], b1[1], b1[3], b2[1], b2[3], b3[1], b3[3]};
#pragma unroll
        for (int ai = 0; ai < 2; ++ai)
#pragma unroll
            for (int tb = 0; tb < 4; ++tb) { float o[8];
#pragma unroll
                for (int bj = 0; bj < 2; ++bj)
#pragma unroll
                    for (int j = 0; j < 4; j += 2) {
                        typedef float f32x2_ __attribute__((ext_vector_type(2)));
                        const f32x2_ a0 = {acc[ai][bj][tb][0][j], acc[ai][bj][tb][0][j + 1]}, a1 = {acc[ai][bj][tb][1][j], acc[ai][bj][tb][1][j + 1]};
                        const f32x2_ bg2 = {bg[4 * bj + j], bg[4 * bj + j + 1]}, bu2 = {bu[4 * bj + j], bu[4 * bj + j + 1]};
                        f32x2_ gt = a0 * 0.015625f + bg2, up = a1 * 0.015625f + bu2;
                        gt[0] = fminf(gt[0], 7.0f); gt[1] = fminf(gt[1], 7.0f); up[0] = fminf(fmaxf(up[0], -7.0f), 7.0f); up[1] = fminf(fmaxf(up[1], -7.0f), 7.0f);
                        f32x2_ e = gt * (-1.702f * 1.4426950408889634f); e[0] = __builtin_amdgcn_exp2f(e[0]); e[1] = __builtin_amdgcn_exp2f(e[1]);
                        f32x2_ d = e + 1.0f; d[0] = __builtin_amdgcn_rcpf(d[0]); d[1] = __builtin_amdgcn_rcpf(d[1]);
                        const f32x2_ r = gt * d * (up + 1.0f); o[4 * bj + j] = r[0]; o[4 * bj + j + 1] = r[1]; }
                int w0 = __builtin_amdgcn_cvt_pk_fp8_f32(o[0], o[1], 0, false); w0 = __builtin_amdgcn_cvt_pk_fp8_f32(o[2], o[3], w0, true);
                int w1 = __builtin_amdgcn_cvt_pk_fp8_f32(o[4], o[5], 0, false); w1 = __builtin_amdgcn_cvt_pk_fp8_f32(o[6], o[7], w1, true);
                *(u32x2*)(act + (size_t)(row0 + ai * HALF + tb * 16) * DM + ja) = (u32x2){(unsigned)w0, (unsigned)w1}; }
    }
};
struct EpiDown8 {
    unsigned char* y; const float* bd; const int* tile_e;
    __device__ __forceinline__ void operator()(AccRef8 acc, const Unit& u, int wr, int wc, int t15, int q) const {
        const int row0 = u.pm * BM + wr * 64 + t15;
        const float* bp = bd + (size_t)tile_e[u.pm] * DM;
        const int c0 = u.pn * BM + 64 * wc + 16 * q;
        f32x4 bb[2][2];
#pragma unroll
        for (int bj = 0; bj < 2; ++bj)
#pragma unroll
            for (int pb = 0; pb < 2; ++pb) bb[bj][pb] = *(const f32x4*)(bp + c0 + 8 * bj + 4 * pb);
#pragma unroll
        for (int ai = 0; ai < 2; ++ai)
#pragma unroll
            for (int tb = 0; tb < 4; ++tb) { int w4[4];
#pragma unroll
                for (int bj = 0; bj < 2; ++bj)
#pragma unroll
                    for (int pb = 0; pb < 2; ++pb) { const f32x4 o = acc[ai][bj][tb][pb] * 0.015625f + bb[bj][pb];
                        const int x = __builtin_amdgcn_cvt_pk_fp8_f32(o[0], o[1], 0, false); w4[2 * bj + pb] = __builtin_amdgcn_cvt_pk_fp8_f32(o[2], o[3], x, true); }
                *(u32x4*)(y + (size_t)(row0 + ai * HALF + tb * 16) * DM + c0) = (u32x4){(unsigned)w4[0], (unsigned)w4[1], (unsigned)w4[2], (unsigned)w4[3]}; }
    }
};
struct EpiGateMerge8 {
    unsigned char* O; const unsigned char* gates;
    template <bool FINAL, class AccT> __device__ __forceinline__ void scale(AccT& acc, const Unit& u, int wr, int wc, int t15, int q) const {
        const int row0 = u.pm * BM + wr * 64 + t15, c0 = u.pn * BM + 64 * wc + 16 * q;
#pragma unroll
        for (int ai = 0; ai < 2; ++ai) {
            u32x4 ga[4], gb[4];
#pragma unroll
            for (int tb = 0; tb < 4; ++tb) { const size_t row = (size_t)(row0 + ai * HALF + tb * 16);
                if constexpr (!FINAL) ga[tb] = *(const u32x4*)(gates + row * NGATE + c0);
                gb[tb] = *(const u32x4*)(gates + row * NGATE + DM + c0); }
            asm volatile("s_waitcnt vmcnt(0)" ::: "memory");
#pragma unroll
            for (int tb = 0; tb < 4; ++tb) { const size_t row = (size_t)(row0 + ai * HALF + tb * 16); int w4[4];
#pragma unroll
                for (int bj = 0; bj < 2; ++bj)
#pragma unroll
                    for (int pb = 0; pb < 2; ++pb) { const unsigned wb = gb[tb][2 * bj + pb]; f32x4 v = acc[ai][bj][tb][pb];
#pragma unroll
                        for (int j = 0; j < 4; ++j) { const float b = fmaxf((float)((wb >> (8 * j)) & 0xffu), 1.0f);
                            if constexpr (FINAL) v[j] *= b * (1.0f / (255.0f * 64.0f));
                            else { const unsigned wa = ga[tb][2 * bj + pb]; v[j] *= (float)((wa >> (8 * j)) & 0xffu) * __builtin_amdgcn_rcpf(b); } }
                        if constexpr (FINAL) { const int x = __builtin_amdgcn_cvt_pk_fp8_f32(v[0], v[1], 0, false); w4[2 * bj + pb] = __builtin_amdgcn_cvt_pk_fp8_f32(v[2], v[3], x, true); }
                        else acc[ai][bj][tb][pb] = v; }
                if constexpr (FINAL) *(u32x4*)(O + row * DM + c0) = (u32x4){(unsigned)w4[0], (unsigned)w4[1], (unsigned)w4[2], (unsigned)w4[3]}; }
            asm volatile("" ::: "memory");
        }
    }
    __device__ __forceinline__ void mid(f32x4 (&acc)[2][2][4][2], const Unit& u, int wr, int wc, int t15, int q) const { scale<false>(acc, u, wr, wc, t15, q); }
    __device__ __forceinline__ void operator()(AccRef8 acc, const Unit& u, int wr, int wc, int t15, int q) const { scale<true>(acc, u, wr, wc, t15, q); }
};
struct EpiProj8 {
    bf16_t* proj; float* ssqp;
    __device__ __forceinline__ void operator()(AccRef8 acc, const Unit& u, int wr, int wc, int t15, int q) const {
        const int row0 = u.pm * BM + wr * 64 + t15, c0 = u.pn * BM + 64 * wc + 16 * q;
        const bool lat = (u.pn >= 5) && (u.pn <= 7);
#pragma unroll
        for (int ai = 0; ai < 2; ++ai)
#pragma unroll
            for (int tb = 0; tb < 4; ++tb) { const size_t row = (size_t)(row0 + ai * HALF + tb * 16); bf16_t* rowp = proj + row * NPROJ + c0;
#pragma unroll
                for (int bj = 0; bj < 2; ++bj) *(u32x4*)(rowp + 8 * bj) = pack8(acc[ai][bj][tb][0] * 0.015625f, acc[ai][bj][tb][1] * 0.015625f);
                if (lat) { f32x4 sq = {0.f, 0.f, 0.f, 0.f};
#pragma unroll
                    for (int bj = 0; bj < 2; ++bj)
#pragma unroll
                        for (int pb = 0; pb < 2; ++pb) { const f32x4 v = acc[ai][bj][tb][pb] * 0.015625f; sq += v * v; }
                    float ss = (sq[0] + sq[1]) + (sq[2] + sq[3]);
                    ss += __shfl_xor(ss, 16); ss += __shfl_xor(ss, 32);
                    if (q == 0) ssqp[row * 12 + 4 * (u.pn - 5) + wc] = ss; } }
    }
};
struct EpiRes8 {
    const float* x; bf16_t* out; float* ssqh;
    __device__ __forceinline__ void operator()(AccRef8 acc, const Unit& u, int wr, int wc, int t15, int q) const {
        const int row0 = u.pm * BM + wr * 64 + t15, c0 = u.pn * BM + 64 * wc + 16 * q;
#pragma unroll
        for (int ai = 0; ai < 2; ++ai) {
            f32x4 xv[4][2][2];
#pragma unroll
            for (int tb = 0; tb < 4; ++tb) { const size_t off = (size_t)(row0 + ai * HALF + tb * 16) * DM + c0;
#pragma unroll
                for (int bj = 0; bj < 2; ++bj)
#pragma unroll
                    for (int pb = 0; pb < 2; ++pb) xv[tb][bj][pb] = *(const f32x4*)(x + off + 8 * bj + 4 * pb); }
            asm volatile("s_waitcnt vmcnt(0)" ::: "memory");
#pragma unroll
            for (int tb = 0; tb < 4; ++tb) { const size_t row = (size_t)(row0 + ai * HALF + tb * 16), off = row * DM + c0; f32x4 sq = {0.f, 0.f, 0.f, 0.f};
#pragma unroll
                for (int bj = 0; bj < 2; ++bj) { const f32x4 h0 = xv[tb][bj][0] + acc[ai][bj][tb][0] * (1.0f / 1024.0f), h1 = xv[tb][bj][1] + acc[ai][bj][tb][1] * (1.0f / 1024.0f);
                    *(u32x4*)(out + off + 8 * bj) = pack8(h0, h1); sq += h0 * h0 + h1 * h1; }
                float ss = (sq[0] + sq[1]) + (sq[2] + sq[3]); ss += __shfl_xor(ss, 16); ss += __shfl_xor(ss, 32);
                if (q == 0) ssqh[row * 32 + 4 * u.pn + wc] = ss; }
            asm volatile("" ::: "memory");
        }
    }
};
struct EpiGates8 {
    unsigned char* gates; const float* b_gate;
    __device__ __forceinline__ void operator()(AccRef8 acc, const Unit& u, int wr, int wc, int t15, int q) const {
        const int row0 = u.pm * BM + wr * 64 + t15;
        const int c0 = u.pn * BM + 64 * wc + 16 * q;
        f32x4 bb[2][2];
#pragma unroll
        for (int bj = 0; bj < 2; ++bj)
#pragma unroll
            for (int pb = 0; pb < 2; ++pb) bb[bj][pb] = *(const f32x4*)(b_gate + c0 + 8 * bj + 4 * pb);
#pragma unroll
        for (int ai = 0; ai < 2; ++ai)
#pragma unroll
            for (int tb = 0; tb < 4; ++tb) { unsigned qq[4];
#pragma unroll
                for (int bj = 0; bj < 2; ++bj)
#pragma unroll
                    for (int pb = 0; pb < 2; ++pb) { float o[4];
#pragma unroll
                        for (int j = 0; j < 4; j += 2) {
                            typedef float f32x2_ __attribute__((ext_vector_type(2)));
                            const f32x2_ a = {acc[ai][bj][tb][pb][j], acc[ai][bj][tb][pb][j + 1]}, b2 = {bb[bj][pb][j], bb[bj][pb][j + 1]};
                            f32x2_ e = (a * 0.015625f + b2) * -1.4426950408889634f; e[0] = __builtin_amdgcn_exp2f(e[0]); e[1] = __builtin_amdgcn_exp2f(e[1]);
                            f32x2_ d = e + 1.0f; d[0] = __builtin_amdgcn_rcpf(d[0]); d[1] = __builtin_amdgcn_rcpf(d[1]);
                            const f32x2_ r = d * 255.0f + 0.5f; o[j] = r[0]; o[j + 1] = r[1]; }
                        qq[2 * bj + pb] = (unsigned)o[0] | ((unsigned)o[1] << 8) | ((unsigned)o[2] << 16) | ((unsigned)o[3] << 24); }
                *(u32x4*)(gates + (size_t)(row0 + ai * HALF + tb * 16) * NGATE + c0) = (u32x4){qq[0], qq[1], qq[2], qq[3]}; }
    }
};
}

struct Args { const void* in[21]; float* out; unsigned char* ws; int ph_lo, ph_hi; };

struct Frame {
    LAS unsigned char* lds; unsigned char* ws; unsigned* ctl;
    int tid, lane, wave, G, bx;
    const float *x, *g_attn, *w_in, *b_gate, *sinks, *g_q, *w_uq, *g_kv, *w_ukv, *w_o_swa, *w_o_mla, *w_out, *g_ffn, *w_router, *b_router, *w_gate_up, *b_gate_up, *w_down, *b_down, *g_final;
    const int* positions; float* out;
};

template <int MODE> __device__ __forceinline__ int rowmap(int n) {
    if (MODE == 1) return n < NLOW ? n : n + (NPROJ - NLOW);
    if (MODE == 2) { const int j = n >> 1, t = n & 1; return 8 * (j >> 2) + 4 * t + (j & 3); }
    return n;
}
__device__ __forceinline__ int perm32_inv(int x) { return 16 * ((x >> 2) & 1) + 4 * (x >> 3) + (x & 3); }
__host__ __device__ __forceinline__ int wide_map(int c) { return 128 * ((c >> 3) & 1) + 32 * (c >> 6) + 8 * ((c >> 4) & 3) + (c & 7); }
template <int MODE, bool PERM, bool WIDE = false> __device__ __forceinline__ void p0_convert_item(const float* W, int K, int N, bf16_t* WB, int item, int lane, int ldw = 0, int nkt_img = 0, int kt_off = 0, const float* kgain = nullptr) {
    if (ldw == 0) ldw = N;
    const int nblk = (N + 255) / 256, kb = item / nblk, nb = item % nblk, k0 = 32 * kb, n = 256 * nb + 4 * lane;
    if (n >= N) return;
    const f32x4* src = (const f32x4*)(W + (size_t)k0 * ldw + n);
    f32x4 v[32];
#pragma unroll
    for (int r = 0; r < 32; ++r) v[r] = src[(size_t)r * (ldw / 4)];
    if (kgain) {
#pragma unroll
        for (int r = 0; r < 32; ++r) v[r] = v[r] * kgain[k0 + r]; }
    const int nkt = nkt_img ? nkt_img : K / 64;
#pragma unroll
    for (int cmp = 0; cmp < 4; ++cmp) {
        const int p0_ = rowmap<MODE>(n + cmp), p = WIDE ? (p0_ & ~255) + wide_map(p0_ & 255) : p0_, q = p & 127, R = PERM ? ((q & ~31) + perm32_inv(q & 31)) : q;
        char* tile = (char*)WB + ((size_t)(p >> 8) * nkt + kt_off + (kb >> 1)) * 32768 + ((p >> 7) & 1) * 16384;
#pragma unroll
        for (int g8 = 0; g8 < 4; ++g8) { u32x4 o;
            o.x = cvt_pk_bf16(v[8 * g8 + 0][cmp], v[8 * g8 + 1][cmp]); o.y = cvt_pk_bf16(v[8 * g8 + 2][cmp], v[8 * g8 + 3][cmp]);
            o.z = cvt_pk_bf16(v[8 * g8 + 4][cmp], v[8 * g8 + 5][cmp]); o.w = cvt_pk_bf16(v[8 * g8 + 6][cmp], v[8 * g8 + 7][cmp]);
            *(u32x4*)(tile + pg8::lds_byte(R, 32 * (kb & 1) + 8 * g8)) = o; }
    }
}
template <bool GU> __device__ __forceinline__ void p0_convert_item_f8(const float* W, int K, int N, unsigned char* WB, int item, int lane, int ldw = 0, int nkt_img = 0, int kt_off = 0) {
    if (ldw == 0) ldw = N;
    const int nblk = (N + 255) / 256, kb = item / nblk, nb = item % nblk, k0 = 32 * kb, n = 256 * nb + 4 * lane;
    if (n >= N) return;
    const f32x4* src = (const f32x4*)(W + (size_t)k0 * ldw + n);
    f32x4 v[32];
#pragma unroll
    for (int r = 0; r < 32; ++r) v[r] = src[(size_t)r * (ldw / 4)];
    const int nkt = nkt_img ? nkt_img : K / 128, kt = kt_off + (k0 >> 7), c0 = (k0 & 127) >> 4;
#pragma unroll
    for (int cmp = 0; cmp < 4; ++cmp) {
        const int nl = n + cmp, j = (nl & 255) >> 1, t = nl & 1;
        const int P = (nl & ~255) + (GU ? 128 * ((j >> 2) & 1) + 32 * (j >> 5) + 16 * t + 4 * ((j >> 3) & 3) + (j & 3) : 128 * ((nl >> 3) & 1) + 32 * ((nl >> 6) & 3) + 16 * ((nl >> 2) & 1) + 4 * ((nl >> 4) & 3) + (nl & 3));
        const int q = P & 127, row = q;
        unsigned char* tile = WB + ((size_t)(P >> 8) * nkt + kt) * 32768 + ((P >> 7) & 1) * 16384;
#pragma unroll
        for (int g = 0; g < 2; ++g) { int w[4];
#pragma unroll
            for (int d = 0; d < 4; ++d) { int x = __builtin_amdgcn_cvt_pk_fp8_f32(v[16 * g + 4 * d + 0][cmp] * 64.0f, v[16 * g + 4 * d + 1][cmp] * 64.0f, 0, false);
                w[d] = __builtin_amdgcn_cvt_pk_fp8_f32(v[16 * g + 4 * d + 2][cmp] * 64.0f, v[16 * g + 4 * d + 3][cmp] * 64.0f, x, true); }
            *(u32x4*)(tile + pg8::img8(row, c0 + g)) = (u32x4){(unsigned)w[0], (unsigned)w[1], (unsigned)w[2], (unsigned)w[3]}; }
    }
}
__device__ __forceinline__ void p0_moe_convert_block(Frame& F) {
    constexpr int NI_GU = NEXP * 16 * 16, NI_D = NEXP * 16 * 8, NIT = NI_GU + NI_D;
    const int lane = F.lane, w = F.wave, tid = F.tid;
    unsigned char* WGU = (unsigned char*)(F.ws + WS_WGU); unsigned char* WD = (unsigned char*)(F.ws + WS_WD);
#define MC_SRC(it, srcp, ldw_, dstp, gu_, gk_) do { int r_ = (it); const float* W_; int N_; unsigned char* D_; \
        if (r_ < NI_GU) { const int e_ = r_ >> 8, rem_ = r_ & 255, kt_ = rem_ >> 4, pn_ = rem_ & 15; W_ = F.w_gate_up + (size_t)e_ * DM * 2 * DM + (size_t)(128 * kt_) * (2 * DM) + 256 * pn_; N_ = 2 * DM; \
            D_ = WGU + (size_t)e_ * 2 * DM * DM + ((size_t)pn_ * 16 + kt_) * 32768; gu_ = true; gk_ = F.g_ffn + 128 * kt_ + 16 * w; }     \
        else { r_ -= NI_GU; const int e_ = r_ >> 7, rem_ = r_ & 127, kt_ = rem_ >> 3, pn_ = rem_ & 7; W_ = F.w_down + (size_t)e_ * DM * DM + (size_t)(128 * kt_) * DM + 256 * pn_; N_ = DM; \
            D_ = WD + (size_t)e_ * DM * DM + ((size_t)pn_ * 16 + kt_) * 32768; gu_ = false; } \
        srcp = (const f32x4*)(W_ + (size_t)(16 * w) * N_ + 4 * lane); ldw_ = N_ / 4; dstp = D_; } while (0)
#define MC_LOAD(v, srcp, ldw_) do { _Pragma("unroll") for (int r = 0; r < 16; ++r) v[r] = srcp[(size_t)r * ldw_]; } while (0)
#define MC_STEP(v, buf, dstp, gu_, gk_) do { float gs_[16]; _Pragma("unroll") for (int r = 0; r < 16; ++r) gs_[r] = gu_ ? gk_[r] * 64.0f : 64.0f; \
        _Pragma("unroll") for (int cmp = 0; cmp < 4; ++cmp) { const int nl = 4 * lane + cmp, j = nl >> 1, t = nl & 1, P = gu_ ? 128 * ((j >> 2) & 1) + 32 * (j >> 5) + 16 * t + 4 * ((j >> 3) & 3) + (j & 3) : 128 * ((nl >> 3) & 1) + 32 * ((nl >> 6) & 3) + 16 * ((nl >> 2) & 1) + 4 * ((nl >> 4) & 3) + (nl & 3); \
            const int q = P & 127, row = q; int wq[4]; \
            _Pragma("unroll") for (int d = 0; d < 4; ++d) { const int x = __builtin_amdgcn_cvt_pk_fp8_f32(v[4 * d + 0][cmp] * gs_[4 * d + 0], v[4 * d + 1][cmp] * gs_[4 * d + 1], 0, false); \
                wq[d] = __builtin_amdgcn_cvt_pk_fp8_f32(v[4 * d + 2][cmp] * gs_[4 * d + 2], v[4 * d + 3][cmp] * gs_[4 * d + 3], x, true); } \
            *(LAS u32x4*)((buf) + ((P >> 7) & 1) * 16384 + pg8::img8(row, w)) = (u32x4){(unsigned)wq[0], (unsigned)wq[1], (unsigned)wq[2], (unsigned)wq[3]}; } \
        __syncthreads(); \
        _Pragma("unroll") for (int q4 = 0; q4 < 4; ++q4) *(u32x4*)((dstp) + tid * 16 + q4 * 8192) = *(const LAS u32x4*)((buf) + tid * 16 + q4 * 8192); } while (0)
    f32x4 va[16], vb[16];
    const f32x4* sa; const f32x4* sb; int la = 0, lb = 0; unsigned char* da = nullptr; unsigned char* db = nullptr; bool ga = false, gb = false; const float* gka = F.g_ffn; const float* gkb = F.g_ffn;
    int it = F.bx;
    if (it < NIT) { MC_SRC(it, sa, la, da, ga, gka); MC_LOAD(va, sa, la); }
    __syncthreads();
    for (; it < NIT; it += 2 * F.G) {
        const int it1 = it + F.G, it2 = it + 2 * F.G;
        if (it1 < NIT) { MC_SRC(it1, sb, lb, db, gb, gkb); MC_LOAD(vb, sb, lb); }
        MC_STEP(va, F.lds, da, ga, gka);
        if (it1 < NIT) {
            if (it2 < NIT) { MC_SRC(it2, sa, la, da, ga, gka); MC_LOAD(va, sa, la); }
            MC_STEP(vb, F.lds + 32768, db, gb, gkb);
        }
    }
    __syncthreads();
#undef MC_SRC
#undef MC_LOAD
#undef MC_STEP
}
__device__ __forceinline__ void p0_prologue(Frame& F) {
    const int gw = F.bx * NWAVES + F.wave, NGW = F.G * NWAVES;
    bf16_t* WIN = (bf16_t*)(F.ws + WS_WIN); bf16_t* WUQ = (bf16_t*)(F.ws + WS_WUQ); bf16_t* WUKV = (bf16_t*)(F.ws + WS_WUKV);
    bf16_t* WOA = (bf16_t*)(F.ws + WS_WOA); bf16_t* WOB = (bf16_t*)(F.ws + WS_WOB); bf16_t* WOUT = (bf16_t*)(F.ws + WS_WOUT);
    bf16_t* WGU = (bf16_t*)(F.ws + WS_WGU); bf16_t* WD = (bf16_t*)(F.ws + WS_WD);
    constexpr int I_IN = (DM / 32) * ((NLOW + 255) / 256), I_ING = (DM / 32) * (NGATE / 256), I_UQ = (512 / 32) * (1536 / 256), I_UKV = (256 / 32) * (2048 / 256), I_OA = (1024 / 32) * (DM / 256), I_OUT = (DM / 32) * (DM / 256);
    constexpr int I_GU1 = (DM / 32) * (2 * DM / 256), I_D1 = (DM / 32) * (DM / 256);
    (void)WGU; (void)WD; (void)I_GU1; (void)I_D1;
    constexpr int NITEMS = I_IN + I_ING + I_UQ + I_UKV + 2 * I_OA + I_OUT;
    for (int it = gw; it < NITEMS; it += NGW) {
        int r = it;
        if (r < I_IN) { p0_convert_item_f8<false>(F.w_in, DM, NLOW, (unsigned char*)WIN, r, F.lane, NIN_LOG); continue; } r -= I_IN;
        if (r < I_ING) { p0_convert_item_f8<false>(F.w_in + NLOW, DM, NGATE, (unsigned char*)WIN + WIN_GATES_OFF, r, F.lane, NIN_LOG); continue; } r -= I_ING;
        if (r < I_UQ) { p0_convert_item<0, true, true>(F.w_uq, 512, 1536, WUQ, r, F.lane, 0, 0, 0, F.g_q); continue; } r -= I_UQ;
        if (r < I_UKV) { p0_convert_item<0, true>(F.w_ukv, 256, 2048, WUKV, r, F.lane, 0, 0, 0, F.g_kv); continue; } r -= I_UKV;
        if (r < I_OA) { p0_convert_item_f8<false>(F.w_o_swa, 1024, DM, (unsigned char*)WOA, r, F.lane, 0, 16, 0); continue; } r -= I_OA;
        if (r < I_OA) { (void)WOB; p0_convert_item_f8<false>(F.w_o_mla, 1024, DM, (unsigned char*)WOA, r, F.lane, 0, 16, 8); continue; } r -= I_OA;
        { p0_convert_item_f8<false>(F.w_out, DM, DM, (unsigned char*)WOUT, r, F.lane); }
    }
    p0_moe_convert_block(F);
    { constexpr int NPAD = NPROJ - NLOW, nz = (DM / 128) * NPAD * 8;
      for (int i = F.bx * NTHREADS + F.tid; i < nz; i += F.G * NTHREADS) { const int c = i & 7, col = (i >> 3) % NPAD, kt = (i >> 3) / NPAD, p0_ = NLOW + col, nl = p0_ & 255;
          const int P = (p0_ & ~255) + 128 * ((nl >> 3) & 1) + 32 * ((nl >> 6) & 3) + 16 * ((nl >> 2) & 1) + 4 * ((nl >> 4) & 3) + (nl & 3), q = P & 127;
          *(u32x4*)((unsigned char*)WIN + ((size_t)(P >> 8) * (DM / 128) + kt) * 32768 + ((P >> 7) & 1) * 16384 + pg8::img8(q, c)) = (u32x4){0u, 0u, 0u, 0u}; } }
    { int* idr = (int*)(F.ws + WS_IDROW); for (int i = F.bx * NTHREADS + F.tid; i < PROWS; i += F.G * NTHREADS) idr[i] = i; }
    { bf16_t* wrh = (bf16_t*)(F.ws + WS_WRT); bf16_t* wrl = wrh + NEXP * DM;
      for (int i = F.bx * NTHREADS + F.tid; i < DM * NEXP; i += F.G * NTHREADS) { const int d = i >> 5, e = i & 31; const float wv = F.w_router[i] * F.g_ffn[d];
          const unsigned hb = cvt_pk_bf16(wv, 0.f) & 0xffffu; const unsigned lb = cvt_pk_bf16(wv - bf_lo(hb), 0.f) & 0xffffu; wrh[e * DM + d] = (bf16_t)hb; wrl[e * DM + d] = (bf16_t)lb; } }
    float* CS = (float*)(F.ws + WS_CS);
#ifndef P0B_REP
#define P0B_REP 1
#endif
    for (int rep_ = 0; rep_ < P0B_REP; ++rep_)
    for (int m = gw; m < NTOK; m += NGW) {
        const f32x4* xr = (const f32x4*)(F.x + (size_t)m * DM) + F.lane; const f32x4* gr = (const f32x4*)F.g_attn + F.lane;
        f32x4 v[8]; float s = 0.f;
#pragma unroll
        for (int j = 0; j < 8; ++j) { v[j] = xr[64 * j]; s += (v[j].x * v[j].x + v[j].y * v[j].y) + (v[j].z * v[j].z + v[j].w * v[j].w); }
        const float rstd = 1.0f / sqrtf(wave_sum(s) * (1.0f / DM) + EPS);
#pragma unroll
        for (int j = 0; j < 8; ++j) { const f32x4 gg = gr[64 * j]; const float y0 = v[j].x * rstd * gg.x, y1 = v[j].y * rstd * gg.y, y2 = v[j].z * rstd * gg.z, y3 = v[j].w * rstd * gg.w;
            int w8 = __builtin_amdgcn_cvt_pk_fp8_f32(y0, y1, 0, false); w8 = __builtin_amdgcn_cvt_pk_fp8_f32(y2, y3, w8, true); ((unsigned*)(F.ws + WS_XN8 + (size_t)m * DM))[F.lane + 64 * j] = (unsigned)w8; }
        { const int i = F.lane & 31; const float inv_freq = powf(10000.0f, -(float)i * 2.0f / 64.0f); const float ang = (float)F.positions[m] * inv_freq;
          CS[(size_t)m * 64 + F.lane] = (F.lane < 32) ? cosf(ang) : sinf(ang); }
    }
}

__device__ __forceinline__ void rope4(u32x2& a, u32x2& b, f32x4 c, f32x4 s) {
    const float x1[4] = {bf_lo(a.x), bf_hi(a.x), bf_lo(a.y), bf_hi(a.y)}, x2[4] = {bf_lo(b.x), bf_hi(b.x), bf_lo(b.y), bf_hi(b.y)};
    float o1[4], o2[4];
#pragma unroll
    for (int j = 0; j < 4; ++j) { o1[j] = x1[j] * c[j] - x2[j] * s[j]; o2[j] = x2[j] * c[j] + x1[j] * s[j]; }
    a.x = cvt_pk_bf16(o1[0], o1[1]); a.y = cvt_pk_bf16(o1[2], o1[3]); b.x = cvt_pk_bf16(o2[0], o2[1]); b.y = cvt_pk_bf16(o2[2], o2[3]);
}
namespace pg8 {
__device__ __forceinline__ float row_rstd_q(const float* ssqp, size_t row) { const f32x4 a = *(const f32x4*)(ssqp + row * 12), b = *(const f32x4*)(ssqp + row * 12 + 4);
    return 1.0f / sqrtf((((a[0] + a[1]) + (a[2] + a[3])) + ((b[0] + b[1]) + (b[2] + b[3]))) * (1.0f / 512.0f) + EPS); }
__device__ __forceinline__ float row_rstd_kv(const float* ssqp, size_t row) { const f32x4 a = *(const f32x4*)(ssqp + row * 12 + 8);
    return 1.0f / sqrtf(((a[0] + a[1]) + (a[2] + a[3])) * (1.0f / 256.0f) + EPS); }
struct EpiQn { static constexpr bool PERM = true;
    bf16_t* O; const float* ssqp; float scl;
    __device__ __forceinline__ void operator()(AccRef acc, const Unit& u, int wr, int wc, int fr, int fq) const {
        const int row0 = u.pm * BM + wr * 64 + fr, col0 = u.pn * BM + wc * 64 + 16 * fq;
#pragma unroll
        for (int ai = 0; ai < 2; ++ai)
#pragma unroll
            for (int m = 0; m < 4; ++m) { const size_t row = (size_t)(row0 + ai * HALF + m * 16); const float sc = row_rstd_q(ssqp, row) * scl; bf16_t* rowp = O + row * 1536 + col0;
#pragma unroll
                for (int bj = 0; bj < 2; ++bj) *(u32x4*)(rowp + bj * 8) = pack8(acc[ai][bj][m][0] * sc, acc[ai][bj][m][1] * sc); }
    }
};
struct EpiKVn { static constexpr bool PERM = true;
    bf16_t* kmla; bf16_t* vmla; const float* ssqp; const bf16_t* proj; const float* cs;
    __device__ __forceinline__ void operator()(AccRef acc, const Unit& u, int wr, int wc, int fr, int fq) const {
        const int row0 = u.pm * BM + wr * 64 + fr, c0 = wc * 32 + 8 * fq;
#pragma unroll
        for (int ai = 0; ai < 2; ++ai)
#pragma unroll
            for (int m = 0; m < 4; ++m) { const size_t row = (size_t)(row0 + ai * HALF + m * 16); const float sc = row_rstd_kv(ssqp, row);
                const size_t hrow = ((row >> 11) * 8 + u.pn) * 2048 + (row & 2047);
                *(u32x4*)(kmla + hrow * 192 + c0) = pack8(acc[ai][0][m][0] * sc, acc[ai][0][m][1] * sc);
                *(u32x4*)(vmla + hrow * 128 + c0) = pack8(acc[ai][1][m][0] * sc, acc[ai][1][m][1] * sc); }
        const int tid_ = (wr * 4 + wc) * 64 + fq * 16 + fr;
#pragma unroll
        for (int it = 0; it < 4; ++it) { const int idx = tid_ + 512 * it, i0 = 4 * (idx & 7); const size_t row = (size_t)(u.pm * BM + (idx >> 3));
            const bf16_t* pr = proj + row * NPROJ + PC_KR;
            u32x2 a = *(const u32x2*)(pr + i0), b = *(const u32x2*)(pr + 32 + i0);
            const f32x4 c = *(const f32x4*)(cs + row * 64 + i0), sn = *(const f32x4*)(cs + row * 64 + 32 + i0);
            rope4(a, b, c, sn);
            bf16_t* kp = kmla + (((row >> 11) * 8 + u.pn) * 2048 + (row & 2047)) * 192 + 128 + i0;
            *(u32x2*)kp = a; *(u32x2*)(kp + 32) = b; }
    }
};
}
__device__ __forceinline__ void p2_postproj(Frame& F) {
    const int gw = F.bx * NWAVES + F.wave, NGW = F.G * NWAVES, lane = F.lane;
    bf16_t* PROJ = (bf16_t*)(F.ws + WS_PROJ); const float* CS = (const float*)(F.ws + WS_CS);
    bf16_t* CQ = (bf16_t*)(F.ws + WS_CQ); bf16_t* CKV = (bf16_t*)(F.ws + WS_CKV); bf16_t* KMLA = (bf16_t*)(F.ws + WS_KMLA);
    constexpr int R2 = 4;
    const int hd = lane >> 3, i0 = 4 * (lane & 7); const int base = (hd < 2) ? PC_KA + hd * 64 : PC_KR;
    const f32x4 gq0 = *(const f32x4*)(F.g_q + 8 * lane), gq1 = *(const f32x4*)(F.g_q + 8 * lane + 4), gk0 = *(const f32x4*)(F.g_kv + 4 * lane);
    for (int m0 = gw; m0 < NTOK; m0 += R2 * NGW) {
        f32x4 rc[R2], rs[R2]; u32x2 ra[R2], rb[R2], wkv[R2]; u32x4 wq[R2];
#pragma unroll
        for (int j = 0; j < R2; ++j) { const int m = m0 + j * NGW; if (m < NTOK) { bf16_t* pr = PROJ + (size_t)m * NPROJ;
            if (lane < 24) { rc[j] = *(const f32x4*)(CS + (size_t)m * 64 + i0); rs[j] = *(const f32x4*)(CS + (size_t)m * 64 + 32 + i0);
                ra[j] = *(u32x2*)(pr + base + i0); rb[j] = *(u32x2*)(pr + base + 32 + i0); }
            wq[j] = *(const u32x4*)(pr + PC_DQ + 8 * lane); wkv[j] = *(const u32x2*)(pr + PC_DKV + 4 * lane); } }
#pragma unroll
        for (int j = 0; j < R2; ++j) { const int m = m0 + j * NGW; if (m < NTOK) { bf16_t* pr = PROJ + (size_t)m * NPROJ;
            if (lane < 24) { u32x2 a = ra[j], b = rb[j];
                rope4(a, b, rc[j], rs[j]);
                if (hd < 2) { *(u32x2*)(pr + base + i0) = a; *(u32x2*)(pr + base + 32 + i0) = b; }
                else { bf16_t* kp = KMLA + ((size_t)(m >> 11) * (8 * 2048) + (m & 2047)) * 192 + 128 + i0;
#pragma unroll
                    for (int hh = 0; hh < 8; ++hh) { *(u32x2*)(kp + (size_t)hh * (2048 * 192)) = a; *(u32x2*)(kp + (size_t)hh * (2048 * 192) + 32) = b; } } }
            { const u32x4 w = wq[j];
              float v[8] = {bf_lo(w.x), bf_hi(w.x), bf_lo(w.y), bf_hi(w.y), bf_lo(w.z), bf_hi(w.z), bf_lo(w.w), bf_hi(w.w)}; float sq = 0.f;
#pragma unroll
              for (int t = 0; t < 8; ++t) sq += v[t] * v[t];
              const float rstd = 1.0f / sqrtf(wave_sum(sq) * (1.0f / 512.0f) + EPS);
              u32x4 o; o.x = cvt_pk_bf16(v[0] * rstd * gq0[0], v[1] * rstd * gq0[1]); o.y = cvt_pk_bf16(v[2] * rstd * gq0[2], v[3] * rstd * gq0[3]);
              o.z = cvt_pk_bf16(v[4] * rstd * gq1[0], v[5] * rstd * gq1[1]); o.w = cvt_pk_bf16(v[6] * rstd * gq1[2], v[7] * rstd * gq1[3]);
              *(u32x4*)(CQ + (size_t)m * 512 + 8 * lane) = o; }
            { const u32x2 w = wkv[j];
              float v[4] = {bf_lo(w.x), bf_hi(w.x), bf_lo(w.y), bf_hi(w.y)}; float sq = (v[0] * v[0] + v[1] * v[1]) + (v[2] * v[2] + v[3] * v[3]);
              const float rstd = 1.0f / sqrtf(wave_sum(sq) * (1.0f / 256.0f) + EPS);
              u32x2 o; o.x = cvt_pk_bf16(v[0] * rstd * gk0[0], v[1] * rstd * gk0[1]); o.y = cvt_pk_bf16(v[2] * rstd * gk0[2], v[3] * rstd * gk0[3]);
              *(u32x2*)(CKV + (size_t)m * 256 + 4 * lane) = o; } } }
    }
}

__device__ __forceinline__ int crow(int r, int hi) { return (r & 3) + 8 * (r >> 2) + 4 * hi; }
__device__ __forceinline__ bf16x8 tr2(const LAS unsigned char* p0, const LAS unsigned char* p1) {
    const v4i16_t a = __builtin_amdgcn_ds_read_tr16_b64_v4i16((LAS v4i16_t*)p0), b = __builtin_amdgcn_ds_read_tr16_b64_v4i16((LAS v4i16_t*)p1);
    bf16x8 r; r[0] = a[0]; r[1] = a[1]; r[2] = a[2]; r[3] = a[3]; r[4] = b[0]; r[5] = b[1]; r[6] = b[2]; r[7] = b[3]; return r;
}
__device__ __forceinline__ void rope_frag(bf16x8& f1, bf16x8& f2, const float* cs, int i0, float scl = 1.0f) {
    const f32x4 c0 = *(const f32x4*)(cs + i0) * scl, c1 = *(const f32x4*)(cs + i0 + 4) * scl, s0 = *(const f32x4*)(cs + 32 + i0) * scl, s1 = *(const f32x4*)(cs + 32 + i0 + 4) * scl;
    u32x4 a = __builtin_bit_cast(u32x4, f1), b = __builtin_bit_cast(u32x4, f2);
    u32x2 a0 = {a.x, a.y}, b0 = {b.x, b.y}, a1 = {a.z, a.w}, b1 = {b.z, b.w};
    rope4(a0, b0, c0, s0); rope4(a1, b1, c1, s1);
    f1 = __builtin_bit_cast(bf16x8, (u32x4){a0.x, a0.y, a1.x, a1.y}); f2 = __builtin_bit_cast(bf16x8, (u32x4){b0.x, b0.y, b1.x, b1.y});
}
__device__ __forceinline__ bf16x8 pack_p(const f32x16& p, int s2) {
    u32x4 w;
    asm volatile("s_nop 0\n\tv_cvt_pk_bf16_f32 %0, %4, %5\n\tv_cvt_pk_bf16_f32 %1, %6, %7\n\tv_cvt_pk_bf16_f32 %2, %8, %9\n\tv_cvt_pk_bf16_f32 %3, %10, %11"
                 : "=&v"(w.x), "=&v"(w.y), "=&v"(w.z), "=&v"(w.w)
                 : "v"(p[8 * s2 + 0]), "v"(p[8 * s2 + 1]), "v"(p[8 * s2 + 2]), "v"(p[8 * s2 + 3]), "v"(p[8 * s2 + 4]), "v"(p[8 * s2 + 5]), "v"(p[8 * s2 + 6]), "v"(p[8 * s2 + 7]));
    return __builtin_bit_cast(bf16x8, w);
}

constexpr int SWA_KRS = 144;
constexpr int SWA_LDS_K = 0, SWA_LDS_V = 256 * SWA_KRS;
__device__ __forceinline__ void swa_phase(Frame& F) {
    const bf16_t* PROJ = (const bf16_t*)(F.ws + WS_PROJ); const float* CS = (const float*)(F.ws + WS_CS); bf16_t* OUTA = (bf16_t*)(F.ws + WS_OUTA);
    LAS unsigned char* Kl = F.lds + SWA_LDS_K; LAS unsigned char* Vl = F.lds + SWA_LDS_V;
    int lane = F.lane; asm volatile("" : "+v"(lane));
    const int w = F.wave, l31 = lane & 31, h = lane >> 5;
    const int vq = (lane & 15) >> 2, vp = lane & 3, vg = (lane >> 4) & 1;
    const int vlane = (4 * h + vq) * 64 + (16 * vg + 4 * vp) * 2;
    for (int u = F.bx; u < BATCH * 16 * 2; u += F.G) {
        const int kvh = u & 1, nb = (u >> 1) & 15, b = u >> 5;
        const int tok0 = b * SEQ + nb * 128;
        __syncthreads();
#pragma unroll
        for (int j = 0; j < 4; ++j) { const int id = F.tid + 512 * j, row = id >> 3, ch = id & 7;
            u32x4 kv = (u32x4){0u, 0u, 0u, 0u}, vv = (u32x4){0u, 0u, 0u, 0u};
            if (nb > 0 || row >= 128) { const size_t tok = (size_t)(tok0 - 128 + row); const bf16_t* src = PROJ + tok * NPROJ + kvh * 64 + ch * 8;
                vv = *(const u32x4*)(src + PC_VA);
                const u32x4 ko = *(const u32x4*)(src + PC_KA), kp = *(const u32x4*)(src + PC_KA + ((ch & 4) ? -32 : 32));
                const float* cs = CS + tok * 64 + 8 * (ch & 3);
                const f32x4 c0 = *(const f32x4*)cs, c1 = *(const f32x4*)(cs + 4), s0 = *(const f32x4*)(cs + 32), s1 = *(const f32x4*)(cs + 36);
                const float sg = (ch & 4) ? 1.0f : -1.0f;
                const unsigned kow[4] = {ko.x, ko.y, ko.z, ko.w}, kpw[4] = {kp.x, kp.y, kp.z, kp.w}; unsigned ow[4];
#pragma unroll
                for (int e = 0; e < 4; ++e) { const float cl = e < 2 ? c0[2 * e] : c1[2 * e - 4], ch_ = e < 2 ? c0[2 * e + 1] : c1[2 * e - 3], sl = e < 2 ? s0[2 * e] : s1[2 * e - 4], sh = e < 2 ? s0[2 * e + 1] : s1[2 * e - 3];
                    ow[e] = cvt_pk_bf16(bf_lo(kow[e]) * cl + sg * bf_lo(kpw[e]) * sl, bf_hi(kow[e]) * ch_ + sg * bf_hi(kpw[e]) * sh); }
                kv = (u32x4){ow[0], ow[1], ow[2], ow[3]}; }
            *(LAS u32x4*)(Kl + row * SWA_KRS + ch * 16) = kv;
            *(LAS u32x4*)(Vl + ((row >> 3) * 2 + (ch >> 2)) * 512 + (row & 7) * 64 + (ch & 3) * 16) = vv; }
        __syncthreads();
        const int hq = kvh * 8 + w; const float sink = F.sinks[hq];
        for (int i = 0; i < 4; ++i) {
            const size_t row0 = (size_t)tok0 + 32 * i;
            bf16x8 Qf[4];
            { const char* qp = (const char*)PROJ + (row0 * NPROJ + hq * 64) * 2; const unsigned qo = (unsigned)(l31 * (NPROJ * 2) + 16 * h);
#pragma unroll
              for (int ks = 0; ks < 4; ++ks) Qf[ks] = *(const bf16x8*)(qp + qo + 32 * ks);
              const float* cs = (const float*)((const char*)CS + row0 * 256 + (unsigned)(l31 * 256));
              rope_frag(Qf[0], Qf[2], cs, 8 * h, 0.125f * 1.4426950408889634f); rope_frag(Qf[1], Qf[3], cs, 16 + 8 * h, 0.125f * 1.4426950408889634f); }
            f32x16 O[2];
#pragma unroll
            for (int db = 0; db < 2; ++db)
#pragma unroll
                for (int r = 0; r < 16; ++r) O[db][r] = 0.f;
            const float sinkl = sink * 1.4426950408889634f;
            float mrun = sinkl, lrun = 0.f;
            const int tcmp = l31 - 4 * h;
#pragma unroll 1
            for (int kb = 0; kb < 5; ++kb) {
                if (nb == 0 && i + kb < 4) continue;
                const int kk0 = 32 * (i + kb);
                f32x16 Sx;
#pragma unroll
                for (int r = 0; r < 16; ++r) Sx[r] = 0.f;
                const LAS unsigned char* kp = Kl + kk0 * SWA_KRS + l31 * SWA_KRS + 16 * h;
#pragma unroll
                for (int ks = 0; ks < 4; ++ks) Sx = __builtin_amdgcn_mfma_f32_32x32x16_bf16(*(const LAS bf16x8*)(kp + 32 * ks), Qf[ks], Sx, 0, 0, 0);
                const LAS unsigned char* vb = Vl + (kk0 >> 3) * 1024 + vlane;
                bf16x8 vf[4];
#pragma unroll
                for (int db = 0; db < 2; ++db) { vf[2 * db] = tr2(vb + db * 512, vb + db * 512 + 1024); vf[2 * db + 1] = tr2(vb + db * 512 + 2048, vb + db * 512 + 3072); }
                __builtin_amdgcn_sched_barrier(0);
                if (kb == 0) {
#pragma unroll
                    for (int r = 0; r < 16; ++r) if (!((r & 3) + 8 * (r >> 2) > tcmp)) Sx[r] = -1e30f;
                } else if (kb == 4) {
#pragma unroll
                    for (int r = 0; r < 16; ++r) if ((r & 3) + 8 * (r >> 2) > tcmp) Sx[r] = -1e30f;
                }
                float mx = Sx[0];
#pragma unroll
                for (int r = 1; r < 16; ++r) mx = fmaxf(mx, Sx[r]);
                mx = fmaxf(mx, __shfl_xor(mx, 32));
                if (__builtin_amdgcn_ballot_w64(mx > mrun + 8.f) != 0) {
                    const float mn = fmaxf(mrun, mx);
                    const float alpha = __builtin_amdgcn_exp2f(mrun - mn);
                    mrun = mn; lrun *= alpha;
#pragma unroll
                    for (int db = 0; db < 2; ++db)
#pragma unroll
                        for (int r = 0; r < 16; ++r) O[db][r] *= alpha;
                }
                float ps = 0.f;
#pragma unroll
                for (int r = 0; r < 16; ++r) { const float p = __builtin_amdgcn_exp2f(Sx[r] - mrun); Sx[r] = p; ps += p; }
                lrun += ps;
                const bf16x8 P0 = pack_p(Sx, 0), P1 = pack_p(Sx, 1);
                __builtin_amdgcn_sched_barrier(0);
#pragma unroll
                for (int db = 0; db < 2; ++db) {
                    O[db] = __builtin_amdgcn_mfma_f32_32x32x16_bf16(vf[2 * db], P0, O[db], 0, 0, 0);
                    O[db] = __builtin_amdgcn_mfma_f32_32x32x16_bf16(vf[2 * db + 1], P1, O[db], 0, 0, 0);
                }
            }
            const float ltot = lrun + __shfl_xor(lrun, 32) + __builtin_amdgcn_exp2f(sinkl - mrun);
            const float inv = 1.0f / ltot;
            char* op = (char*)OUTA + (row0 * 2048 + hq * 64); const unsigned oo = (unsigned)(l31 * 2048 + 4 * h);
            const float inv16 = inv * 16.0f;
#pragma unroll
            for (int db = 0; db < 2; ++db)
#pragma unroll
                for (int g4 = 0; g4 < 4; ++g4) { int wv = __builtin_amdgcn_cvt_pk_fp8_f32(O[db][4 * g4] * inv16, O[db][4 * g4 + 1] * inv16, 0, false); wv = __builtin_amdgcn_cvt_pk_fp8_f32(O[db][4 * g4 + 2] * inv16, O[db][4 * g4 + 3] * inv16, wv, true);
                    *(unsigned*)(op + oo + 32 * db + 8 * g4) = (unsigned)wv; }
        }
    }
    __syncthreads();
}

constexpr int MLA_KRS = 400, MLA_KB = 64 * MLA_KRS, MLA_VB = 64 * 256, MLA_BUF = MLA_KB + MLA_VB;
typedef float f32x2m __attribute__((ext_vector_type(2)));
__device__ __forceinline__ void mla_phase(Frame& F) {
    const char* QBc = (const char*)(F.ws + WS_QB); const char* KMLA = (const char*)(F.ws + WS_KMLA); const char* VMLA = (const char*)(F.ws + WS_VMLA);
    const char* CSc = (const char*)(F.ws + WS_CS); char* OUTBc = (char*)(F.ws + WS_OUTA) + 1024;
    int lane = F.lane; asm volatile("" : "+v"(lane));
    const int w = F.wave, l31 = lane & 31, h = lane >> 5;
    const int vq = (lane & 15) >> 2, vp = lane & 3, vg = (lane >> 4) & 1;
    const int vlane = (4 * h + vq) * 64 + (16 * vg + 4 * vp) * 2;
    const int klane = l31 * MLA_KRS + 16 * h;
    constexpr float C2 = 0.07216878364870322f * 1.4426950408889634f;
    for (int it0 = F.bx; it0 < BATCH * 8 * 4; it0 += F.G) {
        const int it = (F.G == 256) ? ((it0 & 7) * 64 + ((it0 >> 3) & 31) + 32 * (it0 >> 8)) : it0;
        const int pr = it & 3, hh = (it >> 2) & 7, b = it >> 5;
        for (int half = 0; half < 2; ++half) {
            const int qb = half ? pr : (7 - pr);
            const int nkt = 4 * (qb + 1);
            const size_t row0 = (size_t)b * SEQ + 256 * qb + 32 * w;
            const int qpos = 256 * qb + 32 * w + l31;
            f32x16 O[4];
#pragma unroll
            for (int db = 0; db < 4; ++db)
#pragma unroll
                for (int r = 0; r < 16; ++r) O[db][r] = 0.f;
            float mrun = -1e30f, lrun = 0.f;
            const size_t hrow0 = ((size_t)b * 8 + hh) * SEQ;
#define MLA_DMAK(kt, bufp) do { const char* kb_ = KMLA + (hrow0 + 64 * (kt)) * 384; \
              _Pragma("unroll") for (int j = 0; j < 4; ++j) { const int q = w + 8 * j; \
                if (q < 25) { const int s_ = 64 * q + lane, row = s_ / 25, ch = s_ - 25 * row; const unsigned off = (unsigned)(row * 384 + ch * 16); \
                    glds16_asm(kb_, off, (unsigned)(size_t)((bufp) + q * 1024)); } } } while (0)
#define MLA_DMAV(kt, bufp) do { const char* vb_ = VMLA + (hrow0 + 64 * (kt)) * 256; \
              _Pragma("unroll") for (int j = 0; j < 2; ++j) { const int q = w + 8 * j; \
                const int s_ = 64 * q + lane, sub = s_ >> 5, row = (sub >> 2) * 8 + ((s_ >> 2) & 7), ch = (sub & 3) * 4 + (s_ & 3); const unsigned off = (unsigned)(row * 256 + ch * 16); \
                glds16_asm(vb_, off, (unsigned)(size_t)((bufp) + q * 1024)); } } while (0)
#define MLA_SB() __builtin_amdgcn_sched_barrier(0)
#define MLA_LDK(p) (*(const LAS bf16x8*)(p))
#define MLA_E(SP, r) do { const float p_ = __builtin_amdgcn_exp2f(SP[r] - mrun); SP[r] = p_; ps += p_; } while (0)
#define MLA_E2(SP, r) do { f32x2m t_ = (f32x2m){SP[r], SP[(r) + 1]} - mrun; t_[0] = __builtin_amdgcn_exp2f(t_[0]); t_[1] = __builtin_amdgcn_exp2f(t_[1]); SP[r] = t_[0]; SP[(r) + 1] = t_[1]; ps2 += t_; } while (0)
#define MLA_QKM(SN, f, ks) SN = __builtin_amdgcn_mfma_f32_32x32x16_bf16(f, Qf[ks], SN, 0, 0, 0)
#define MLA_PEND_PLAIN(SP, vbp) do { float ps = 0.f; \
                _Pragma("unroll") for (int r = 0; r < 16; ++r) MLA_E(SP, r); \
                lrun += ps; \
                const bf16x8 P0 = pack_p(SP, 0), P1 = pack_p(SP, 1); \
                const LAS unsigned char* vb = (vbp); \
                _Pragma("unroll") for (int db = 0; db < 4; ++db) { \
                    O[db] = __builtin_amdgcn_mfma_f32_32x32x16_bf16(tr2(vb + db * 512, vb + db * 512 + 4 * 512), P0, O[db], 0, 0, 0); \
                    O[db] = __builtin_amdgcn_mfma_f32_32x32x16_bf16(tr2(vb + db * 512 + 8 * 512, vb + db * 512 + 12 * 512), P1, O[db], 0, 0, 0); } } while (0)
#define MLA_STAGE(SN, SP, kpp, vbp, NIDX) do { const int n_ = (NIDX); \
                if (n_ <= nlast + 1) {                                    \
                    const LAS unsigned char* kp = (kpp); const LAS unsigned char* vb = (vbp); \
                    bf16x8 kfA[4], kfB[4], vf[8], P0, P1; f32x2m ps2 = {0.f, 0.f}; \
                    _Pragma("unroll") for (int j = 0; j < 4; ++j) kfA[j] = MLA_LDK(kp + 32 * j); \
                    _Pragma("unroll") for (int j = 0; j < 4; ++j) kfB[j] = MLA_LDK(kp + 32 * (4 + j)); \
                    _Pragma("unroll") for (int r = 0; r < 16; ++r) SN[r] = 0.f; \
                    MLA_SB(); \
                    MLA_E2(SP, 0); MLA_SB(); \
                    MLA_QKM(SN, kfA[0], 0); MLA_E2(SP, 2); MLA_SB(); \
                    MLA_QKM(SN, kfA[1], 1); MLA_SB(); \
                    MLA_QKM(SN, kfA[2], 2); MLA_E2(SP, 4); MLA_SB(); \
                    MLA_QKM(SN, kfA[3], 3); MLA_SB(); \
                    _Pragma("unroll") for (int j = 0; j < 4; ++j) kfA[j] = MLA_LDK(kp + 32 * (8 + j)); \
                    MLA_SB(); \
                    MLA_QKM(SN, kfB[0], 4); MLA_E2(SP, 6); MLA_SB(); \
                    MLA_QKM(SN, kfB[1], 5); P0 = pack_p(SP, 0); MLA_SB(); \
                    MLA_QKM(SN, kfB[2], 6); MLA_E2(SP, 8); MLA_SB(); \
                    MLA_QKM(SN, kfB[3], 7); MLA_E2(SP, 10); MLA_SB(); \
                    _Pragma("unroll") for (int db = 0; db < 2; ++db) { vf[2 * db] = tr2(vb + db * 512, vb + db * 512 + 4 * 512); vf[2 * db + 1] = tr2(vb + db * 512 + 8 * 512, vb + db * 512 + 12 * 512); } \
                    MLA_SB(); \
                    MLA_QKM(SN, kfA[0], 8); MLA_E2(SP, 12); MLA_SB(); \
                    MLA_QKM(SN, kfA[1], 9); MLA_SB(); \
                    MLA_QKM(SN, kfA[2], 10); MLA_E2(SP, 14); MLA_SB(); \
                    MLA_QKM(SN, kfA[3], 11); lrun += ps2[0] + ps2[1]; P1 = pack_p(SP, 1); MLA_SB(); \
                    _Pragma("unroll") for (int db = 2; db < 4; ++db) { vf[2 * db] = tr2(vb + db * 512, vb + db * 512 + 4 * 512); vf[2 * db + 1] = tr2(vb + db * 512 + 8 * 512, vb + db * 512 + 12 * 512); } \
                    MLA_SB(); \
                    if (n_ >= nlast) {                                    \
                        _Pragma("unroll") for (int r = 0; r < 16; ++r) { const int key = 32 * n_ + crow(r, h); if (key > qpos) SN[r] = -1e30f; } \
                    } \
                    float mx; \
                    O[0] = __builtin_amdgcn_mfma_f32_32x32x16_bf16(vf[0], P0, O[0], 0, 0, 0); MLA_SB(); \
                    O[0] = __builtin_amdgcn_mfma_f32_32x32x16_bf16(vf[1], P1, O[0], 0, 0, 0); MLA_SB(); \
                    O[1] = __builtin_amdgcn_mfma_f32_32x32x16_bf16(vf[2], P0, O[1], 0, 0, 0); mx = fmaxf(fmaxf(SN[0], SN[1]), SN[2]); MLA_SB(); \
                    O[1] = __builtin_amdgcn_mfma_f32_32x32x16_bf16(vf[3], P1, O[1], 0, 0, 0); mx = fmaxf(fmaxf(mx, SN[3]), SN[4]); mx = fmaxf(fmaxf(mx, SN[5]), SN[6]); MLA_SB(); \
                    O[2] = __builtin_amdgcn_mfma_f32_32x32x16_bf16(vf[4], P0, O[2], 0, 0, 0); mx = fmaxf(fmaxf(mx, SN[7]), SN[8]); mx = fmaxf(fmaxf(mx, SN[9]), SN[10]); MLA_SB(); \
                    O[2] = __builtin_amdgcn_mfma_f32_32x32x16_bf16(vf[5], P1, O[2], 0, 0, 0); mx = fmaxf(fmaxf(mx, SN[11]), SN[12]); mx = fmaxf(fmaxf(mx, SN[13]), SN[14]); MLA_SB(); \
                    O[3] = __builtin_amdgcn_mfma_f32_32x32x16_bf16(vf[6], P0, O[3], 0, 0, 0); mx = fmaxf(mx, SN[15]); MLA_SB(); \
                    O[3] = __builtin_amdgcn_mfma_f32_32x32x16_bf16(vf[7], P1, O[3], 0, 0, 0); MLA_SB(); \
                    mx = fmaxf(mx, __shfl_xor(mx, 32)); \
                      \
                    if (__builtin_amdgcn_ballot_w64(mx > mrun + 8.f) != 0) { \
                        const float mn = fmaxf(mrun, mx); \
                        const float alpha = __builtin_amdgcn_exp2f(mrun - mn); \
                        mrun = mn; lrun *= alpha; \
                        _Pragma("unroll") for (int db = 0; db < 4; ++db) _Pragma("unroll") for (int r = 0; r < 16; ++r) O[db][r] *= alpha; \
                    } \
                } } while (0)
#define MLA_KB_(i) (F.lds + (i) * MLA_KB)
#define MLA_VB_(i) (F.lds + 3 * MLA_KB + (i) * MLA_VB)
#define MLA_TILE(KT, BI) do { const int kt_ = (KT); \
                  \
                if (kt_ + 1 < nkt) asm volatile("s_waitcnt vmcnt(3) lgkmcnt(0)" ::: "memory"); else asm volatile("s_waitcnt vmcnt(0) lgkmcnt(0)" ::: "memory"); \
                __builtin_amdgcn_s_barrier(); asm volatile("" ::: "memory");     \
                  \
                  \
                if (w < 4) { if (kt_ + 1 < nkt) MLA_DMAV(kt_ + 1, MLA_VB_(((BI) + 1) % 3)); if (kt_ + 2 < nkt) MLA_DMAK(kt_ + 2, MLA_KB_(((BI) + 2) % 3)); } \
                  \
                const LAS unsigned char* vprev = (kt_ == 0) ? (MLA_VB_(BI) + vlane) : (MLA_VB_(((BI) + 2) % 3) + 16 * 512 + vlane); \
                MLA_STAGE(Sa, Sb, MLA_KB_(BI) + klane, vprev, 2 * kt_); \
                if (w >= 4) { if (kt_ + 1 < nkt) MLA_DMAV(kt_ + 1, MLA_VB_(((BI) + 1) % 3)); if (kt_ + 2 < nkt) MLA_DMAK(kt_ + 2, MLA_KB_(((BI) + 2) % 3)); } \
                MLA_STAGE(Sb, Sa, MLA_KB_(BI) + 32 * MLA_KRS + klane, MLA_VB_(BI) + vlane, 2 * kt_ + 1); \
                } while (0)
            const int nlast = 8 * qb + w;
            f32x16 Sa, Sb;
#pragma unroll
            for (int r = 0; r < 16; ++r) { Sa[r] = 0.f; Sb[r] = -__builtin_inff(); }
            __syncthreads();
            MLA_DMAK(0, MLA_KB_(0)); MLA_DMAV(0, MLA_VB_(0));
            if (nkt > 1) MLA_DMAK(1, MLA_KB_(1));
            bf16x8 Qf[12];
            { const char* qp = QBc + (row0 * 1536 + hh * 192) * 2; const unsigned qo = (unsigned)(l31 * 3072 + 16 * h);
#pragma unroll
              for (int ks = 0; ks < 12; ++ks) Qf[ks] = *(const bf16x8*)(qp + qo + 32 * ks);
              const float* cs = (const float*)(CSc + row0 * 256 + (unsigned)(l31 * 256));
              rope_frag(Qf[8], Qf[10], cs, 8 * h); rope_frag(Qf[9], Qf[11], cs, 16 + 8 * h); }
#pragma unroll 1
            for (int kt = 0; kt < nkt; kt += 3) {
                MLA_TILE(kt, 0);
                if (kt + 1 < nkt) MLA_TILE(kt + 1, 1);
                if (kt + 2 < nkt) MLA_TILE(kt + 2, 2);
            }
            if (w == 7) { MLA_PEND_PLAIN(Sb, MLA_VB_((nkt - 1) % 3) + 16 * 512 + vlane); }
#undef MLA_TILE
#undef MLA_STAGE
#undef MLA_PEND_PLAIN
#undef MLA_DMAK
#undef MLA_DMAV
            const float ltot = lrun + __shfl_xor(lrun, 32);
            const float inv = 1.0f / ltot;
            char* op = OUTBc + (row0 * 2048 + hh * 128); const unsigned oo = (unsigned)(l31 * 2048 + 4 * h);
            const float inv16 = inv * 16.0f;
#pragma unroll
            for (int db = 0; db < 4; ++db)
#pragma unroll
                for (int g4 = 0; g4 < 4; ++g4) { int wv = __builtin_amdgcn_cvt_pk_fp8_f32(O[db][4 * g4] * inv16, O[db][4 * g4 + 1] * inv16, 0, false); wv = __builtin_amdgcn_cvt_pk_fp8_f32(O[db][4 * g4 + 2] * inv16, O[db][4 * g4 + 3] * inv16, wv, true);
                    *(unsigned*)(op + oo + 32 * db + 8 * g4) = (unsigned)wv; }
        }
    }
    __syncthreads();
}

__device__ __forceinline__ void p7_router(Frame& F) {
    const char* Hc = (const char*)(F.ws + WS_H);
    const bf16_t* WRH = (const bf16_t*)(F.ws + WS_WRT); const bf16_t* WRL = WRH + NEXP * DM;
    int* TOPE = (int*)(F.ws + WS_TOPE); float* TOPW = (float*)(F.ws + WS_TOPW); int* CNT = (int*)(F.ws + WS_CNT);
    const float* SSQH = (const float*)(F.ws + WS_CKV); unsigned char* HN8 = (unsigned char*)(F.ws + WS_XN);
    constexpr int A_BYTES = 32 * 4096, LG_OFF = A_BYTES, HIST_OFF = LG_OFF + 32 * 33 * 4, RS_OFF = HIST_OFF + 128;
    LAS float* red = (LAS float*)F.lds; LAS float* lg = (LAS float*)(F.lds + LG_OFF); LAS int* hist = (LAS int*)(F.lds + HIST_OFF); LAS float* rsl = (LAS float*)(F.lds + RS_OFF);
    int lane = F.lane; asm volatile("" : "+v"(lane));
    const int w = F.wave, l31 = lane & 31, h = lane >> 5;
    bf16x8 bh[16];
#pragma unroll
    for (int ks = 0; ks < 16; ++ks) { const size_t bo = (size_t)l31 * DM + 256 * w + 16 * ks + 8 * h; bh[ks] = *(const bf16x8*)(WRH + bo); }
    for (int c = F.bx; c < NTOK / 128; c += F.G) {
        __syncthreads();
        if (F.tid < NEXP) hist[F.tid] = 0;
        for (int tt = 0; tt < 4; ++tt) {
            const int r0 = 128 * c + 32 * tt;
            __syncthreads();
            { const char* hb = Hc + (size_t)r0 * 4096;
#pragma unroll
              for (int j = 0; j < 16; ++j) { const int p = w + 8 * j, s_ = 64 * p + lane, row = s_ >> 8, pos = s_ & 255;
                  glds16_asm(hb, (unsigned)(row * 4096 + ((pos ^ (row & 15)) << 4)), (unsigned)(size_t)(F.lds + p * 1024)); } }
            if (F.tid < 32) { const float* sp = SSQH + (size_t)(r0 + F.tid) * 32; float ssum = 0.f;
#pragma unroll
                for (int q4 = 0; q4 < 8; ++q4) { const f32x4 v = *(const f32x4*)(sp + 4 * q4); ssum += (v[0] + v[1]) + (v[2] + v[3]); }
                const float rs = 1.0f / sqrtf(ssum * (1.0f / DM) + EPS); rsl[F.tid] = rs; }
            asm volatile("s_waitcnt vmcnt(0)" ::: "memory");
            __syncthreads();
            f32x16 acc;
#pragma unroll
            for (int r = 0; r < 16; ++r) acc[r] = 0.f;
#pragma unroll
            for (int ks = 0; ks < 16; ++ks) { const int ch = 32 * w + 2 * ks + h;
                const bf16x8 ah = *(const LAS bf16x8*)(F.lds + l31 * 4096 + ((ch ^ (l31 & 15)) << 4));
                const bf16x8 blk = *(const bf16x8*)(WRL + (size_t)l31 * DM + 256 * w + 16 * ks + 8 * h);
                acc = __builtin_amdgcn_mfma_f32_32x32x16_bf16(ah, bh[ks], acc, 0, 0, 0);
                acc = __builtin_amdgcn_mfma_f32_32x32x16_bf16(ah, blk, acc, 0, 0, 0); }
#pragma unroll 4
            for (int j = 0; j < 16; ++j) { const int s_ = F.tid + 512 * j, row = s_ >> 8, g = (s_ & 255) ^ (row & 15); const float rs = rsl[row];
                const u32x4 hw = *(const LAS u32x4*)(F.lds + s_ * 16);
                int y0 = __builtin_amdgcn_cvt_pk_fp8_f32(bf_lo(hw.x) * rs, bf_hi(hw.x) * rs, 0, false); y0 = __builtin_amdgcn_cvt_pk_fp8_f32(bf_lo(hw.y) * rs, bf_hi(hw.y) * rs, y0, true);
                int y1 = __builtin_amdgcn_cvt_pk_fp8_f32(bf_lo(hw.z) * rs, bf_hi(hw.z) * rs, 0, false); y1 = __builtin_amdgcn_cvt_pk_fp8_f32(bf_lo(hw.w) * rs, bf_hi(hw.w) * rs, y1, true);
                *(u32x2*)(HN8 + (size_t)(r0 + row) * DM + g * 8) = (u32x2){(unsigned)y0, (unsigned)y1}; }
            __syncthreads();
#pragma unroll
            for (int r = 0; r < 16; ++r) red[(w * 32 + crow(r, h)) * 32 + l31] = acc[r];
            __syncthreads();
#pragma unroll
            for (int q = 0; q < 2; ++q) { const int idx = F.tid + 512 * q, row = idx >> 5, e = idx & 31; float sum = 0.f;
#pragma unroll
                for (int ww = 0; ww < 8; ++ww) sum += red[(ww * 32 + row) * 32 + e];
                lg[row * 33 + e] = sum * rsl[row] + F.b_router[e]; }
            __syncthreads();
#pragma unroll
            for (int rr = 0; rr < 4; ++rr) {
                float lv = (lane < 32) ? lg[(4 * w + rr) * 33 + l31] : -1e30f; float tv[4]; int te[4];
#pragma unroll
                for (int k = 0; k < 4; ++k) {
                    float bv = lv; int bi = lane;
#pragma unroll
                    for (int o = 1; o < 64; o <<= 1) { const float ov = __shfl_xor(bv, o); const int oi = __shfl_xor(bi, o); if (ov > bv || (ov == bv && oi < bi)) { bv = ov; bi = oi; } }
                    tv[k] = bv; te[k] = bi; if (lane == bi) lv = -3e38f;
                }
                const float e1 = __expf(tv[1] - tv[0]), e2 = __expf(tv[2] - tv[0]), e3 = __expf(tv[3] - tv[0]); const float inv = 1.0f / (1.0f + e1 + e2 + e3);
                if (lane == 0) { const int row = r0 + 4 * w + rr;
                    *(int4*)(TOPE + (size_t)row * 4) = make_int4(te[0], te[1], te[2], te[3]);
                    *(float4*)(TOPW + (size_t)row * 4) = make_float4(inv, e1 * inv, e2 * inv, e3 * inv);
                    atomicAdd((int*)hist + te[0], 1); atomicAdd((int*)hist + te[1], 1); atomicAdd((int*)hist + te[2], 1); atomicAdd((int*)hist + te[3], 1); }
            }
        }
        __syncthreads();
        if (F.tid < NEXP) CNT[c * NEXP + F.tid] = hist[F.tid];
    }
    __syncthreads();
}

__device__ __forceinline__ void p8_slots(Frame& F) {
    const int* CNT = (const int*)(F.ws + WS_CNT); const int* TOPE = (const int*)(F.ws + WS_TOPE);
    int* SLOT = (int*)(F.ws + WS_SLOT); int* ROWTOK = (int*)(F.ws + WS_ROWTOK); int* TILEE = (int*)(F.ws + WS_TILEE);
    LAS int* red_all = (LAS int*)F.lds;
    LAS int* red_pre = red_all + 512;
    LAS int* tot = red_pre + 512;
    LAS int* pre = tot + 32;
    LAS int* pstart = pre + 32;
    LAS int* le = pstart + 64;
    LAS int* ls = le + 512;
    constexpr int NCH = NTOK / 128;
    for (int c = F.bx; c < NCH; c += F.G) {
        __syncthreads();
        { const int e = F.tid & 31, part = F.tid >> 5; int sa = 0, sp = 0;
          for (int cc = part; cc < NCH; cc += 16) { const int v = CNT[cc * NEXP + e]; sa += v; if (cc < c) sp += v; }
          red_all[part * 32 + e] = sa; red_pre[part * 32 + e] = sp; }
        le[F.tid] = TOPE[(size_t)c * 512 + F.tid];
        __syncthreads();
        if (F.tid < 32) { int sa = 0, sp = 0;
#pragma unroll
            for (int p = 0; p < 16; ++p) { sa += red_all[p * 32 + F.tid]; sp += red_pre[p * 32 + F.tid]; }
            tot[F.tid] = sa; pre[F.tid] = sp; }
        __syncthreads();
        if (F.tid == 0) { int a = 0; for (int e = 0; e < NEXP; ++e) { pstart[e] = a; a += (tot[e] + 255) / 256 * 256; } pstart[32] = a; }
        __syncthreads();
        if (F.tid < 32) { const int e = F.tid; int run = pstart[e] + pre[e];
            for (int a = 0; a < 512; ++a) { if (le[a] == e) { ls[a] = run; ++run; } } }
        __syncthreads();
        { const int a = F.tid, token = 128 * c + (a >> 2), slot = ls[a]; SLOT[(size_t)c * 512 + a] = slot; ROWTOK[slot] = token; }
        if (c < NEXP) { const int e = c; for (int r = pstart[e] + tot[e] + F.tid; r < pstart[e + 1]; r += NTHREADS) ROWTOK[r] = 0; }
        if (c == 0) { const int ntl = pstart[32] / 256;
            for (int t = F.tid; t < ntl; t += NTHREADS) { int e = 0; for (int q = 1; q < NEXP; ++q) if (t * 256 >= pstart[q]) e = q; TILEE[t] = e; }
            if (F.tid == 0) F.ctl[CW_NT] = (unsigned)ntl; }
    }
    __syncthreads();
}

__device__ __forceinline__ void p11_final(Frame& F) {
    const int gw = F.bx * NWAVES + F.wave, NGW = F.G * NWAVES, lane = F.lane;
    const bf16_t* YB = (const bf16_t*)(F.ws + WS_YBUF); const int* SLOT = (const int*)(F.ws + WS_SLOT); const float* TOPW = (const float*)(F.ws + WS_TOPW);
#ifdef DBG_DUMP
    for (int m = gw; m < NTOK; m += NGW) {
        const bf16_t* src = (const bf16_t*)(F.ws + DBG_DUMP_OFF) + (size_t)((m + DBG_DUMP_SHIFT) % NTOK) * DBG_DUMP_PITCH + DBG_DUMP_COL;
        #ifdef DBG_TWICE
        const bf16_t* src2 = (const bf16_t*)(F.ws + WS_ACT) + (size_t)m * DBG_DUMP_PITCH + DBG_DUMP_COL;
        for (int d = lane; d < DM; d += 64) F.out[(size_t)m * DM + d] = (bf_lo((unsigned)src[d]) - bf_lo((unsigned)src2[d])) * 1000.f + 1.0f;
#else
        for (int d = lane; d < DM; d += 64) F.out[(size_t)m * DM + d] = (d < DBG_DUMP_N) ? bf_lo((unsigned)src[d]) : 0.f;
#endif
    }
    return;
#endif
    constexpr int R11 = 2;
    typedef float f32x2_ __attribute__((ext_vector_type(2)));
    int4 sl[R11]; float4 tw[R11];
#pragma unroll
    for (int q = 0; q < R11; ++q) { const int m = gw + q * NGW; sl[q] = make_int4(0, 0, 0, 0); tw[q] = make_float4(0.f, 0.f, 0.f, 0.f);
        if (m < NTOK) { sl[q] = *(const int4*)(SLOT + (size_t)m * 4); tw[q] = *(const float4*)(TOPW + (size_t)m * 4); } }
    for (int m0 = gw; m0 < NTOK; m0 += R11 * NGW) {
        u32x2 hw[R11][8]; unsigned ya[R11][8], yb[R11][8], yc[R11][8], yd[R11][8];
#pragma unroll
        for (int q = 0; q < R11; ++q) { const int m = m0 + q * NGW; if (m < NTOK) {
            const u32x2* hb = (const u32x2*)((const bf16_t*)(F.ws + WS_H) + (size_t)m * DM) + lane;
            const unsigned* y0 = (const unsigned*)((const unsigned char*)YB + (size_t)sl[q].x * DM) + lane; const unsigned* y1 = (const unsigned*)((const unsigned char*)YB + (size_t)sl[q].y * DM) + lane;
            const unsigned* y2 = (const unsigned*)((const unsigned char*)YB + (size_t)sl[q].z * DM) + lane; const unsigned* y3 = (const unsigned*)((const unsigned char*)YB + (size_t)sl[q].w * DM) + lane;
#pragma unroll
            for (int j = 0; j < 8; ++j) { hw[q][j] = hb[64 * j]; ya[q][j] = y0[64 * j]; yb[q][j] = y1[64 * j]; yc[q][j] = y2[64 * j]; yd[q][j] = y3[64 * j]; } } }
        float4 twc[R11];
#pragma unroll
        for (int q = 0; q < R11; ++q) { twc[q] = tw[q]; const int mn = m0 + (R11 + q) * NGW;
            if (mn < NTOK) { sl[q] = *(const int4*)(SLOT + (size_t)mn * 4); tw[q] = *(const float4*)(TOPW + (size_t)mn * 4); } }
#pragma unroll
        for (int q = 0; q < R11; ++q) { const int m = m0 + q * NGW; if (m < NTOK) {
            f32x4* hr = (f32x4*)(F.out + (size_t)m * DM) + lane;
            f32x4 v[8]; float s = 0.f;
#pragma unroll
            for (int j = 0; j < 8; ++j) { v[j] = (f32x4){bf_lo(hw[q][j].x), bf_hi(hw[q][j].x), bf_lo(hw[q][j].y), bf_hi(hw[q][j].y)};
                const unsigned a = ya[q][j], b = yb[q][j], c = yc[q][j], d = yd[q][j];
                const f32x2_ a0 = __builtin_amdgcn_cvt_pk_f32_fp8((int)a, false), a1 = __builtin_amdgcn_cvt_pk_f32_fp8((int)a, true), b0 = __builtin_amdgcn_cvt_pk_f32_fp8((int)b, false), b1 = __builtin_amdgcn_cvt_pk_f32_fp8((int)b, true);
                const f32x2_ c0 = __builtin_amdgcn_cvt_pk_f32_fp8((int)c, false), c1 = __builtin_amdgcn_cvt_pk_f32_fp8((int)c, true), d0 = __builtin_amdgcn_cvt_pk_f32_fp8((int)d, false), d1 = __builtin_amdgcn_cvt_pk_f32_fp8((int)d, true);
                v[j].x += twc[q].x * a0[0] + twc[q].y * b0[0] + twc[q].z * c0[0] + twc[q].w * d0[0];
                v[j].y += twc[q].x * a0[1] + twc[q].y * b0[1] + twc[q].z * c0[1] + twc[q].w * d0[1];
                v[j].z += twc[q].x * a1[0] + twc[q].y * b1[0] + twc[q].z * c1[0] + twc[q].w * d1[0];
                v[j].w += twc[q].x * a1[1] + twc[q].y * b1[1] + twc[q].z * c1[1] + twc[q].w * d1[1];
                s += (v[j].x * v[j].x + v[j].y * v[j].y) + (v[j].z * v[j].z + v[j].w * v[j].w); }
            const float rstd = 1.0f / sqrtf(wave_sum(s) * (1.0f / DM) + EPS);
#pragma unroll
            for (int j = 0; j < 8; ++j) { const f32x4 gg = ((const f32x4*)F.g_final)[lane + 64 * j]; hr[64 * j] = v[j] * rstd * gg; } } }
    }
}

__global__ void __launch_bounds__(NTHREADS, 2) fwd_kernel(Args args) {
    __shared__ __attribute__((aligned(16))) unsigned char lds_raw[LDS_BYTES];
    Frame F;
    F.lds = (LAS unsigned char*)lds_raw; F.ws = args.ws; F.ctl = (unsigned*)(args.ws + WS_CTL);
    F.tid = threadIdx.x; F.lane = F.tid & 63; F.wave = __builtin_amdgcn_readfirstlane(F.tid >> 6); F.G = gridDim.x; F.bx = blockIdx.x;
    F.x = (const float*)args.in[0]; F.positions = (const int*)args.in[1]; F.g_attn = (const float*)args.in[2]; F.w_in = (const float*)args.in[3]; F.b_gate = (const float*)args.in[4];
    F.sinks = (const float*)args.in[5]; F.g_q = (const float*)args.in[6]; F.w_uq = (const float*)args.in[7]; F.g_kv = (const float*)args.in[8]; F.w_ukv = (const float*)args.in[9];
    F.w_o_swa = (const float*)args.in[10]; F.w_o_mla = (const float*)args.in[11]; F.w_out = (const float*)args.in[12]; F.g_ffn = (const float*)args.in[13]; F.w_router = (const float*)args.in[14];
    F.b_router = (const float*)args.in[15]; F.w_gate_up = (const float*)args.in[16]; F.b_gate_up = (const float*)args.in[17]; F.w_down = (const float*)args.in[18]; F.b_down = (const float*)args.in[19];
    F.g_final = (const float*)args.in[20]; F.out = args.out;
    volatile LAS unsigned* MISC = (volatile LAS unsigned*)(F.lds + MISC_OFF);
#ifdef DBG_ZERO_LDS
    for (int u = F.tid; u < RING_BYTES / 4; u += NTHREADS) ((LAS unsigned*)(F.lds))[u] = 0u;
#endif
    for (int u = F.tid; u < (LDS_BYTES - MISC_OFF) / 4; u += NTHREADS) ((LAS unsigned*)(F.lds + MISC_OFF))[u] = 0u;
    __syncthreads();
    const int lo = args.ph_lo, hi = args.ph_hi;
    const bool multi = (hi - lo) > 1;
    XcdBarrier bar; bar.bar = F.ctl + CW_BAR; bar.x = 0; bar.st = nullptr;
    if (multi) bar = xcd_barrier_post(F.ctl + CW_BAR, MISC + 8);
#ifndef PHMASK
#ifdef DBG_NOMOE
#define PHMASK 0x87F
#else
#define PHMASK 0xFFF
#endif
#endif
#define IN(k) (((PHMASK >> (k)) & 1) && lo <= (k) && (k) < hi)
#define SEAM(k) do { if (IN(k) && IN((k) + 1)) xcd_barrier(bar); } while (0)
    unsigned char* ws = args.ws;
    bf16_t* XN = (bf16_t*)(ws + WS_XN); bf16_t* PROJ = (bf16_t*)(ws + WS_PROJ); unsigned char* GATES = (unsigned char*)(ws + WS_GATES);
    const int* TILEE = (const int*)(ws + WS_TILEE); const int* ROWTOK = (const int*)(ws + WS_ROWTOK);

#ifndef REPMASK
#define REPMASK 0
#endif
#define NREP(k) (((REPMASK >> (k)) & 1) + 1)
    if (IN(0)) { for (int rep = 0; rep < NREP(0); ++rep) p0_prologue(F); SEAM(0); }
    if (IN(1)) {
        { pg8::Gemm8 g{(const unsigned char*)(ws + WS_XN8), (const unsigned char*)(ws + WS_WIN), DM, DM, nullptr, 0, (const int*)(ws + WS_IDROW)}; pg8::StaticOrder S; S.init(NTOK / 256, NPROJ / 256, F.G, F.bx);
          pg8::EpiProj8 E{PROJ, (float*)(ws + WS_CQ)};
          for (int rep = 0; rep < NREP(1); ++rep) pg8::gemm_phase_f8<pg8::EpiProj8>(F.lds, g, S, E); }
        { pg8::Gemm8 g{(const unsigned char*)(ws + WS_XN8), (const unsigned char*)(ws + WS_WIN + WIN_GATES_OFF), DM, DM, nullptr, 0, (const int*)(ws + WS_IDROW)}; pg8::StaticOrder S; S.init(NTOK / 256, NGATE / 256, F.G, F.bx);
          pg8::EpiGates8 E{GATES, F.b_gate};
          for (int rep = 0; rep < NREP(1); ++rep) pg8::gemm_phase_f8<pg8::EpiGates8>(F.lds, g, S, E); }
        SEAM(1);
    }
#ifdef DBG_TWICE
    if (IN(2)) {
        pg8::Gemm g{XN, (const bf16_t*)(ws + WS_WIN), DM, DM, nullptr, 0, nullptr}; pg8::StaticOrder S; S.init(NTOK / 256, NIN_PHYS / 256, F.G, F.bx);
        pg8::EpiProj E{(bf16_t*)(ws + WS_YBUF), (bf16_t*)(ws + WS_ACT), F.b_gate};
        pg8::gemm_phase<pg8::EpiProj, false, false>(F.lds, g, S, E);
    }
#else
#endif
    if (IN(3)) {
#ifndef P3_SKIP_GEMM
        { pg8::Gemm g{PROJ + PC_DQ, (const bf16_t*)(ws + WS_WUQ), NPROJ, 512, nullptr, 0, nullptr}; pg8::StaticOrder S; S.init(NTOK / 256, 1536 / 256, F.G, F.bx);
          pg8::EpiQn E{(bf16_t*)(ws + WS_QB), (const float*)(ws + WS_CQ), 0.07216878364870322f * 1.4426950408889634f};
          for (int rep = 0; rep < NREP(12); ++rep) pg8::gemm_phase<pg8::EpiQn, false, false>(F.lds, g, S, E); }
        { pg8::Gemm g{PROJ + PC_DKV, (const bf16_t*)(ws + WS_WUKV), NPROJ, 256, nullptr, 0, nullptr}; pg8::StaticOrder S; S.init(NTOK / 256, 2048 / 256, F.G, F.bx);
          pg8::EpiKVn E{(bf16_t*)(ws + WS_KMLA), (bf16_t*)(ws + WS_VMLA), (const float*)(ws + WS_CQ), PROJ, (const float*)(ws + WS_CS)};
          for (int rep = 0; rep < NREP(12); ++rep) pg8::gemm_phase<pg8::EpiKVn, false, false>(F.lds, g, S, E); }
#endif
#ifndef P3_SKIP_SWA
        for (int rep = 0; rep < NREP(3); ++rep) swa_phase(F);
#endif
        SEAM(3);
    }
    if (IN(4)) { for (int rep = 0; rep < NREP(4); ++rep) mla_phase(F); SEAM(4); }
    if (IN(5)) {
        pg8::Gemm8 g{(const unsigned char*)(ws + WS_OUTA), (const unsigned char*)(ws + WS_WOA), DM, DM, nullptr, 0, (const int*)(ws + WS_IDROW)}; pg8::StaticOrder S; S.init(NTOK / 256, DM / 256, F.G, F.bx);
        pg8::EpiGateMerge8 E{(unsigned char*)(ws + WS_MIX), GATES};
        for (int rep = 0; rep < NREP(5); ++rep) pg8::gemm_phase_f8<pg8::EpiGateMerge8, true>(F.lds, g, S, E);
        SEAM(5);
    }
    if (IN(6)) {
        pg8::Gemm8 g{(const unsigned char*)(ws + WS_MIX), (const unsigned char*)(ws + WS_WOUT), DM, DM, nullptr, 0, (const int*)(ws + WS_IDROW)}; pg8::StaticOrder S; S.init(NTOK / 256, DM / 256, F.G, F.bx);
        pg8::EpiRes8 E{F.x, (bf16_t*)(ws + WS_H), (float*)(ws + WS_CKV)};
        for (int rep = 0; rep < NREP(6); ++rep) pg8::gemm_phase_f8<pg8::EpiRes8>(F.lds, g, S, E);
        SEAM(6);
    }
    if (IN(7)) { for (int rep = 0; rep < NREP(7); ++rep) p7_router(F); SEAM(7); }
    if (IN(8)) { p8_slots(F); SEAM(8); }
    if (IN(9)) {
        const int ntl = (int)__hip_atomic_load(F.ctl + CW_NT, __ATOMIC_RELAXED, __HIP_MEMORY_SCOPE_AGENT);
        pg8::Gemm8 g{(const unsigned char*)XN, (const unsigned char*)(ws + WS_WGU), DM, DM, TILEE, (size_t)2 * DM * DM, ROWTOK}; pg8::StaticOrder S; S.init(ntl, 2 * DM / 256, F.G, F.bx);
        pg8::EpiSwiglu8 E{(unsigned char*)(ws + WS_ACT), F.b_gate_up, TILEE};
        for (int rep = 0; rep < NREP(9); ++rep) pg8::gemm_phase_f8<pg8::EpiSwiglu8>(F.lds, g, S, E);
        SEAM(9);
    }
#ifdef DBG_TWICE
    if (IN(10)) {
        const int gw = F.bx * NWAVES + F.wave, NGW = F.G * NWAVES; unsigned cnt = 0;
        for (int m = gw; m < NTOK; m += NGW) {
            const bf16_t* s1 = (const bf16_t*)(ws + DBG_CMP_OFF1) + (size_t)m * DBG_CMP_PITCH; const bf16_t* s2 = (const bf16_t*)(ws + DBG_CMP_OFF2) + (size_t)m * DBG_CMP_PITCH;
            for (int d = F.lane; d < 2048; d += 64) cnt += (s1[d] != s2[d]) ? 1u : 0u;
        }
        if (cnt) atomicAdd(F.ctl + 32, cnt);
    }
    if (IN(11)) {
        const unsigned c = __hip_atomic_load(F.ctl + 32, __ATOMIC_RELAXED, __HIP_MEMORY_SCOPE_AGENT);
        const float v = c == 0 ? 1.0f : (c < 1000u ? 2.0f : (c < 100000u ? 3.0f : (c < 10000000u ? 4.0f : 5.0f)));
        for (size_t i = (size_t)F.bx * NTHREADS + F.tid; i < (size_t)NTOK * DM; i += (size_t)F.G * NTHREADS) F.out[i] = v;
        return;
    }
#endif
    if (IN(10)) {
        const int ntl = (int)__hip_atomic_load(F.ctl + CW_NT, __ATOMIC_RELAXED, __HIP_MEMORY_SCOPE_AGENT);
        pg8::Gemm8 g{(const unsigned char*)(ws + WS_ACT), (const unsigned char*)(ws + WS_WD), DM, DM, TILEE, (size_t)DM * DM, (const int*)(ws + WS_IDROW)}; pg8::StaticOrder S; S.init(ntl, DM / 256, F.G, F.bx);
        pg8::EpiDown8 E{(unsigned char*)(ws + WS_YBUF), F.b_down, TILEE};
        for (int rep = 0; rep < NREP(10); ++rep) pg8::gemm_phase_f8<pg8::EpiDown8>(F.lds, g, S, E);
        SEAM(10);
    }
    if (IN(11)) { p11_final(F); }
#undef IN
#undef SEAM
}

extern "C" void kernel_launch(void* const* d_in, const int* in_sizes, int n_in, void* d_out, int out_size, void* d_ws, size_t ws_size, hipStream_t stream) {
    static int grid = 0;
    if (grid == 0) {
        if (n_in != 21 || out_size != NTOK * DM || ws_size < WS_END) { fprintf(stderr, "kernel_launch: unexpected problem (n_in %d, out %d, ws %zu)\n", n_in, out_size, ws_size); grid = -1; return; }
        int dev = 0, cus = 0, per_cu = 0;
        if (hipGetDevice(&dev) != hipSuccess || hipDeviceGetAttribute(&cus, hipDeviceAttributeMultiprocessorCount, dev) != hipSuccess) { grid = -1; return; }
        if (hipOccupancyMaxActiveBlocksPerMultiprocessor(&per_cu, (const void*)fwd_kernel, NTHREADS, 0) != hipSuccess || per_cu < 1) { fprintf(stderr, "kernel_launch: occupancy query says %d\n", per_cu); }
        (void)hipGetLastError();
        grid = cus;
    }
    if (grid < 0) return;
    if (hipMemsetAsync((char*)d_ws + WS_CTL, 0, CTL_ZERO_BYTES, stream) != hipSuccess) return;
    Args a{};
    for (int i = 0; i < 21; ++i) a.in[i] = d_in[i];
    a.out = (float*)d_out; a.ws = (unsigned char*)d_ws;
#if MK_ONE_LAUNCH
    a.ph_lo = 0; a.ph_hi = 12;
    hipLaunchKernelGGL(fwd_kernel, dim3(grid), dim3(NTHREADS), 0, stream, a);
#else
    for (int p = 0; p < 12; ++p) { a.ph_lo = p; a.ph_hi = p + 1; hipLaunchKernelGGL(fwd_kernel, dim3(grid), dim3(NTHREADS), 0, stream, a); }
#endif
}
```

```cpp
#include <hip/hip_runtime.h>
#include <cstdio>
#include <cstdint>

#ifndef MK_ONE_LAUNCH
#define MK_ONE_LAUNCH 1
#endif

#define LAS __attribute__((address_space(3)))
#define GAS __attribute__((address_space(1)))
typedef unsigned short bf16_t;
typedef short bf16x8 __attribute__((ext_vector_type(8)));
typedef short s16x4 __attribute__((ext_vector_type(4)));
typedef float f32x4 __attribute__((ext_vector_type(4)));
typedef float f32x16 __attribute__((ext_vector_type(16)));
typedef unsigned u32x4 __attribute__((ext_vector_type(4)));
typedef unsigned u32x2 __attribute__((ext_vector_type(2)));
typedef short v4i16_t __attribute__((ext_vector_type(4)));

constexpr int DM = 2048, BATCH = 16, SEQ = 2048, NTOK = BATCH * SEQ;
constexpr int NPROJ = 2304;
constexpr int PC_KA = 1024, PC_VA = 1152, PC_DQ = 1280, PC_DKV = 1792, PC_KR = 2048;
constexpr int NGATE = 4096, NIN_PHYS = 6400, NIN_LOG = 6208, NLOW = 2112;
constexpr int NEXP = 32, TOPK = 4, MAXTILES = 544, PROWS = MAXTILES * 256;
constexpr float EPS = 1e-6f;

constexpr size_t MiB = 1ull << 20;
constexpr size_t WS_CTL = 0, CTL_ZERO_BYTES = 1 * MiB;
constexpr size_t WS_CS = 1 * MiB, WS_WRT = 9 * MiB, WS_WIN = 10 * MiB, WS_WUQ = 36 * MiB, WS_WUKV = 38 * MiB, WS_WOA = 40 * MiB, WS_WOB = 45 * MiB, WS_WOUT = 50 * MiB;
constexpr size_t WS_WGU = 64 * MiB, WS_WD = 580 * MiB, WS_XN = 840 * MiB, WS_PROJ = 968 * MiB, WS_GATES = 1112 * MiB, WS_CQ = 1368 * MiB, WS_CKV = 1400 * MiB;
constexpr size_t WS_QB = 1416 * MiB, WS_KMLA = 1512 * MiB  , WS_VMLA = 1610 * MiB  ;
constexpr size_t WS_OUTA = 1676 * MiB, WS_OUTB = 1740 * MiB, WS_MIX = 1804 * MiB;
constexpr size_t WS_TOPE = 1932 * MiB, WS_TOPW = 1933 * MiB, WS_SLOT = 1934 * MiB, WS_ROWTOK = 1935 * MiB, WS_TILEE = 1936 * MiB, WS_CNT = 1937 * MiB;
constexpr size_t WS_ACT = 1940 * MiB, WS_YBUF = 2484 * MiB, WS_END = 3028 * MiB;
constexpr size_t WS_H = WS_OUTA;
constexpr size_t WS_XN8 = WS_YBUF  , WS_IDROW = 60 * MiB, WIN_GATES_OFF = 16 * MiB;
constexpr int LDPAD = 16;
constexpr int CW_NT = 16, CW_BAR = 4096;

constexpr int RING_BYTES = 131072, LDS_BYTES = 147456, MISC_OFF = LDS_BYTES - 256;
constexpr int NWAVES = 8, NTHREADS = 512;

__device__ __forceinline__ unsigned cvt_pk_bf16(float lo, float hi) { unsigned r; asm volatile("v_cvt_pk_bf16_f32 %0, %1, %2" : "=v"(r) : "v"(lo), "v"(hi)); return r; }
__device__ __forceinline__ unsigned cvt_pk_bf16_t(float lo, float hi) { unsigned r; asm volatile("s_nop 0\n\tv_cvt_pk_bf16_f32 %0, %1, %2" : "=v"(r) : "v"(lo), "v"(hi)); return r; }
__device__ __forceinline__ float bf_lo(unsigned w) { return __uint_as_float(w << 16); }
__device__ __forceinline__ float bf_hi(unsigned w) { return __uint_as_float(w & 0xffff0000u); }
__device__ __forceinline__ float wave_sum(float v) {
#pragma unroll
    for (int o = 1; o < 64; o <<= 1) v += __shfl_xor(v, o);
    return v;
}
__device__ __forceinline__ float fast_sigmoid(float x) { return __builtin_amdgcn_rcpf(1.0f + __builtin_amdgcn_exp2f(-1.4426950408889634f * x)); }
__device__ __forceinline__ const char* uni_ptr(const char* p) { const unsigned long long v = (unsigned long long)p; const unsigned lo = __builtin_amdgcn_readfirstlane((unsigned)v), hi = __builtin_amdgcn_readfirstlane((unsigned)(v >> 32)); return (const char*)(((unsigned long long)hi << 32) | lo); }
__device__ __forceinline__ void glds16_asm(const char* sbase, unsigned voff, unsigned lds_dst) {
    unsigned keep;
    asm volatile("s_mov_b32 %0, m0\n\ts_mov_b32 m0, %3\n\ts_nop 0\n\tglobal_load_lds_dwordx4 %1, %2\n\ts_mov_b32 m0, %0" : "=&s"(keep) : "v"(voff), "s"(sbase), "s"(lds_dst) : "memory");
}
#define LDS_WAIT() asm volatile("s_waitcnt lgkmcnt(0)" ::: "memory")

#define XB_TMO      128
#define XB_XCNT(j)  (256  + 64 * (j))
#define XB_XSUB(j)  (1280 + 64 * (j))
#define XB_XGEN(j)  (2304 + 64 * (j))
#define XB_TOP      3328
#define XB_TOPGEN   3392
#define XCD_BAR_WORDS 3456
#define XB_SPIN_CAP (1u << 18)
__device__ __forceinline__ unsigned xb_ld(unsigned* p)              { return __hip_atomic_load(p, __ATOMIC_RELAXED, __HIP_MEMORY_SCOPE_AGENT); }
__device__ __forceinline__ unsigned xb_add(unsigned* p, unsigned v) { return __hip_atomic_fetch_add(p, v, __ATOMIC_RELAXED, __HIP_MEMORY_SCOPE_AGENT); }
__device__ __forceinline__ unsigned xb_xcc_id() { return (unsigned)__builtin_amdgcn_s_getreg((3 << 11) | 20) & 0xFu; }
#define XB_SPIN(cond, bar) do { unsigned _sp = 0; while (cond) { __builtin_amdgcn_s_sleep(1); \
    if ((++_sp & 255u) == 0u) { if (xb_ld(&(bar)[XB_TMO])) break; if (_sp > XB_SPIN_CAP) { atomicAdd(&(bar)[XB_TMO], 1u); break; } } } } while (0)
struct XcdBarrier { unsigned* bar; unsigned x; volatile LAS unsigned* st; };
__device__ __forceinline__ XcdBarrier xcd_barrier_post(unsigned* bar, volatile LAS unsigned* st) {
    XcdBarrier b; b.bar = bar; b.x = xb_xcc_id(); b.st = st;
    if (threadIdx.x == 0) (void)xb_add(&bar[XB_XCNT(b.x)], 1u);
    return b;
}
__device__ __forceinline__ void xcd_barrier_complete(unsigned* bar, unsigned x, unsigned& nloc, unsigned& nx) {
    const unsigned G = gridDim.x * gridDim.y * gridDim.z;
    unsigned sum, cnt, mine, sp = 0u;
    for (;;) {
        sum = 0u; cnt = 0u; mine = 0u;
#pragma unroll
        for (unsigned j = 0; j < 16; ++j) { const unsigned c = xb_ld(&bar[XB_XCNT(j)]); sum += c; cnt += (c > 0u) ? 1u : 0u; mine = (j == x) ? c : mine; }
        if (sum == G) break;
        __builtin_amdgcn_s_sleep(1);
        if ((++sp & 255u) == 0u) { if (xb_ld(&bar[XB_TMO])) break; if (sp > XB_SPIN_CAP) { atomicAdd(&bar[XB_TMO], 1u); break; } }
    }
    nloc = mine > 0u ? mine : 1u; nx = cnt > 0u ? cnt : 1u;
}
__device__ __forceinline__ void xcd_barrier(const XcdBarrier& b) {
    asm volatile("s_waitcnt vmcnt(0)" ::: "memory");
    __syncthreads();
    if (threadIdx.x == 0) {
        unsigned* bar = b.bar;
        __builtin_amdgcn_s_waitcnt(0);
        unsigned nloc = b.st[0], nx = b.st[1];
        if (nloc == 0u) { xcd_barrier_complete(bar, b.x, nloc, nx); b.st[0] = nloc; b.st[1] = nx; }
        const unsigned old = xb_add(&bar[XB_XSUB(b.x)], 1u);
        const unsigned gen = old / nloc;
        if (old + 1u == (gen + 1u) * nloc) {
            __builtin_amdgcn_fence(__ATOMIC_RELEASE, "agent");
            asm volatile("s_waitcnt vmcnt(0)" ::: "memory");
            const unsigned og = xb_add(&bar[XB_TOP], 1u);
            const unsigned tg = og / nx;
            if (og + 1u == (tg + 1u) * nx) xb_add(&bar[XB_TOPGEN], 1u);
            else XB_SPIN(xb_ld(&bar[XB_TOPGEN]) == tg, bar);
            __builtin_amdgcn_fence(__ATOMIC_ACQUIRE, "agent");
            xb_add(&bar[XB_XGEN(b.x)], 1u);
            asm volatile("s_waitcnt vmcnt(0)" ::: "memory");
        } else {
            XB_SPIN(xb_ld(&bar[XB_XGEN(b.x)]) == gen, bar);
            __builtin_amdgcn_fence(__ATOMIC_ACQUIRE, "agent");
            asm volatile("s_waitcnt vmcnt(0)" ::: "memory");
        }
    }
    __syncthreads();
}

namespace pg8 {
constexpr int BM = 256, BK = 64, HALF = 128, HTB = HALF * BK * 2, STAGE_BYTES = 8 * HTB, NXCD = 8, WGM = 8;
__host__ __device__ __forceinline__ int lds_byte(int r, int c) { const int st = (r >> 4) * 2 + (c >> 5), rr = r & 15, cc = c & 31, ob = rr * 64 + cc * 2; return st * 1024 + (ob ^ (((ob >> 9) & 1) << 5)); }
__host__ __device__ __forceinline__ void stage_rc(int b, int& R, int& C) { const int st = b / 1024, sb = b % 1024, swz = sb ^ (((sb >> 9) & 1) << 5); R = (st >> 1) * 16 + swz / 64; C = (st & 1) * 32 + (swz % 64) / 2; }
__host__ __device__ __forceinline__ int perm32(int rho) { const int n = rho >> 4, i = rho & 15; return 8 * (i >> 2) + 4 * n + (i & 3); }
struct Unit { int pm, pn; };
struct Gemm { const bf16_t* A; const bf16_t* Bt; int lda, K; const int* tile_e; size_t estride; const int* rowtok; };
struct StaticOrder {
    int nM, nN, nwg, G, c;
    __device__ void init(int nM_, int nN_, int G_, int c_) { nM = nM_; nN = nN_; nwg = nM * nN; G = G_; c = c_; }
    __device__ bool next(int i, Unit& u) const {
        const long L = (long)i * G + c; if (L >= nwg) return false;
        int wgid = (int)L; { const int q = nwg / NXCD, r = nwg % NXCD, xcd = wgid % NXCD, off = wgid / NXCD; wgid = (xcd < r ? xcd * (q + 1) : r * (q + 1) + (xcd - r) * q) + off; }
        const int nig = WGM * nN, gid = wgid / nig, fm = gid * WGM, gsz = (nM - fm) < WGM ? (nM - fm) : WGM;
        u.pm = fm + ((wgid % nig) % gsz); u.pn = (wgid % nig) / gsz; return true;
    }
};
template <class Epi, bool GROUPED, bool GATHER, bool MIDHOOK = false>
__device__ __forceinline__ void gemm_phase(LAS unsigned char* lds, const Gemm g, const StaticOrder& S, const Epi& E) {
    int tid = threadIdx.x; asm volatile("" : "+v"(tid));
    const int wid = __builtin_amdgcn_readfirstlane(tid >> 6), lane = tid & 63, wr = wid >> 2, wc = wid & 3, fr = lane & 15, fq = lane >> 4;
    int K = g.K; asm volatile("" : "+s"(K));
    const int nt = K / BK, lda = g.lda;
    unsigned voffB[2];
#pragma unroll
    for (int i = 0; i < 2; ++i) { int R, C; stage_rc(tid * 16 + i * 8192, R, C); const int Rb = Epi::PERM ? ((R & ~31) + perm32(R & 31)) : R;
        (void)Rb; voffB[i] = (unsigned)(tid * 16 + i * 8192); }
    const size_t kstep = (size_t)(BK * 2);
    const size_t kstepB = 32768, hstepB = 16384, tstepB = (size_t)nt * 32768;
    const unsigned ldsw = (unsigned)wid * 1024u;
    const int aoff = lds_byte(wr * 64 + fr, fq * 8), boff = lds_byte(wc * 32 + fr, fq * 8);
#define PG8_SA(b, h) (((b) * 2 + (h)) * HTB)
#define PG8_SB(b, h) ((4 + (b) * 2 + (h)) * HTB)
#define PG8_STAGE(bufoff, gbase, voff) do { _Pragma("unroll") for (int _i = 0; _i < 2; ++_i) \
        __builtin_amdgcn_global_load_lds((const unsigned*)((const char*)(gbase) + (voff)[_i]), (LAS unsigned*)(lds + (bufoff) + ldsw + _i * 8192), 16, 0, 0); } while (0)
#define PG8_LDA(dst, b, h) do { _Pragma("unroll") for (int m = 0; m < 4; ++m) _Pragma("unroll") for (int k = 0; k < 2; ++k) dst[m][k] = *(const LAS bf16x8*)(lds + PG8_SA(b, h) + aoff + m * 2048 + k * 1024); } while (0)
#define PG8_LDB(dst, b, h) do { _Pragma("unroll") for (int n = 0; n < 2; ++n) _Pragma("unroll") for (int k = 0; k < 2; ++k) dst[n][k] = *(const LAS bf16x8*)(lds + PG8_SB(b, h) + boff + n * 2048 + k * 1024); } while (0)
#define PG8_MMA(ai, bj, At, Bt) do { __builtin_amdgcn_s_setprio(1); _Pragma("unroll") for (int m = 0; m < 4; ++m) _Pragma("unroll") for (int n = 0; n < 2; ++n) _Pragma("unroll") for (int k = 0; k < 2; ++k) \
        acc[ai][bj][m][n] = __builtin_amdgcn_mfma_f32_16x16x32_bf16(Bt[n][k], At[m][k], acc[ai][bj][m][n], 0, 0, 0); __builtin_amdgcn_s_setprio(0); } while (0)
#ifdef DBG_SAFE_GEMM
#define PG8_WAIT_V(n) asm volatile("s_waitcnt vmcnt(0)" ::: "memory")
#else
#define PG8_WAIT_V(n) asm volatile("s_waitcnt vmcnt(" #n ")" ::: "memory")
#endif
#define PG8_WAIT_L(n) asm volatile("s_waitcnt lgkmcnt(" #n ")" ::: "memory")
#define PG8_BAR __builtin_amdgcn_s_barrier()
#define PG8_SCHED __builtin_amdgcn_sched_barrier(0)
#define PG8_AOFF(vo, u) do { int _t = tid; asm volatile("" : "+v"(_t));     \
        _Pragma("unroll") for (int _i = 0; _i < 2; ++_i) { int _R, _C; stage_rc(_t * 16 + _i * 8192, _R, _C); \
        _Pragma("unroll") for (int _h = 0; _h < 2; ++_h) { \
        const int _r = (u).pm * BM + _h * HALF + _R; (vo)[_h][_i] = (unsigned)(g.rowtok[_r] * lda + _C) * 2u; } } } while (0)
#define PG8_STGA(bufoff, aptr, gptr, h, vo) do { if constexpr (GATHER) PG8_STAGE(bufoff, gptr, (vo)[h]); else PG8_STAGE(bufoff, (aptr) + (h) * hstepA, voffA); } while (0)
#define PF8_AOFF_LDS(vo, rt) do { int _t = tid; asm volatile("" : "+v"(_t)); \
        _Pragma("unroll") for (int _i = 0; _i < 2; ++_i) { const int _p = _t + 512 * _i, _R = _p >> 3, _C = ((_p & 7) ^ sw8(_R)) << 4; \
        _Pragma("unroll") for (int _h = 0; _h < 2; ++_h) (vo)[_h][_i] = (unsigned)((rt)[_h * HALF + _R] * lda + _C); } } while (0)
    Unit cur, nxt; int ui = 0;
    if (!S.next(0, cur)) return;
    f32x4 acc[2][2][4][2];
#pragma unroll
    for (int a = 0; a < 2; ++a)
#pragma unroll
        for (int b = 0; b < 2; ++b)
#pragma unroll
            for (int m = 0; m < 4; ++m)
#pragma unroll
                for (int n = 0; n < 2; ++n) acc[a][b][m][n] = (f32x4){0.f, 0.f, 0.f, 0.f};
    bf16x8 At[4][2], B0[2][2], B1[2][2];
    unsigned voC[2][2], voffA[2];
    LAS u32x4* const gslot = (LAS u32x4*)(lds + STAGE_BYTES) + tid;
    const size_t hstepA = (size_t)HALF * lda * 2, tstepA = 2 * hstepA;
    if constexpr (GATHER) { PG8_AOFF(voC, cur); voffA[0] = 0; voffA[1] = 0; }
    else {
#pragma unroll
        for (int i = 0; i < 2; ++i) { int R, C; stage_rc(tid * 16 + i * 8192, R, C); voffA[i] = (unsigned)(R * lda + C) * 2u; }
#pragma unroll
        for (int h = 0; h < 2; ++h)
#pragma unroll
            for (int i = 0; i < 2; ++i) voC[h][i] = 0;
    }
    const char* const Abase = (const char*)g.A;
    const char* cA = GATHER ? Abase : Abase + (size_t)cur.pm * tstepA;
    const char* cB = (const char*)g.Bt + (GROUPED ? (size_t)g.tile_e[cur.pm] * g.estride * 2 : (size_t)0) + (size_t)cur.pn * tstepB;
    PG8_STAGE(PG8_SB(0, 0), cB, voffB); PG8_STAGE(PG8_SB(0, 1), cB + hstepB, voffB); PG8_STGA(PG8_SA(0, 0), cA, Abase, 0, voC); PG8_STGA(PG8_SA(0, 1), cA, Abase, 1, voC);
    if (wr == 1) PG8_BAR;
    PG8_WAIT_V(2); PG8_BAR;
    PG8_STAGE(PG8_SB(1, 0), cB + kstepB, voffB); PG8_STGA(PG8_SA(1, 0), cA + kstep, Abase + kstep, 0, voC); PG8_STAGE(PG8_SB(1, 1), cB + hstepB + kstepB, voffB);
    PG8_WAIT_V(6); PG8_BAR;
    for (;;) {
        const bool has_next = S.next(ui + 1, nxt);
        const char* nB = cB; const char* nA = cA;
        if (has_next) { nB = (const char*)g.Bt + (GROUPED ? (size_t)g.tile_e[nxt.pm] * g.estride * 2 : (size_t)0) + (size_t)nxt.pn * tstepB;
            if constexpr (GATHER) { unsigned vt[2][2]; PG8_AOFF(vt, nxt); *gslot = (u32x4){vt[0][0], vt[0][1], vt[1][0], vt[1][1]}; } else nA = Abase + (size_t)nxt.pm * tstepA; }
        else if constexpr (GATHER) *gslot = (u32x4){voC[0][0], voC[0][1], voC[1][0], voC[1][1]};
#pragma unroll 1
        for (int t = 0; t < nt; t += 2) {
            const bool last = (t == nt - 2);
            const char* a1 = cA + (size_t)(t + 1) * kstep;
            const char* a2 = last ? nA : cA + (size_t)(t + 2) * kstep; const char* b2 = last ? nB : cB + (size_t)(t + 2) * kstepB;
            const char* a3 = a2 + kstep; const char* b3 = b2 + kstepB;
            if constexpr (MIDHOOK) { if (t == nt / 2) { int ln_ = lane; asm volatile("" : "+v"(ln_)); E.mid(acc, cur, wr, wc, ln_ & 15, ln_ >> 4); } }
            PG8_LDB(B0, 0, 0); PG8_LDB(B1, 0, 1); PG8_SCHED; PG8_LDA(At, 0, 0); PG8_STGA(PG8_SA(1, 1), a1, a1, 1, voC);
            if constexpr (GATHER) { if (last) { const u32x4 q = *gslot; voC[0][0] = q.x; voC[0][1] = q.y; voC[1][0] = q.z; voC[1][1] = q.w; } }
            PG8_WAIT_V(8); PG8_WAIT_L(0); PG8_BAR; PG8_MMA(0, 0, At, B0); PG8_MMA(0, 1, At, B1); PG8_BAR; PG8_SCHED;
            PG8_LDA(At, 0, 1); PG8_STAGE(PG8_SB(0, 0), b2, voffB); PG8_STAGE(PG8_SB(0, 1), b2 + hstepB, voffB); PG8_STGA(PG8_SA(0, 0), a2, a2, 0, voC);
            PG8_WAIT_V(8); PG8_WAIT_L(0); PG8_BAR; PG8_MMA(1, 0, At, B0); PG8_MMA(1, 1, At, B1); PG8_BAR; PG8_SCHED;
            PG8_LDB(B0, 1, 0); PG8_LDB(B1, 1, 1); PG8_SCHED; PG8_LDA(At, 1, 0); PG8_STGA(PG8_SA(0, 1), a2, a2, 1, voC);
            PG8_WAIT_V(8); PG8_WAIT_L(0); PG8_BAR; PG8_MMA(0, 0, At, B0); PG8_MMA(0, 1, At, B1); PG8_BAR; PG8_SCHED;
            PG8_LDA(At, 1, 1); PG8_STAGE(PG8_SB(1, 0), b3, voffB); PG8_STAGE(PG8_SB(1, 1), b3 + hstepB, voffB); PG8_STGA(PG8_SA(1, 0), a3, a3, 0, voC);
            PG8_WAIT_V(8); PG8_WAIT_L(0); PG8_BAR; PG8_MMA(1, 0, At, B0); PG8_MMA(1, 1, At, B1); PG8_BAR; PG8_SCHED;
        }
        if (wr == 0) PG8_BAR;
        { int ln_ = lane; asm volatile("" : "+v"(ln_)); E(acc, cur, wr, wc, ln_ & 15, ln_ >> 4); }
        if (!has_next) break;
#pragma unroll
        for (int a = 0; a < 2; ++a)
#pragma unroll
            for (int b = 0; b < 2; ++b)
#pragma unroll
                for (int m = 0; m < 4; ++m)
#pragma unroll
                    for (int n = 0; n < 2; ++n) acc[a][b][m][n] = (f32x4){0.f, 0.f, 0.f, 0.f};
        cur = nxt; cB = nB; cA = nA; ++ui;
        if (wr == 1) PG8_BAR;
    }
    PG8_WAIT_V(0);
    PG8_BAR;
#undef PG8_SA
#undef PG8_SB
#undef PG8_STAGE
#undef PG8_LDA
#undef PG8_LDB
#undef PG8_MMA
#undef PG8_WAIT_V
#undef PG8_WAIT_L
#undef PG8_BAR
#undef PG8_SCHED
#undef PG8_AOFF
#undef PG8_STGA
}

struct GemmO { const bf16_t* A; const bf16_t* Bt; int M, N, K; };
template <class Epi, class Sched, bool ALIGN_EPI = false, bool SP2 = false>
__device__ __forceinline__ void gemm_phase_orig(LAS unsigned char* lds, const GemmO g, const Sched& S, const Epi& E) {
    const int tid = threadIdx.x, wid = __builtin_amdgcn_readfirstlane(tid >> 6), lane = tid & 63, wr = wid >> 2, wc = wid & 3, fr = lane & 15, fq = lane >> 4;
    const int K = g.K, nt = K / BK;
    unsigned voffA[2], voffB[2];
#pragma unroll
    for (int i = 0; i < 2; ++i) { int R, C; stage_rc(tid * 16 + i * 8192, R, C); const int Rb = Epi::PERM ? ((R & ~31) + perm32(R & 31)) : R;
        voffA[i] = (unsigned)(R * K + C) * 2u; voffB[i] = (unsigned)(Rb * K + C) * 2u; }
    const size_t kstep = (size_t)(BK * 2);
    const size_t hstep = (size_t)HALF * K * 2;
    const size_t tstep = 2 * hstep;
    const unsigned ldsw = (unsigned)wid * 1024u;
    const int aoff = lds_byte(wr * 64 + fr, fq * 8), boff = lds_byte(wc * 32 + fr, fq * 8);
#define PG8_SA(b, h) (((b) * 2 + (h)) * HTB)
#define PG8_SB(b, h) ((4 + (b) * 2 + (h)) * HTB)
#define PG8_STAGE(bufoff, gbase, voff) do { _Pragma("unroll") for (int _i = 0; _i < 2; ++_i) \
        __builtin_amdgcn_global_load_lds((const unsigned*)((const char*)(gbase) + (voff)[_i]), (LAS unsigned*)(lds + (bufoff) + ldsw + _i * 8192), 16, 0, 0); } while (0)
#define PG8_LDA(dst, b, h) do { _Pragma("unroll") for (int m = 0; m < 4; ++m) _Pragma("unroll") for (int k = 0; k < 2; ++k) dst[m][k] = *(const LAS bf16x8*)(lds + PG8_SA(b, h) + aoff + m * 2048 + k * 1024); } while (0)
#define PG8_LDB(dst, b, h) do { _Pragma("unroll") for (int n = 0; n < 2; ++n) _Pragma("unroll") for (int k = 0; k < 2; ++k) dst[n][k] = *(const LAS bf16x8*)(lds + PG8_SB(b, h) + boff + n * 2048 + k * 1024); } while (0)
#define PG8_MMA(ai, bj, At, Bt) do { __builtin_amdgcn_s_setprio(1); _Pragma("unroll") for (int m = 0; m < 4; ++m) _Pragma("unroll") for (int n = 0; n < 2; ++n) _Pragma("unroll") for (int k = 0; k < 2; ++k) \
        acc[ai][bj][m][n] = __builtin_amdgcn_mfma_f32_16x16x32_bf16(Bt[n][k], At[m][k], acc[ai][bj][m][n], 0, 0, 0); __builtin_amdgcn_s_setprio(0); } while (0)
#define PG8_WAIT_V(n) asm volatile("s_waitcnt vmcnt(" #n ")" ::: "memory")
#define PG8_WAIT_L(n) asm volatile("s_waitcnt lgkmcnt(" #n ")" ::: "memory")
#define PG8_BAR __builtin_amdgcn_s_barrier()
#define PG8_SCHED __builtin_amdgcn_sched_barrier(0)
    Unit cur, nxt; int ui = 0;
    if (!S.next(0, cur)) return;
    f32x4 acc[2][2][4][2];
#pragma unroll
    for (int a = 0; a < 2; ++a)
#pragma unroll
        for (int b = 0; b < 2; ++b)
#pragma unroll
            for (int m = 0; m < 4; ++m)
#pragma unroll
                for (int n = 0; n < 2; ++n) acc[a][b][m][n] = (f32x4){0.f, 0.f, 0.f, 0.f};
    bf16x8 At[4][2], B0[2][2], B1[2][2];
    const char* cA = (const char*)g.A + (size_t)cur.pm * tstep; const char* cB = (const char*)g.Bt + (size_t)cur.pn * tstep;

    if constexpr (SP2) {
        PG8_STAGE(PG8_SB(0, 0), cB, voffB); PG8_STAGE(PG8_SB(0, 1), cB + hstep, voffB); PG8_STAGE(PG8_SA(0, 0), cA, voffA); PG8_STAGE(PG8_SA(0, 1), cA + hstep, voffA);
        if (wr == 1) PG8_BAR;
        PG8_WAIT_V(2); PG8_BAR;
        PG8_STAGE(PG8_SB(1, 0), cB + kstep, voffB); PG8_STAGE(PG8_SA(1, 0), cA + kstep, voffA); PG8_STAGE(PG8_SB(1, 1), cB + hstep + kstep, voffB);
        PG8_WAIT_V(6); PG8_BAR;
    } else {
        PG8_STAGE(PG8_SB(0, 0), cB, voffB); PG8_STAGE(PG8_SA(0, 0), cA, voffA); PG8_STAGE(PG8_SB(0, 1), cB + hstep, voffB); PG8_STAGE(PG8_SA(0, 1), cA + hstep, voffA);
        if (wr == 1) PG8_BAR;
        PG8_WAIT_V(4); PG8_BAR;
        PG8_STAGE(PG8_SB(1, 0), cB + kstep, voffB); PG8_STAGE(PG8_SA(1, 0), cA + kstep, voffA); PG8_STAGE(PG8_SB(1, 1), cB + hstep + kstep, voffB);
        PG8_WAIT_V(6); PG8_BAR;
    }
    for (;;) {
        const bool has_next = S.next(ui + 1, nxt);
        const char* nA = has_next ? (const char*)g.A + (size_t)nxt.pm * tstep : cA; const char* nB = has_next ? (const char*)g.Bt + (size_t)nxt.pn * tstep : cB;
        for (int t = 0; t < nt; t += 2) {
            const bool last = (t == nt - 2);
            const char* a1 = cA + (size_t)(t + 1) * kstep;
            const char* a2 = last ? nA : cA + (size_t)(t + 2) * kstep; const char* b2 = last ? nB : cB + (size_t)(t + 2) * kstep;
            const char* a3 = a2 + kstep; const char* b3 = b2 + kstep;

            if constexpr (SP2) {
            PG8_LDB(B0, 0, 0); PG8_LDB(B1, 0, 1); PG8_SCHED; PG8_LDA(At, 0, 0); PG8_STAGE(PG8_SA(1, 1), a1 + hstep, voffA);
            PG8_WAIT_V(8); PG8_WAIT_L(0); PG8_BAR; PG8_MMA(0, 0, At, B0); PG8_MMA(0, 1, At, B1); PG8_BAR; PG8_SCHED;
            PG8_LDA(At, 0, 1); PG8_STAGE(PG8_SB(0, 0), b2, voffB); PG8_STAGE(PG8_SB(0, 1), b2 + hstep, voffB); PG8_STAGE(PG8_SA(0, 0), a2, voffA);
            PG8_WAIT_V(8); PG8_WAIT_L(0); PG8_BAR; PG8_MMA(1, 0, At, B0); PG8_MMA(1, 1, At, B1); PG8_BAR; PG8_SCHED;
            PG8_LDB(B0, 1, 0); PG8_LDB(B1, 1, 1); PG8_SCHED; PG8_LDA(At, 1, 0); PG8_STAGE(PG8_SA(0, 1), a2 + hstep, voffA);
            PG8_WAIT_V(8); PG8_WAIT_L(0); PG8_BAR; PG8_MMA(0, 0, At, B0); PG8_MMA(0, 1, At, B1); PG8_BAR; PG8_SCHED;
            PG8_LDA(At, 1, 1); PG8_STAGE(PG8_SB(1, 0), b3, voffB); PG8_STAGE(PG8_SB(1, 1), b3 + hstep, voffB); PG8_STAGE(PG8_SA(1, 0), a3, voffA);
            PG8_WAIT_V(8); PG8_WAIT_L(0); PG8_BAR; PG8_MMA(1, 0, At, B0); PG8_MMA(1, 1, At, B1); PG8_BAR; PG8_SCHED;
            } else {
            PG8_LDB(B0, 0, 0); PG8_SCHED; PG8_LDA(At, 0, 0); PG8_STAGE(PG8_SA(1, 1), a1 + hstep, voffA);
            PG8_WAIT_L(8); PG8_BAR; PG8_WAIT_L(0); PG8_MMA(0, 0, At, B0); PG8_BAR; PG8_SCHED;
            PG8_LDB(B1, 0, 1); PG8_STAGE(PG8_SB(0, 0), b2, voffB);
            PG8_BAR; PG8_WAIT_L(0); PG8_MMA(0, 1, At, B1); PG8_BAR;
            PG8_LDA(At, 0, 1); PG8_STAGE(PG8_SA(0, 0), a2, voffA);
            PG8_BAR; PG8_WAIT_L(0); PG8_MMA(1, 0, At, B0); PG8_BAR; PG8_SCHED;
            PG8_STAGE(PG8_SB(0, 1), b2 + hstep, voffB);
            PG8_WAIT_V(6); PG8_BAR; PG8_MMA(1, 1, At, B1); PG8_BAR;
            PG8_LDB(B0, 1, 0); PG8_SCHED; PG8_LDA(At, 1, 0); PG8_STAGE(PG8_SA(0, 1), a2 + hstep, voffA);
            PG8_WAIT_L(8); PG8_BAR; PG8_WAIT_L(0); PG8_MMA(0, 0, At, B0); PG8_BAR; PG8_SCHED;
            PG8_LDB(B1, 1, 1); PG8_STAGE(PG8_SB(1, 0), b3, voffB);
            PG8_BAR; PG8_WAIT_L(0); PG8_MMA(0, 1, At, B1); PG8_BAR;
            PG8_LDA(At, 1, 1); PG8_STAGE(PG8_SA(1, 0), a3, voffA);
            PG8_BAR; PG8_WAIT_L(0); PG8_MMA(1, 0, At, B0); PG8_BAR; PG8_SCHED;
            PG8_STAGE(PG8_SB(1, 1), b3 + hstep, voffB);
            PG8_WAIT_V(6); PG8_BAR; PG8_MMA(1, 1, At, B1); PG8_BAR;
            }
        }
        if constexpr (ALIGN_EPI) { if (wr == 0) PG8_BAR; }
        E(acc, cur, wr, wc, fr, fq);
        if (!has_next) break;
#pragma unroll
        for (int a = 0; a < 2; ++a)
#pragma unroll
            for (int b = 0; b < 2; ++b)
#pragma unroll
                for (int m = 0; m < 4; ++m)
#pragma unroll
                    for (int n = 0; n < 2; ++n) acc[a][b][m][n] = (f32x4){0.f, 0.f, 0.f, 0.f};
        cur = nxt; cA = nA; cB = nB; ++ui;
        if constexpr (ALIGN_EPI) { if (wr == 1) PG8_BAR; }
    }
    PG8_WAIT_V(0);
    if constexpr (!ALIGN_EPI) { if (wr == 0) PG8_BAR; }
    PG8_BAR;
#undef PG8_SA
#undef PG8_SB
#undef PG8_STAGE
#undef PG8_LDA
#undef PG8_LDB
#undef PG8_MMA
#undef PG8_WAIT_V
#undef PG8_WAIT_L
#undef PG8_BAR
#undef PG8_SCHED
}

typedef const f32x4 (&AccRef)[2][2][4][2];
__device__ __forceinline__ u32x4 pack8(f32x4 v0, f32x4 v1) { u32x4 w; w.x = cvt_pk_bf16(v0[0], v0[1]); w.y = cvt_pk_bf16(v0[2], v0[3]); w.z = cvt_pk_bf16(v1[0], v1[1]); w.w = cvt_pk_bf16(v1[2], v1[3]); return w; }

struct EpiProj { static constexpr bool PERM = true;
    bf16_t* proj; bf16_t* gates; const float* b_gate;
    __device__ __forceinline__ void operator()(AccRef acc, const Unit& u, int wr, int wc, int fr, int fq) const {
        const int row0 = u.pm * BM + wr * 64 + fr;
        if (u.pn < 9) {
            const int col0 = u.pn * BM + wc * 64 + 16 * fq;
#pragma unroll
            for (int ai = 0; ai < 2; ++ai)
#pragma unroll
                for (int m = 0; m < 4; ++m) { bf16_t* rowp = proj + (size_t)(row0 + ai * HALF + m * 16) * NPROJ + col0;
#pragma unroll
                    for (int bj = 0; bj < 2; ++bj) *(u32x4*)(rowp + bj * 8) = pack8(acc[ai][bj][m][0], acc[ai][bj][m][1]); }
        } else {
            const int col0 = (u.pn - 9) * BM + wc * 64 + 16 * fq;
            f32x4 bv[2][2];
#pragma unroll
            for (int bj = 0; bj < 2; ++bj)
#pragma unroll
                for (int n = 0; n < 2; ++n) bv[bj][n] = *(const f32x4*)(b_gate + col0 + bj * 8 + 4 * n);
#pragma unroll
            for (int ai = 0; ai < 2; ++ai)
#pragma unroll
                for (int m = 0; m < 4; ++m) { bf16_t* rowp = gates + (size_t)(row0 + ai * HALF + m * 16) * NGATE + col0;
#pragma unroll
                    for (int bj = 0; bj < 2; ++bj) { f32x4 v0 = acc[ai][bj][m][0] + bv[bj][0], v1 = acc[ai][bj][m][1] + bv[bj][1];
#pragma unroll
                        for (int j = 0; j < 4; ++j) { v0[j] = fast_sigmoid(v0[j]); v1[j] = fast_sigmoid(v1[j]); }
                        u32x4 w; w.x = cvt_pk_bf16_t(v0[0], v0[1]); w.y = cvt_pk_bf16_t(v0[2], v0[3]); w.z = cvt_pk_bf16_t(v1[0], v1[1]); w.w = cvt_pk_bf16_t(v1[2], v1[3]);
                        *(u32x4*)(rowp + bj * 8) = w; } }
        }
    }
};
template <bool BIAS> struct EpiBf16 { static constexpr bool PERM = true;
    bf16_t* O; int ldc; const float* bias; const int* tile_e; int bstride; float scl;
    __device__ __forceinline__ void operator()(AccRef acc, const Unit& u, int wr, int wc, int fr, int fq) const {
        const int row0 = u.pm * BM + wr * 64 + fr, col0 = u.pn * BM + wc * 64 + 16 * fq;
        f32x4 bv[2][2];
#pragma unroll
        for (int bj = 0; bj < 2; ++bj)
#pragma unroll
            for (int n = 0; n < 2; ++n) bv[bj][n] = (f32x4){0.f, 0.f, 0.f, 0.f};
        if constexpr (BIAS) { const float* bp = bias + (size_t)tile_e[u.pm] * bstride + col0;
#pragma unroll
            for (int bj = 0; bj < 2; ++bj)
#pragma unroll
                for (int n = 0; n < 2; ++n) bv[bj][n] = *(const f32x4*)(bp + bj * 8 + 4 * n); }
#pragma unroll
        for (int ai = 0; ai < 2; ++ai)
#pragma unroll
            for (int m = 0; m < 4; ++m) { bf16_t* rowp = O + (size_t)(row0 + ai * HALF + m * 16) * ldc + col0;
#pragma unroll
                for (int bj = 0; bj < 2; ++bj) *(u32x4*)(rowp + bj * 8) = pack8((acc[ai][bj][m][0] + bv[bj][0]) * scl, (acc[ai][bj][m][1] + bv[bj][1]) * scl); }
    }
};
struct EpiKV { static constexpr bool PERM = true;
    bf16_t* kmla; bf16_t* vmla;
    __device__ __forceinline__ void operator()(AccRef acc, const Unit& u, int wr, int wc, int fr, int fq) const {
        const int row0 = u.pm * BM + wr * 64 + fr, c0 = wc * 32 + 8 * fq;
#pragma unroll
        for (int ai = 0; ai < 2; ++ai)
#pragma unroll
            for (int m = 0; m < 4; ++m) { const size_t row = (size_t)(row0 + ai * HALF + m * 16);
                const size_t hrow = ((row >> 11) * 8 + u.pn) * 2048 + (row & 2047);
                *(u32x4*)(kmla + hrow * 192 + c0) = pack8(acc[ai][0][m][0], acc[ai][0][m][1]);
                *(u32x4*)(vmla + hrow * 128 + c0) = pack8(acc[ai][1][m][0], acc[ai][1][m][1]); }
    }
};
template <bool ADD> struct EpiGateMix { static constexpr bool PERM = true;
    bf16_t* O; const unsigned char* gates; int goff;
    __device__ __forceinline__ void operator()(AccRef acc, const Unit& u, int wr, int wc, int fr, int fq) const {
        const int row0 = u.pm * BM + wr * 64 + fr, col0 = u.pn * BM + wc * 32 + 8 * fq;
        constexpr float I255 = 1.0f / 255.0f;
#pragma unroll
        for (int ai = 0; ai < 2; ++ai) {
            u32x2 gw[4][2]; u32x4 pw[4][2];
#pragma unroll
            for (int m = 0; m < 4; ++m)
#pragma unroll
                for (int bj = 0; bj < 2; ++bj) { const size_t row = (size_t)(row0 + ai * HALF + m * 16);
                    gw[m][bj] = *(const u32x2*)(gates + row * NGATE + goff + col0 + bj * HALF);
                    if constexpr (ADD) pw[m][bj] = *(const u32x4*)(O + row * DM + col0 + bj * HALF); }
            asm volatile("s_waitcnt vmcnt(0)" ::: "memory");
#pragma unroll
            for (int m = 0; m < 4; ++m)
#pragma unroll
                for (int bj = 0; bj < 2; ++bj) { const size_t row = (size_t)(row0 + ai * HALF + m * 16); const u32x2 g2 = gw[m][bj];
                    f32x4 v0 = acc[ai][bj][m][0], v1 = acc[ai][bj][m][1];
                    v0[0] *= (float)(g2.x & 0xffu) * I255; v0[1] *= (float)((g2.x >> 8) & 0xffu) * I255; v0[2] *= (float)((g2.x >> 16) & 0xffu) * I255; v0[3] *= (float)(g2.x >> 24) * I255;
                    v1[0] *= (float)(g2.y & 0xffu) * I255; v1[1] *= (float)((g2.y >> 8) & 0xffu) * I255; v1[2] *= (float)((g2.y >> 16) & 0xffu) * I255; v1[3] *= (float)(g2.y >> 24) * I255;
                    if constexpr (ADD) { const u32x4 p4 = pw[m][bj];
                        v0[0] += bf_lo(p4.x); v0[1] += bf_hi(p4.x); v0[2] += bf_lo(p4.y); v0[3] += bf_hi(p4.y);
                        v1[0] += bf_lo(p4.z); v1[1] += bf_hi(p4.z); v1[2] += bf_lo(p4.w); v1[3] += bf_hi(p4.w); }
                    *(u32x4*)(O + row * DM + col0 + bj * HALF) = pack8(v0, v1); }
            asm volatile("" ::: "memory");
        }
    }
};
struct EpiGateMerge { static constexpr bool PERM = true;
    unsigned char* O; const unsigned char* gates;
    template <bool FINAL, class AccT> __device__ __forceinline__ void scale(AccT& acc, const Unit& u, int wr, int wc, int fr, int fq) const {
        const int row0 = u.pm * BM + wr * 64 + fr, col0 = u.pn * BM + wc * 64 + 16 * fq;
#pragma unroll
        for (int ai = 0; ai < 2; ++ai) {
            u32x2 ga[4][2], gb[4][2];
#pragma unroll
            for (int m = 0; m < 4; ++m)
#pragma unroll
                for (int bj = 0; bj < 2; ++bj) { const size_t row = (size_t)(row0 + ai * HALF + m * 16);
                    if constexpr (!FINAL) ga[m][bj] = *(const u32x2*)(gates + row * NGATE + col0 + bj * 8);
                    gb[m][bj] = *(const u32x2*)(gates + row * NGATE + DM + col0 + bj * 8); }
            asm volatile("s_waitcnt vmcnt(0)" ::: "memory");
#pragma unroll
            for (int m = 0; m < 4; ++m)
#pragma unroll
                for (int bj = 0; bj < 2; ++bj) { const size_t row = (size_t)(row0 + ai * HALF + m * 16);
                    float f[8];
#pragma unroll
                    for (int j = 0; j < 8; ++j) { const unsigned wb = j < 4 ? gb[m][bj].x : gb[m][bj].y; const float b = fmaxf((float)((wb >> (8 * (j & 3))) & 0xffu), 1.0f);
                        if constexpr (FINAL) f[j] = b * (1.0f / 255.0f);
                        else { const unsigned wa = j < 4 ? ga[m][bj].x : ga[m][bj].y; f[j] = (float)((wa >> (8 * (j & 3))) & 0xffu) * __builtin_amdgcn_rcpf(b); } }
                    f32x4 v0 = acc[ai][bj][m][0], v1 = acc[ai][bj][m][1];
                    v0[0] *= f[0]; v0[1] *= f[1]; v0[2] *= f[2]; v0[3] *= f[3]; v1[0] *= f[4]; v1[1] *= f[5]; v1[2] *= f[6]; v1[3] *= f[7];
                    if constexpr (FINAL) { int w0 = __builtin_amdgcn_cvt_pk_fp8_f32(v0[0] * 16.0f, v0[1] * 16.0f, 0, false); w0 = __builtin_amdgcn_cvt_pk_fp8_f32(v0[2] * 16.0f, v0[3] * 16.0f, w0, true);
                        int w1 = __builtin_amdgcn_cvt_pk_fp8_f32(v1[0] * 16.0f, v1[1] * 16.0f, 0, false); w1 = __builtin_amdgcn_cvt_pk_fp8_f32(v1[2] * 16.0f, v1[3] * 16.0f, w1, true);
                        *(u32x2*)(O + row * DM + col0 + bj * 8) = (u32x2){(unsigned)w0, (unsigned)w1}; }
                    else { acc[ai][bj][m][0] = v0; acc[ai][bj][m][1] = v1; } }
            asm volatile("" ::: "memory");
        }
    }
    __device__ __forceinline__ void mid(f32x4 (&acc)[2][2][4][2], const Unit& u, int wr, int wc, int fr, int fq) const { scale<false>(acc, u, wr, wc, fr, fq); }
    __device__ __forceinline__ void operator()(AccRef acc, const Unit& u, int wr, int wc, int fr, int fq) const { scale<true>(acc, u, wr, wc, fr, fq); }
};
struct EpiResF32 { static constexpr bool PERM = false;
    const float* x; float* out;
    __device__ __forceinline__ void operator()(AccRef acc, const Unit& u, int wr, int wc, int fr, int fq) const {
        const int row0 = u.pm * BM + wr * 64 + fr, col0 = u.pn * BM + wc * 32 + 4 * fq;
#pragma unroll
        for (int ai = 0; ai < 2; ++ai) {
            f32x4 xv[4][2][2];
#pragma unroll
            for (int m = 0; m < 4; ++m) { const size_t off = (size_t)(row0 + ai * HALF + m * 16) * DM + col0;
#pragma unroll
                for (int bj = 0; bj < 2; ++bj)
#pragma unroll
                    for (int n = 0; n < 2; ++n) xv[m][bj][n] = *(const f32x4*)(x + off + bj * HALF + n * 16); }
            asm volatile("s_waitcnt vmcnt(0)" ::: "memory");
#pragma unroll
            for (int m = 0; m < 4; ++m) { const size_t off = (size_t)(row0 + ai * HALF + m * 16) * DM + col0;
#pragma unroll
                for (int bj = 0; bj < 2; ++bj)
#pragma unroll
                    for (int n = 0; n < 2; ++n) *(f32x4*)(out + off + bj * HALF + n * 16) = xv[m][bj][n] + acc[ai][bj][m][n]; }
            asm volatile("" ::: "memory");
        }
    }
};
struct EpiResBf16 { static constexpr bool PERM = true;
    const float* x; bf16_t* out;
    __device__ __forceinline__ void operator()(AccRef acc, const Unit& u, int wr, int wc, int fr, int fq) const {
        const int row0 = u.pm * BM + wr * 64 + fr, col0 = u.pn * BM + wc * 64 + 16 * fq;
#pragma unroll
        for (int ai = 0; ai < 2; ++ai) {
            f32x4 xv[4][2][2];
#pragma unroll
            for (int m = 0; m < 4; ++m) { const size_t off = (size_t)(row0 + ai * HALF + m * 16) * DM + col0;
#pragma unroll
                for (int bj = 0; bj < 2; ++bj)
#pragma unroll
                    for (int n = 0; n < 2; ++n) xv[m][bj][n] = *(const f32x4*)(x + off + bj * 8 + n * 4); }
            asm volatile("s_waitcnt vmcnt(0)" ::: "memory");
#pragma unroll
            for (int m = 0; m < 4; ++m) { const size_t off = (size_t)(row0 + ai * HALF + m * 16) * DM + col0;
#pragma unroll
                for (int bj = 0; bj < 2; ++bj) *(u32x4*)(out + off + bj * 8) = pack8(xv[m][bj][0] + acc[ai][bj][m][0], xv[m][bj][1] + acc[ai][bj][m][1]); }
            asm volatile("" ::: "memory");
        }
    }
};
struct EpiSwiglu { static constexpr bool PERM = true;
    bf16_t* act; const float* bgu; const int* tile_e;
    __device__ __forceinline__ void operator()(AccRef acc, const Unit& u, int wr, int wc, int fr, int fq) const {
        const int row0 = u.pm * BM + wr * 64 + fr, p0 = u.pn * BM + wc * 32 + 8 * fq;
        const float* bp = bgu + (size_t)tile_e[u.pm] * (2 * DM) + p0;
        f32x4 bg[2], bu[2];
#pragma unroll
        for (int bj = 0; bj < 2; ++bj) { const f32x4 a = *(const f32x4*)(bp + bj * HALF), b = *(const f32x4*)(bp + bj * HALF + 4);
            bg[bj] = (f32x4){a[0], a[2], b[0], b[2]}; bu[bj] = (f32x4){a[1], a[3], b[1], b[3]}; }
#pragma unroll
        for (int ai = 0; ai < 2; ++ai)
#pragma unroll
            for (int m = 0; m < 4; ++m) { bf16_t* rowp = act + (size_t)(row0 + ai * HALF + m * 16) * DM + (p0 >> 1);
#pragma unroll
                for (int bj = 0; bj < 2; ++bj) { const f32x4 gt = acc[ai][bj][m][0] + bg[bj], up = acc[ai][bj][m][1] + bu[bj]; float o[4];
#pragma unroll
                    for (int j = 0; j < 4; ++j) { const float gg = fminf(gt[j], 7.0f), uu = fminf(fmaxf(up[j], -7.0f), 7.0f); o[j] = gg * fast_sigmoid(1.702f * gg) * (uu + 1.0f); }
                    u32x2 w; w.x = cvt_pk_bf16(o[0], o[1]); w.y = cvt_pk_bf16(o[2], o[3]);
                    *(u32x2*)(rowp + bj * (HALF / 2)) = w; } }
    }
};

typedef int v8i32 __attribute__((ext_vector_type(8)));
__host__ __device__ __forceinline__ int sw8(int row) { return ((row >> 1) & 7) ^ ((((row >> 2) ^ (row >> 3)) & 1) << 1); }
__host__ __device__ __forceinline__ int img8(int row, int c) { return row * 128 + ((c ^ sw8(row)) << 4); }
struct Gemm8 { const unsigned char* A; const unsigned char* Bt; int lda, K; const int* tile_e; size_t estride; const int* rowtok; };
typedef const f32x4 (&AccRef8)[2][2][4][2];
template <class Epi, bool MIDHOOK = false>
__device__ __forceinline__ void gemm_phase_f8(LAS unsigned char* lds, const Gemm8 g, const StaticOrder& S, const Epi& E) {
    int tid = threadIdx.x; asm volatile("" : "+v"(tid));
    const int wid = __builtin_amdgcn_readfirstlane(tid >> 6), lane = tid & 63, wr = wid >> 2, wc = wid & 3, r15 = lane & 15, kq = lane >> 4;
    int K = g.K; asm volatile("" : "+s"(K));
    const int nt = K / 128, lda = g.lda;
    unsigned voffB[2];
#pragma unroll
    for (int i = 0; i < 2; ++i) voffB[i] = (unsigned)(tid * 16 + i * 8192);
    const size_t kstep = 128;
    const size_t kstepB = 32768, hstepB = 16384, tstepB = (size_t)nt * 32768;
    const unsigned ldsw = (unsigned)wid * 1024u;
    const int sw = sw8(r15);
    int aadr[2], badr[2];
#pragma unroll
    for (int x = 0; x < 2; ++x) { const int c = 2 * kq + x; aadr[x] = (wr * 64 + r15) * 128 + ((c ^ sw) << 4); badr[x] = (wc * 32 + r15) * 128 + ((c ^ sw) << 4); }
#define PF8_SA(b, h) (((b) * 2 + (h)) * HTB)
#define PF8_SB(b, h) ((4 + (b) * 2 + (h)) * HTB)
#define PF8_STAGE(bufoff, gbase, voff) do { _Pragma("unroll") for (int _i = 0; _i < 2; ++_i) \
        __builtin_amdgcn_global_load_lds((const unsigned*)((const char*)(gbase) + (voff)[_i]), (LAS unsigned*)(lds + (bufoff) + ldsw + _i * 8192), 16, 0, 0); } while (0)
#define PF8_LD(dst, off) do { const u32x4 _a = *(const LAS u32x4*)(lds + (off)[0]), _b = *(const LAS u32x4*)(lds + (off)[1]); \
        dst = (v8i32){(int)_a.x, (int)_a.y, (int)_a.z, (int)_a.w, (int)_b.x, (int)_b.y, (int)_b.z, (int)_b.w}; } while (0)
#define PF8_LDA(dst, b, h) do { _Pragma("unroll") for (int tb = 0; tb < 4; ++tb) { const int _o[2] = {PF8_SA(b, h) + aadr[0] + tb * 2048, PF8_SA(b, h) + aadr[1] + tb * 2048}; PF8_LD(dst[tb], _o); } } while (0)
#define PF8_LDB(dst, b, h) do { _Pragma("unroll") for (int pb = 0; pb < 2; ++pb) { const int _o[2] = {PF8_SB(b, h) + badr[0] + pb * 2048, PF8_SB(b, h) + badr[1] + pb * 2048}; PF8_LD(dst[pb], _o); } } while (0)
#define PF8_MMA(ai, bj, At, Bt) do { __builtin_amdgcn_s_setprio(1); _Pragma("unroll") for (int tb = 0; tb < 4; ++tb) _Pragma("unroll") for (int pb = 0; pb < 2; ++pb) \
        acc[ai][bj][tb][pb] = __builtin_amdgcn_mfma_scale_f32_16x16x128_f8f6f4(Bt[pb], At[tb], acc[ai][bj][tb][pb], 0, 0, 0, 0, 0, 0); __builtin_amdgcn_s_setprio(0); } while (0)
#define PF8_WAIT_V(n) asm volatile("s_waitcnt vmcnt(" #n ")" ::: "memory")
#define PF8_WAIT_L(n) asm volatile("s_waitcnt lgkmcnt(" #n ")" ::: "memory")
#define PF8_BAR __builtin_amdgcn_s_barrier()
#define PF8_SCHED __builtin_amdgcn_sched_barrier(0)
#define PF8_AOFF(vo, u) do { int _t = tid; asm volatile("" : "+v"(_t)); \
        _Pragma("unroll") for (int _i = 0; _i < 2; ++_i) { const int _p = _t + 512 * _i, _R = _p >> 3, _C = ((_p & 7) ^ sw8(_R)) << 4; \
        _Pragma("unroll") for (int _h = 0; _h < 2; ++_h) { const int _r = (u).pm * BM + _h * HALF + _R; (vo)[_h][_i] = (unsigned)(g.rowtok[_r] * lda + _C); } } } while (0)
    Unit cur, nxt; int ui = 0;
    LAS int* const te_l = (LAS int*)(lds + STAGE_BYTES + 2048);
    if (g.tile_e) { for (int i = tid; i < S.nM; i += NTHREADS) te_l[i] = g.tile_e[i]; }
    __syncthreads();
    if (!S.next(0, cur)) return;
    f32x4 acc[2][2][4][2];
#pragma unroll
    for (int a = 0; a < 2; ++a)
#pragma unroll
        for (int b = 0; b < 2; ++b)
#pragma unroll
            for (int m = 0; m < 4; ++m)
#pragma unroll
                for (int r = 0; r < 2; ++r) acc[a][b][m][r] = (f32x4){0.f, 0.f, 0.f, 0.f};
    v8i32 At[4], B0[2], B1[2];
    unsigned voC[2][2];
    LAS u32x4* const gslot = (LAS u32x4*)(lds + STAGE_BYTES) + tid;
    PF8_AOFF(voC, cur);
    const char* const Abase = (const char*)g.A;
    const char* cB = (const char*)g.Bt + (g.tile_e ? (size_t)g.tile_e[cur.pm] * g.estride : (size_t)0) + (size_t)cur.pn * tstepB;
    PF8_STAGE(PF8_SB(0, 0), cB, voffB); PF8_STAGE(PF8_SB(0, 1), cB + hstepB, voffB); PF8_STAGE(PF8_SA(0, 0), Abase, voC[0]); PF8_STAGE(PF8_SA(0, 1), Abase, voC[1]);
    if (wr == 1) PF8_BAR;
    PF8_WAIT_V(2); PF8_BAR;
    PF8_STAGE(PF8_SB(1, 0), cB + kstepB, voffB); PF8_STAGE(PF8_SA(1, 0), Abase + kstep, voC[0]); PF8_STAGE(PF8_SB(1, 1), cB + hstepB + kstepB, voffB);
    PF8_WAIT_V(6); PF8_BAR;
    for (;;) {
        const bool has_next = S.next(ui + 1, nxt);
        const char* nB = cB;
        if (has_next) { const int npm = __builtin_amdgcn_readfirstlane(nxt.pm);
            nB = (const char*)g.Bt + (g.tile_e ? (size_t)te_l[npm] * g.estride : (size_t)0) + (size_t)nxt.pn * tstepB;
            if (wid == 0) glds16_asm((const char*)(g.rowtok + (size_t)npm * BM), (unsigned)(lane * 16), (unsigned)(size_t)(lds + STAGE_BYTES + ((ui + 1) & 1) * 1024)); }
#pragma unroll 1
        for (int t = 0; t < nt; t += 2) {
            const bool last = (t == nt - 2);
            if constexpr (MIDHOOK) { if (t == nt / 2) { int ln_ = lane; asm volatile("" : "+v"(ln_)); E.mid(acc, cur, wr, wc, ln_ & 15, ln_ >> 4); } }
            const char* a1 = Abase + (size_t)(t + 1) * kstep;
            const char* a2 = last ? Abase : Abase + (size_t)(t + 2) * kstep; const char* b2 = last ? nB : cB + (size_t)(t + 2) * kstepB;
            const char* a3 = a2 + kstep; const char* b3 = b2 + kstepB;
            PF8_LDB(B0, 0, 0); PF8_LDB(B1, 0, 1); PF8_SCHED; PF8_LDA(At, 0, 0); PF8_STAGE(PF8_SA(1, 1), a1, voC[1]);
            if (last && has_next) { const LAS int* rt = (const LAS int*)(lds + STAGE_BYTES + ((ui + 1) & 1) * 1024); PF8_AOFF_LDS(voC, rt); }
            PF8_WAIT_V(8); PF8_WAIT_L(0); PF8_BAR; PF8_MMA(0, 0, At, B0); PF8_MMA(0, 1, At, B1); PF8_BAR; PF8_SCHED;
            PF8_LDA(At, 0, 1); PF8_STAGE(PF8_SB(0, 0), b2, voffB); PF8_STAGE(PF8_SB(0, 1), b2 + hstepB, voffB); PF8_STAGE(PF8_SA(0, 0), a2, voC[0]);
            PF8_WAIT_V(8); PF8_WAIT_L(0); PF8_BAR; PF8_MMA(1, 0, At, B0); PF8_MMA(1, 1, At, B1); PF8_BAR; PF8_SCHED;
            PF8_LDB(B0, 1, 0); PF8_LDB(B1, 1, 1); PF8_SCHED; PF8_LDA(At, 1, 0); PF8_STAGE(PF8_SA(0, 1), a2, voC[1]);
            PF8_WAIT_V(8); PF8_WAIT_L(0); PF8_BAR; PF8_MMA(0, 0, At, B0); PF8_MMA(0, 1, At, B1); PF8_BAR; PF8_SCHED;
            PF8_LDA(At, 1, 1); PF8_STAGE(PF8_SB(1, 0), b3, voffB); PF8_STAGE(PF8_SB(1, 1), b3 + hstepB, voffB); PF8_STAGE(PF8_SA(1, 0), a3, voC[0]);
            PF8_WAIT_V(8); PF8_WAIT_L(0); PF8_BAR; PF8_MMA(1, 0, At, B0); PF8_MMA(1, 1, At, B1); PF8_BAR; PF8_SCHED;
        }
        if (wr == 0) PF8_BAR;
        { int ln_ = lane; asm volatile("" : "+v"(ln_)); E(acc, cur, wr, wc, ln_ & 15, ln_ >> 4); }
        if (!has_next) break;
#pragma unroll
        for (int a = 0; a < 2; ++a)
#pragma unroll
            for (int b = 0; b < 2; ++b)
#pragma unroll
                for (int m = 0; m < 4; ++m)
#pragma unroll
                    for (int r = 0; r < 2; ++r) acc[a][b][m][r] = (f32x4){0.f, 0.f, 0.f, 0.f};
        cur = nxt; cB = nB; ++ui;
        if (wr == 1) PF8_BAR;
    }
    PF8_WAIT_V(0);
    PF8_BAR;
#undef PF8_SA
#undef PF8_SB
#undef PF8_STAGE
#undef PF8_LD
#undef PF8_LDA
#undef PF8_LDB
#undef PF8_MMA
#undef PF8_WAIT_V
#undef PF8_WAIT_L
#undef PF8_BAR
#undef PF8_SCHED
#undef PF8_AOFF
}
struct EpiSwiglu8 {
    unsigned char* act; const float* bgu; const int* tile_e;
    __device__ __forceinline__ void operator()(AccRef8 acc, const Unit& u, int wr, int wc, int t15, int q) const {
        const int row0 = u.pm * BM + wr * 64 + t15;
        const float* bp = bgu + (size_t)tile_e[u.pm] * (2 * DM);
        const int ja = u.pn * 128 + 32 * wc + 8 * q;
        const f32x4 b0 = *(const f32x4*)(bp + 2 * ja), b1 = *(const f32x4*)(bp + 2 * ja + 4), b2 = *(const f32x4*)(bp + 2 * ja + 8), b3 = *(const f32x4*)(bp + 2 * ja + 12);
        const float bg[8] = {b0[0], b0[2], b1[0], b1[2], b2[0], b2[2], b3[0], b3[2]}, bu[8] = {b0[1], b0[3], b1[1], b1[3], b2[1], b2[3], b3[1], b3[3]};
#pragma unroll
        for (int ai = 0; ai < 2; ++ai)
#pragma unroll
            for (int tb = 0; tb < 4; ++tb) { float o[8];
#pragma unroll
                for (int bj = 0; bj < 2; ++bj)
#pragma unroll
                    for (int j = 0; j < 4; j += 2) {
                        typedef float f32x2_ __attribute__((ext_vector_type(2)));
                        const f32x2_ a0 = {acc[ai][bj][tb][0][j], acc[ai][bj][tb][0][j + 1]}, a1 = {acc[ai][bj][tb][1][j], acc[ai][bj][tb][1][j + 1]};
                        const f32x2_ bg2 = {bg[4 * bj + j], bg[4 * bj + j + 1]}, bu2 = {bu[4 * bj + j], bu[4 * bj + j + 1]};
                        f32x2_ gt = a0 * 0.015625f + bg2, up = a1 * 0.015625f + bu2;
                        gt[0] = fminf(gt[0], 7.0f); gt[1] = fminf(gt[1], 7.0f); up[0] = fminf(fmaxf(up[0], -7.0f), 7.0f); up[1] = fminf(fmaxf(up[1], -7.0f), 7.0f);
                        f32x2_ e = gt * (-1.702f * 1.4426950408889634f); e[0] = __builtin_amdgcn_exp2f(e[0]); e[1] = __builtin_amdgcn_exp2f(e[1]);
                        f32x2_ d = e + 1.0f; d[0] = __builtin_amdgcn_rcpf(d[0]); d[1] = __builtin_amdgcn_rcpf(d[1]);
                        const f32x2_ r = gt * d * (up + 1.0f); o[4 * bj + j] = r[0]; o[4 * bj + j + 1] = r[1]; }
                int w0 = __builtin_amdgcn_cvt_pk_fp8_f32(o[0], o[1], 0, false); w0 = __builtin_amdgcn_cvt_pk_fp8_f32(o[2], o[3], w0, true);
                int w1 = __builtin_amdgcn_cvt_pk_fp8_f32(o[4], o[5], 0, false); w1 = __builtin_amdgcn_cvt_pk_fp8_f32(o[6], o[7], w1, true);
                *(u32x2*)(act + (size_t)(row0 + ai * HALF + tb * 16) * DM + ja) = (u32x2){(unsigned)w0, (unsigned)w1}; }
    }
};
struct EpiDown8 {
    unsigned char* y; const float* bd; const int* tile_e;
    __device__ __forceinline__ void operator()(AccRef8 acc, const Unit& u, int wr, int wc, int t15, int q) const {
        const int row0 = u.pm * BM + wr * 64 + t15;
        const float* bp = bd + (size_t)tile_e[u.pm] * DM;
        const int c0 = u.pn * BM + 64 * wc + 16 * q;
        f32x4 bb[2][2];
#pragma unroll
        for (int bj = 0; bj < 2; ++bj)
#pragma unroll
            for (int pb = 0; pb < 2; ++pb) bb[bj][pb] = *(const f32x4*)(bp + c0 + 8 * bj + 4 * pb);
#pragma unroll
        for (int ai = 0; ai < 2; ++ai)
#pragma unroll
            for (int tb = 0; tb < 4; ++tb) { int w4[4];
#pragma unroll
                for (int bj = 0; bj < 2; ++bj)
#pragma unroll
                    for (int pb = 0; pb < 2; ++pb) { const f32x4 o = acc[ai][bj][tb][pb] * 0.015625f + bb[bj][pb];
                        const int x = __builtin_amdgcn_cvt_pk_fp8_f32(o[0], o[1], 0, false); w4[2 * bj + pb] = __builtin_amdgcn_cvt_pk_fp8_f32(o[2], o[3], x, true); }
                *(u32x4*)(y + (size_t)(row0 + ai * HALF + tb * 16) * DM + c0) = (u32x4){(unsigned)w4[0], (unsigned)w4[1], (unsigned)w4[2], (unsigned)w4[3]}; }
    }
};
struct EpiGateMerge8 {
    unsigned char* O; const unsigned char* gates;
    template <bool FINAL, class AccT> __device__ __forceinline__ void scale(AccT& acc, const Unit& u, int wr, int wc, int t15, int q) const {
        const int row0 = u.pm * BM + wr * 64 + t15, c0 = u.pn * BM + 64 * wc + 16 * q;
#pragma unroll
        for (int ai = 0; ai < 2; ++ai) {
            u32x4 ga[4], gb[4];
#pragma unroll
            for (int tb = 0; tb < 4; ++tb) { const size_t row = (size_t)(row0 + ai * HALF + tb * 16);
                if constexpr (!FINAL) ga[tb] = *(const u32x4*)(gates + row * NGATE + c0);
                gb[tb] = *(const u32x4*)(gates + row * NGATE + DM + c0); }
            asm volatile("s_waitcnt vmcnt(0)" ::: "memory");
#pragma unroll
            for (int tb = 0; tb < 4; ++tb) { const size_t row = (size_t)(row0 + ai * HALF + tb * 16); int w4[4];
#pragma unroll
                for (int bj = 0; bj < 2; ++bj)
#pragma unroll
                    for (int pb = 0; pb < 2; ++pb) { const unsigned wb = gb[tb][2 * bj + pb]; f32x4 v = acc[ai][bj][tb][pb];
#pragma unroll
                        for (int j = 0; j < 4; ++j) { const float b = fmaxf((float)((wb >> (8 * j)) & 0xffu), 1.0f);
                            if constexpr (FINAL) v[j] *= b * (1.0f / (255.0f * 64.0f));
                            else { const unsigned wa = ga[tb][2 * bj + pb]; v[j] *= (float)((wa >> (8 * j)) & 0xffu) * __builtin_amdgcn_rcpf(b); } }
                        if constexpr (FINAL) { const int x = __builtin_amdgcn_cvt_pk_fp8_f32(v[0], v[1], 0, false); w4[2 * bj + pb] = __builtin_amdgcn_cvt_pk_fp8_f32(v[2], v[3], x, true); }
                        else acc[ai][bj][tb][pb] = v; }
                if constexpr (FINAL) *(u32x4*)(O + row * DM + c0) = (u32x4){(unsigned)w4[0], (unsigned)w4[1], (unsigned)w4[2], (unsigned)w4[3]}; }
            asm volatile("" ::: "memory");
        }
    }
    __device__ __forceinline__ void mid(f32x4 (&acc)[2][2][4][2], const Unit& u, int wr, int wc, int t15, int q) const { scale<false>(acc, u, wr, wc, t15, q); }
    __device__ __forceinline__ void operator()(AccRef8 acc, const Unit& u, int wr, int wc, int t15, int q) const { scale<true>(acc, u, wr, wc, t15, q); }
};
struct EpiProj8 {
    bf16_t* proj; float* ssqp;
    __device__ __forceinline__ void operator()(AccRef8 acc, const Unit& u, int wr, int wc, int t15, int q) const {
        const int row0 = u.pm * BM + wr * 64 + t15, c0 = u.pn * BM + 64 * wc + 16 * q;
        const bool lat = (u.pn >= 5) && (u.pn <= 7);
#pragma unroll
        for (int ai = 0; ai < 2; ++ai)
#pragma unroll
            for (int tb = 0; tb < 4; ++tb) { const size_t row = (size_t)(row0 + ai * HALF + tb * 16); bf16_t* rowp = proj + row * NPROJ + c0;
#pragma unroll
                for (int bj = 0; bj < 2; ++bj) *(u32x4*)(rowp + 8 * bj) = pack8(acc[ai][bj][tb][0] * 0.015625f, acc[ai][bj][tb][1] * 0.015625f);
                if (lat) { f32x4 sq = {0.f, 0.f, 0.f, 0.f};
#pragma unroll
                    for (int bj = 0; bj < 2; ++bj)
#pragma unroll
                        for (int pb = 0; pb < 2; ++pb) { const f32x4 v = acc[ai][bj][tb][pb] * 0.015625f; sq += v * v; }
                    float ss = (sq[0] + sq[1]) + (sq[2] + sq[3]);
                    ss += __shfl_xor(ss, 16); ss += __shfl_xor(ss, 32);
                    if (q == 0) ssqp[row * 12 + 4 * (u.pn - 5) + wc] = ss; } }
    }
};
struct EpiRes8 {
    const float* x; bf16_t* out; float* ssqh;
    __device__ __forceinline__ void operator()(AccRef8 acc, const Unit& u, int wr, int wc, int t15, int q) const {
        const int row0 = u.pm * BM + wr * 64 + t15, c0 = u.pn * BM + 64 * wc + 16 * q;
#pragma unroll
        for (int ai = 0; ai < 2; ++ai) {
            f32x4 xv[4][2][2];
#pragma unroll
            for (int tb = 0; tb < 4; ++tb) { const size_t off = (size_t)(row0 + ai * HALF + tb * 16) * DM + c0;
#pragma unroll
                for (int bj = 0; bj < 2; ++bj)
#pragma unroll
                    for (int pb = 0; pb < 2; ++pb) xv[tb][bj][pb] = *(const f32x4*)(x + off + 8 * bj + 4 * pb); }
            asm volatile("s_waitcnt vmcnt(0)" ::: "memory");
#pragma unroll
            for (int tb = 0; tb < 4; ++tb) { const size_t row = (size_t)(row0 + ai * HALF + tb * 16), off = row * DM + c0; f32x4 sq = {0.f, 0.f, 0.f, 0.f};
#pragma unroll
                for (int bj = 0; bj < 2; ++bj) { const f32x4 h0 = xv[tb][bj][0] + acc[ai][bj][tb][0] * (1.0f / 1024.0f), h1 = xv[tb][bj][1] + acc[ai][bj][tb][1] * (1.0f / 1024.0f);
                    *(u32x4*)(out + off + 8 * bj) = pack8(h0, h1); sq += h0 * h0 + h1 * h1; }
                float ss = (sq[0] + sq[1]) + (sq[2] + sq[3]); ss += __shfl_xor(ss, 16); ss += __shfl_xor(ss, 32);
                if (q == 0) ssqh[row * 32 + 4 * u.pn + wc] = ss; }
            asm volatile("" ::: "memory");
        }
    }
};
struct EpiGates8 {
    unsigned char* gates; const float* b_gate;
    __device__ __forceinline__ void operator()(AccRef8 acc, const Unit& u, int wr, int wc, int t15, int q) const {
        const int row0 = u.pm * BM + wr * 64 + t15;
        const int c0 = u.pn * BM + 64 * wc + 16 * q;
        f32x4 bb[2][2];
#pragma unroll
        for (int bj = 0; bj < 2; ++bj)
#pragma unroll
            for (int pb = 0; pb < 2; ++pb) bb[bj][pb] = *(const f32x4*)(b_gate + c0 + 8 * bj + 4 * pb);
#pragma unroll
        for (int ai = 0; ai < 2; ++ai)
#pragma unroll
            for (int tb = 0; tb < 4; ++tb) { unsigned qq[4];
#pragma unroll
                for (int bj = 0; bj < 2; ++bj)
#pragma unroll
                    for (int pb = 0; pb < 2; ++pb) { float o[4];
#pragma unroll
                        for (int j = 0; j < 4; j += 2) {
                            typedef float f32x2_ __attribute__((ext_vector_type(2)));
                            const f32x2_ a = {acc[ai][bj][tb][pb][j], acc[ai][bj][tb][pb][j + 1]}, b2 = {bb[bj][pb][j], bb[bj][pb][j + 1]};
                            f32x2_ e = (a * 0.015625f + b2) * -1.4426950408889634f; e[0] = __builtin_amdgcn_exp2f(e[0]); e[1] = __builtin_amdgcn_exp2f(e[1]);
                            f32x2_ d = e + 1.0f; d[0] = __builtin_amdgcn_rcpf(d[0]); d[1] = __builtin_amdgcn_rcpf(d[1]);
                            const f32x2_ r = d * 255.0f + 0.5f; o[j] = r[0]; o[j + 1] = r[1]; }
                        qq[2 * bj + pb] = (unsigned)o[0] | ((unsigned)o[1] << 8) | ((unsigned)o[2] << 16) | ((unsigned)o[3] << 24); }
                *(u32x4*)(gates + (size_t)(row0 + ai * HALF + tb * 16) * NGATE + c0) = (u32x4){qq[0], qq[1], qq[2], qq[3]}; }
    }
};
}

struct Args { const void* in[21]; float* out; unsigned char* ws; int ph_lo, ph_hi; };

struct Frame {
    LAS unsigned char* lds; unsigned char* ws; unsigned* ctl;
    int tid, lane, wave, G, bx;
    const float *x, *g_attn, *w_in, *b_gate, *sinks, *g_q, *w_uq, *g_kv, *w_ukv, *w_o_swa, *w_o_mla, *w_out, *g_ffn, *w_router, *b_router, *w_gate_up, *b_gate_up, *w_down, *b_down, *g_final;
    const int* positions; float* out;
};

template <int MODE> __device__ __forceinline__ int rowmap(int n) {
    if (MODE == 1) return n < NLOW ? n : n + (NPROJ - NLOW);
    if (MODE == 2) { const int j = n >> 1, t = n & 1; return 8 * (j >> 2) + 4 * t + (j & 3); }
    return n;
}
__device__ __forceinline__ int perm32_inv(int x) { return 16 * ((x >> 2) & 1) + 4 * (x >> 3) + (x & 3); }
__host__ __device__ __forceinline__ int wide_map(int c) { return 128 * ((c >> 3) & 1) + 32 * (c >> 6) + 8 * ((c >> 4) & 3) + (c & 7); }
template <int MODE, bool PERM, bool WIDE = false> __device__ __forceinline__ void p0_convert_item(const float* W, int K, int N, bf16_t* WB, int item, int lane, int ldw = 0, int nkt_img = 0, int kt_off = 0, const float* kgain = nullptr) {
    if (ldw == 0) ldw = N;
    const int nblk = (N + 255) / 256, kb = item / nblk, nb = item % nblk, k0 = 32 * kb, n = 256 * nb + 4 * lane;
    if (n >= N) return;
    const f32x4* src = (const f32x4*)(W + (size_t)k0 * ldw + n);
    f32x4 v[32];
#pragma unroll
    for (int r = 0; r < 32; ++r) v[r] = src[(size_t)r * (ldw / 4)];
    if (kgain) {
#pragma unroll
        for (int r = 0; r < 32; ++r) v[r] = v[r] * kgain[k0 + r]; }
    const int nkt = nkt_img ? nkt_img : K / 64;
#pragma unroll
    for (int cmp = 0; cmp < 4; ++cmp) {
        const int p0_ = rowmap<MODE>(n + cmp), p = WIDE ? (p0_ & ~255) + wide_map(p0_ & 255) : p0_, q = p & 127, R = PERM ? ((q & ~31) + perm32_inv(q & 31)) : q;
        char* tile = (char*)WB + ((size_t)(p >> 8) * nkt + kt_off + (kb >> 1)) * 32768 + ((p >> 7) & 1) * 16384;
#pragma unroll
        for (int g8 = 0; g8 < 4; ++g8) { u32x4 o;
            o.x = cvt_pk_bf16(v[8 * g8 + 0][cmp], v[8 * g8 + 1][cmp]); o.y = cvt_pk_bf16(v[8 * g8 + 2][cmp], v[8 * g8 + 3][cmp]);
            o.z = cvt_pk_bf16(v[8 * g8 + 4][cmp], v[8 * g8 + 5][cmp]); o.w = cvt_pk_bf16(v[8 * g8 + 6][cmp], v[8 * g8 + 7][cmp]);
            *(u32x4*)(tile + pg8::lds_byte(R, 32 * (kb & 1) + 8 * g8)) = o; }
    }
}
template <bool GU> __device__ __forceinline__ void p0_convert_item_f8(const float* W, int K, int N, unsigned char* WB, int item, int lane, int ldw = 0, int nkt_img = 0, int kt_off = 0) {
    if (ldw == 0) ldw = N;
    const int nblk = (N + 255) / 256, kb = item / nblk, nb = item % nblk, k0 = 32 * kb, n = 256 * nb + 4 * lane;
    if (n >= N) return;
    const f32x4* src = (const f32x4*)(W + (size_t)k0 * ldw + n);
    f32x4 v[32];
#pragma unroll
    for (int r = 0; r < 32; ++r) v[r] = src[(size_t)r * (ldw / 4)];
    const int nkt = nkt_img ? nkt_img : K / 128, kt = kt_off + (k0 >> 7), c0 = (k0 & 127) >> 4;
#pragma unroll
    for (int cmp = 0; cmp < 4; ++cmp) {
        const int nl = n + cmp, j = (nl & 255) >> 1, t = nl & 1;
        const int P = (nl & ~255) + (GU ? 128 * ((j >> 2) & 1) + 32 * (j >> 5) + 16 * t + 4 * ((j >> 3) & 3) + (j & 3) : 128 * ((nl >> 3) & 1) + 32 * ((nl >> 6) & 3) + 16 * ((nl >> 2) & 1) + 4 * ((nl >> 4) & 3) + (nl & 3));
        const int q = P & 127, row = q;
        unsigned char* tile = WB + ((size_t)(P >> 8) * nkt + kt) * 32768 + ((P >> 7) & 1) * 16384;
#pragma unroll
        for (int g = 0; g < 2; ++g) { int w[4];
#pragma unroll
            for (int d = 0; d < 4; ++d) { int x = __builtin_amdgcn_cvt_pk_fp8_f32(v[16 * g + 4 * d + 0][cmp] * 64.0f, v[16 * g + 4 * d + 1][cmp] * 64.0f, 0, false);
                w[d] = __builtin_amdgcn_cvt_pk_fp8_f32(v[16 * g + 4 * d + 2][cmp] * 64.0f, v[16 * g + 4 * d + 3][cmp] * 64.0f, x, true); }
            *(u32x4*)(tile + pg8::img8(row, c0 + g)) = (u32x4){(unsigned)w[0], (unsigned)w[1], (unsigned)w[2], (unsigned)w[3]}; }
    }
}
__device__ __forceinline__ void p0_moe_convert_block(Frame& F) {
    constexpr int NI_GU = NEXP * 16 * 16, NI_D = NEXP * 16 * 8, NIT = NI_GU + NI_D;
    const int lane = F.lane, w = F.wave, tid = F.tid;
    unsigned char* WGU = (unsigned char*)(F.ws + WS_WGU); unsigned char* WD = (unsigned char*)(F.ws + WS_WD);
#define MC_SRC(it, srcp, ldw_, dstp, gu_, gk_) do { int r_ = (it); const float* W_; int N_; unsigned char* D_; \
        if (r_ < NI_GU) { const int e_ = r_ >> 8, rem_ = r_ & 255, kt_ = rem_ >> 4, pn_ = rem_ & 15; W_ = F.w_gate_up + (size_t)e_ * DM * 2 * DM + (size_t)(128 * kt_) * (2 * DM) + 256 * pn_; N_ = 2 * DM; \
            D_ = WGU + (size_t)e_ * 2 * DM * DM + ((size_t)pn_ * 16 + kt_) * 32768; gu_ = true; gk_ = F.g_ffn + 128 * kt_ + 16 * w; }     \
        else { r_ -= NI_GU; const int e_ = r_ >> 7, rem_ = r_ & 127, kt_ = rem_ >> 3, pn_ = rem_ & 7; W_ = F.w_down + (size_t)e_ * DM * DM + (size_t)(128 * kt_) * DM + 256 * pn_; N_ = DM; \
            D_ = WD + (size_t)e_ * DM * DM + ((size_t)pn_ * 16 + kt_) * 32768; gu_ = false; } \
        srcp = (const f32x4*)(W_ + (size_t)(16 * w) * N_ + 4 * lane); ldw_ = N_ / 4; dstp = D_; } while (0)
#define MC_LOAD(v, srcp, ldw_) do { _Pragma("unroll") for (int r = 0; r < 16; ++r) v[r] = srcp[(size_t)r * ldw_]; } while (0)
#define MC_STEP(v, buf, dstp, gu_, gk_) do { float gs_[16]; _Pragma("unroll") for (int r = 0; r < 16; ++r) gs_[r] = gu_ ? gk_[r] * 64.0f : 64.0f; \
        _Pragma("unroll") for (int cmp = 0; cmp < 4; ++cmp) { const int nl = 4 * lane + cmp, j = nl >> 1, t = nl & 1, P = gu_ ? 128 * ((j >> 2) & 1) + 32 * (j >> 5) + 16 * t + 4 * ((j >> 3) & 3) + (j & 3) : 128 * ((nl >> 3) & 1) + 32 * ((nl >> 6) & 3) + 16 * ((nl >> 2) & 1) + 4 * ((nl >> 4) & 3) + (nl & 3); \
            const int q = P & 127, row = q; int wq[4]; \
            _Pragma("unroll") for (int d = 0; d < 4; ++d) { const int x = __builtin_amdgcn_cvt_pk_fp8_f32(v[4 * d + 0][cmp] * gs_[4 * d + 0], v[4 * d + 1][cmp] * gs_[4 * d + 1], 0, false); \
                wq[d] = __builtin_amdgcn_cvt_pk_fp8_f32(v[4 * d + 2][cmp] * gs_[4 * d + 2], v[4 * d + 3][cmp] * gs_[4 * d + 3], x, true); } \
            *(LAS u32x4*)((buf) + ((P >> 7) & 1) * 16384 + pg8::img8(row, w)) = (u32x4){(unsigned)wq[0], (unsigned)wq[1], (unsigned)wq[2], (unsigned)wq[3]}; } \
        __syncthreads(); \
        _Pragma("unroll") for (int q4 = 0; q4 < 4; ++q4) *(u32x4*)((dstp) + tid * 16 + q4 * 8192) = *(const LAS u32x4*)((buf) + tid * 16 + q4 * 8192); } while (0)
    f32x4 va[16], vb[16];
    const f32x4* sa; const f32x4* sb; int la = 0, lb = 0; unsigned char* da = nullptr; unsigned char* db = nullptr; bool ga = false, gb = false; const float* gka = F.g_ffn; const float* gkb = F.g_ffn;
    int it = F.bx;
    if (it < NIT) { MC_SRC(it, sa, la, da, ga, gka); MC_LOAD(va, sa, la); }
    __syncthreads();
    for (; it < NIT; it += 2 * F.G) {
        const int it1 = it + F.G, it2 = it + 2 * F.G;
        if (it1 < NIT) { MC_SRC(it1, sb, lb, db, gb, gkb); MC_LOAD(vb, sb, lb); }
        MC_STEP(va, F.lds, da, ga, gka);
        if (it1 < NIT) {
            if (it2 < NIT) { MC_SRC(it2, sa, la, da, ga, gka); MC_LOAD(va, sa, la); }
            MC_STEP(vb, F.lds + 32768, db, gb, gkb);
        }
    }
    __syncthreads();
#undef MC_SRC
#undef MC_LOAD
#undef MC_STEP
}
__device__ __forceinline__ void p0_prologue(Frame& F) {
    const int gw = F.bx * NWAVES + F.wave, NGW = F.G * NWAVES;
    bf16_t* WIN = (bf16_t*)(F.ws + WS_WIN); bf16_t* WUQ = (bf16_t*)(F.ws + WS_WUQ); bf16_t* WUKV = (bf16_t*)(F.ws + WS_WUKV);
    bf16_t* WOA = (bf16_t*)(F.ws + WS_WOA); bf16_t* WOB = (bf16_t*)(F.ws + WS_WOB); bf16_t* WOUT = (bf16_t*)(F.ws + WS_WOUT);
    bf16_t* WGU = (bf16_t*)(F.ws + WS_WGU); bf16_t* WD = (bf16_t*)(F.ws + WS_WD);
    constexpr int I_IN = (DM / 32) * ((NLOW + 255) / 256), I_ING = (DM / 32) * (NGATE / 256), I_UQ = (512 / 32) * (1536 / 256), I_UKV = (256 / 32) * (2048 / 256), I_OA = (1024 / 32) * (DM / 256), I_OUT = (DM / 32) * (DM / 256);
    constexpr int I_GU1 = (DM / 32) * (2 * DM / 256), I_D1 = (DM / 32) * (DM / 256);
    (void)WGU; (void)WD; (void)I_GU1; (void)I_D1;
    constexpr int NITEMS = I_IN + I_ING + I_UQ + I_UKV + 2 * I_OA + I_OUT;
    for (int it = gw; it < NITEMS; it += NGW) {
        int r = it;
        if (r < I_IN) { p0_convert_item_f8<false>(F.w_in, DM, NLOW, (unsigned char*)WIN, r, F.lane, NIN_LOG); continue; } r -= I_IN;
        if (r < I_ING) { p0_convert_item_f8<false>(F.w_in + NLOW, DM, NGATE, (unsigned char*)WIN + WIN_GATES_OFF, r, F.lane, NIN_LOG); continue; } r -= I_ING;
        if (r < I_UQ) { p0_convert_item<0, true, true>(F.w_uq, 512, 1536, WUQ, r, F.lane, 0, 0, 0, F.g_q); continue; } r -= I_UQ;
        if (r < I_UKV) { p0_convert_item<0, true>(F.w_ukv, 256, 2048, WUKV, r, F.lane, 0, 0, 0, F.g_kv); continue; } r -= I_UKV;
        if (r < I_OA) { p0_convert_item_f8<false>(F.w_o_swa, 1024, DM, (unsigned char*)WOA, r, F.lane, 0, 16, 0); continue; } r -= I_OA;
        if (r < I_OA) { (void)WOB; p0_convert_item_f8<false>(F.w_o_mla, 1024, DM, (unsigned char*)WOA, r, F.lane, 0, 16, 8); continue; } r -= I_OA;
        { p0_convert_item_f8<false>(F.w_out, DM, DM, (unsigned char*)WOUT, r, F.lane); }
    }
    p0_moe_convert_block(F);
    { constexpr int NPAD = NPROJ - NLOW, nz = (DM / 128) * NPAD * 8;
      for (int i = F.bx * NTHREADS + F.tid; i < nz; i += F.G * NTHREADS) { const int c = i & 7, col = (i >> 3) % NPAD, kt = (i >> 3) / NPAD, p0_ = NLOW + col, nl = p0_ & 255;
          const int P = (p0_ & ~255) + 128 * ((nl >> 3) & 1) + 32 * ((nl >> 6) & 3) + 16 * ((nl >> 2) & 1) + 4 * ((nl >> 4) & 3) + (nl & 3), q = P & 127;
          *(u32x4*)((unsigned char*)WIN + ((size_t)(P >> 8) * (DM / 128) + kt) * 32768 + ((P >> 7) & 1) * 16384 + pg8::img8(q, c)) = (u32x4){0u, 0u, 0u, 0u}; } }
    { int* idr = (int*)(F.ws + WS_IDROW); for (int i = F.bx * NTHREADS + F.tid; i < PROWS; i += F.G * NTHREADS) idr[i] = i; }
    { bf16_t* wrh = (bf16_t*)(F.ws + WS_WRT); bf16_t* wrl = wrh + NEXP * DM;
      for (int i = F.bx * NTHREADS + F.tid; i < DM * NEXP; i += F.G * NTHREADS) { const int d = i >> 5, e = i & 31; const float wv = F.w_router[i] * F.g_ffn[d];
          const unsigned hb = cvt_pk_bf16(wv, 0.f) & 0xffffu; const unsigned lb = cvt_pk_bf16(wv - bf_lo(hb), 0.f) & 0xffffu; wrh[e * DM + d] = (bf16_t)hb; wrl[e * DM + d] = (bf16_t)lb; } }
    float* CS = (float*)(F.ws + WS_CS);
#ifndef P0B_REP
#define P0B_REP 1
#endif
    for (int rep_ = 0; rep_ < P0B_REP; ++rep_)
    for (int m = gw; m < NTOK; m += NGW) {
        const f32x4* xr = (const f32x4*)(F.x + (size_t)m * DM) + F.lane; const f32x4* gr = (const f32x4*)F.g_attn + F.lane;
        f32x4 v[8]; float s = 0.f;
#pragma unroll
        for (int j = 0; j < 8; ++j) { v[j] = xr[64 * j]; s += (v[j].x * v[j].x + v[j].y * v[j].y) + (v[j].z * v[j].z + v[j].w * v[j].w); }
        const float rstd = 1.0f / sqrtf(wave_sum(s) * (1.0f / DM) + EPS);
#pragma unroll
        for (int j = 0; j < 8; ++j) { const f32x4 gg = gr[64 * j]; const float y0 = v[j].x * rstd * gg.x, y1 = v[j].y * rstd * gg.y, y2 = v[j].z * rstd * gg.z, y3 = v[j].w * rstd * gg.w;
            int w8 = __builtin_amdgcn_cvt_pk_fp8_f32(y0, y1, 0, false); w8 = __builtin_amdgcn_cvt_pk_fp8_f32(y2, y3, w8, true); ((unsigned*)(F.ws + WS_XN8 + (size_t)m * DM))[F.lane + 64 * j] = (unsigned)w8; }
        { const int i = F.lane & 31; const float inv_freq = powf(10000.0f, -(float)i * 2.0f / 64.0f); const float ang = (float)F.positions[m] * inv_freq;
          CS[(size_t)m * 64 + F.lane] = (F.lane < 32) ? cosf(ang) : sinf(ang); }
    }
}

__device__ __forceinline__ void rope4(u32x2& a, u32x2& b, f32x4 c, f32x4 s) {
    const float x1[4] = {bf_lo(a.x), bf_hi(a.x), bf_lo(a.y), bf_hi(a.y)}, x2[4] = {bf_lo(b.x), bf_hi(b.x), bf_lo(b.y), bf_hi(b.y)};
    float o1[4], o2[4];
#pragma unroll
    for (int j = 0; j < 4; ++j) { o1[j] = x1[j] * c[j] - x2[j] * s[j]; o2[j] = x2[j] * c[j] + x1[j] * s[j]; }
    a.x = cvt_pk_bf16(o1[0], o1[1]); a.y = cvt_pk_bf16(o1[2], o1[3]); b.x = cvt_pk_bf16(o2[0], o2[1]); b.y = cvt_pk_bf16(o2[2], o2[3]);
}
namespace pg8 {
__device__ __forceinline__ float row_rstd_q(const float* ssqp, size_t row) { const f32x4 a = *(const f32x4*)(ssqp + row * 12), b = *(const f32x4*)(ssqp + row * 12 + 4);
    return 1.0f / sqrtf((((a[0] + a[1]) + (a[2] + a[3])) + ((b[0] + b[1]) + (b[2] + b[3]))) * (1.0f / 512.0f) + EPS); }
__device__ __forceinline__ float row_rstd_kv(const float* ssqp, size_t row) { const f32x4 a = *(const f32x4*)(ssqp + row * 12 + 8);
    return 1.0f / sqrtf(((a[0] + a[1]) + (a[2] + a[3])) * (1.0f / 256.0f) + EPS); }
struct EpiQn { static constexpr bool PERM = true;
    bf16_t* O; const float* ssqp; float scl;
    __device__ __forceinline__ void operator()(AccRef acc, const Unit& u, int wr, int wc, int fr, int fq) const {
        const int row0 = u.pm * BM + wr * 64 + fr, col0 = u.pn * BM + wc * 64 + 16 * fq;
#pragma unroll
        for (int ai = 0; ai < 2; ++ai)
#pragma unroll
            for (int m = 0; m < 4; ++m) { const size_t row = (size_t)(row0 + ai * HALF + m * 16); const float sc = row_rstd_q(ssqp, row) * scl; bf16_t* rowp = O + row * 1536 + col0;
#pragma unroll
                for (int bj = 0; bj < 2; ++bj) *(u32x4*)(rowp + bj * 8) = pack8(acc[ai][bj][m][0] * sc, acc[ai][bj][m][1] * sc); }
    }
};
struct EpiKVn { static constexpr bool PERM = true;
    bf16_t* kmla; bf16_t* vmla; const float* ssqp; const bf16_t* proj; const float* cs;
    __device__ __forceinline__ void operator()(AccRef acc, const Unit& u, int wr, int wc, int fr, int fq) const {
        const int row0 = u.pm * BM + wr * 64 + fr, c0 = wc * 32 + 8 * fq;
#pragma unroll
        for (int ai = 0; ai < 2; ++ai)
#pragma unroll
            for (int m = 0; m < 4; ++m) { const size_t row = (size_t)(row0 + ai * HALF + m * 16); const float sc = row_rstd_kv(ssqp, row);
                const size_t hrow = ((row >> 11) * 8 + u.pn) * 2048 + (row & 2047);
                *(u32x4*)(kmla + hrow * 192 + c0) = pack8(acc[ai][0][m][0] * sc, acc[ai][0][m][1] * sc);
                *(u32x4*)(vmla + hrow * 128 + c0) = pack8(acc[ai][1][m][0] * sc, acc[ai][1][m][1] * sc); }
        const int tid_ = (wr * 4 + wc) * 64 + fq * 16 + fr;
#pragma unroll
        for (int it = 0; it < 4; ++it) { const int idx = tid_ + 512 * it, i0 = 4 * (idx & 7); const size_t row = (size_t)(u.pm * BM + (idx >> 3));
            const bf16_t* pr = proj + row * NPROJ + PC_KR;
            u32x2 a = *(const u32x2*)(pr + i0), b = *(const u32x2*)(pr + 32 + i0);
            const f32x4 c = *(const f32x4*)(cs + row * 64 + i0), sn = *(const f32x4*)(cs + row * 64 + 32 + i0);
            rope4(a, b, c, sn);
            bf16_t* kp = kmla + (((row >> 11) * 8 + u.pn) * 2048 + (row & 2047)) * 192 + 128 + i0;
            *(u32x2*)kp = a; *(u32x2*)(kp + 32) = b; }
    }
};
}
__device__ __forceinline__ void p2_postproj(Frame& F) {
    const int gw = F.bx * NWAVES + F.wave, NGW = F.G * NWAVES, lane = F.lane;
    bf16_t* PROJ = (bf16_t*)(F.ws + WS_PROJ); const float* CS = (const float*)(F.ws + WS_CS);
    bf16_t* CQ = (bf16_t*)(F.ws + WS_CQ); bf16_t* CKV = (bf16_t*)(F.ws + WS_CKV); bf16_t* KMLA = (bf16_t*)(F.ws + WS_KMLA);
    constexpr int R2 = 4;
    const int hd = lane >> 3, i0 = 4 * (lane & 7); const int base = (hd < 2) ? PC_KA + hd * 64 : PC_KR;
    const f32x4 gq0 = *(const f32x4*)(F.g_q + 8 * lane), gq1 = *(const f32x4*)(F.g_q + 8 * lane + 4), gk0 = *(const f32x4*)(F.g_kv + 4 * lane);
    for (int m0 = gw; m0 < NTOK; m0 += R2 * NGW) {
        f32x4 rc[R2], rs[R2]; u32x2 ra[R2], rb[R2], wkv[R2]; u32x4 wq[R2];
#pragma unroll
        for (int j = 0; j < R2; ++j) { const int m = m0 + j * NGW; if (m < NTOK) { bf16_t* pr = PROJ + (size_t)m * NPROJ;
            if (lane < 24) { rc[j] = *(const f32x4*)(CS + (size_t)m * 64 + i0); rs[j] = *(const f32x4*)(CS + (size_t)m * 64 + 32 + i0);
                ra[j] = *(u32x2*)(pr + base + i0); rb[j] = *(u32x2*)(pr + base + 32 + i0); }
            wq[j] = *(const u32x4*)(pr + PC_DQ + 8 * lane); wkv[j] = *(const u32x2*)(pr + PC_DKV + 4 * lane); } }
#pragma unroll
        for (int j = 0; j < R2; ++j) { const int m = m0 + j * NGW; if (m < NTOK) { bf16_t* pr = PROJ + (size_t)m * NPROJ;
            if (lane < 24) { u32x2 a = ra[j], b = rb[j];
                rope4(a, b, rc[j], rs[j]);
                if (hd < 2) { *(u32x2*)(pr + base + i0) = a; *(u32x2*)(pr + base + 32 + i0) = b; }
                else { bf16_t* kp = KMLA + ((size_t)(m >> 11) * (8 * 2048) + (m & 2047)) * 192 + 128 + i0;
#pragma unroll
                    for (int hh = 0; hh < 8; ++hh) { *(u32x2*)(kp + (size_t)hh * (2048 * 192)) = a; *(u32x2*)(kp + (size_t)hh * (2048 * 192) + 32) = b; } } }
            { const u32x4 w = wq[j];
              float v[8] = {bf_lo(w.x), bf_hi(w.x), bf_lo(w.y), bf_hi(w.y), bf_lo(w.z), bf_hi(w.z), bf_lo(w.w), bf_hi(w.w)}; float sq = 0.f;
#pragma unroll
              for (int t = 0; t < 8; ++t) sq += v[t] * v[t];
              const float rstd = 1.0f / sqrtf(wave_sum(sq) * (1.0f / 512.0f) + EPS);
              u32x4 o; o.x = cvt_pk_bf16(v[0] * rstd * gq0[0], v[1] * rstd * gq0[1]); o.y = cvt_pk_bf16(v[2] * rstd * gq0[2], v[3] * rstd * gq0[3]);
              o.z = cvt_pk_bf16(v[4] * rstd * gq1[0], v[5] * rstd * gq1[1]); o.w = cvt_pk_bf16(v[6] * rstd * gq1[2], v[7] * rstd * gq1[3]);
              *(u32x4*)(CQ + (size_t)m * 512 + 8 * lane) = o; }
            { const u32x2 w = wkv[j];
              float v[4] = {bf_lo(w.x), bf_hi(w.x), bf_lo(w.y), bf_hi(w.y)}; float sq = (v[0] * v[0] + v[1] * v[1]) + (v[2] * v[2] + v[3] * v[3]);
              const float rstd = 1.0f / sqrtf(wave_sum(sq) * (1.0f / 256.0f) + EPS);
              u32x2 o; o.x = cvt_pk_bf16(v[0] * rstd * gk0[0], v[1] * rstd * gk0[1]); o.y = cvt_pk_bf16(v[2] * rstd * gk0[2], v[3] * rstd * gk0[3]);
              *(u32x2*)(CKV + (size_t)m * 256 + 4 * lane) = o; } } }
    }
}

__device__ __forceinline__ int crow(int r, int hi) { return (r & 3) + 8 * (r >> 2) + 4 * hi; }
__device__ __forceinline__ bf16x8 tr2(const LAS unsigned char* p0, const LAS unsigned char* p1) {
    const v4i16_t a = __builtin_amdgcn_ds_read_tr16_b64_v4i16((LAS v4i16_t*)p0), b = __builtin_amdgcn_ds_read_tr16_b64_v4i16((LAS v4i16_t*)p1);
    bf16x8 r; r[0] = a[0]; r[1] = a[1]; r[2] = a[2]; r[3] = a[3]; r[4] = b[0]; r[5] = b[1]; r[6] = b[2]; r[7] = b[3]; return r;
}
__device__ __forceinline__ void rope_frag(bf16x8& f1, bf16x8& f2, const float* cs, int i0, float scl = 1.0f) {
    const f32x4 c0 = *(const f32x4*)(cs + i0) * scl, c1 = *(const f32x4*)(cs + i0 + 4) * scl, s0 = *(const f32x4*)(cs + 32 + i0) * scl, s1 = *(const f32x4*)(cs + 32 + i0 + 4) * scl;
    u32x4 a = __builtin_bit_cast(u32x4, f1), b = __builtin_bit_cast(u32x4, f2);
    u32x2 a0 = {a.x, a.y}, b0 = {b.x, b.y}, a1 = {a.z, a.w}, b1 = {b.z, b.w};
    rope4(a0, b0, c0, s0); rope4(a1, b1, c1, s1);
    f1 = __builtin_bit_cast(bf16x8, (u32x4){a0.x, a0.y, a1.x, a1.y}); f2 = __builtin_bit_cast(bf16x8, (u32x4){b0.x, b0.y, b1.x, b1.y});
}
__device__ __forceinline__ bf16x8 pack_p(const f32x16& p, int s2) {
    u32x4 w;
    asm volatile("s_nop 0\n\tv_cvt_pk_bf16_f32 %0, %4, %5\n\tv_cvt_pk_bf16_f32 %1, %6, %7\n\tv_cvt_pk_bf16_f32 %2, %8, %9\n\tv_cvt_pk_bf16_f32 %3, %10, %11"
                 : "=&v"(w.x), "=&v"(w.y), "=&v"(w.z), "=&v"(w.w)
                 : "v"(p[8 * s2 + 0]), "v"(p[8 * s2 + 1]), "v"(p[8 * s2 + 2]), "v"(p[8 * s2 + 3]), "v"(p[8 * s2 + 4]), "v"(p[8 * s2 + 5]), "v"(p[8 * s2 + 6]), "v"(p[8 * s2 + 7]));
    return __builtin_bit_cast(bf16x8, w);
}

constexpr int SWA_KRS = 144;
constexpr int SWA_LDS_K = 0, SWA_LDS_V = 256 * SWA_KRS;
__device__ __forceinline__ void swa_phase(Frame& F) {
    const bf16_t* PROJ = (const bf16_t*)(F.ws + WS_PROJ); const float* CS = (const float*)(F.ws + WS_CS); bf16_t* OUTA = (bf16_t*)(F.ws + WS_OUTA);
    LAS unsigned char* Kl = F.lds + SWA_LDS_K; LAS unsigned char* Vl = F.lds + SWA_LDS_V;
    int lane = F.lane; asm volatile("" : "+v"(lane));
    const int w = F.wave, l31 = lane & 31, h = lane >> 5;
    const int vq = (lane & 15) >> 2, vp = lane & 3, vg = (lane >> 4) & 1;
    const int vlane = (4 * h + vq) * 64 + (16 * vg + 4 * vp) * 2;
    for (int u = F.bx; u < BATCH * 16 * 2; u += F.G) {
        const int kvh = u & 1, nb = (u >> 1) & 15, b = u >> 5;
        const int tok0 = b * SEQ + nb * 128;
        __syncthreads();
#pragma unroll
        for (int j = 0; j < 4; ++j) { const int id = F.tid + 512 * j, row = id >> 3, ch = id & 7;
            u32x4 kv = (u32x4){0u, 0u, 0u, 0u}, vv = (u32x4){0u, 0u, 0u, 0u};
            if (nb > 0 || row >= 128) { const size_t tok = (size_t)(tok0 - 128 + row); const bf16_t* src = PROJ + tok * NPROJ + kvh * 64 + ch * 8;
                vv = *(const u32x4*)(src + PC_VA);
                const u32x4 ko = *(const u32x4*)(src + PC_KA), kp = *(const u32x4*)(src + PC_KA + ((ch & 4) ? -32 : 32));
                const float* cs = CS + tok * 64 + 8 * (ch & 3);
                const f32x4 c0 = *(const f32x4*)cs, c1 = *(const f32x4*)(cs + 4), s0 = *(const f32x4*)(cs + 32), s1 = *(const f32x4*)(cs + 36);
                const float sg = (ch & 4) ? 1.0f : -1.0f;
                const unsigned kow[4] = {ko.x, ko.y, ko.z, ko.w}, kpw[4] = {kp.x, kp.y, kp.z, kp.w}; unsigned ow[4];
#pragma unroll
                for (int e = 0; e < 4; ++e) { const float cl = e < 2 ? c0[2 * e] : c1[2 * e - 4], ch_ = e < 2 ? c0[2 * e + 1] : c1[2 * e - 3], sl = e < 2 ? s0[2 * e] : s1[2 * e - 4], sh = e < 2 ? s0[2 * e + 1] : s1[2 * e - 3];
                    ow[e] = cvt_pk_bf16(bf_lo(kow[e]) * cl + sg * bf_lo(kpw[e]) * sl, bf_hi(kow[e]) * ch_ + sg * bf_hi(kpw[e]) * sh); }
                kv = (u32x4){ow[0], ow[1], ow[2], ow[3]}; }
            *(LAS u32x4*)(Kl + row * SWA_KRS + ch * 16) = kv;
            *(LAS u32x4*)(Vl + ((row >> 3) * 2 + (ch >> 2)) * 512 + (row & 7) * 64 + (ch & 3) * 16) = vv; }
        __syncthreads();
        const int hq = kvh * 8 + w; const float sink = F.sinks[hq];
        for (int i = 0; i < 4; ++i) {
            const size_t row0 = (size_t)tok0 + 32 * i;
            bf16x8 Qf[4];
            { const char* qp = (const char*)PROJ + (row0 * NPROJ + hq * 64) * 2; const unsigned qo = (unsigned)(l31 * (NPROJ * 2) + 16 * h);
#pragma unroll
              for (int ks = 0; ks < 4; ++ks) Qf[ks] = *(const bf16x8*)(qp + qo + 32 * ks);
              const float* cs = (const float*)((const char*)CS + row0 * 256 + (unsigned)(l31 * 256));
              rope_frag(Qf[0], Qf[2], cs, 8 * h, 0.125f * 1.4426950408889634f); rope_frag(Qf[1], Qf[3], cs, 16 + 8 * h, 0.125f * 1.4426950408889634f); }
            f32x16 O[2];
#pragma unroll
            for (int db = 0; db < 2; ++db)
#pragma unroll
                for (int r = 0; r < 16; ++r) O[db][r] = 0.f;
            const float sinkl = sink * 1.4426950408889634f;
            float mrun = sinkl, lrun = 0.f;
            const int tcmp = l31 - 4 * h;
#pragma unroll 1
            for (int kb = 0; kb < 5; ++kb) {
                if (nb == 0 && i + kb < 4) continue;
                const int kk0 = 32 * (i + kb);
                f32x16 Sx;
#pragma unroll
                for (int r = 0; r < 16; ++r) Sx[r] = 0.f;
                const LAS unsigned char* kp = Kl + kk0 * SWA_KRS + l31 * SWA_KRS + 16 * h;
#pragma unroll
                for (int ks = 0; ks < 4; ++ks) Sx = __builtin_amdgcn_mfma_f32_32x32x16_bf16(*(const LAS bf16x8*)(kp + 32 * ks), Qf[ks], Sx, 0, 0, 0);
                const LAS unsigned char* vb = Vl + (kk0 >> 3) * 1024 + vlane;
                bf16x8 vf[4];
#pragma unroll
                for (int db = 0; db < 2; ++db) { vf[2 * db] = tr2(vb + db * 512, vb + db * 512 + 1024); vf[2 * db + 1] = tr2(vb + db * 512 + 2048, vb + db * 512 + 3072); }
                __builtin_amdgcn_sched_barrier(0);
                if (kb == 0) {
#pragma unroll
                    for (int r = 0; r < 16; ++r) if (!((r & 3) + 8 * (r >> 2) > tcmp)) Sx[r] = -1e30f;
                } else if (kb == 4) {
#pragma unroll
                    for (int r = 0; r < 16; ++r) if ((r & 3) + 8 * (r >> 2) > tcmp) Sx[r] = -1e30f;
                }
                float mx = Sx[0];
#pragma unroll
                for (int r = 1; r < 16; ++r) mx = fmaxf(mx, Sx[r]);
                mx = fmaxf(mx, __shfl_xor(mx, 32));
                if (__builtin_amdgcn_ballot_w64(mx > mrun + 8.f) != 0) {
                    const float mn = fmaxf(mrun, mx);
                    const float alpha = __builtin_amdgcn_exp2f(mrun - mn);
                    mrun = mn; lrun *= alpha;
#pragma unroll
                    for (int db = 0; db < 2; ++db)
#pragma unroll
                        for (int r = 0; r < 16; ++r) O[db][r] *= alpha;
                }
                float ps = 0.f;
#pragma unroll
                for (int r = 0; r < 16; ++r) { const float p = __builtin_amdgcn_exp2f(Sx[r] - mrun); Sx[r] = p; ps += p; }
                lrun += ps;
                const bf16x8 P0 = pack_p(Sx, 0), P1 = pack_p(Sx, 1);
                __builtin_amdgcn_sched_barrier(0);
#pragma unroll
                for (int db = 0; db < 2; ++db) {
                    O[db] = __builtin_amdgcn_mfma_f32_32x32x16_bf16(vf[2 * db], P0, O[db], 0, 0, 0);
                    O[db] = __builtin_amdgcn_mfma_f32_32x32x16_bf16(vf[2 * db + 1], P1, O[db], 0, 0, 0);
                }
            }
            const float ltot = lrun + __shfl_xor(lrun, 32) + __builtin_amdgcn_exp2f(sinkl - mrun);
            const float inv = 1.0f / ltot;
            char* op = (char*)OUTA + (row0 * 2048 + hq * 64); const unsigned oo = (unsigned)(l31 * 2048 + 4 * h);
            const float inv16 = inv * 16.0f;
#pragma unroll
            for (int db = 0; db < 2; ++db)
#pragma unroll
                for (int g4 = 0; g4 < 4; ++g4) { int wv = __builtin_amdgcn_cvt_pk_fp8_f32(O[db][4 * g4] * inv16, O[db][4 * g4 + 1] * inv16, 0, false); wv = __builtin_amdgcn_cvt_pk_fp8_f32(O[db][4 * g4 + 2] * inv16, O[db][4 * g4 + 3] * inv16, wv, true);
                    *(unsigned*)(op + oo + 32 * db + 8 * g4) = (unsigned)wv; }
        }
    }
    __syncthreads();
}

constexpr int MLA_KRS = 400, MLA_KB = 64 * MLA_KRS, MLA_VB = 64 * 256, MLA_BUF = MLA_KB + MLA_VB;
typedef float f32x2m __attribute__((ext_vector_type(2)));
__device__ __forceinline__ void mla_phase(Frame& F) {
    const char* QBc = (const char*)(F.ws + WS_QB); const char* KMLA = (const char*)(F.ws + WS_KMLA); const char* VMLA = (const char*)(F.ws + WS_VMLA);
    const char* CSc = (const char*)(F.ws + WS_CS); char* OUTBc = (char*)(F.ws + WS_OUTA) + 1024;
    int lane = F.lane; asm volatile("" : "+v"(lane));
    const int w = F.wave, l31 = lane & 31, h = lane >> 5;
    const int vq = (lane & 15) >> 2, vp = lane & 3, vg = (lane >> 4) & 1;
    const int vlane = (4 * h + vq) * 64 + (16 * vg + 4 * vp) * 2;
    const int klane = l31 * MLA_KRS + 16 * h;
    constexpr float C2 = 0.07216878364870322f * 1.4426950408889634f;
    for (int it0 = F.bx; it0 < BATCH * 8 * 4; it0 += F.G) {
        const int it = (F.G == 256) ? ((it0 & 7) * 64 + ((it0 >> 3) & 31) + 32 * (it0 >> 8)) : it0;
        const int pr = it & 3, hh = (it >> 2) & 7, b = it >> 5;
        for (int half = 0; half < 2; ++half) {
            const int qb = half ? pr : (7 - pr);
            const int nkt = 4 * (qb + 1);
            const size_t row0 = (size_t)b * SEQ + 256 * qb + 32 * w;
            const int qpos = 256 * qb + 32 * w + l31;
            f32x16 O[4];
#pragma unroll
            for (int db = 0; db < 4; ++db)
#pragma unroll
                for (int r = 0; r < 16; ++r) O[db][r] = 0.f;
            float mrun = -1e30f, lrun = 0.f;
            const size_t hrow0 = ((size_t)b * 8 + hh) * SEQ;
#define MLA_DMAK(kt, bufp) do { const char* kb_ = KMLA + (hrow0 + 64 * (kt)) * 384; \
              _Pragma("unroll") for (int j = 0; j < 4; ++j) { const int q = w + 8 * j; \
                if (q < 25) { const int s_ = 64 * q + lane, row = s_ / 25, ch = s_ - 25 * row; const unsigned off = (unsigned)(row * 384 + ch * 16); \
                    glds16_asm(kb_, off, (unsigned)(size_t)((bufp) + q * 1024)); } } } while (0)
#define MLA_DMAV(kt, bufp) do { const char* vb_ = VMLA + (hrow0 + 64 * (kt)) * 256; \
              _Pragma("unroll") for (int j = 0; j < 2; ++j) { const int q = w + 8 * j; \
                const int s_ = 64 * q + lane, sub = s_ >> 5, row = (sub >> 2) * 8 + ((s_ >> 2) & 7), ch = (sub & 3) * 4 + (s_ & 3); const unsigned off = (unsigned)(row * 256 + ch * 16); \
                glds16_asm(vb_, off, (unsigned)(size_t)((bufp) + q * 1024)); } } while (0)
#define MLA_SB() __builtin_amdgcn_sched_barrier(0)
#define MLA_LDK(p) (*(const LAS bf16x8*)(p))
#define MLA_E(SP, r) do { const float p_ = __builtin_amdgcn_exp2f(SP[r] - mrun); SP[r] = p_; ps += p_; } while (0)
#define MLA_E2(SP, r) do { f32x2m t_ = (f32x2m){SP[r], SP[(r) + 1]} - mrun; t_[0] = __builtin_amdgcn_exp2f(t_[0]); t_[1] = __builtin_amdgcn_exp2f(t_[1]); SP[r] = t_[0]; SP[(r) + 1] = t_[1]; ps2 += t_; } while (0)
#define MLA_QKM(SN, f, ks) SN = __builtin_amdgcn_mfma_f32_32x32x16_bf16(f, Qf[ks], SN, 0, 0, 0)
#define MLA_PEND_PLAIN(SP, vbp) do { float ps = 0.f; \
                _Pragma("unroll") for (int r = 0; r < 16; ++r) MLA_E(SP, r); \
                lrun += ps; \
                const bf16x8 P0 = pack_p(SP, 0), P1 = pack_p(SP, 1); \
                const LAS unsigned char* vb = (vbp); \
                _Pragma("unroll") for (int db = 0; db < 4; ++db) { \
                    O[db] = __builtin_amdgcn_mfma_f32_32x32x16_bf16(tr2(vb + db * 512, vb + db * 512 + 4 * 512), P0, O[db], 0, 0, 0); \
                    O[db] = __builtin_amdgcn_mfma_f32_32x32x16_bf16(tr2(vb + db * 512 + 8 * 512, vb + db * 512 + 12 * 512), P1, O[db], 0, 0, 0); } } while (0)
#define MLA_STAGE(SN, SP, kpp, vbp, NIDX) do { const int n_ = (NIDX); \
                if (n_ <= nlast + 1) {                                    \
                    const LAS unsigned char* kp = (kpp); const LAS unsigned char* vb = (vbp); \
                    bf16x8 kfA[4], kfB[4], vf[8], P0, P1; f32x2m ps2 = {0.f, 0.f}; \
                    _Pragma("unroll") for (int j = 0; j < 4; ++j) kfA[j] = MLA_LDK(kp + 32 * j); \
                    _Pragma("unroll") for (int j = 0; j < 4; ++j) kfB[j] = MLA_LDK(kp + 32 * (4 + j)); \
                    _Pragma("unroll") for (int r = 0; r < 16; ++r) SN[r] = 0.f; \
                    MLA_SB(); \
                    MLA_E2(SP, 0); MLA_SB(); \
                    MLA_QKM(SN, kfA[0], 0); MLA_E2(SP, 2); MLA_SB(); \
                    MLA_QKM(SN, kfA[1], 1); MLA_SB(); \
                    MLA_QKM(SN, kfA[2], 2); MLA_E2(SP, 4); MLA_SB(); \
                    MLA_QKM(SN, kfA[3], 3); MLA_SB(); \
                    _Pragma("unroll") for (int j = 0; j < 4; ++j) kfA[j] = MLA_LDK(kp + 32 * (8 + j)); \
                    MLA_SB(); \
                    MLA_QKM(SN, kfB[0], 4); MLA_E2(SP, 6); MLA_SB(); \
                    MLA_QKM(SN, kfB[1], 5); P0 = pack_p(SP, 0); MLA_SB(); \
                    MLA_QKM(SN, kfB[2], 6); MLA_E2(SP, 8); MLA_SB(); \
                    MLA_QKM(SN, kfB[3], 7); MLA_E2(SP, 10); MLA_SB(); \
                    _Pragma("unroll") for (int db = 0; db < 2; ++db) { vf[2 * db] = tr2(vb + db * 512, vb + db * 512 + 4 * 512); vf[2 * db + 1] = tr2(vb + db * 512 + 8 * 512, vb + db * 512 + 12 * 512); } \
                    MLA_SB(); \
                    MLA_QKM(SN, kfA[0], 8); MLA_E2(SP, 12); MLA_SB(); \
                    MLA_QKM(SN, kfA[1], 9); MLA_SB(); \
                    MLA_QKM(SN, kfA[2], 10); MLA_E2(SP, 14); MLA_SB(); \
                    MLA_QKM(SN, kfA[3], 11); lrun += ps2[0] + ps2[1]; P1 = pack_p(SP, 1); MLA_SB(); \
                    _Pragma("unroll") for (int db = 2; db < 4; ++db) { vf[2 * db] = tr2(vb + db * 512, vb + db * 512 + 4 * 512); vf[2 * db + 1] = tr2(vb + db * 512 + 8 * 512, vb + db * 512 + 12 * 512); } \
                    MLA_SB(); \
                    if (n_ >= nlast) {                                    \
                        _Pragma("unroll") for (int r = 0; r < 16; ++r) { const int key = 32 * n_ + crow(r, h); if (key > qpos) SN[r] = -1e30f; } \
                    } \
                    float mx; \
                    O[0] = __builtin_amdgcn_mfma_f32_32x32x16_bf16(vf[0], P0, O[0], 0, 0, 0); MLA_SB(); \
                    O[0] = __builtin_amdgcn_mfma_f32_32x32x16_bf16(vf[1], P1, O[0], 0, 0, 0); MLA_SB(); \
                    O[1] = __builtin_amdgcn_mfma_f32_32x32x16_bf16(vf[2], P0, O[1], 0, 0, 0); mx = fmaxf(fmaxf(SN[0], SN[1]), SN[2]); MLA_SB(); \
                    O[1] = __builtin_amdgcn_mfma_f32_32x32x16_bf16(vf[3], P1, O[1], 0, 0, 0); mx = fmaxf(fmaxf(mx, SN[3]), SN[4]); mx = fmaxf(fmaxf(mx, SN[5]), SN[6]); MLA_SB(); \
                    O[2] = __builtin_amdgcn_mfma_f32_32x32x16_bf16(vf[4], P0, O[2], 0, 0, 0); mx = fmaxf(fmaxf(mx, SN[7]), SN[8]); mx = fmaxf(fmaxf(mx, SN[9]), SN[10]); MLA_SB(); \
                    O[2] = __builtin_amdgcn_mfma_f32_32x32x16_bf16(vf[5], P1, O[2], 0, 0, 0); mx = fmaxf(fmaxf(mx, SN[11]), SN[12]); mx = fmaxf(fmaxf(mx, SN[13]), SN[14]); MLA_SB(); \
                    O[3] = __builtin_amdgcn_mfma_f32_32x32x16_bf16(vf[6], P0, O[3], 0, 0, 0); mx = fmaxf(mx, SN[15]); MLA_SB(); \
                    O[3] = __builtin_amdgcn_mfma_f32_32x32x16_bf16(vf[7], P1, O[3], 0, 0, 0); MLA_SB(); \
                    mx = fmaxf(mx, __shfl_xor(mx, 32)); \
                      \
                    if (__builtin_amdgcn_ballot_w64(mx > mrun + 8.f) != 0) { \
                        const float mn = fmaxf(mrun, mx); \
                        const float alpha = __builtin_amdgcn_exp2f(mrun - mn); \
                        mrun = mn; lrun *= alpha; \
                        _Pragma("unroll") for (int db = 0; db < 4; ++db) _Pragma("unroll") for (int r = 0; r < 16; ++r) O[db][r] *= alpha; \
                    } \
                } } while (0)
#define MLA_KB_(i) (F.lds + (i) * MLA_KB)
#define MLA_VB_(i) (F.lds + 3 * MLA_KB + (i) * MLA_VB)
#define MLA_TILE(KT, BI) do { const int kt_ = (KT); \
                  \
                if (kt_ + 1 < nkt) asm volatile("s_waitcnt vmcnt(3) lgkmcnt(0)" ::: "memory"); else asm volatile("s_waitcnt vmcnt(0) lgkmcnt(0)" ::: "memory"); \
                __builtin_amdgcn_s_barrier(); asm volatile("" ::: "memory");     \
                  \
                  \
                if (w < 4) { if (kt_ + 1 < nkt) MLA_DMAV(kt_ + 1, MLA_VB_(((BI) + 1) % 3)); if (kt_ + 2 < nkt) MLA_DMAK(kt_ + 2, MLA_KB_(((BI) + 2) % 3)); } \
                  \
                const LAS unsigned char* vprev = (kt_ == 0) ? (MLA_VB_(BI) + vlane) : (MLA_VB_(((BI) + 2) % 3) + 16 * 512 + vlane); \
                MLA_STAGE(Sa, Sb, MLA_KB_(BI) + klane, vprev, 2 * kt_); \
                if (w >= 4) { if (kt_ + 1 < nkt) MLA_DMAV(kt_ + 1, MLA_VB_(((BI) + 1) % 3)); if (kt_ + 2 < nkt) MLA_DMAK(kt_ + 2, MLA_KB_(((BI) + 2) % 3)); } \
                MLA_STAGE(Sb, Sa, MLA_KB_(BI) + 32 * MLA_KRS + klane, MLA_VB_(BI) + vlane, 2 * kt_ + 1); \
                } while (0)
            const int nlast = 8 * qb + w;
            f32x16 Sa, Sb;
#pragma unroll
            for (int r = 0; r < 16; ++r) { Sa[r] = 0.f; Sb[r] = -__builtin_inff(); }
            __syncthreads();
            MLA_DMAK(0, MLA_KB_(0)); MLA_DMAV(0, MLA_VB_(0));
            if (nkt > 1) MLA_DMAK(1, MLA_KB_(1));
            bf16x8 Qf[12];
            { const char* qp = QBc + (row0 * 1536 + hh * 192) * 2; const unsigned qo = (unsigned)(l31 * 3072 + 16 * h);
#pragma unroll
              for (int ks = 0; ks < 12; ++ks) Qf[ks] = *(const bf16x8*)(qp + qo + 32 * ks);
              const float* cs = (const float*)(CSc + row0 * 256 + (unsigned)(l31 * 256));
              rope_frag(Qf[8], Qf[10], cs, 8 * h); rope_frag(Qf[9], Qf[11], cs, 16 + 8 * h); }
#pragma unroll 1
            for (int kt = 0; kt < nkt; kt += 3) {
                MLA_TILE(kt, 0);
                if (kt + 1 < nkt) MLA_TILE(kt + 1, 1);
                if (kt + 2 < nkt) MLA_TILE(kt + 2, 2);
            }
            if (w == 7) { MLA_PEND_PLAIN(Sb, MLA_VB_((nkt - 1) % 3) + 16 * 512 + vlane); }
#undef MLA_TILE
#undef MLA_STAGE
#undef MLA_PEND_PLAIN
#undef MLA_DMAK
#undef MLA_DMAV
            const float ltot = lrun + __shfl_xor(lrun, 32);
            const float inv = 1.0f / ltot;
            char* op = OUTBc + (row0 * 2048 + hh * 128); const unsigned oo = (unsigned)(l31 * 2048 + 4 * h);
            const float inv16 = inv * 16.0f;
#pragma unroll
            for (int db = 0; db < 4; ++db)
#pragma unroll
                for (int g4 = 0; g4 < 4; ++g4) { int wv = __builtin_amdgcn_cvt_pk_fp8_f32(O[db][4 * g4] * inv16, O[db][4 * g4 + 1] * inv16, 0, false); wv = __builtin_amdgcn_cvt_pk_fp8_f32(O[db][4 * g4 + 2] * inv16, O[db][4 * g4 + 3] * inv16, wv, true);
                    *(unsigned*)(op + oo + 32 * db + 8 * g4) = (unsigned)wv; }
        }
    }
    __syncthreads();
}

__device__ __forceinline__ void p7_router(Frame& F) {
    const char* Hc = (const char*)(F.ws + WS_H);
    const bf16_t* WRH = (const bf16_t*)(F.ws + WS_WRT); const bf16_t* WRL = WRH + NEXP * DM;
    int* TOPE = (int*)(F.ws + WS_TOPE); float* TOPW = (float*)(F.ws + WS_TOPW); int* CNT = (int*)(F.ws + WS_CNT);
    const float* SSQH = (const float*)(F.ws + WS_CKV); unsigned char* HN8 = (unsigned char*)(F.ws + WS_XN);
    constexpr int A_BYTES = 32 * 4096, LG_OFF = A_BYTES, HIST_OFF = LG_OFF + 32 * 33 * 4, RS_OFF = HIST_OFF + 128;
    LAS float* red = (LAS float*)F.lds; LAS float* lg = (LAS float*)(F.lds + LG_OFF); LAS int* hist = (LAS int*)(F.lds + HIST_OFF); LAS float* rsl = (LAS float*)(F.lds + RS_OFF);
    int lane = F.lane; asm volatile("" : "+v"(lane));
    const int w = F.wave, l31 = lane & 31, h = lane >> 5;
    bf16x8 bh[16];
#pragma unroll
    for (int ks = 0; ks < 16; ++ks) { const size_t bo = (size_t)l31 * DM + 256 * w + 16 * ks + 8 * h; bh[ks] = *(const bf16x8*)(WRH + bo); }
    for (int c = F.bx; c < NTOK / 128; c += F.G) {
        __syncthreads();
        if (F.tid < NEXP) hist[F.tid] = 0;
        for (int tt = 0; tt < 4; ++tt) {
            const int r0 = 128 * c + 32 * tt;
            __syncthreads();
            { const char* hb = Hc + (size_t)r0 * 4096;
#pragma unroll
              for (int j = 0; j < 16; ++j) { const int p = w + 8 * j, s_ = 64 * p + lane, row = s_ >> 8, pos = s_ & 255;
                  glds16_asm(hb, (unsigned)(row * 4096 + ((pos ^ (row & 15)) << 4)), (unsigned)(size_t)(F.lds + p * 1024)); } }
            if (F.tid < 32) { const float* sp = SSQH + (size_t)(r0 + F.tid) * 32; float ssum = 0.f;
#pragma unroll
                for (int q4 = 0; q4 < 8; ++q4) { const f32x4 v = *(const f32x4*)(sp + 4 * q4); ssum += (v[0] + v[1]) + (v[2] + v[3]); }
                const float rs = 1.0f / sqrtf(ssum * (1.0f / DM) + EPS); rsl[F.tid] = rs; }
            asm volatile("s_waitcnt vmcnt(0)" ::: "memory");
            __syncthreads();
            f32x16 acc;
#pragma unroll
            for (int r = 0; r < 16; ++r) acc[r] = 0.f;
#pragma unroll
            for (int ks = 0; ks < 16; ++ks) { const int ch = 32 * w + 2 * ks + h;
                const bf16x8 ah = *(const LAS bf16x8*)(F.lds + l31 * 4096 + ((ch ^ (l31 & 15)) << 4));
                const bf16x8 blk = *(const bf16x8*)(WRL + (size_t)l31 * DM + 256 * w + 16 * ks + 8 * h);
                acc = __builtin_amdgcn_mfma_f32_32x32x16_bf16(ah, bh[ks], acc, 0, 0, 0);
                acc = __builtin_amdgcn_mfma_f32_32x32x16_bf16(ah, blk, acc, 0, 0, 0); }
#pragma unroll 4
            for (int j = 0; j < 16; ++j) { const int s_ = F.tid + 512 * j, row = s_ >> 8, g = (s_ & 255) ^ (row & 15); const float rs = rsl[row];
                const u32x4 hw = *(const LAS u32x4*)(F.lds + s_ * 16);
                int y0 = __builtin_amdgcn_cvt_pk_fp8_f32(bf_lo(hw.x) * rs, bf_hi(hw.x) * rs, 0, false); y0 = __builtin_amdgcn_cvt_pk_fp8_f32(bf_lo(hw.y) * rs, bf_hi(hw.y) * rs, y0, true);
                int y1 = __builtin_amdgcn_cvt_pk_fp8_f32(bf_lo(hw.z) * rs, bf_hi(hw.z) * rs, 0, false); y1 = __builtin_amdgcn_cvt_pk_fp8_f32(bf_lo(hw.w) * rs, bf_hi(hw.w) * rs, y1, true);
                *(u32x2*)(HN8 + (size_t)(r0 + row) * DM + g * 8) = (u32x2){(unsigned)y0, (unsigned)y1}; }
            __syncthreads();
#pragma unroll
            for (int r = 0; r < 16; ++r) red[(w * 32 + crow(r, h)) * 32 + l31] = acc[r];
            __syncthreads();
#pragma unroll
            for (int q = 0; q < 2; ++q) { const int idx = F.tid + 512 * q, row = idx >> 5, e = idx & 31; float sum = 0.f;
#pragma unroll
                for (int ww = 0; ww < 8; ++ww) sum += red[(ww * 32 + row) * 32 + e];
                lg[row * 33 + e] = sum * rsl[row] + F.b_router[e]; }
            __syncthreads();
#pragma unroll
            for (int rr = 0; rr < 4; ++rr) {
                float lv = (lane < 32) ? lg[(4 * w + rr) * 33 + l31] : -1e30f; float tv[4]; int te[4];
#pragma unroll
                for (int k = 0; k < 4; ++k) {
                    float bv = lv; int bi = lane;
#pragma unroll
                    for (int o = 1; o < 64; o <<= 1) { const float ov = __shfl_xor(bv, o); const int oi = __shfl_xor(bi, o); if (ov > bv || (ov == bv && oi < bi)) { bv = ov; bi = oi; } }
                    tv[k] = bv; te[k] = bi; if (lane == bi) lv = -3e38f;
                }
                const float e1 = __expf(tv[1] - tv[0]), e2 = __expf(tv[2] - tv[0]), e3 = __expf(tv[3] - tv[0]); const float inv = 1.0f / (1.0f + e1 + e2 + e3);
                if (lane == 0) { const int row = r0 + 4 * w + rr;
                    *(int4*)(TOPE + (size_t)row * 4) = make_int4(te[0], te[1], te[2], te[3]);
                    *(float4*)(TOPW + (size_t)row * 4) = make_float4(inv, e1 * inv, e2 * inv, e3 * inv);
                    atomicAdd((int*)hist + te[0], 1); atomicAdd((int*)hist + te[1], 1); atomicAdd((int*)hist + te[2], 1); atomicAdd((int*)hist + te[3], 1); }
            }
        }
        __syncthreads();
        if (F.tid < NEXP) CNT[c * NEXP + F.tid] = hist[F.tid];
    }
    __syncthreads();
}

__device__ __forceinline__ void p8_slots(Frame& F) {
    const int* CNT = (const int*)(F.ws + WS_CNT); const int* TOPE = (const int*)(F.ws + WS_TOPE);
    int* SLOT = (int*)(F.ws + WS_SLOT); int* ROWTOK = (int*)(F.ws + WS_ROWTOK); int* TILEE = (int*)(F.ws + WS_TILEE);
    LAS int* red_all = (LAS int*)F.lds;
    LAS int* red_pre = red_all + 512;
    LAS int* tot = red_pre + 512;
    LAS int* pre = tot + 32;
    LAS int* pstart = pre + 32;
    LAS int* le = pstart + 64;
    LAS int* ls = le + 512;
    constexpr int NCH = NTOK / 128;
    for (int c = F.bx; c < NCH; c += F.G) {
        __syncthreads();
        { const int e = F.tid & 31, part = F.tid >> 5; int sa = 0, sp = 0;
          for (int cc = part; cc < NCH; cc += 16) { const int v = CNT[cc * NEXP + e]; sa += v; if (cc < c) sp += v; }
          red_all[part * 32 + e] = sa; red_pre[part * 32 + e] = sp; }
        le[F.tid] = TOPE[(size_t)c * 512 + F.tid];
        __syncthreads();
        if (F.tid < 32) { int sa = 0, sp = 0;
#pragma unroll
            for (int p = 0; p < 16; ++p) { sa += red_all[p * 32 + F.tid]; sp += red_pre[p * 32 + F.tid]; }
            tot[F.tid] = sa; pre[F.tid] = sp; }
        __syncthreads();
        if (F.tid == 0) { int a = 0; for (int e = 0; e < NEXP; ++e) { pstart[e] = a; a += (tot[e] + 255) / 256 * 256; } pstart[32] = a; }
        __syncthreads();
        if (F.tid < 32) { const int e = F.tid; int run = pstart[e] + pre[e];
            for (int a = 0; a < 512; ++a) { if (le[a] == e) { ls[a] = run; ++run; } } }
        __syncthreads();
        { const int a = F.tid, token = 128 * c + (a >> 2), slot = ls[a]; SLOT[(size_t)c * 512 + a] = slot; ROWTOK[slot] = token; }
        if (c < NEXP) { const int e = c; for (int r = pstart[e] + tot[e] + F.tid; r < pstart[e + 1]; r += NTHREADS) ROWTOK[r] = 0; }
        if (c == 0) { const int ntl = pstart[32] / 256;
            for (int t = F.tid; t < ntl; t += NTHREADS) { int e = 0; for (int q = 1; q < NEXP; ++q) if (t * 256 >= pstart[q]) e = q; TILEE[t] = e; }
            if (F.tid == 0) F.ctl[CW_NT] = (unsigned)ntl; }
    }
    __syncthreads();
}

__device__ __forceinline__ void p11_final(Frame& F) {
    const int gw = F.bx * NWAVES + F.wave, NGW = F.G * NWAVES, lane = F.lane;
    const bf16_t* YB = (const bf16_t*)(F.ws + WS_YBUF); const int* SLOT = (const int*)(F.ws + WS_SLOT); const float* TOPW = (const float*)(F.ws + WS_TOPW);
#ifdef DBG_DUMP
    for (int m = gw; m < NTOK; m += NGW) {
        const bf16_t* src = (const bf16_t*)(F.ws + DBG_DUMP_OFF) + (size_t)((m + DBG_DUMP_SHIFT) % NTOK) * DBG_DUMP_PITCH + DBG_DUMP_COL;
        #ifdef DBG_TWICE
        const bf16_t* src2 = (const bf16_t*)(F.ws + WS_ACT) + (size_t)m * DBG_DUMP_PITCH + DBG_DUMP_COL;
        for (int d = lane; d < DM; d += 64) F.out[(size_t)m * DM + d] = (bf_lo((unsigned)src[d]) - bf_lo((unsigned)src2[d])) * 1000.f + 1.0f;
#else
        for (int d = lane; d < DM; d += 64) F.out[(size_t)m * DM + d] = (d < DBG_DUMP_N) ? bf_lo((unsigned)src[d]) : 0.f;
#endif
    }
    return;
#endif
    constexpr int R11 = 2;
    typedef float f32x2_ __attribute__((ext_vector_type(2)));
    int4 sl[R11]; float4 tw[R11];
#pragma unroll
    for (int q = 0; q < R11; ++q) { const int m = gw + q * NGW; sl[q] = make_int4(0, 0, 0, 0); tw[q] = make_float4(0.f, 0.f, 0.f, 0.f);
        if (m < NTOK) { sl[q] = *(const int4*)(SLOT + (size_t)m * 4); tw[q] = *(const float4*)(TOPW + (size_t)m * 4); } }
    for (int m0 = gw; m0 < NTOK; m0 += R11 * NGW) {
        u32x2 hw[R11][8]; unsigned ya[R11][8], yb[R11][8], yc[R11][8], yd[R11][8];
#pragma unroll
        for (int q = 0; q < R11; ++q) { const int m = m0 + q * NGW; if (m < NTOK) {
            const u32x2* hb = (const u32x2*)((const bf16_t*)(F.ws + WS_H) + (size_t)m * DM) + lane;
            const unsigned* y0 = (const unsigned*)((const unsigned char*)YB + (size_t)sl[q].x * DM) + lane; const unsigned* y1 = (const unsigned*)((const unsigned char*)YB + (size_t)sl[q].y * DM) + lane;
            const unsigned* y2 = (const unsigned*)((const unsigned char*)YB + (size_t)sl[q].z * DM) + lane; const unsigned* y3 = (const unsigned*)((const unsigned char*)YB + (size_t)sl[q].w * DM) + lane;
#pragma unroll
            for (int j = 0; j < 8; ++j) { hw[q][j] = hb[64 * j]; ya[q][j] = y0[64 * j]; yb[q][j] = y1[64 * j]; yc[q][j] = y2[64 * j]; yd[q][j] = y3[64 * j]; } } }
        float4 twc[R11];
#pragma unroll
        for (int q = 0; q < R11; ++q) { twc[q] = tw[q]; const int mn = m0 + (R11 + q) * NGW;
            if (mn < NTOK) { sl[q] = *(const int4*)(SLOT + (size_t)mn * 4); tw[q] = *(const float4*)(TOPW + (size_t)mn * 4); } }
#pragma unroll
        for (int q = 0; q < R11; ++q) { const int m = m0 + q * NGW; if (m < NTOK) {
            f32x4* hr = (f32x4*)(F.out + (size_t)m * DM) + lane;
            f32x4 v[8]; float s = 0.f;
#pragma unroll
            for (int j = 0; j < 8; ++j) { v[j] = (f32x4){bf_lo(hw[q][j].x), bf_hi(hw[q][j].x), bf_lo(hw[q][j].y), bf_hi(hw[q][j].y)};
                const unsigned a = ya[q][j], b = yb[q][j], c = yc[q][j], d = yd[q][j];
                const f32x2_ a0 = __builtin_amdgcn_cvt_pk_f32_fp8((int)a, false), a1 = __builtin_amdgcn_cvt_pk_f32_fp8((int)a, true), b0 = __builtin_amdgcn_cvt_pk_f32_fp8((int)b, false), b1 = __builtin_amdgcn_cvt_pk_f32_fp8((int)b, true);
                const f32x2_ c0 = __builtin_amdgcn_cvt_pk_f32_fp8((int)c, false), c1 = __builtin_amdgcn_cvt_pk_f32_fp8((int)c, true), d0 = __builtin_amdgcn_cvt_pk_f32_fp8((int)d, false), d1 = __builtin_amdgcn_cvt_pk_f32_fp8((int)d, true);
                v[j].x += twc[q].x * a0[0] + twc[q].y * b0[0] + twc[q].z * c0[0] + twc[q].w * d0[0];
                v[j].y += twc[q].x * a0[1] + twc[q].y * b0[1] + twc[q].z * c0[1] + twc[q].w * d0[1];
                v[j].z += twc[q].x * a1[0] + twc[q].y * b1[0] + twc[q].z * c1[0] + twc[q].w * d1[0];
                v[j].w += twc[q].x * a1[1] + twc[q].y * b1[1] + twc[q].z * c1[1] + twc[q].w * d1[1];
                s += (v[j].x * v[j].x + v[j].y * v[j].y) + (v[j].z * v[j].z + v[j].w * v[j].w); }
            const float rstd = 1.0f / sqrtf(wave_sum(s) * (1.0f / DM) + EPS);
#pragma unroll
            for (int j = 0; j < 8; ++j) { const f32x4 gg = ((const f32x4*)F.g_final)[lane + 64 * j]; hr[64 * j] = v[j] * rstd * gg; } } }
    }
}

__global__ void __launch_bounds__(NTHREADS, 2) fwd_kernel(Args args) {
    __shared__ __attribute__((aligned(16))) unsigned char lds_raw[LDS_BYTES];
    Frame F;
    F.lds = (LAS unsigned char*)lds_raw; F.ws = args.ws; F.ctl = (unsigned*)(args.ws + WS_CTL);
    F.tid = threadIdx.x; F.lane = F.tid & 63; F.wave = __builtin_amdgcn_readfirstlane(F.tid >> 6); F.G = gridDim.x; F.bx = blockIdx.x;
    F.x = (const float*)args.in[0]; F.positions = (const int*)args.in[1]; F.g_attn = (const float*)args.in[2]; F.w_in = (const float*)args.in[3]; F.b_gate = (const float*)args.in[4];
    F.sinks = (const float*)args.in[5]; F.g_q = (const float*)args.in[6]; F.w_uq = (const float*)args.in[7]; F.g_kv = (const float*)args.in[8]; F.w_ukv = (const float*)args.in[9];
    F.w_o_swa = (const float*)args.in[10]; F.w_o_mla = (const float*)args.in[11]; F.w_out = (const float*)args.in[12]; F.g_ffn = (const float*)args.in[13]; F.w_router = (const float*)args.in[14];
    F.b_router = (const float*)args.in[15]; F.w_gate_up = (const float*)args.in[16]; F.b_gate_up = (const float*)args.in[17]; F.w_down = (const float*)args.in[18]; F.b_down = (const float*)args.in[19];
    F.g_final = (const float*)args.in[20]; F.out = args.out;
    volatile LAS unsigned* MISC = (volatile LAS unsigned*)(F.lds + MISC_OFF);
#ifdef DBG_ZERO_LDS
    for (int u = F.tid; u < RING_BYTES / 4; u += NTHREADS) ((LAS unsigned*)(F.lds))[u] = 0u;
#endif
    for (int u = F.tid; u < (LDS_BYTES - MISC_OFF) / 4; u += NTHREADS) ((LAS unsigned*)(F.lds + MISC_OFF))[u] = 0u;
    __syncthreads();
    const int lo = args.ph_lo, hi = args.ph_hi;
    const bool multi = (hi - lo) > 1;
    XcdBarrier bar; bar.bar = F.ctl + CW_BAR; bar.x = 0; bar.st = nullptr;
    if (multi) bar = xcd_barrier_post(F.ctl + CW_BAR, MISC + 8);
#ifndef PHMASK
#ifdef DBG_NOMOE
#define PHMASK 0x87F
#else
#define PHMASK 0xFFF
#endif
#endif
#define IN(k) (((PHMASK >> (k)) & 1) && lo <= (k) && (k) < hi)
#define SEAM(k) do { if (IN(k) && IN((k) + 1)) xcd_barrier(bar); } while (0)
    unsigned char* ws = args.ws;
    bf16_t* XN = (bf16_t*)(ws + WS_XN); bf16_t* PROJ = (bf16_t*)(ws + WS_PROJ); unsigned char* GATES = (unsigned char*)(ws + WS_GATES);
    const int* TILEE = (const int*)(ws + WS_TILEE); const int* ROWTOK = (const int*)(ws + WS_ROWTOK);

#ifndef REPMASK
#define REPMASK 0
#endif
#define NREP(k) (((REPMASK >> (k)) & 1) + 1)
    if (IN(0)) { for (int rep = 0; rep < NREP(0); ++rep) p0_prologue(F); SEAM(0); }
    if (IN(1)) {
        { pg8::Gemm8 g{(const unsigned char*)(ws + WS_XN8), (const unsigned char*)(ws + WS_WIN), DM, DM, nullptr, 0, (const int*)(ws + WS_IDROW)}; pg8::StaticOrder S; S.init(NTOK / 256, NPROJ / 256, F.G, F.bx);
          pg8::EpiProj8 E{PROJ, (float*)(ws + WS_CQ)};
          for (int rep = 0; rep < NREP(1); ++rep) pg8::gemm_phase_f8<pg8::EpiProj8>(F.lds, g, S, E); }
        { pg8::Gemm8 g{(const unsigned char*)(ws + WS_XN8), (const unsigned char*)(ws + WS_WIN + WIN_GATES_OFF), DM, DM, nullptr, 0, (const int*)(ws + WS_IDROW)}; pg8::StaticOrder S; S.init(NTOK / 256, NGATE / 256, F.G, F.bx);
          pg8::EpiGates8 E{GATES, F.b_gate};
          for (int rep = 0; rep < NREP(1); ++rep) pg8::gemm_phase_f8<pg8::EpiGates8>(F.lds, g, S, E); }
        SEAM(1);
    }
#ifdef DBG_TWICE
    if (IN(2)) {
        pg8::Gemm g{XN, (const bf16_t*)(ws + WS_WIN), DM, DM, nullptr, 0, nullptr}; pg8::StaticOrder S; S.init(NTOK / 256, NIN_PHYS / 256, F.G, F.bx);
        pg8::EpiProj E{(bf16_t*)(ws + WS_YBUF), (bf16_t*)(ws + WS_ACT), F.b_gate};
        pg8::gemm_phase<pg8::EpiProj, false, false>(F.lds, g, S, E);
    }
#else
#endif
    if (IN(3)) {
#ifndef P3_SKIP_GEMM
        { pg8::Gemm g{PROJ + PC_DQ, (const bf16_t*)(ws + WS_WUQ), NPROJ, 512, nullptr, 0, nullptr}; pg8::StaticOrder S; S.init(NTOK / 256, 1536 / 256, F.G, F.bx);
          pg8::EpiQn E{(bf16_t*)(ws + WS_QB), (const float*)(ws + WS_CQ), 0.07216878364870322f * 1.4426950408889634f};
          for (int rep = 0; rep < NREP(12); ++rep) pg8::gemm_phase<pg8::EpiQn, false, false>(F.lds, g, S, E); }
        { pg8::Gemm g{PROJ + PC_DKV, (const bf16_t*)(ws + WS_WUKV), NPROJ, 256, nullptr, 0, nullptr}; pg8::StaticOrder S; S.init(NTOK / 256, 2048 / 256, F.G, F.bx);
          pg8::EpiKVn E{(bf16_t*)(ws + WS_KMLA), (bf16_t*)(ws + WS_VMLA), (const float*)(ws + WS_CQ), PROJ, (const float*)(ws + WS_CS)};
          for (int rep = 0; rep < NREP(12); ++rep) pg8::gemm_phase<pg8::EpiKVn, false, false>(F.lds, g, S, E); }
#endif
#ifndef P3_SKIP_SWA
        for (int rep = 0; rep < NREP(3); ++rep) swa_phase(F);
#endif
        SEAM(3);
    }
    if (IN(4)) { for (int rep = 0; rep < NREP(4); ++rep) mla_phase(F); SEAM(4); }
    if (IN(5)) {
        pg8::Gemm8 g{(const unsigned char*)(ws + WS_OUTA), (const unsigned char*)(ws + WS_WOA), DM, DM, nullptr, 0, (const int*)(ws + WS_IDROW)}; pg8::StaticOrder S; S.init(NTOK / 256, DM / 256, F.G, F.bx);
        pg8::EpiGateMerge8 E{(unsigned char*)(ws + WS_MIX), GATES};
        for (int rep = 0; rep < NREP(5); ++rep) pg8::gemm_phase_f8<pg8::EpiGateMerge8, true>(F.lds, g, S, E);
        SEAM(5);
    }
    if (IN(6)) {
        pg8::Gemm8 g{(const unsigned char*)(ws + WS_MIX), (const unsigned char*)(ws + WS_WOUT), DM, DM, nullptr, 0, (const int*)(ws + WS_IDROW)}; pg8::StaticOrder S; S.init(NTOK / 256, DM / 256, F.G, F.bx);
        pg8::EpiRes8 E{F.x, (bf16_t*)(ws + WS_H), (float*)(ws + WS_CKV)};
        for (int rep = 0; rep < NREP(6); ++rep) pg8::gemm_phase_f8<pg8::EpiRes8>(F.lds, g, S, E);
        SEAM(6);
    }
    if (IN(7)) { for (int rep = 0; rep < NREP(7); ++rep) p7_router(F); SEAM(7); }
    if (IN(8)) { p8_slots(F); SEAM(8); }
    if (IN(9)) {
        const int ntl = (int)__hip_atomic_load(F.ctl + CW_NT, __ATOMIC_RELAXED, __HIP_MEMORY_SCOPE_AGENT);
        pg8::Gemm8 g{(const unsigned char*)XN, (const unsigned char*)(ws + WS_WGU), DM, DM, TILEE, (size_t)2 * DM * DM, ROWTOK}; pg8::StaticOrder S; S.init(ntl, 2 * DM / 256, F.G, F.bx);
        pg8::EpiSwiglu8 E{(unsigned char*)(ws + WS_ACT), F.b_gate_up, TILEE};
        for (int rep = 0; rep < NREP(9); ++rep) pg8::gemm_phase_f8<pg8::EpiSwiglu8>(F.lds, g, S, E);
        SEAM(9);
    }
#ifdef DBG_TWICE
    if (IN(10)) {
        const int gw = F.bx * NWAVES + F.wave, NGW = F.G * NWAVES; unsigned cnt = 0;
        for (int m = gw; m < NTOK; m += NGW) {
            const bf16_t* s1 = (const bf16_t*)(ws + DBG_CMP_OFF1) + (size_t)m * DBG_CMP_PITCH; const bf16_t* s2 = (const bf16_t*)(ws + DBG_CMP_OFF2) + (size_t)m * DBG_CMP_PITCH;
            for (int d = F.lane; d < 2048; d += 64) cnt += (s1[d] != s2[d]) ? 1u : 0u;
        }
        if (cnt) atomicAdd(F.ctl + 32, cnt);
    }
    if (IN(11)) {
        const unsigned c = __hip_atomic_load(F.ctl + 32, __ATOMIC_RELAXED, __HIP_MEMORY_SCOPE_AGENT);
        const float v = c == 0 ? 1.0f : (c < 1000u ? 2.0f : (c < 100000u ? 3.0f : (c < 10000000u ? 4.0f : 5.0f)));
        for (size_t i = (size_t)F.bx * NTHREADS + F.tid; i < (size_t)NTOK * DM; i += (size_t)F.G * NTHREADS) F.out[i] = v;
        return;
    }
#endif
    if (IN(10)) {
        const int ntl = (int)__hip_atomic_load(F.ctl + CW_NT, __ATOMIC_RELAXED, __HIP_MEMORY_SCOPE_AGENT);
        pg8::Gemm8 g{(const unsigned char*)(ws + WS_ACT), (const unsigned char*)(ws + WS_WD), DM, DM, TILEE, (size_t)DM * DM, (const int*)(ws + WS_IDROW)}; pg8::StaticOrder S; S.init(ntl, DM / 256, F.G, F.bx);
        pg8::EpiDown8 E{(unsigned char*)(ws + WS_YBUF), F.b_down, TILEE};
        for (int rep = 0; rep < NREP(10); ++rep) pg8::gemm_phase_f8<pg8::EpiDown8>(F.lds, g, S, E);
        SEAM(10);
    }
    if (IN(11)) { p11_final(F); }
#undef IN
#undef SEAM
}

extern "C" void kernel_launch(void* const* d_in, const int* in_sizes, int n_in, void* d_out, int out_size, void* d_ws, size_t ws_size, hipStream_t stream) {
    static int grid = 0;
    if (grid == 0) {
        if (n_in != 21 || out_size != NTOK * DM || ws_size < WS_END) { fprintf(stderr, "kernel_launch: unexpected problem (n_in %d, out %d, ws %zu)\n", n_in, out_size, ws_size); grid = -1; return; }
        int dev = 0, cus = 0, per_cu = 0;
        if (hipGetDevice(&dev) != hipSuccess || hipDeviceGetAttribute(&cus, hipDeviceAttributeMultiprocessorCount, dev) != hipSuccess) { grid = -1; return; }
        if (hipOccupancyMaxActiveBlocksPerMultiprocessor(&per_cu, (const void*)fwd_kernel, NTHREADS, 0) != hipSuccess || per_cu < 1) { fprintf(stderr, "kernel_launch: occupancy query says %d\n", per_cu); }
        (void)hipGetLastError();
        grid = cus;
    }
    if (grid < 0) return;
    if (hipMemsetAsync((char*)d_ws + WS_CTL, 0, CTL_ZERO_BYTES, stream) != hipSuccess) return;
    Args a{};
    for (int i = 0; i < 21; ++i) a.in[i] = d_in[i];
    a.out = (float*)d_out; a.ws = (unsigned char*)d_ws;
#if MK_ONE_LAUNCH
    a.ph_lo = 0; a.ph_hi = 12;
    hipLaunchKernelGGL(fwd_kernel, dim3(grid), dim3(NTHREADS), 0, stream, a);
#else
    for (int p = 0; p < 12; ++p) { a.ph_lo = p; a.ph_hi = p + 1; hipLaunchKernelGGL(fwd_kernel, dim3(grid), dim3(NTHREADS), 0, stream, a); }
#endif
}
```

```cpp
#include <hip/hip_runtime.h>
#include <cstdio>
#include <cstdint>

#ifndef MK_ONE_LAUNCH
#define MK_ONE_LAUNCH 1
#endif

#define LAS __attribute__((address_space(3)))
#define GAS __attribute__((address_space(1)))
typedef unsigned short bf16_t;
typedef short bf16x8 __attribute__((ext_vector_type(8)));
typedef short s16x4 __attribute__((ext_vector_type(4)));
typedef float f32x4 __attribute__((ext_vector_type(4)));
typedef float f32x16 __attribute__((ext_vector_type(16)));
typedef unsigned u32x4 __attribute__((ext_vector_type(4)));
typedef unsigned u32x2 __attribute__((ext_vector_type(2)));
typedef short v4i16_t __attribute__((ext_vector_type(4)));

constexpr int DM = 2048, BATCH = 16, SEQ = 2048, NTOK = BATCH * SEQ;
constexpr int NPROJ = 2304;
constexpr int PC_KA = 1024, PC_VA = 1152, PC_DQ = 1280, PC_DKV = 1792, PC_KR = 2048;
constexpr int NGATE = 4096, NIN_PHYS = 6400, NIN_LOG = 6208, NLOW = 2112;
constexpr int NEXP = 32, TOPK = 4, MAXTILES = 544, PROWS = MAXTILES * 256;
constexpr float EPS = 1e-6f;

constexpr size_t MiB = 1ull << 20;
constexpr size_t WS_CTL = 0, CTL_ZERO_BYTES = 1 * MiB;
constexpr size_t WS_CS = 1 * MiB, WS_WRT = 9 * MiB, WS_WIN = 10 * MiB, WS_WUQ = 36 * MiB, WS_WUKV = 38 * MiB, WS_WOA = 40 * MiB, WS_WOB = 45 * MiB, WS_WOUT = 50 * MiB;
constexpr size_t WS_WGU = 64 * MiB, WS_WD = 580 * MiB, WS_XN = 840 * MiB, WS_PROJ = 968 * MiB, WS_GATES = 1112 * MiB, WS_CQ = 1368 * MiB, WS_CKV = 1400 * MiB;
constexpr size_t WS_QB = 1416 * MiB, WS_KMLA = 1512 * MiB  , WS_VMLA = 1610 * MiB  ;
constexpr size_t WS_OUTA = 1676 * MiB, WS_OUTB = 1740 * MiB, WS_MIX = 1804 * MiB;
constexpr size_t WS_TOPE = 1932 * MiB, WS_TOPW = 1933 * MiB, WS_SLOT = 1934 * MiB, WS_ROWTOK = 1935 * MiB, WS_TILEE = 1936 * MiB, WS_CNT = 1937 * MiB;
constexpr size_t WS_ACT = 1940 * MiB, WS_YBUF = 2484 * MiB, WS_END = 3028 * MiB;
constexpr size_t WS_H = WS_OUTA;
constexpr size_t WS_XN8 = WS_YBUF  , WS_IDROW = 60 * MiB, WIN_GATES_OFF = 16 * MiB;
constexpr int LDPAD = 16;
constexpr int CW_NT = 16, CW_BAR = 4096;

constexpr int RING_BYTES = 131072, LDS_BYTES = 147456, MISC_OFF = LDS_BYTES - 256;
constexpr int NWAVES = 8, NTHREADS = 512;

__device__ __forceinline__ unsigned cvt_pk_bf16(float lo, float hi) { unsigned r; asm volatile("v_cvt_pk_bf16_f32 %0, %1, %2" : "=v"(r) : "v"(lo), "v"(hi)); return r; }
__device__ __forceinline__ unsigned cvt_pk_bf16_t(float lo, float hi) { unsigned r; asm volatile("s_nop 0\n\tv_cvt_pk_bf16_f32 %0, %1, %2" : "=v"(r) : "v"(lo), "v"(hi)); return r; }
__device__ __forceinline__ float bf_lo(unsigned w) { return __uint_as_float(w << 16); }
__device__ __forceinline__ float bf_hi(unsigned w) { return __uint_as_float(w & 0xffff0000u); }
__device__ __forceinline__ float wave_sum(float v) {
#pragma unroll
    for (int o = 1; o < 64; o <<= 1) v += __shfl_xor(v, o);
    return v;
}
__device__ __forceinline__ float fast_sigmoid(float x) { return __builtin_amdgcn_rcpf(1.0f + __builtin_amdgcn_exp2f(-1.4426950408889634f * x)); }
__device__ __forceinline__ const char* uni_ptr(const char* p) { const unsigned long long v = (unsigned long long)p; const unsigned lo = __builtin_amdgcn_readfirstlane((unsigned)v), hi = __builtin_amdgcn_readfirstlane((unsigned)(v >> 32)); return (const char*)(((unsigned long long)hi << 32) | lo); }
__device__ __forceinline__ void glds16_asm(const char* sbase, unsigned voff, unsigned lds_dst) {
    unsigned keep;
    asm volatile("s_mov_b32 %0, m0\n\ts_mov_b32 m0, %3\n\ts_nop 0\n\tglobal_load_lds_dwordx4 %1, %2\n\ts_mov_b32 m0, %0" : "=&s"(keep) : "v"(voff), "s"(sbase), "s"(lds_dst) : "memory");
}
#define LDS_WAIT() asm volatile("s_waitcnt lgkmcnt(0)" ::: "memory")

#define XB_TMO      128
#define XB_XCNT(j)  (256  + 64 * (j))
#define XB_XSUB(j)  (1280 + 64 * (j))
#define XB_XGEN(j)  (2304 + 64 * (j))
#define XB_TOP      3328
#define XB_TOPGEN   3392
#define XCD_BAR_WORDS 3456
#define XB_SPIN_CAP (1u << 18)
__device__ __forceinline__ unsigned xb_ld(unsigned* p)              { return __hip_atomic_load(p, __ATOMIC_RELAXED, __HIP_MEMORY_SCOPE_AGENT); }
__device__ __forceinline__ unsigned xb_add(unsigned* p, unsigned v) { return __hip_atomic_fetch_add(p, v, __ATOMIC_RELAXED, __HIP_MEMORY_SCOPE_AGENT); }
__device__ __forceinline__ unsigned xb_xcc_id() { return (unsigned)__builtin_amdgcn_s_getreg((3 << 11) | 20) & 0xFu; }
#define XB_SPIN(cond, bar) do { unsigned _sp = 0; while (cond) { __builtin_amdgcn_s_sleep(1); \
    if ((++_sp & 255u) == 0u) { if (xb_ld(&(bar)[XB_TMO])) break; if (_sp > XB_SPIN_CAP) { atomicAdd(&(bar)[XB_TMO], 1u); break; } } } } while (0)
struct XcdBarrier { unsigned* bar; unsigned x; volatile LAS unsigned* st; };
__device__ __forceinline__ XcdBarrier xcd_barrier_post(unsigned* bar, volatile LAS unsigned* st) {
    XcdBarrier b; b.bar = bar; b.x = xb_xcc_id(); b.st = st;
    if (threadIdx.x == 0) (void)xb_add(&bar[XB_XCNT(b.x)], 1u);
    return b;
}
__device__ __forceinline__ void xcd_barrier_complete(unsigned* bar, unsigned x, unsigned& nloc, unsigned& nx) {
    const unsigned G = gridDim.x * gridDim.y * gridDim.z;
    unsigned sum, cnt, mine, sp = 0u;
    for (;;) {
        sum = 0u; cnt = 0u; mine = 0u;
#pragma unroll
        for (unsigned j = 0; j < 16; ++j) { const unsigned c = xb_ld(&bar[XB_XCNT(j)]); sum += c; cnt += (c > 0u) ? 1u : 0u; mine = (j == x) ? c : mine; }
        if (sum == G) break;
        __builtin_amdgcn_s_sleep(1);
        if ((++sp & 255u) == 0u) { if (xb_ld(&bar[XB_TMO])) break; if (sp > XB_SPIN_CAP) { atomicAdd(&bar[XB_TMO], 1u); break; } }
    }
    nloc = mine > 0u ? mine : 1u; nx = cnt > 0u ? cnt : 1u;
}
__device__ __forceinline__ void xcd_barrier(const XcdBarrier& b) {
    asm volatile("s_waitcnt vmcnt(0)" ::: "memory");
    __syncthreads();
    if (threadIdx.x == 0) {
        unsigned* bar = b.bar;
        __builtin_amdgcn_s_waitcnt(0);
        unsigned nloc = b.st[0], nx = b.st[1];
        if (nloc == 0u) { xcd_barrier_complete(bar, b.x, nloc, nx); b.st[0] = nloc; b.st[1] = nx; }
        const unsigned old = xb_add(&bar[XB_XSUB(b.x)], 1u);
        const unsigned gen = old / nloc;
        if (old + 1u == (gen + 1u) * nloc) {
            __builtin_amdgcn_fence(__ATOMIC_RELEASE, "agent");
            asm volatile("s_waitcnt vmcnt(0)" ::: "memory");
            const unsigned og = xb_add(&bar[XB_TOP], 1u);
            const unsigned tg = og / nx;
            if (og + 1u == (tg + 1u) * nx) xb_add(&bar[XB_TOPGEN], 1u);
            else XB_SPIN(xb_ld(&bar[XB_TOPGEN]) == tg, bar);
            __builtin_amdgcn_fence(__ATOMIC_ACQUIRE, "agent");
            xb_add(&bar[XB_XGEN(b.x)], 1u);
            asm volatile("s_waitcnt vmcnt(0)" ::: "memory");
        } else {
            XB_SPIN(xb_ld(&bar[XB_XGEN(b.x)]) == gen, bar);
            __builtin_amdgcn_fence(__ATOMIC_ACQUIRE, "agent");
            asm volatile("s_waitcnt vmcnt(0)" ::: "memory");
        }
    }
    __syncthreads();
}

namespace pg8 {
constexpr int BM = 256, BK = 64, HALF = 128, HTB = HALF * BK * 2, STAGE_BYTES = 8 * HTB, NXCD = 8, WGM = 8;
__host__ __device__ __forceinline__ int lds_byte(int r, int c) { const int st = (r >> 4) * 2 + (c >> 5), rr = r & 15, cc = c & 31, ob = rr * 64 + cc * 2; return st * 1024 + (ob ^ (((ob >> 9) & 1) << 5)); }
__host__ __device__ __forceinline__ void stage_rc(int b, int& R, int& C) { const int st = b / 1024, sb = b % 1024, swz = sb ^ (((sb >> 9) & 1) << 5); R = (st >> 1) * 16 + swz / 64; C = (st & 1) * 32 + (swz % 64) / 2; }
__host__ __device__ __forceinline__ int perm32(int rho) { const int n = rho >> 4, i = rho & 15; return 8 * (i >> 2) + 4 * n + (i & 3); }
struct Unit { int pm, pn; };
struct Gemm { const bf16_t* A; const bf16_t* Bt; int lda, K; const int* tile_e; size_t estride; const int* rowtok; };
struct StaticOrder {
    int nM, nN, nwg, G, c;
    __device__ void init(int nM_, int nN_, int G_, int c_) { nM = nM_; nN = nN_; nwg = nM * nN; G = G_; c = c_; }
    __device__ bool next(int i, Unit& u) const {
        const long L = (long)i * G + c; if (L >= nwg) return false;
        int wgid = (int)L; { const int q = nwg / NXCD, r = nwg % NXCD, xcd = wgid % NXCD, off = wgid / NXCD; wgid = (xcd < r ? xcd * (q + 1) : r * (q + 1) + (xcd - r) * q) + off; }
        const int nig = WGM * nN, gid = wgid / nig, fm = gid * WGM, gsz = (nM - fm) < WGM ? (nM - fm) : WGM;
        u.pm = fm + ((wgid % nig) % gsz); u.pn = (wgid % nig) / gsz; return true;
    }
};
template <class Epi, bool GROUPED, bool GATHER, bool MIDHOOK = false>
__device__ __forceinline__ void gemm_phase(LAS unsigned char* lds, const Gemm g, const StaticOrder& S, const Epi& E) {
    int tid = threadIdx.x; asm volatile("" : "+v"(tid));
    const int wid = __builtin_amdgcn_readfirstlane(tid >> 6), lane = tid & 63, wr = wid >> 2, wc = wid & 3, fr = lane & 15, fq = lane >> 4;
    int K = g.K; asm volatile("" : "+s"(K));
    const int nt = K / BK, lda = g.lda;
    unsigned voffB[2];
#pragma unroll
    for (int i = 0; i < 2; ++i) { int R, C; stage_rc(tid * 16 + i * 8192, R, C); const int Rb = Epi::PERM ? ((R & ~31) + perm32(R & 31)) : R;
        (void)Rb; voffB[i] = (unsigned)(tid * 16 + i * 8192); }
    const size_t kstep = (size_t)(BK * 2);
    const size_t kstepB = 32768, hstepB = 16384, tstepB = (size_t)nt * 32768;
    const unsigned ldsw = (unsigned)wid * 1024u;
    const int aoff = lds_byte(wr * 64 + fr, fq * 8), boff = lds_byte(wc * 32 + fr, fq * 8);
#define PG8_SA(b, h) (((b) * 2 + (h)) * HTB)
#define PG8_SB(b, h) ((4 + (b) * 2 + (h)) * HTB)
#define PG8_STAGE(bufoff, gbase, voff) do { _Pragma("unroll") for (int _i = 0; _i < 2; ++_i) \
        __builtin_amdgcn_global_load_lds((const unsigned*)((const char*)(gbase) + (voff)[_i]), (LAS unsigned*)(lds + (bufoff) + ldsw + _i * 8192), 16, 0, 0); } while (0)
#define PG8_LDA(dst, b, h) do { _Pragma("unroll") for (int m = 0; m < 4; ++m) _Pragma("unroll") for (int k = 0; k < 2; ++k) dst[m][k] = *(const LAS bf16x8*)(lds + PG8_SA(b, h) + aoff + m * 2048 + k * 1024); } while (0)
#define PG8_LDB(dst, b, h) do { _Pragma("unroll") for (int n = 0; n < 2; ++n) _Pragma("unroll") for (int k = 0; k < 2; ++k) dst[n][k] = *(const LAS bf16x8*)(lds + PG8_SB(b, h) + boff + n * 2048 + k * 1024); } while (0)
#define PG8_MMA(ai, bj, At, Bt) do { __builtin_amdgcn_s_setprio(1); _Pragma("unroll") for (int m = 0; m < 4; ++m) _Pragma("unroll") for (int n = 0; n < 2; ++n) _Pragma("unroll") for (int k = 0; k < 2; ++k) \
        acc[ai][bj][m][n] = __builtin_amdgcn_mfma_f32_16x16x32_bf16(Bt[n][k], At[m][k], acc[ai][bj][m][n], 0, 0, 0); __builtin_amdgcn_s_setprio(0); } while (0)
#ifdef DBG_SAFE_GEMM
#define PG8_WAIT_V(n) asm volatile("s_waitcnt vmcnt(0)" ::: "memory")
#else
#define PG8_WAIT_V(n) asm volatile("s_waitcnt vmcnt(" #n ")" ::: "memory")
#endif
#define PG8_WAIT_L(n) asm volatile("s_waitcnt lgkmcnt(" #n ")" ::: "memory")
#define PG8_BAR __builtin_amdgcn_s_barrier()
#define PG8_SCHED __builtin_amdgcn_sched_barrier(0)
#define PG8_AOFF(vo, u) do { int _t = tid; asm volatile("" : "+v"(_t));     \
        _Pragma("unroll") for (int _i = 0; _i < 2; ++_i) { int _R, _C; stage_rc(_t * 16 + _i * 8192, _R, _C); \
        _Pragma("unroll") for (int _h = 0; _h < 2; ++_h) { \
        const int _r = (u).pm * BM + _h * HALF + _R; (vo)[_h][_i] = (unsigned)(g.rowtok[_r] * lda + _C) * 2u; } } } while (0)
#define PG8_STGA(bufoff, aptr, gptr, h, vo) do { if constexpr (GATHER) PG8_STAGE(bufoff, gptr, (vo)[h]); else PG8_STAGE(bufoff, (aptr) + (h) * hstepA, voffA); } while (0)
#define PF8_AOFF_LDS(vo, rt) do { int _t = tid; asm volatile("" : "+v"(_t)); \
        _Pragma("unroll") for (int _i = 0; _i < 2; ++_i) { const int _p = _t + 512 * _i, _R = _p >> 3, _C = ((_p & 7) ^ sw8(_R)) << 4; \
        _Pragma("unroll") for (int _h = 0; _h < 2; ++_h) (vo)[_h][_i] = (unsigned)((rt)[_h * HALF + _R] * lda + _C); } } while (0)
    Unit cur, nxt; int ui = 0;
    if (!S.next(0, cur)) return;
    f32x4 acc[2][2][4][2];
#pragma unroll
    for (int a = 0; a < 2; ++a)
#pragma unroll
        for (int b = 0; b < 2; ++b)
#pragma unroll
            for (int m = 0; m < 4; ++m)
#pragma unroll
                for (int n = 0; n < 2; ++n) acc[a][b][m][n] = (f32x4){0.f, 0.f, 0.f, 0.f};
    bf16x8 At[4][2], B0[2][2], B1[2][2];
    unsigned voC[2][2], voffA[2];
    LAS u32x4* const gslot = (LAS u32x4*)(lds + STAGE_BYTES) + tid;
    const size_t hstepA = (size_t)HALF * lda * 2, tstepA = 2 * hstepA;
    if constexpr (GATHER) { PG8_AOFF(voC, cur); voffA[0] = 0; voffA[1] = 0; }
    else {
#pragma unroll
        for (int i = 0; i < 2; ++i) { int R, C; stage_rc(tid * 16 + i * 8192, R, C); voffA[i] = (unsigned)(R * lda + C) * 2u; }
#pragma unroll
        for (int h = 0; h < 2; ++h)
#pragma unroll
            for (int i = 0; i < 2; ++i) voC[h][i] = 0;
    }
    const char* const Abase = (const char*)g.A;
    const char* cA = GATHER ? Abase : Abase + (size_t)cur.pm * tstepA;
    const char* cB = (const char*)g.Bt + (GROUPED ? (size_t)g.tile_e[cur.pm] * g.estride * 2 : (size_t)0) + (size_t)cur.pn * tstepB;
    PG8_STAGE(PG8_SB(0, 0), cB, voffB); PG8_STAGE(PG8_SB(0, 1), cB + hstepB, voffB); PG8_STGA(PG8_SA(0, 0), cA, Abase, 0, voC); PG8_STGA(PG8_SA(0, 1), cA, Abase, 1, voC);
    if (wr == 1) PG8_BAR;
    PG8_WAIT_V(2); PG8_BAR;
    PG8_STAGE(PG8_SB(1, 0), cB + kstepB, voffB); PG8_STGA(PG8_SA(1, 0), cA + kstep, Abase + kstep, 0, voC); PG8_STAGE(PG8_SB(1, 1), cB + hstepB + kstepB, voffB);
    PG8_WAIT_V(6); PG8_BAR;
    for (;;) {
        const bool has_next = S.next(ui + 1, nxt);
        const char* nB = cB; const char* nA = cA;
        if (has_next) { nB = (const char*)g.Bt + (GROUPED ? (size_t)g.tile_e[nxt.pm] * g.estride * 2 : (size_t)0) + (size_t)nxt.pn * tstepB;
            if constexpr (GATHER) { unsigned vt[2][2]; PG8_AOFF(vt, nxt); *gslot = (u32x4){vt[0][0], vt[0][1], vt[1][0], vt[1][1]}; } else nA = Abase + (size_t)nxt.pm * tstepA; }
        else if constexpr (GATHER) *gslot = (u32x4){voC[0][0], voC[0][1], voC[1][0], voC[1][1]};
#pragma unroll 1
        for (int t = 0; t < nt; t += 2) {
            const bool last = (t == nt - 2);
            const char* a1 = cA + (size_t)(t + 1) * kstep;
            const char* a2 = last ? nA : cA + (size_t)(t + 2) * kstep; const char* b2 = last ? nB : cB + (size_t)(t + 2) * kstepB;
            const char* a3 = a2 + kstep; const char* b3 = b2 + kstepB;
            if constexpr (MIDHOOK) { if (t == nt / 2) { int ln_ = lane; asm volatile("" : "+v"(ln_)); E.mid(acc, cur, wr, wc, ln_ & 15, ln_ >> 4); } }
            PG8_LDB(B0, 0, 0); PG8_LDB(B1, 0, 1); PG8_SCHED; PG8_LDA(At, 0, 0); PG8_STGA(PG8_SA(1, 1), a1, a1, 1, voC);
            if constexpr (GATHER) { if (last) { const u32x4 q = *gslot; voC[0][0] = q.x; voC[0][1] = q.y; voC[1][0] = q.z; voC[1][1] = q.w; } }
            PG8_WAIT_V(8); PG8_WAIT_L(0); PG8_BAR; PG8_MMA(0, 0, At, B0); PG8_MMA(0, 1, At, B1); PG8_BAR; PG8_SCHED;
            PG8_LDA(At, 0, 1); PG8_STAGE(PG8_SB(0, 0), b2, voffB); PG8_STAGE(PG8_SB(0, 1), b2 + hstepB, voffB); PG8_STGA(PG8_SA(0, 0), a2, a2, 0, voC);
            PG8_WAIT_V(8); PG8_WAIT_L(0); PG8_BAR; PG8_MMA(1, 0, At, B0); PG8_MMA(1, 1, At, B1); PG8_BAR; PG8_SCHED;
            PG8_LDB(B0, 1, 0); PG8_LDB(B1, 1, 1); PG8_SCHED; PG8_LDA(At, 1, 0); PG8_STGA(PG8_SA(0, 1), a2, a2, 1, voC);
            PG8_WAIT_V(8); PG8_WAIT_L(0); PG8_BAR; PG8_MMA(0, 0, At, B0); PG8_MMA(0, 1, At, B1); PG8_BAR; PG8_SCHED;
            PG8_LDA(At, 1, 1); PG8_STAGE(PG8_SB(1, 0), b3, voffB); PG8_STAGE(PG8_SB(1, 1), b3 + hstepB, voffB); PG8_STGA(PG8_SA(1, 0), a3, a3, 0, voC);
            PG8_WAIT_V(8); PG8_WAIT_L(0); PG8_BAR; PG8_MMA(1, 0, At, B0); PG8_MMA(1, 1, At, B1); PG8_BAR; PG8_SCHED;
        }
        if (wr == 0) PG8_BAR;
        { int ln_ = lane; asm volatile("" : "+v"(ln_)); E(acc, cur, wr, wc, ln_ & 15, ln_ >> 4); }
        if (!has_next) break;
#pragma unroll
        for (int a = 0; a < 2; ++a)
#pragma unroll
            for (int b = 0; b < 2; ++b)
#pragma unroll
                for (int m = 0; m < 4; ++m)
#pragma unroll
                    for (int n = 0; n < 2; ++n) acc[a][b][m][n] = (f32x4){0.f, 0.f, 0.f, 0.f};
        cur = nxt; cB = nB; cA = nA; ++ui;
        if (wr == 1) PG8_BAR;
    }
    PG8_WAIT_V(0);
    PG8_BAR;
#undef PG8_SA
#undef PG8_SB
#undef PG8_STAGE
#undef PG8_LDA
#undef PG8_LDB
#undef PG8_MMA
#undef PG8_WAIT_V
#undef PG8_WAIT_L
#undef PG8_BAR
#undef PG8_SCHED
#undef PG8_AOFF
#undef PG8_STGA
}

struct GemmO { const bf16_t* A; const bf16_t* Bt; int M, N, K; };
template <class Epi, class Sched, bool ALIGN_EPI = false, bool SP2 = false>
__device__ __forceinline__ void gemm_phase_orig(LAS unsigned char* lds, const GemmO g, const Sched& S, const Epi& E) {
    const int tid = threadIdx.x, wid = __builtin_amdgcn_readfirstlane(tid >> 6), lane = tid & 63, wr = wid >> 2, wc = wid & 3, fr = lane & 15, fq = lane >> 4;
    const int K = g.K, nt = K / BK;
    unsigned voffA[2], voffB[2];
#pragma unroll
    for (int i = 0; i < 2; ++i) { int R, C; stage_rc(tid * 16 + i * 8192, R, C); const int Rb = Epi::PERM ? ((R & ~31) + perm32(R & 31)) : R;
        voffA[i] = (unsigned)(R * K + C) * 2u; voffB[i] = (unsigned)(Rb * K + C) * 2u; }
    const size_t kstep = (size_t)(BK * 2);
    const size_t hstep = (size_t)HALF * K * 2;
    const size_t tstep = 2 * hstep;
    const unsigned ldsw = (unsigned)wid * 1024u;
    const int aoff = lds_byte(wr * 64 + fr, fq * 8), boff = lds_byte(wc * 32 + fr, fq * 8);
#define PG8_SA(b, h) (((b) * 2 + (h)) * HTB)
#define PG8_SB(b, h) ((4 + (b) * 2 + (h)) * HTB)
#define PG8_STAGE(bufoff, gbase, voff) do { _Pragma("unroll") for (int _i = 0; _i < 2; ++_i) \
        __builtin_amdgcn_global_load_lds((const unsigned*)((const char*)(gbase) + (voff)[_i]), (LAS unsigned*)(lds + (bufoff) + ldsw + _i * 8192), 16, 0, 0); } while (0)
#define PG8_LDA(dst, b, h) do { _Pragma("unroll") for (int m = 0; m < 4; ++m) _Pragma("unroll") for (int k = 0; k < 2; ++k) dst[m][k] = *(const LAS bf16x8*)(lds + PG8_SA(b, h) + aoff + m * 2048 + k * 1024); } while (0)
#define PG8_LDB(dst, b, h) do { _Pragma("unroll") for (int n = 0; n < 2; ++n) _Pragma("unroll") for (int k = 0; k < 2; ++k) dst[n][k] = *(const LAS bf16x8*)(lds + PG8_SB(b, h) + boff + n * 2048 + k * 1024); } while (0)
#define PG8_MMA(ai, bj, At, Bt) do { __builtin_amdgcn_s_setprio(1); _Pragma("unroll") for (int m = 0; m < 4; ++m) _Pragma("unroll") for (int n = 0; n < 2; ++n) _Pragma("unroll") for (int k = 0; k < 2; ++k) \
        acc[ai][bj][m][n] = __builtin_amdgcn_mfma_f32_16x16x32_bf16(Bt[n][k], At[m][k], acc[ai][bj][m][n], 0, 0, 0); __builtin_amdgcn_s_setprio(0); } while (0)
#define PG8_WAIT_V(n) asm volatile("s_waitcnt vmcnt(" #n ")" ::: "memory")
#define PG8_WAIT_L(n) asm volatile("s_waitcnt lgkmcnt(" #n ")" ::: "memory")
#define PG8_BAR __builtin_amdgcn_s_barrier()
#define PG8_SCHED __builtin_amdgcn_sched_barrier(0)
    Unit cur, nxt; int ui = 0;
    if (!S.next(0, cur)) return;
    f32x4 acc[2][2][4][2];
#pragma unroll
    for (int a = 0; a < 2; ++a)
#pragma unroll
        for (int b = 0; b < 2; ++b)
#pragma unroll
            for (int m = 0; m < 4; ++m)
#pragma unroll
                for (int n = 0; n < 2; ++n) acc[a][b][m][n] = (f32x4){0.f, 0.f, 0.f, 0.f};
    bf16x8 At[4][2], B0[2][2], B1[2][2];
    const char* cA = (const char*)g.A + (size_t)cur.pm * tstep; const char* cB = (const char*)g.Bt + (size_t)cur.pn * tstep;

    if constexpr (SP2) {
        PG8_STAGE(PG8_SB(0, 0), cB, voffB); PG8_STAGE(PG8_SB(0, 1), cB + hstep, voffB); PG8_STAGE(PG8_SA(0, 0), cA, voffA); PG8_STAGE(PG8_SA(0, 1), cA + hstep, voffA);
        if (wr == 1) PG8_BAR;
        PG8_WAIT_V(2); PG8_BAR;
        PG8_STAGE(PG8_SB(1, 0), cB + kstep, voffB); PG8_STAGE(PG8_SA(1, 0), cA + kstep, voffA); PG8_STAGE(PG8_SB(1, 1), cB + hstep + kstep, voffB);
        PG8_WAIT_V(6); PG8_BAR;
    } else {
        PG8_STAGE(PG8_SB(0, 0), cB, voffB); PG8_STAGE(PG8_SA(0, 0), cA, voffA); PG8_STAGE(PG8_SB(0, 1), cB + hstep, voffB); PG8_STAGE(PG8_SA(0, 1), cA + hstep, voffA);
        if (wr == 1) PG8_BAR;
        PG8_WAIT_V(4); PG8_BAR;
        PG8_STAGE(PG8_SB(1, 0), cB + kstep, voffB); PG8_STAGE(PG8_SA(1, 0), cA + kstep, voffA); PG8_STAGE(PG8_SB(1, 1), cB + hstep + kstep, voffB);
        PG8_WAIT_V(6); PG8_BAR;
    }
    for (;;) {
        const bool has_next = S.next(ui + 1, nxt);
        const char* nA = has_next ? (const char*)g.A + (size_t)nxt.pm * tstep : cA; const char* nB = has_next ? (const char*)g.Bt + (size_t)nxt.pn * tstep : cB;
        for (int t = 0; t < nt; t += 2) {
            const bool last = (t == nt - 2);
            const char* a1 = cA + (size_t)(t + 1) * kstep;
            const char* a2 = last ? nA : cA + (size_t)(t + 2) * kstep; const char* b2 = last ? nB : cB + (size_t)(t + 2) * kstep;
            const char* a3 = a2 + kstep; const char* b3 = b2 + kstep;

            if constexpr (SP2) {
            PG8_LDB(B0, 0, 0); PG8_LDB(B1, 0, 1); PG8_SCHED; PG8_LDA(At, 0, 0); PG8_STAGE(PG8_SA(1, 1), a1 + hstep, voffA);
            PG8_WAIT_V(8); PG8_WAIT_L(0); PG8_BAR; PG8_MMA(0, 0, At, B0); PG8_MMA(0, 1, At, B1); PG8_BAR; PG8_SCHED;
            PG8_LDA(At, 0, 1); PG8_STAGE(PG8_SB(0, 0), b2, voffB); PG8_STAGE(PG8_SB(0, 1), b2 + hstep, voffB); PG8_STAGE(PG8_SA(0, 0), a2, voffA);
            PG8_WAIT_V(8); PG8_WAIT_L(0); PG8_BAR; PG8_MMA(1, 0, At, B0); PG8_MMA(1, 1, At, B1); PG8_BAR; PG8_SCHED;
            PG8_LDB(B0, 1, 0); PG8_LDB(B1, 1, 1); PG8_SCHED; PG8_LDA(At, 1, 0); PG8_STAGE(PG8_SA(0, 1), a2 + hstep, voffA);
            PG8_WAIT_V(8); PG8_WAIT_L(0); PG8_BAR; PG8_MMA(0, 0, At, B0); PG8_MMA(0, 1, At, B1); PG8_BAR; PG8_SCHED;
            PG8_LDA(At, 1, 1); PG8_STAGE(PG8_SB(1, 0), b3, voffB); PG8_STAGE(PG8_SB(1, 1), b3 + hstep, voffB); PG8_STAGE(PG8_SA(1, 0), a3, voffA);
            PG8_WAIT_V(8); PG8_WAIT_L(0); PG8_BAR; PG8_MMA(1, 0, At, B0); PG8_MMA(1, 1, At, B1); PG8_BAR; PG8_SCHED;
            } else {
            PG8_LDB(B0, 0, 0); PG8_SCHED; PG8_LDA(At, 0, 0); PG8_STAGE(PG8_SA(1, 1), a1 + hstep, voffA);
            PG8_WAIT_L(8); PG8_BAR; PG8_WAIT_L(0); PG8_MMA(0, 0, At, B0); PG8_BAR; PG8_SCHED;
            PG8_LDB(B1, 0, 1); PG8_STAGE(PG8_SB(0, 0), b2, voffB);
            PG8_BAR; PG8_WAIT_L(0); PG8_MMA(0, 1, At, B1); PG8_BAR;
            PG8_LDA(At, 0, 1); PG8_STAGE(PG8_SA(0, 0), a2, voffA);
            PG8_BAR; PG8_WAIT_L(0); PG8_MMA(1, 0, At, B0); PG8_BAR; PG8_SCHED;
            PG8_STAGE(PG8_SB(0, 1), b2 + hstep, voffB);
            PG8_WAIT_V(6); PG8_BAR; PG8_MMA(1, 1, At, B1); PG8_BAR;
            PG8_LDB(B0, 1, 0); PG8_SCHED; PG8_LDA(At, 1, 0); PG8_STAGE(PG8_SA(0, 1), a2 + hstep, voffA);
            PG8_WAIT_L(8); PG8_BAR; PG8_WAIT_L(0); PG8_MMA(0, 0, At, B0); PG8_BAR; PG8_SCHED;
            PG8_LDB(B1, 1, 1); PG8_STAGE(PG8_SB(1, 0), b3, voffB);
            PG8_BAR; PG8_WAIT_L(0); PG8_MMA(0, 1, At, B1); PG8_BAR;
            PG8_LDA(At, 1, 1); PG8_STAGE(PG8_SA(1, 0), a3, voffA);
            PG8_BAR; PG8_WAIT_L(0); PG8_MMA(1, 0, At, B0); PG8_BAR; PG8_SCHED;
            PG8_STAGE(PG8_SB(1, 1), b3 + hstep, voffB);
            PG8_WAIT_V(6); PG8_BAR; PG8_MMA(1, 1, At, B1); PG8_BAR;
            }
        }
        if constexpr (ALIGN_EPI) { if (wr == 0) PG8_BAR; }
        E(acc, cur, wr, wc, fr, fq);
        if (!has_next) break;
#pragma unroll
        for (int a = 0; a < 2; ++a)
#pragma unroll
            for (int b = 0; b < 2; ++b)
#pragma unroll
                for (int m = 0; m < 4; ++m)
#pragma unroll
                    for (int n = 0; n < 2; ++n) acc[a][b][m][n] = (f32x4){0.f, 0.f, 0.f, 0.f};
        cur = nxt; cA = nA; cB = nB; ++ui;
        if constexpr (ALIGN_EPI) { if (wr == 1) PG8_BAR; }
    }
    PG8_WAIT_V(0);
    if constexpr (!ALIGN_EPI) { if (wr == 0) PG8_BAR; }
    PG8_BAR;
#undef PG8_SA
#undef PG8_SB
#undef PG8_STAGE
#undef PG8_LDA
#undef PG8_LDB
#undef PG8_MMA
#undef PG8_WAIT_V
#undef PG8_WAIT_L
#undef PG8_BAR
#undef PG8_SCHED
}

typedef const f32x4 (&AccRef)[2][2][4][2];
__device__ __forceinline__ u32x4 pack8(f32x4 v0, f32x4 v1) { u32x4 w; w.x = cvt_pk_bf16(v0[0], v0[1]); w.y = cvt_pk_bf16(v0[2], v0[3]); w.z = cvt_pk_bf16(v1[0], v1[1]); w.w = cvt_pk_bf16(v1[2], v1[3]); return w; }

struct EpiProj { static constexpr bool PERM = true;
    bf16_t* proj; bf16_t* gates; const float* b_gate;
    __device__ __forceinline__ void operator()(AccRef acc, const Unit& u, int wr, int wc, int fr, int fq) const {
        const int row0 = u.pm * BM + wr * 64 + fr;
        if (u.pn < 9) {
            const int col0 = u.pn * BM + wc * 64 + 16 * fq;
#pragma unroll
            for (int ai = 0; ai < 2; ++ai)
#pragma unroll
                for (int m = 0; m < 4; ++m) { bf16_t* rowp = proj + (size_t)(row0 + ai * HALF + m * 16) * NPROJ + col0;
#pragma unroll
                    for (int bj = 0; bj < 2; ++bj) *(u32x4*)(rowp + bj * 8) = pack8(acc[ai][bj][m][0], acc[ai][bj][m][1]); }
        } else {
            const int col0 = (u.pn - 9) * BM + wc * 64 + 16 * fq;
            f32x4 bv[2][2];
#pragma unroll
            for (int bj = 0; bj < 2; ++bj)
#pragma unroll
                for (int n = 0; n < 2; ++n) bv[bj][n] = *(const f32x4*)(b_gate + col0 + bj * 8 + 4 * n);
#pragma unroll
            for (int ai = 0; ai < 2; ++ai)
#pragma unroll
                for (int m = 0; m < 4; ++m) { bf16_t* rowp = gates + (size_t)(row0 + ai * HALF + m * 16) * NGATE + col0;
#pragma unroll
                    for (int bj = 0; bj < 2; ++bj) { f32x4 v0 = acc[ai][bj][m][0] + bv[bj][0], v1 = acc[ai][bj][m][1] + bv[bj][1];
#pragma unroll
                        for (int j = 0; j < 4; ++j) { v0[j] = fast_sigmoid(v0[j]); v1[j] = fast_sigmoid(v1[j]); }
                        u32x4 w; w.x = cvt_pk_bf16_t(v0[0], v0[1]); w.y = cvt_pk_bf16_t(v0[2], v0[3]); w.z = cvt_pk_bf16_t(v1[0], v1[1]); w.w = cvt_pk_bf16_t(v1[2], v1[3]);
                        *(u32x4*)(rowp + bj * 8) = w; } }
        }
    }
};
template <bool BIAS> struct EpiBf16 { static constexpr bool PERM = true;
    bf16_t* O; int ldc; const float* bias; const int* tile_e; int bstride; float scl;
    __device__ __forceinline__ void operator()(AccRef acc, const Unit& u, int wr, int wc, int fr, int fq) const {
        const int row0 = u.pm * BM + wr * 64 + fr, col0 = u.pn * BM + wc * 64 + 16 * fq;
        f32x4 bv[2][2];
#pragma unroll
        for (int bj = 0; bj < 2; ++bj)
#pragma unroll
            for (int n = 0; n < 2; ++n) bv[bj][n] = (f32x4){0.f, 0.f, 0.f, 0.f};
        if constexpr (BIAS) { const float* bp = bias + (size_t)tile_e[u.pm] * bstride + col0;
#pragma unroll
            for (int bj = 0; bj < 2; ++bj)
#pragma unroll
                for (int n = 0; n < 2; ++n) bv[bj][n] = *(const f32x4*)(bp + bj * 8 + 4 * n); }
#pragma unroll
        for (int ai = 0; ai < 2; ++ai)
#pragma unroll
            for (int m = 0; m < 4; ++m) { bf16_t* rowp = O + (size_t)(row0 + ai * HALF + m * 16) * ldc + col0;
#pragma unroll
                for (int bj = 0; bj < 2; ++bj) *(u32x4*)(rowp + bj * 8) = pack8((acc[ai][bj][m][0] + bv[bj][0]) * scl, (acc[ai][bj][m][1] + bv[bj][1]) * scl); }
    }
};
struct EpiKV { static constexpr bool PERM = true;
    bf16_t* kmla; bf16_t* vmla;
    __device__ __forceinline__ void operator()(AccRef acc, const Unit& u, int wr, int wc, int fr, int fq) const {
        const int row0 = u.pm * BM + wr * 64 + fr, c0 = wc * 32 + 8 * fq;
#pragma unroll
        for (int ai = 0; ai < 2; ++ai)
#pragma unroll
            for (int m = 0; m < 4; ++m) { const size_t row = (size_t)(row0 + ai * HALF + m * 16);
                const size_t hrow = ((row >> 11) * 8 + u.pn) * 2048 + (row & 2047);
                *(u32x4*)(kmla + hrow * 192 + c0) = pack8(acc[ai][0][m][0], acc[ai][0][m][1]);
                *(u32x4*)(vmla + hrow * 128 + c0) = pack8(acc[ai][1][m][0], acc[ai][1][m][1]); }
    }
};
template <bool ADD> struct EpiGateMix { static constexpr bool PERM = true;
    bf16_t* O; const unsigned char* gates; int goff;
    __device__ __forceinline__ void operator()(AccRef acc, const Unit& u, int wr, int wc, int fr, int fq) const {
        const int row0 = u.pm * BM + wr * 64 + fr, col0 = u.pn * BM + wc * 32 + 8 * fq;
        constexpr float I255 = 1.0f / 255.0f;
#pragma unroll
        for (int ai = 0; ai < 2; ++ai) {
            u32x2 gw[4][2]; u32x4 pw[4][2];
#pragma unroll
            for (int m = 0; m < 4; ++m)
#pragma unroll
                for (int bj = 0; bj < 2; ++bj) { const size_t row = (size_t)(row0 + ai * HALF + m * 16);
                    gw[m][bj] = *(const u32x2*)(gates + row * NGATE + goff + col0 + bj * HALF);
                    if constexpr (ADD) pw[m][bj] = *(const u32x4*)(O + row * DM + col0 + bj * HALF); }
            asm volatile("s_waitcnt vmcnt(0)" ::: "memory");
#pragma unroll
            for (int m = 0; m < 4; ++m)
#pragma unroll
                for (int bj = 0; bj < 2; ++bj) { const size_t row = (size_t)(row0 + ai * HALF + m * 16); const u32x2 g2 = gw[m][bj];
                    f32x4 v0 = acc[ai][bj][m][0], v1 = acc[ai][bj][m][1];
                    v0[0] *= (float)(g2.x & 0xffu) * I255; v0[1] *= (float)((g2.x >> 8) & 0xffu) * I255; v0[2] *= (float)((g2.x >> 16) & 0xffu) * I255; v0[3] *= (float)(g2.x >> 24) * I255;
                    v1[0] *= (float)(g2.y & 0xffu) * I255; v1[1] *= (float)((g2.y >> 8) & 0xffu) * I255; v1[2] *= (float)((g2.y >> 16) & 0xffu) * I255; v1[3] *= (float)(g2.y >> 24) * I255;
                    if constexpr (ADD) { const u32x4 p4 = pw[m][bj];
                        v0[0] += bf_lo(p4.x); v0[1] += bf_hi(p4.x); v0[2] += bf_lo(p4.y); v0[3] += bf_hi(p4.y);
                        v1[0] += bf_lo(p4.z); v1[1] += bf_hi(p4.z); v1[2] += bf_lo(p4.w); v1[3] += bf_hi(p4.w); }
                    *(u32x4*)(O + row * DM + col0 + bj * HALF) = pack8(v0, v1); }
            asm volatile("" ::: "memory");
        }
    }
};
struct EpiGateMerge { static constexpr bool PERM = true;
    unsigned char* O; const unsigned char* gates;
    template <bool FINAL, class AccT> __device__ __forceinline__ void scale(AccT& acc, const Unit& u, int wr, int wc, int fr, int fq) const {
        const int row0 = u.pm * BM + wr * 64 + fr, col0 = u.pn * BM + wc * 64 + 16 * fq;
#pragma unroll
        for (int ai = 0; ai < 2; ++ai) {
            u32x2 ga[4][2], gb[4][2];
#pragma unroll
            for (int m = 0; m < 4; ++m)
#pragma unroll
                for (int bj = 0; bj < 2; ++bj) { const size_t row = (size_t)(row0 + ai * HALF + m * 16);
                    if constexpr (!FINAL) ga[m][bj] = *(const u32x2*)(gates + row * NGATE + col0 + bj * 8);
                    gb[m][bj] = *(const u32x2*)(gates + row * NGATE + DM + col0 + bj * 8); }
            asm volatile("s_waitcnt vmcnt(0)" ::: "memory");
#pragma unroll
            for (int m = 0; m < 4; ++m)
#pragma unroll
                for (int bj = 0; bj < 2; ++bj) { const size_t row = (size_t)(row0 + ai * HALF + m * 16);
                    float f[8];
#pragma unroll
                    for (int j = 0; j < 8; ++j) { const unsigned wb = j < 4 ? gb[m][bj].x : gb[m][bj].y; const float b = fmaxf((float)((wb >> (8 * (j & 3))) & 0xffu), 1.0f);
                        if constexpr (FINAL) f[j] = b * (1.0f / 255.0f);
                        else { const unsigned wa = j < 4 ? ga[m][bj].x : ga[m][bj].y; f[j] = (float)((wa >> (8 * (j & 3))) & 0xffu) * __builtin_amdgcn_rcpf(b); } }
                    f32x4 v0 = acc[ai][bj][m][0], v1 = acc[ai][bj][m][1];
                    v0[0] *= f[0]; v0[1] *= f[1]; v0[2] *= f[2]; v0[3] *= f[3]; v1[0] *= f[4]; v1[1] *= f[5]; v1[2] *= f[6]; v1[3] *= f[7];
                    if constexpr (FINAL) { int w0 = __builtin_amdgcn_cvt_pk_fp8_f32(v0[0] * 16.0f, v0[1] * 16.0f, 0, false); w0 = __builtin_amdgcn_cvt_pk_fp8_f32(v0[2] * 16.0f, v0[3] * 16.0f, w0, true);
                        int w1 = __builtin_amdgcn_cvt_pk_fp8_f32(v1[0] * 16.0f, v1[1] * 16.0f, 0, false); w1 = __builtin_amdgcn_cvt_pk_fp8_f32(v1[2] * 16.0f, v1[3] * 16.0f, w1, true);
                        *(u32x2*)(O + row * DM + col0 + bj * 8) = (u32x2){(unsigned)w0, (unsigned)w1}; }
                    else { acc[ai][bj][m][0] = v0; acc[ai][bj][m][1] = v1; } }
            asm volatile("" ::: "memory");
        }
    }
    __device__ __forceinline__ void mid(f32x4 (&acc)[2][2][4][2], const Unit& u, int wr, int wc, int fr, int fq) const { scale<false>(acc, u, wr, wc, fr, fq); }
    __device__ __forceinline__ void operator()(AccRef acc, const Unit& u, int wr, int wc, int fr, int fq) const { scale<true>(acc, u, wr, wc, fr, fq); }
};
struct EpiResF32 { static constexpr bool PERM = false;
    const float* x; float* out;
    __device__ __forceinline__ void operator()(AccRef acc, const Unit& u, int wr, int wc, int fr, int fq) const {
        const int row0 = u.pm * BM + wr * 64 + fr, col0 = u.pn * BM + wc * 32 + 4 * fq;
#pragma unroll
        for (int ai = 0; ai < 2; ++ai) {
            f32x4 xv[4][2][2];
#pragma unroll
            for (int m = 0; m < 4; ++m) { const size_t off = (size_t)(row0 + ai * HALF + m * 16) * DM + col0;
#pragma unroll
                for (int bj = 0; bj < 2; ++bj)
#pragma unroll
                    for (int n = 0; n < 2; ++n) xv[m][bj][n] = *(const f32x4*)(x + off + bj * HALF + n * 16); }
            asm volatile("s_waitcnt vmcnt(0)" ::: "memory");
#pragma unroll
            for (int m = 0; m < 4; ++m) { const size_t off = (size_t)(row0 + ai * HALF + m * 16) * DM + col0;
#pragma unroll
                for (int bj = 0; bj < 2; ++bj)
#pragma unroll
                    for (int n = 0; n < 2; ++n) *(f32x4*)(out + off + bj * HALF + n * 16) = xv[m][bj][n] + acc[ai][bj][m][n]; }
            asm volatile("" ::: "memory");
        }
    }
};
struct EpiResBf16 { static constexpr bool PERM = true;
    const float* x; bf16_t* out;
    __device__ __forceinline__ void operator()(AccRef acc, const Unit& u, int wr, int wc, int fr, int fq) const {
        const int row0 = u.pm * BM + wr * 64 + fr, col0 = u.pn * BM + wc * 64 + 16 * fq;
#pragma unroll
        for (int ai = 0; ai < 2; ++ai) {
            f32x4 xv[4][2][2];
#pragma unroll
            for (int m = 0; m < 4; ++m) { const size_t off = (size_t)(row0 + ai * HALF + m * 16) * DM + col0;
#pragma unroll
                for (int bj = 0; bj < 2; ++bj)
#pragma unroll
                    for (int n = 0; n < 2; ++n) xv[m][bj][n] = *(const f32x4*)(x + off + bj * 8 + n * 4); }
            asm volatile("s_waitcnt vmcnt(0)" ::: "memory");
#pragma unroll
            for (int m = 0; m < 4; ++m) { const size_t off = (size_t)(row0 + ai * HALF + m * 16) * DM + col0;
#pragma unroll
                for (int bj = 0; bj < 2; ++bj) *(u32x4*)(out + off + bj * 8) = pack8(xv[m][bj][0] + acc[ai][bj][m][0], xv[m][bj][1] + acc[ai][bj][m][1]); }
            asm volatile("" ::: "memory");
        }
    }
};
struct EpiSwiglu { static constexpr bool PERM = true;
    bf16_t* act; const float* bgu; const int* tile_e;
    __device__ __forceinline__ void operator()(AccRef acc, const Unit& u, int wr, int wc, int fr, int fq) const {
        const int row0 = u.pm * BM + wr * 64 + fr, p0 = u.pn * BM + wc * 32 + 8 * fq;
        const float* bp = bgu + (size_t)tile_e[u.pm] * (2 * DM) + p0;
        f32x4 bg[2], bu[2];
#pragma unroll
        for (int bj = 0; bj < 2; ++bj) { const f32x4 a = *(const f32x4*)(bp + bj * HALF), b = *(const f32x4*)(bp + bj * HALF + 4);
            bg[bj] = (f32x4){a[0], a[2], b[0], b[2]}; bu[bj] = (f32x4){a[1], a[3], b[1], b[3]}; }
#pragma unroll
        for (int ai = 0; ai < 2; ++ai)
#pragma unroll
            for (int m = 0; m < 4; ++m) { bf16_t* rowp = act + (size_t)(row0 + ai * HALF + m * 16) * DM + (p0 >> 1);
#pragma unroll
                for (int bj = 0; bj < 2; ++bj) { const f32x4 gt = acc[ai][bj][m][0] + bg[bj], up = acc[ai][bj][m][1] + bu[bj]; float o[4];
#pragma unroll
                    for (int j = 0; j < 4; ++j) { const float gg = fminf(gt[j], 7.0f), uu = fminf(fmaxf(up[j], -7.0f), 7.0f); o[j] = gg * fast_sigmoid(1.702f * gg) * (uu + 1.0f); }
                    u32x2 w; w.x = cvt_pk_bf16(o[0], o[1]); w.y = cvt_pk_bf16(o[2], o[3]);
                    *(u32x2*)(rowp + bj * (HALF / 2)) = w; } }
    }
};

typedef int v8i32 __attribute__((ext_vector_type(8)));
__host__ __device__ __forceinline__ int sw8(int row) { return ((row >> 1) & 7) ^ ((((row >> 2) ^ (row >> 3)) & 1) << 1); }
__host__ __device__ __forceinline__ int img8(int row, int c) { return row * 128 + ((c ^ sw8(row)) << 4); }
struct Gemm8 { const unsigned char* A; const unsigned char* Bt; int lda, K; const int* tile_e; size_t estride; const int* rowtok; };
typedef const f32x4 (&AccRef8)[2][2][4][2];
template <class Epi, bool MIDHOOK = false>
__device__ __forceinline__ void gemm_phase_f8(LAS unsigned char* lds, const Gemm8 g, const StaticOrder& S, const Epi& E) {
    int tid = threadIdx.x; asm volatile("" : "+v"(tid));
    const int wid = __builtin_amdgcn_readfirstlane(tid >> 6), lane = tid & 63, wr = wid >> 2, wc = wid & 3, r15 = lane & 15, kq = lane >> 4;
    int K = g.K; asm volatile("" : "+s"(K));
    const int nt = K / 128, lda = g.lda;
    unsigned voffB[2];
#pragma unroll
    for (int i = 0; i < 2; ++i) voffB[i] = (unsigned)(tid * 16 + i * 8192);
    const size_t kstep = 128;
    const size_t kstepB = 32768, hstepB = 16384, tstepB = (size_t)nt * 32768;
    const unsigned ldsw = (unsigned)wid * 1024u;
    const int sw = sw8(r15);
    int aadr[2], badr[2];
#pragma unroll
    for (int x = 0; x < 2; ++x) { const int c = 2 * kq + x; aadr[x] = (wr * 64 + r15) * 128 + ((c ^ sw) << 4); badr[x] = (wc * 32 + r15) * 128 + ((c ^ sw) << 4); }
#define PF8_SA(b, h) (((b) * 2 + (h)) * HTB)
#define PF8_SB(b, h) ((4 + (b) * 2 + (h)) * HTB)
#define PF8_STAGE(bufoff, gbase, voff) do { _Pragma("unroll") for (int _i = 0; _i < 2; ++_i) \
        __builtin_amdgcn_global_load_lds((const unsigned*)((const char*)(gbase) + (voff)[_i]), (LAS unsigned*)(lds + (bufoff) + ldsw + _i * 8192), 16, 0, 0); } while (0)
#define PF8_LD(dst, off) do { const u32x4 _a = *(const LAS u32x4*)(lds + (off)[0]), _b = *(const LAS u32x4*)(lds + (off)[1]); \
        dst = (v8i32){(int)_a.x, (int)_a.y, (int)_a.z, (int)_a.w, (int)_b.x, (int)_b.y, (int)_b.z, (int)_b.w}; } while (0)
#define PF8_LDA(dst, b, h) do { _Pragma("unroll") for (int tb = 0; tb < 4; ++tb) { const int _o[2] = {PF8_SA(b, h) + aadr[0] + tb * 2048, PF8_SA(b, h) + aadr[1] + tb * 2048}; PF8_LD(dst[tb], _o); } } while (0)
#define PF8_LDB(dst, b, h) do { _Pragma("unroll") for (int pb = 0; pb < 2; ++pb) { const int _o[2] = {PF8_SB(b, h) + badr[0] + pb * 2048, PF8_SB(b, h) + badr[1] + pb * 2048}; PF8_LD(dst[pb], _o); } } while (0)
#define PF8_MMA(ai, bj, At, Bt) do { __builtin_amdgcn_s_setprio(1); _Pragma("unroll") for (int tb = 0; tb < 4; ++tb) _Pragma("unroll") for (int pb = 0; pb < 2; ++pb) \
        acc[ai][bj][tb][pb] = __builtin_amdgcn_mfma_scale_f32_16x16x128_f8f6f4(Bt[pb], At[tb], acc[ai][bj][tb][pb], 0, 0, 0, 0, 0, 0); __builtin_amdgcn_s_setprio(0); } while (0)
#define PF8_WAIT_V(n) asm volatile("s_waitcnt vmcnt(" #n ")" ::: "memory")
#define PF8_WAIT_L(n) asm volatile("s_waitcnt lgkmcnt(" #n ")" ::: "memory")
#define PF8_BAR __builtin_amdgcn_s_barrier()
#define PF8_SCHED __builtin_amdgcn_sched_barrier(0)
#define PF8_AOFF(vo, u) do { int _t = tid; asm volatile("" : "+v"(_t)); \
        _Pragma("unroll") for (int _i = 0; _i < 2; ++_i) { const int _p = _t + 512 * _i, _R = _p >> 3, _C = ((_p & 7) ^ sw8(_R)) << 4; \
        _Pragma("unroll") for (int _h = 0; _h < 2; ++_h) { const int _r = (u).pm * BM + _h * HALF + _R; (vo)[_h][_i] = (unsigned)(g.rowtok[_r] * lda + _C); } } } while (0)
    Unit cur, nxt; int ui = 0;
    LAS int* const te_l = (LAS int*)(lds + STAGE_BYTES + 2048);
    if (g.tile_e) { for (int i = tid; i < S.nM; i += NTHREADS) te_l[i] = g.tile_e[i]; }
    __syncthreads();
    if (!S.next(0, cur)) return;
    f32x4 acc[2][2][4][2];
#pragma unroll
    for (int a = 0; a < 2; ++a)
#pragma unroll
        for (int b = 0; b < 2; ++b)
#pragma unroll
            for (int m = 0; m < 4; ++m)
#pragma unroll
                for (int r = 0; r < 2; ++r) acc[a][b][m][r] = (f32x4){0.f, 0.f, 0.f, 0.f};
    v8i32 At[4], B0[2], B1[2];
    unsigned voC[2][2];
    LAS u32x4* const gslot = (LAS u32x4*)(lds + STAGE_BYTES) + tid;
    PF8_AOFF(voC, cur);
    const char* const Abase = (const char*)g.A;
    const char* cB = (const char*)g.Bt + (g.tile_e ? (size_t)g.tile_e[cur.pm] * g.estride : (size_t)0) + (size_t)cur.pn * tstepB;
    PF8_STAGE(PF8_SB(0, 0), cB, voffB); PF8_STAGE(PF8_SB(0, 1), cB + hstepB, voffB); PF8_STAGE(PF8_SA(0, 0), Abase, voC[0]); PF8_STAGE(PF8_SA(0, 1), Abase, voC[1]);
    if (wr == 1) PF8_BAR;
    PF8_WAIT_V(2); PF8_BAR;
    PF8_STAGE(PF8_SB(1, 0), cB + kstepB, voffB); PF8_STAGE(PF8_SA(1, 0), Abase + kstep, voC[0]); PF8_STAGE(PF8_SB(1, 1), cB + hstepB + kstepB, voffB);
    PF8_WAIT_V(6); PF8_BAR;
    for (;;) {
        const bool has_next = S.next(ui + 1, nxt);
        const char* nB = cB;
        if (has_next) { const int npm = __builtin_amdgcn_readfirstlane(nxt.pm);
            nB = (const char*)g.Bt + (g.tile_e ? (size_t)te_l[npm] * g.estride : (size_t)0) + (size_t)nxt.pn * tstepB;
            if (wid == 0) glds16_asm((const char*)(g.rowtok + (size_t)npm * BM), (unsigned)(lane * 16), (unsigned)(size_t)(lds + STAGE_BYTES + ((ui + 1) & 1) * 1024)); }
#pragma unroll 1
        for (int t = 0; t < nt; t += 2) {
            const bool last = (t == nt - 2);
            if constexpr (MIDHOOK) { if (t == nt / 2) { int ln_ = lane; asm volatile("" : "+v"(ln_)); E.mid(acc, cur, wr, wc, ln_ & 15, ln_ >> 4); } }
            const char* a1 = Abase + (size_t)(t + 1) * kstep;
            const char* a2 = last ? Abase : Abase + (size_t)(t + 2) * kstep; const char* b2 = last ? nB : cB + (size_t)(t + 2) * kstepB;
            const char* a3 = a2 + kstep; const char* b3 = b2 + kstepB;
            PF8_LDB(B0, 0, 0); PF8_LDB(B1, 0, 1); PF8_SCHED; PF8_LDA(At, 0, 0); PF8_STAGE(PF8_SA(1, 1), a1, voC[1]);
            if (last && has_next) { const LAS int* rt = (const LAS int*)(lds + STAGE_BYTES + ((ui + 1) & 1) * 1024); PF8_AOFF_LDS(voC, rt); }
            PF8_WAIT_V(8); PF8_WAIT_L(0); PF8_BAR; PF8_MMA(0, 0, At, B0); PF8_MMA(0, 1, At, B1); PF8_BAR; PF8_SCHED;
            PF8_LDA(At, 0, 1); PF8_STAGE(PF8_SB(0, 0), b2, voffB); PF8_STAGE(PF8_SB(0, 1), b2 + hstepB, voffB); PF8_STAGE(PF8_SA(0, 0), a2, voC[0]);
            PF8_WAIT_V(8); PF8_WAIT_L(0); PF8_BAR; PF8_MMA(1, 0, At, B0); PF8_MMA(1, 1, At, B1); PF8_BAR; PF8_SCHED;
            PF8_LDB(B0, 1, 0); PF8_LDB(B1, 1, 1); PF8_SCHED; PF8_LDA(At, 1, 0); PF8_STAGE(PF8_SA(0, 1), a2, voC[1]);
            PF8_WAIT_V(8); PF8_WAIT_L(0); PF8_BAR; PF8_MMA(0, 0, At, B0); PF8_MMA(0, 1, At, B1); PF8_BAR; PF8_SCHED;
            PF8_LDA(At, 1, 1); PF8_STAGE(PF8_SB(1, 0), b3, voffB); PF8_STAGE(PF8_SB(1, 1), b3 + hstepB, voffB); PF8_STAGE(PF8_SA(1, 0), a3, voC[0]);
            PF8_WAIT_V(8); PF8_WAIT_L(0); PF8_BAR; PF8_MMA(1, 0, At, B0); PF8_MMA(1, 1, At, B1); PF8_BAR; PF8_SCHED;
        }
        if (wr == 0) PF8_BAR;
        { int ln_ = lane; asm volatile("" : "+v"(ln_)); E(acc, cur, wr, wc, ln_ & 15, ln_ >> 4); }
        if (!has_next) break;
#pragma unroll
        for (int a = 0; a < 2; ++a)
#pragma unroll
            for (int b = 0; b < 2; ++b)
#pragma unroll
                for (int m = 0; m < 4; ++m)
#pragma unroll
                    for (int r = 0; r < 2; ++r) acc[a][b][m][r] = (f32x4){0.f, 0.f, 0.f, 0.f};
        cur = nxt; cB = nB; ++ui;
        if (wr == 1) PF8_BAR;
    }
    PF8_WAIT_V(0);
    PF8_BAR;
#undef PF8_SA
#undef PF8_SB
#undef PF8_STAGE
#undef PF8_LD
#undef PF8_LDA
#undef PF8_LDB
#undef PF8_MMA
#undef PF8_WAIT_V
#undef PF8_WAIT_L
#undef PF8_BAR
#undef PF8_SCHED
#undef PF8_AOFF
}
struct EpiSwiglu8 {
    unsigned char* act; const float* bgu; const int* tile_e;
    __device__ __forceinline__ void operator()(AccRef8 acc, const Unit& u, int wr, int wc, int t15, int q) const {
        const int row0 = u.pm * BM + wr * 64 + t15;
        const float* bp = bgu + (size_t)tile_e[u.pm] * (2 * DM);
        const int ja = u.pn * 128 + 32 * wc + 8 * q;
        const f32x4 b0 = *(const f32x4*)(bp + 2 * ja), b1 = *(const f32x4*)(bp + 2 * ja + 4), b2 = *(const f32x4*)(bp + 2 * ja + 8), b3 = *(const f32x4*)(bp + 2 * ja + 12);
        const float bg[8] = {b0[0], b0[2], b1[0], b1[2], b2[0], b2[2], b3[0], b3[2]}, bu[8] = {b0[1], b0[3], b1[1], b1[3], b2[1], b2[3], b3[1], b3[3]};
#pragma unroll
        for (int ai = 0; ai < 2; ++ai)
#pragma unroll
            for (int tb = 0; tb < 4; ++tb) { float o[8];
#pragma unroll
                for (int bj = 0; bj < 2; ++bj)
#pragma unroll
                    for (int j = 0; j < 4; j += 2) {
                        typedef float f32x2_ __attribute__((ext_vector_type(2)));
                        const f32x2_ a0 = {acc[ai][bj][tb][0][j], acc[ai][bj][tb][0][j + 1]}, a1 = {acc[ai][bj][tb][1][j], acc[ai][bj][tb][1][j + 1]};
                        const f32x2_ bg2 = {bg[4 * bj + j], bg[4 * bj + j + 1]}, bu2 = {bu[4 * bj + j], bu[4 * bj + j + 1]};
                        f32x2_ gt = a0 * 0.015625f + bg2, up = a1 * 0.015625f + bu2;
                        gt[0] = fminf(gt[0], 7.0f); gt[1] = fminf(gt[1], 7.0f); up[0] = fminf(fmaxf(up[0], -7.0f), 7.0f); up[1] = fminf(fmaxf(up[1], -7.0f), 7.0f);
                        f32x2_ e = gt * (-1.702f * 1.4426950408889634f); e[0] = __builtin_amdgcn_exp2f(e[0]); e[1] = __builtin_amdgcn_exp2f(e[1]);
                        f32x2_ d = e + 1.0f; d[0] = __builtin_amdgcn_rcpf(d[0]); d[1] = __builtin_amdgcn_rcpf(d[1]);
                        const f32x2_ r = gt * d * (up + 1.0f); o[4 * bj + j] = r[0]; o[4 * bj + j + 1] = r[1]; }
                int w0 = __builtin_amdgcn_cvt_pk_fp8_f32(o[0], o[1], 0, false); w0 = __builtin_amdgcn_cvt_pk_fp8_f32(o[2], o[3], w0, true);
                int w1 = __builtin_amdgcn_cvt_pk_fp8_f32(o[4], o[5], 0, false); w1 = __builtin_amdgcn_cvt_pk_fp8_f32(o[6], o[7], w1, true);
                *(u32x2*)(act + (size_t)(row0 + ai * HALF + tb * 16) * DM + ja) = (u32x2){(unsigned)w0, (unsigned)w1}; }
    }
};
struct EpiDown8 {
    unsigned char* y; const float* bd; const int* tile_e;
    __device__ __forceinline__ void operator()(AccRef8 acc, const Unit& u, int wr, int wc, int t15, int q) const {
        const int row0 = u.pm * BM + wr * 64 + t15;
        const float* bp = bd + (size_t)tile_e[u.pm] * DM;
        const int c0 = u.pn * BM + 64 * wc + 16 * q;
        f32x4 bb[2][2];
#pragma unroll
        for (int bj = 0; bj < 2; ++bj)
#pragma unroll
            for (int pb = 0; pb < 2; ++pb) bb[bj][pb] = *(const f32x4*)(bp + c0 + 8 * bj + 4 * pb);
#pragma unroll
        for (int ai = 0; ai < 2; ++ai)
#pragma unroll
            for (int tb = 0; tb < 4; ++tb) { int w4[4];
#pragma unroll
                for (int bj = 0; bj < 2; ++bj)
#pragma unroll
                    for (int pb = 0; pb < 2; ++pb) { const f32x4 o = acc[ai][bj][tb][pb] * 0.015625f + bb[bj][pb];
                        const int x = __builtin_amdgcn_cvt_pk_fp8_f32(o[0], o[1], 0, false); w4[2 * bj + pb] = __builtin_amdgcn_cvt_pk_fp8_f32(o[2], o[3], x, true); }
                *(u32x4*)(y + (size_t)(row0 + ai * HALF + tb * 16) * DM + c0) = (u32x4){(unsigned)w4[0], (unsigned)w4[1], (unsigned)w4[2], (unsigned)w4[3]}; }
    }
};
struct EpiGateMerge8 {
    unsigned char* O; const unsigned char* gates;
    template <bool FINAL, class AccT> __device__ __forceinline__ void scale(AccT& acc, const Unit& u, int wr, int wc, int t15, int q) const {
        const int row0 = u.pm * BM + wr * 64 + t15, c0 = u.pn * BM + 64 * wc + 16 * q;
#pragma unroll
        for (int ai = 0; ai < 2; ++ai) {
            u32x4 ga[4], gb[4];
#pragma unroll
            for (int tb = 0; tb < 4; ++tb) { const size_t row = (size_t)(row0 + ai * HALF + tb * 16);
                if constexpr (!FINAL) ga[tb] = *(const u32x4*)(gates + row * NGATE + c0);
                gb[tb] = *(const u32x4*)(gates + row * NGATE + DM + c0); }
            asm volatile("s_waitcnt vmcnt(0)" ::: "memory");
#pragma unroll
            for (int tb = 0; tb < 4; ++tb) { const size_t row = (size_t)(row0 + ai * HALF + tb * 16); int w4[4];
#pragma unroll
                for (int bj = 0; bj < 2; ++bj)
#pragma unroll
                    for (int pb = 0; pb < 2; ++pb) { const unsigned wb = gb[tb][2 * bj + pb]; f32x4 v = acc[ai][bj][tb][pb];
#pragma unroll
                        for (int j = 0; j < 4; ++j) { const float b = fmaxf((float)((wb >> (8 * j)) & 0xffu), 1.0f);
                            if constexpr (FINAL) v[j] *= b * (1.0f / (255.0f * 64.0f));
                            else { const unsigned wa = ga[tb][2 * bj + pb]; v[j] *= (float)((wa >> (8 * j)) & 0xffu) * __builtin_amdgcn_rcpf(b); } }
                        if constexpr (FINAL) { const int x = __builtin_amdgcn_cvt_pk_fp8_f32(v[0], v[1], 0, false); w4[2 * bj + pb] = __builtin_amdgcn_cvt_pk_fp8_f32(v[2], v[3], x, true); }
                        else acc[ai][bj][tb][pb] = v; }
                if constexpr (FINAL) *(u32x4*)(O + row * DM + c0) = (u32x4){(unsigned)w4[0], (unsigned)w4[1], (unsigned)w4[2], (unsigned)w4[3]}; }
            asm volatile("" ::: "memory");
        }
    }
    __device__ __forceinline__ void mid(f32x4 (&acc)[2][2][4][2], const Unit& u, int wr, int wc, int t15, int q) const { scale<false>(acc, u, wr, wc, t15, q); }
    __device__ __forceinline__ void operator()(AccRef8 acc, const Unit& u, int wr, int wc, int t15, int q) const { scale<true>(acc, u, wr, wc, t15, q); }
};
struct EpiProj8 {
    bf16_t* proj; float* ssqp;
    __device__ __forceinline__ void operator()(AccRef8 acc, const Unit& u, int wr, int wc, int t15, int q) const {
        const int row0 = u.pm * BM + wr * 64 + t15, c0 = u.pn * BM + 64 * wc + 16 * q;
        const bool lat = (u.pn >= 5) && (u.pn <= 7);
#pragma unroll
        for (int ai = 0; ai < 2; ++ai)
#pragma unroll
            for (int tb = 0; tb < 4; ++tb) { const size_t row = (size_t)(row0 + ai * HALF + tb * 16); bf16_t* rowp = proj + row * NPROJ + c0;
#pragma unroll
                for (int bj = 0; bj < 2; ++bj) *(u32x4*)(rowp + 8 * bj) = pack8(acc[ai][bj][tb][0] * 0.015625f, acc[ai][bj][tb][1] * 0.015625f);
                if (lat) { f32x4 sq = {0.f, 0.f, 0.f, 0.f};
#pragma unroll
                    for (int bj = 0; bj < 2; ++bj)
#pragma unroll
                        for (int pb = 0; pb < 2; ++pb) { const f32x4 v = acc[ai][bj][tb][pb] * 0.015625f; sq += v * v; }
                    float ss = (sq[0] + sq[1]) + (sq[2] + sq[3]);
                    ss += __shfl_xor(ss, 16); ss += __shfl_xor(ss, 32);
                    if (q == 0) ssqp[row * 12 + 4 * (u.pn - 5) + wc] = ss; } }
    }
};
struct EpiRes8 {
    const float* x; bf16_t* out; float* ssqh;
    __device__ __forceinline__ void operator()(AccRef8 acc, const Unit& u, int wr, int wc, int t15, int q) const {
        const int row0 = u.pm * BM + wr * 64 + t15, c0 = u.pn * BM + 64 * wc + 16 * q;
#pragma unroll
        for (int ai = 0; ai < 2; ++ai) {
            f32x4 xv[4][2][2];
#pragma unroll
            for (int tb = 0; tb < 4; ++tb) { const size_t off = (size_t)(row0 + ai * HALF + tb * 16) * DM + c0;
#pragma unroll
                for (int bj = 0; bj < 2; ++bj)
#pragma unroll
                    for (int pb = 0; pb < 2; ++pb) xv[tb][bj][pb] = *(const f32x4*)(x + off + 8 * bj + 4 * pb); }
            asm volatile("s_waitcnt vmcnt(0)" ::: "memory");
#pragma unroll
            for (int tb = 0; tb < 4; ++tb) { const size_t row = (size_t)(row0 + ai * HALF + tb * 16), off = row * DM + c0; f32x4 sq = {0.f, 0.f, 0.f, 0.f};
#pragma unroll
                for (int bj = 0; bj < 2; ++bj) { const f32x4 h0 = xv[tb][bj][0] + acc[ai][bj][tb][0] * (1.0f / 1024.0f), h1 = xv[tb][bj][1] + acc[ai][bj][tb][1] * (1.0f / 1024.0f);
                    *(u32x4*)(out + off + 8 * bj) = pack8(h0, h1); sq += h0 * h0 + h1 * h1; }
                float ss = (sq[0] + sq[1]) + (sq[2] + sq[3]); ss += __shfl_xor(ss, 16); ss += __shfl_xor(ss, 32);
                if (q == 0) ssqh[row * 32 + 4 * u.pn + wc] = ss; }
            asm volatile("" ::: "memory");
        }
    }
};
struct EpiGates8 {
    unsigned char* gates; const float* b_gate;
    __device__ __forceinline__ void operator()(AccRef8 acc, const Unit& u, int wr, int wc, int t15, int q) const {
        const int row0 = u.pm * BM + wr * 64 + t15;
        const int c0 = u.pn * BM + 64 * wc + 16 * q;
        f32x4 bb[2][2];
#pragma unroll
        for (int bj = 0; bj < 2; ++bj)
#pragma unroll
            for (int pb = 0; pb < 2; ++pb) bb[bj][pb] = *(const f32x4*)(b_gate + c0 + 8 * bj + 4 * pb);
#pragma unroll
        for (int ai = 0; ai < 2; ++ai)
#pragma unroll
            for (int tb = 0; tb < 4; ++tb) { unsigned qq[4];
#pragma unroll
                for (int bj = 0; bj < 2; ++bj)
#pragma unroll
                    for (int pb = 0; pb < 2; ++pb) { float o[4];
#pragma unroll
                        for (int j = 0; j < 4; j += 2) {
                            typedef float f32x2_ __attribute__((ext_vector_type(2)));
                            const f32x2_ a = {acc[ai][bj][tb][pb][j], acc[ai][bj][tb][pb][j + 1]}, b2 = {bb[bj][pb][j], bb[bj][pb][j + 1]};
                            f32x2_ e = (a * 0.015625f + b2) * -1.4426950408889634f; e[0] = __builtin_amdgcn_exp2f(e[0]); e[1] = __builtin_amdgcn_exp2f(e[1]);
                            f32x2_ d = e + 1.0f; d[0] = __builtin_amdgcn_rcpf(d[0]); d[1] = __builtin_amdgcn_rcpf(d[1]);
                            const f32x2_ r = d * 255.0f + 0.5f; o[j] = r[0]; o[j + 1] = r[1]; }
                        qq[2 * bj + pb] = (unsigned)o[0] | ((unsigned)o[1] << 8) | ((unsigned)o[2] << 16) | ((unsigned)o[3] << 24); }
                *(u32x4*)(gates + (size_t)(row0 + ai * HALF + tb * 16) * NGATE + c0) = (u32x4){qq[0], qq[1], qq[2], qq[3]}; }
    }
};
}

struct Args { const void* in[21]; float* out; unsigned char* ws; int ph_lo, ph_hi; };

struct Frame {
    LAS unsigned char* lds; unsigned char* ws; unsigned* ctl;
    int tid, lane, wave, G, bx;
    const float *x, *g_attn, *w_in, *b_gate, *sinks, *g_q, *w_uq, *g_kv, *w_ukv, *w_o_swa, *w_o_mla, *w_out, *g_ffn, *w_router, *b_router, *w_gate_up, *b_gate_up, *w_down, *b_down, *g_final;
    const int* positions; float* out;
};

template <int MODE> __device__ __forceinline__ int rowmap(int n) {
    if (MODE == 1) return n < NLOW ? n : n + (NPROJ - NLOW);
    if (MODE == 2) { const int j = n >> 1, t = n & 1; return 8 * (j >> 2) + 4 * t + (j & 3); }
    return n;
}
__device__ __forceinline__ int perm32_inv(int x) { return 16 * ((x >> 2) & 1) + 4 * (x >> 3) + (x & 3); }
__host__ __device__ __forceinline__ int wide_map(int c) { return 128 * ((c >> 3) & 1) + 32 * (c >> 6) + 8 * ((c >> 4) & 3) + (c & 7); }
template <int MODE, bool PERM, bool WIDE = false> __device__ __forceinline__ void p0_convert_item(const float* W, int K, int N, bf16_t* WB, int item, int lane, int ldw = 0, int nkt_img = 0, int kt_off = 0, const float* kgain = nullptr) {
    if (ldw == 0) ldw = N;
    const int nblk = (N + 255) / 256, kb = item / nblk, nb = item % nblk, k0 = 32 * kb, n = 256 * nb + 4 * lane;
    if (n >= N) return;
    const f32x4* src = (const f32x4*)(W + (size_t)k0 * ldw + n);
    f32x4 v[32];
#pragma unroll
    for (int r = 0; r < 32; ++r) v[r] = src[(size_t)r * (ldw / 4)];
    if (kgain) {
#pragma unroll
        for (int r = 0; r < 32; ++r) v[r] = v[r] * kgain[k0 + r]; }
    const int nkt = nkt_img ? nkt_img : K / 64;
#pragma unroll
    for (int cmp = 0; cmp < 4; ++cmp) {
        const int p0_ = rowmap<MODE>(n + cmp), p = WIDE ? (p0_ & ~255) + wide_map(p0_ & 255) : p0_, q = p & 127, R = PERM ? ((q & ~31) + perm32_inv(q & 31)) : q;
        char* tile = (char*)WB + ((size_t)(p >> 8) * nkt + kt_off + (kb >> 1)) * 32768 + ((p >> 7) & 1) * 16384;
#pragma unroll
        for (int g8 = 0; g8 < 4; ++g8) { u32x4 o;
            o.x = cvt_pk_bf16(v[8 * g8 + 0][cmp], v[8 * g8 + 1][cmp]); o.y = cvt_pk_bf16(v[8 * g8 + 2][cmp], v[8 * g8 + 3][cmp]);
            o.z = cvt_pk_bf16(v[8 * g8 + 4][cmp], v[8 * g8 + 5][cmp]); o.w = cvt_pk_bf16(v[8 * g8 + 6][cmp], v[8 * g8 + 7][cmp]);
            *(u32x4*)(tile + pg8::lds_byte(R, 32 * (kb & 1) + 8 * g8)) = o; }
    }
}
template <bool GU> __device__ __forceinline__ void p0_convert_item_f8(const float* W, int K, int N, unsigned char* WB, int item, int lane, int ldw = 0, int nkt_img = 0, int kt_off = 0) {
    if (ldw == 0) ldw = N;
    const int nblk = (N + 255) / 256, kb = item / nblk, nb = item % nblk, k0 = 32 * kb, n = 256 * nb + 4 * lane;
    if (n >= N) return;
    const f32x4* src = (const f32x4*)(W + (size_t)k0 * ldw + n);
    f32x4 v[32];
#pragma unroll
    for (int r = 0; r < 32; ++r) v[r] = src[(size_t)r * (ldw / 4)];
    const int nkt = nkt_img ? nkt_img : K / 128, kt = kt_off + (k0 >> 7), c0 = (k0 & 127) >> 4;
#pragma unroll
    for (int cmp = 0; cmp < 4; ++cmp) {
        const int nl = n + cmp, j = (nl & 255) >> 1, t = nl & 1;
        const int P = (nl & ~255) + (GU ? 128 * ((j >> 2) & 1) + 32 * (j >> 5) + 16 * t + 4 * ((j >> 3) & 3) + (j & 3) : 128 * ((nl >> 3) & 1) + 32 * ((nl >> 6) & 3) + 16 * ((nl >> 2) & 1) + 4 * ((nl >> 4) & 3) + (nl & 3));
        const int q = P & 127, row = q;
        unsigned char* tile = WB + ((size_t)(P >> 8) * nkt + kt) * 32768 + ((P >> 7) & 1) * 16384;
#pragma unroll
        for (int g = 0; g < 2; ++g) { int w[4];
#pragma unroll
            for (int d = 0; d < 4; ++d) { int x = __builtin_amdgcn_cvt_pk_fp8_f32(v[16 * g + 4 * d + 0][cmp] * 64.0f, v[16 * g + 4 * d + 1][cmp] * 64.0f, 0, false);
                w[d] = __builtin_amdgcn_cvt_pk_fp8_f32(v[16 * g + 4 * d + 2][cmp] * 64.0f, v[16 * g + 4 * d + 3][cmp] * 64.0f, x, true); }
            *(u32x4*)(tile + pg8::img8(row, c0 + g)) = (u32x4){(unsigned)w[0], (unsigned)w[1], (unsigned)w[2], (unsigned)w[3]}; }
    }
}
__device__ __forceinline__ void p0_moe_convert_block(Frame& F) {
    constexpr int NI_GU = NEXP * 16 * 16, NI_D = NEXP * 16 * 8, NIT = NI_GU + NI_D;
    const int lane = F.lane, w = F.wave, tid = F.tid;
    unsigned char* WGU = (unsigned char*)(F.ws + WS_WGU); unsigned char* WD = (unsigned char*)(F.ws + WS_WD);
#define MC_SRC(it, srcp, ldw_, dstp, gu_, gk_) do { int r_ = (it); const float* W_; int N_; unsigned char* D_; \
        if (r_ < NI_GU) { const int e_ = r_ >> 8, rem_ = r_ & 255, kt_ = rem_ >> 4, pn_ = rem_ & 15; W_ = F.w_gate_up + (size_t)e_ * DM * 2 * DM + (size_t)(128 * kt_) * (2 * DM) + 256 * pn_; N_ = 2 * DM; \
            D_ = WGU + (size_t)e_ * 2 * DM * DM + ((size_t)pn_ * 16 + kt_) * 32768; gu_ = true; gk_ = F.g_ffn + 128 * kt_ + 16 * w; }     \
        else { r_ -= NI_GU; const int e_ = r_ >> 7, rem_ = r_ & 127, kt_ = rem_ >> 3, pn_ = rem_ & 7; W_ = F.w_down + (size_t)e_ * DM * DM + (size_t)(128 * kt_) * DM + 256 * pn_; N_ = DM; \
            D_ = WD + (size_t)e_ * DM * DM + ((size_t)pn_ * 16 + kt_) * 32768; gu_ = false; } \
        srcp = (const f32x4*)(W_ + (size_t)(16 * w) * N_ + 4 * lane); ldw_ = N_ / 4; dstp = D_; } while (0)
#define MC_LOAD(v, srcp, ldw_) do { _Pragma("unroll") for (int r = 0; r < 16; ++r) v[r] = srcp[(size_t)r * ldw_]; } while (0)
#define MC_STEP(v, buf, dstp, gu_, gk_) do { float gs_[16]; _Pragma("unroll") for (int r = 0; r < 16; ++r) gs_[r] = gu_ ? gk_[r] * 64.0f : 64.0f; \
        _Pragma("unroll") for (int cmp = 0; cmp < 4; ++cmp) { const int nl = 4 * lane + cmp, j = nl >> 1, t = nl & 1, P = gu_ ? 128 * ((j >> 2) & 1) + 32 * (j >> 5) + 16 * t + 4 * ((j >> 3) & 3) + (j & 3) : 128 * ((nl >> 3) & 1) + 32 * ((nl >> 6) & 3) + 16 * ((nl >> 2) & 1) + 4 * ((nl >> 4) & 3) + (nl & 3); \
            const int q = P & 127, row = q; int wq[4]; \
            _Pragma("unroll") for (int d = 0; d < 4; ++d) { const int x = __builtin_amdgcn_cvt_pk_fp8_f32(v[4 * d + 0][cmp] * gs_[4 * d + 0], v[4 * d + 1][cmp] * gs_[4 * d + 1], 0, false); \
                wq[d] = __builtin_amdgcn_cvt_pk_fp8_f32(v[4 * d + 2][cmp] * gs_[4 * d + 2], v[4 * d + 3][cmp] * gs_[4 * d + 3], x, true); } \
            *(LAS u32x4*)((buf) + ((P >> 7) & 1) * 16384 + pg8::img8(row, w)) = (u32x4){(unsigned)wq[0], (unsigned)wq[1], (unsigned)wq[2], (unsigned)wq[3]}; } \
        __syncthreads(); \
        _Pragma("unroll") for (int q4 = 0; q4 < 4; ++q4) *(u32x4*)((dstp) + tid * 16 + q4 * 8192) = *(const LAS u32x4*)((buf) + tid * 16 + q4 * 8192); } while (0)
    f32x4 va[16], vb[16];
    const f32x4* sa; const f32x4* sb; int la = 0, lb = 0; unsigned char* da = nullptr; unsigned char* db = nullptr; bool ga = false, gb = false; const float* gka = F.g_ffn; const float* gkb = F.g_ffn;
    int it = F.bx;
    if (it < NIT) { MC_SRC(it, sa, la, da, ga, gka); MC_LOAD(va, sa, la); }
    __syncthreads();
    for (; it < NIT; it += 2 * F.G) {
        const int it1 = it + F.G, it2 = it + 2 * F.G;
        if (it1 < NIT) { MC_SRC(it1, sb, lb, db, gb, gkb); MC_LOAD(vb, sb, lb); }
        MC_STEP(va, F.lds, da, ga, gka);
        if (it1 < NIT) {
            if (it2 < NIT) { MC_SRC(it2, sa, la, da, ga, gka); MC_LOAD(va, sa, la); }
            MC_STEP(vb, F.lds + 32768, db, gb, gkb);
        }
    }
    __syncthreads();
#undef MC_SRC
#undef MC_LOAD
#undef MC_STEP
}
__device__ __forceinline__ void p0_prologue(Frame& F) {
    const int gw = F.bx * NWAVES + F.wave, NGW = F.G * NWAVES;
    bf16_t* WIN = (bf16_t*)(F.ws + WS_WIN); bf16_t* WUQ = (bf16_t*)(F.ws + WS_WUQ); bf16_t* WUKV = (bf16_t*)(F.ws + WS_WUKV);
    bf16_t* WOA = (bf16_t*)(F.ws + WS_WOA); bf16_t* WOB = (bf16_t*)(F.ws + WS_WOB); bf16_t* WOUT = (bf16_t*)(F.ws + WS_WOUT);
    bf16_t* WGU = (bf16_t*)(F.ws + WS_WGU); bf16_t* WD = (bf16_t*)(F.ws + WS_WD);
    constexpr int I_IN = (DM / 32) * ((NLOW + 255) / 256), I_ING = (DM / 32) * (NGATE / 256), I_UQ = (512 / 32) * (1536 / 256), I_UKV = (256 / 32) * (2048 / 256), I_OA = (1024 / 32) * (DM / 256), I_OUT = (DM / 32) * (DM / 256);
    constexpr int I_GU1 = (DM / 32) * (2 * DM / 256), I_D1 = (DM / 32) * (DM / 256);
    (void)WGU; (void)WD; (void)I_GU1; (void)I_D1;
    constexpr int NITEMS = I_IN + I_ING + I_UQ + I_UKV + 2 * I_OA + I_OUT;
    for (int it = gw; it < NITEMS; it += NGW) {
        int r = it;
        if (r < I_IN) { p0_convert_item_f8<false>(F.w_in, DM, NLOW, (unsigned char*)WIN, r, F.lane, NIN_LOG); continue; } r -= I_IN;
        if (r < I_ING) { p0_convert_item_f8<false>(F.w_in + NLOW, DM, NGATE, (unsigned char*)WIN + WIN_GATES_OFF, r, F.lane, NIN_LOG); continue; } r -= I_ING;
        if (r < I_UQ) { p0_convert_item<0, true, true>(F.w_uq, 512, 1536, WUQ, r, F.lane, 0, 0, 0, F.g_q); continue; } r -= I_UQ;
        if (r < I_UKV) { p0_convert_item<0, true>(F.w_ukv, 256, 2048, WUKV, r, F.lane, 0, 0, 0, F.g_kv); continue; } r -= I_UKV;
        if (r < I_OA) { p0_convert_item_f8<false>(F.w_o_swa, 1024, DM, (unsigned char*)WOA, r, F.lane, 0, 16, 0); continue; } r -= I_OA;
        if (r < I_OA) { (void)WOB; p0_convert_item_f8<false>(F.w_o_mla, 1024, DM, (unsigned char*)WOA, r, F.lane, 0, 16, 8); continue; } r -= I_OA;
        { p0_convert_item_f8<false>(F.w_out, DM, DM, (unsigned char*)WOUT, r, F.lane); }
    }
    p0_moe_convert_block(F);
    { constexpr int NPAD = NPROJ - NLOW, nz = (DM / 128) * NPAD * 8;
      for (int i = F.bx * NTHREADS + F.tid; i < nz; i += F.G * NTHREADS) { const int c = i & 7, col = (i >> 3) % NPAD, kt = (i >> 3) / NPAD, p0_ = NLOW + col, nl = p0_ & 255;
          const int P = (p0_ & ~255) + 128 * ((nl >> 3) & 1) + 32 * ((nl >> 6) & 3) + 16 * ((nl >> 2) & 1) + 4 * ((nl >> 4) & 3) + (nl & 3), q = P & 127;
          *(u32x4*)((unsigned char*)WIN + ((size_t)(P >> 8) * (DM / 128) + kt) * 32768 + ((P >> 7) & 1) * 16384 + pg8::img8(q, c)) = (u32x4){0u, 0u, 0u, 0u}; } }
    { int* idr = (int*)(F.ws + WS_IDROW); for (int i = F.bx * NTHREADS + F.tid; i < PROWS; i += F.G * NTHREADS) idr[i] = i; }
    { bf16_t* wrh = (bf16_t*)(F.ws + WS_WRT); bf16_t* wrl = wrh + NEXP * DM;
      for (int i = F.bx * NTHREADS + F.tid; i < DM * NEXP; i += F.G * NTHREADS) { const int d = i >> 5, e = i & 31; const float wv = F.w_router[i] * F.g_ffn[d];
          const unsigned hb = cvt_pk_bf16(wv, 0.f) & 0xffffu; const unsigned lb = cvt_pk_bf16(wv - bf_lo(hb), 0.f) & 0xffffu; wrh[e * DM + d] = (bf16_t)hb; wrl[e * DM + d] = (bf16_t)lb; } }
    float* CS = (float*)(F.ws + WS_CS);
#ifndef P0B_REP
#define P0B_REP 1
#endif
    for (int rep_ = 0; rep_ < P0B_REP; ++rep_)
    for (int m = gw; m < NTOK; m += NGW) {
        const f32x4* xr = (const f32x4*)(F.x + (size_t)m * DM) + F.lane; const f32x4* gr = (const f32x4*)F.g_attn + F.lane;
        f32x4 v[8]; float s = 0.f;
#pragma unroll
        for (int j = 0; j < 8; ++j) { v[j] = xr[64 * j]; s += (v[j].x * v[j].x + v[j].y * v[j].y) + (v[j].z * v[j].z + v[j].w * v[j].w); }
        const float rstd = 1.0f / sqrtf(wave_sum(s) * (1.0f / DM) + EPS);
#pragma unroll
        for (int j = 0; j < 8; ++j) { const f32x4 gg = gr[64 * j]; const float y0 = v[j].x * rstd * gg.x, y1 = v[j].y * rstd * gg.y, y2 = v[j].z * rstd * gg.z, y3 = v[j].w * rstd * gg.w;
            int w8 = __builtin_amdgcn_cvt_pk_fp8_f32(y0, y1, 0, false); w8 = __builtin_amdgcn_cvt_pk_fp8_f32(y2, y3, w8, true); ((unsigned*)(F.ws + WS_XN8 + (size_t)m * DM))[F.lane + 64 * j] = (unsigned)w8; }
        { const int i = F.lane & 31; const float inv_freq = powf(10000.0f, -(float)i * 2.0f / 64.0f); const float ang = (float)F.positions[m] * inv_freq;
          CS[(size_t)m * 64 + F.lane] = (F.lane < 32) ? cosf(ang) : sinf(ang); }
    }
}

__device__ __forceinline__ void rope4(u32x2& a, u32x2& b, f32x4 c, f32x4 s) {
    const float x1[4] = {bf_lo(a.x), bf_hi(a.x), bf_lo(a.y), bf_hi(a.y)}, x2[4] = {bf_lo(b.x), bf_hi(b.x), bf_lo(b.y), bf_hi(b.y)};
    float o1[4], o2[4];
#pragma unroll
    for (int j = 0; j < 4; ++j) { o1[j] = x1[j] * c[j] - x2[j] * s[j]; o2[j] = x2[j] * c[j] + x1[j] * s[j]; }
    a.x = cvt_pk_bf16(o1[0], o1[1]); a.y = cvt_pk_bf16(o1[2], o1[3]); b.x = cvt_pk_bf16(o2[0], o2[1]); b.y = cvt_pk_bf16(o2[2], o2[3]);
}
namespace pg8 {
__device__ __forceinline__ float row_rstd_q(const float* ssqp, size_t row) { const f32x4 a = *(const f32x4*)(ssqp + row * 12), b = *(const f32x4*)(ssqp + row * 12 + 4);
    return 1.0f / sqrtf((((a[0] + a[1]) + (a[2] + a[3])) + ((b[0] + b[1]) + (b[2] + b[3]))) * (1.0f / 512.0f) + EPS); }
__device__ __forceinline__ float row_rstd_kv(const float* ssqp, size_t row) { const f32x4 a = *(const f32x4*)(ssqp + row * 12 + 8);
    return 1.0f / sqrtf(((a[0] + a[1]) + (a[2] + a[3])) * (1.0f / 256.0f) + EPS); }
struct EpiQn { static constexpr bool PERM = true;
    bf16_t* O; const float* ssqp; float scl;
    __device__ __forceinline__ void operator()(AccRef acc, const Unit& u, int wr, int wc, int fr, int fq) const {
        const int row0 = u.pm * BM + wr * 64 + fr, col0 = u.pn * BM + wc * 64 + 16 * fq;
#pragma unroll
        for (int ai = 0; ai < 2; ++ai)
#pragma unroll
            for (int m = 0; m < 4; ++m) { const size_t row = (size_t)(row0 + ai * HALF + m * 16); const float sc = row_rstd_q(ssqp, row) * scl; bf16_t* rowp = O + row * 1536 + col0;
#pragma unroll
                for (int bj = 0; bj < 2; ++bj) *(u32x4*)(rowp + bj * 8) = pack8(acc[ai][bj][m][0] * sc, acc[ai][bj][m][1] * sc); }
    }
};
struct EpiKVn { static constexpr bool PERM = true;
    bf16_t* kmla; bf16_t* vmla; const float* ssqp; const bf16_t* proj; const float* cs;
    __device__ __forceinline__ void operator()(AccRef acc, const Unit& u, int wr, int wc, int fr, int fq) const {
        const int row0 = u.pm * BM + wr * 64 + fr, c0 = wc * 32 + 8 * fq;
#pragma unroll
        for (int ai = 0; ai < 2; ++ai)
#pragma unroll
            for (int m = 0; m < 4; ++m) { const size_t row = (size_t)(row0 + ai * HALF + m * 16); const float sc = row_rstd_kv(ssqp, row);
                const size_t hrow = ((row >> 11) * 8 + u.pn) * 2048 + (row & 2047);
                *(u32x4*)(kmla + hrow * 192 + c0) = pack8(acc[ai][0][m][0] * sc, acc[ai][0][m][1] * sc);
                *(u32x4*)(vmla + hrow * 128 + c0) = pack8(acc[ai][1][m][0] * sc, acc[ai][1][m][1] * sc); }
        const int tid_ = (wr * 4 + wc) * 64 + fq * 16 + fr;
#pragma unroll
        for (int it = 0; it < 4; ++it) { const int idx = tid_ + 512 * it, i0 = 4 * (idx & 7); const size_t row = (size_t)(u.pm * BM + (idx >> 3));
            const bf16_t* pr = proj + row * NPROJ + PC_KR;
            u32x2 a = *(const u32x2*)(pr + i0), b = *(const u32x2*)(pr + 32 + i0);
            const f32x4 c = *(const f32x4*)(cs + row * 64 + i0), sn = *(const f32x4*)(cs + row * 64 + 32 + i0);
            rope4(a, b, c, sn);
            bf16_t* kp = kmla + (((row >> 11) * 8 + u.pn) * 2048 + (row & 2047)) * 192 + 128 + i0;
            *(u32x2*)kp = a; *(u32x2*)(kp + 32) = b; }
    }
};
}
__device__ __forceinline__ void p2_postproj(Frame& F) {
    const int gw = F.bx * NWAVES + F.wave, NGW = F.G * NWAVES, lane = F.lane;
    bf16_t* PROJ = (bf16_t*)(F.ws + WS_PROJ); const float* CS = (const float*)(F.ws + WS_CS);
    bf16_t* CQ = (bf16_t*)(F.ws + WS_CQ); bf16_t* CKV = (bf16_t*)(F.ws + WS_CKV); bf16_t* KMLA = (bf16_t*)(F.ws + WS_KMLA);
    constexpr int R2 = 4;
    const int hd = lane >> 3, i0 = 4 * (lane & 7); const int base = (hd < 2) ? PC_KA + hd * 64 : PC_KR;
    const f32x4 gq0 = *(const f32x4*)(F.g_q + 8 * lane), gq1 = *(const f32x4*)(F.g_q + 8 * lane + 4), gk0 = *(const f32x4*)(F.g_kv + 4 * lane);
    for (int m0 = gw; m0 < NTOK; m0 += R2 * NGW) {
        f32x4 rc[R2], rs[R2]; u32x2 ra[R2], rb[R2], wkv[R2]; u32x4 wq[R2];
#pragma unroll
        for (int j = 0; j < R2; ++j) { const int m = m0 + j * NGW; if (m < NTOK) { bf16_t* pr = PROJ + (size_t)m * NPROJ;
            if (lane < 24) { rc[j] = *(const f32x4*)(CS + (size_t)m * 64 + i0); rs[j] = *(const f32x4*)(CS + (size_t)m * 64 + 32 + i0);
                ra[j] = *(u32x2*)(pr + base + i0); rb[j] = *(u32x2*)(pr + base + 32 + i0); }
            wq[j] = *(const u32x4*)(pr + PC_DQ + 8 * lane); wkv[j] = *(const u32x2*)(pr + PC_DKV + 4 * lane); } }
#pragma unroll
        for (int j = 0; j < R2; ++j) { const int m = m0 + j * NGW; if (m < NTOK) { bf16_t* pr = PROJ + (size_t)m * NPROJ;
            if (lane < 24) { u32x2 a = ra[j], b = rb[j];
                rope4(a, b, rc[j], rs[j]);
                if (hd < 2) { *(u32x2*)(pr + base + i0) = a; *(u32x2*)(pr + base + 32 + i0) = b; }
                else { bf16_t* kp = KMLA + ((size_t)(m >> 11) * (8 * 2048) + (m & 2047)) * 192 + 128 + i0;
#pragma unroll
                    for (int hh = 0; hh < 8; ++hh) { *(u32x2*)(kp + (size_t)hh * (2048 * 192)) = a; *(u32x2*)(kp + (size_t)hh * (2048 * 192) + 32) = b; } } }
            { const u32x4 w = wq[j];
              float v[8] = {bf_lo(w.x), bf_hi(w.x), bf_lo(w.y), bf_hi(w.y), bf_lo(w.z), bf_hi(w.z), bf_lo(w.w), bf_hi(w.w)}; float sq = 0.f;
#pragma unroll
              for (int t = 0; t < 8; ++t) sq += v[t] * v[t];
              const float rstd = 1.0f / sqrtf(wave_sum(sq) * (1.0f / 512.0f) + EPS);
              u32x4 o; o.x = cvt_pk_bf16(v[0] * rstd * gq0[0], v[1] * rstd * gq0[1]); o.y = cvt_pk_bf16(v[2] * rstd * gq0[2], v[3] * rstd * gq0[3]);
              o.z = cvt_pk_bf16(v[4] * rstd * gq1[0], v[5] * rstd * gq1[1]); o.w = cvt_pk_bf16(v[6] * rstd * gq1[2], v[7] * rstd * gq1[3]);
              *(u32x4*)(CQ + (size_t)m * 512 + 8 * lane) = o; }
            { const u32x2 w = wkv[j];
              float v[4] = {bf_lo(w.x), bf_hi(w.x), bf_lo(w.y), bf_hi(w.y)}; float sq = (v[0] * v[0] + v[1] * v[1]) + (v[2] * v[2] + v[3] * v[3]);
              const float rstd = 1.0f / sqrtf(wave_sum(sq) * (1.0f / 256.0f) + EPS);
              u32x2 o; o.x = cvt_pk_bf16(v[0] * rstd * gk0[0], v[1] * rstd * gk0[1]); o.y = cvt_pk_bf16(v[2] * rstd * gk0[2], v[3] * rstd * gk0[3]);
              *(u32x2*)(CKV + (size_t)m * 256 + 4 * lane) = o; } } }
    }
}

__device__ __forceinline__ int crow(int r, int hi) { return (r & 3) + 8 * (r >> 2) + 4 * hi; }
__device__ __forceinline__ bf16x8 tr2(const LAS unsigned char* p0, const LAS unsigned char* p1) {
    const v4i16_t a = __builtin_amdgcn_ds_read_tr16_b64_v4i16((LAS v4i16_t*)p0), b = __builtin_amdgcn_ds_read_tr16_b64_v4i16((LAS v4i16_t*)p1);
    bf16x8 r; r[0] = a[0]; r[1] = a[1]; r[2] = a[2]; r[3] = a[3]; r[4] = b[0]; r[5] = b[1]; r[6] = b[2]; r[7] = b[3]; return r;
}
__device__ __forceinline__ void rope_frag(bf16x8& f1, bf16x8& f2, const float* cs, int i0, float scl = 1.0f) {
    const f32x4 c0 = *(const f32x4*)(cs + i0) * scl, c1 = *(const f32x4*)(cs + i0 + 4) * scl, s0 = *(const f32x4*)(cs + 32 + i0) * scl, s1 = *(const f32x4*)(cs + 32 + i0 + 4) * scl;
    u32x4 a = __builtin_bit_cast(u32x4, f1), b = __builtin_bit_cast(u32x4, f2);
    u32x2 a0 = {a.x, a.y}, b0 = {b.x, b.y}, a1 = {a.z, a.w}, b1 = {b.z, b.w};
    rope4(a0, b0, c0, s0); rope4(a1, b1, c1, s1);
    f1 = __builtin_bit_cast(bf16x8, (u32x4){a0.x, a0.y, a1.x, a1.y}); f2 = __builtin_bit_cast(bf16x8, (u32x4){b0.x, b0.y, b1.x, b1.y});
}
__device__ __forceinline__ bf16x8 pack_p(const f32x16& p, int s2) {
    u32x4 w;
    asm volatile("s_nop 0\n\tv_cvt_pk_bf16_f32 %0, %4, %5\n\tv_cvt_pk_bf16_f32 %1, %6, %7\n\tv_cvt_pk_bf16_f32 %2, %8, %9\n\tv_cvt_pk_bf16_f32 %3, %10, %11"
                 : "=&v"(w.x), "=&v"(w.y), "=&v"(w.z), "=&v"(w.w)
                 : "v"(p[8 * s2 + 0]), "v"(p[8 * s2 + 1]), "v"(p[8 * s2 + 2]), "v"(p[8 * s2 + 3]), "v"(p[8 * s2 + 4]), "v"(p[8 * s2 + 5]), "v"(p[8 * s2 + 6]), "v"(p[8 * s2 + 7]));
    return __builtin_bit_cast(bf16x8, w);
}

constexpr int SWA_KRS = 144;
constexpr int SWA_LDS_K = 0, SWA_LDS_V = 256 * SWA_KRS;
__device__ __forceinline__ void swa_phase(Frame& F) {
    const bf16_t* PROJ = (const bf16_t*)(F.ws + WS_PROJ); const float* CS = (const float*)(F.ws + WS_CS); bf16_t* OUTA = (bf16_t*)(F.ws + WS_OUTA);
    LAS unsigned char* Kl = F.lds + SWA_LDS_K; LAS unsigned char* Vl = F.lds + SWA_LDS_V;
    int lane = F.lane; asm volatile("" : "+v"(lane));
    const int w = F.wave, l31 = lane & 31, h = lane >> 5;
    const int vq = (lane & 15) >> 2, vp = lane & 3, vg = (lane >> 4) & 1;
    const int vlane = (4 * h + vq) * 64 + (16 * vg + 4 * vp) * 2;
    for (int u = F.bx; u < BATCH * 16 * 2; u += F.G) {
        const int kvh = u & 1, nb = (u >> 1) & 15, b = u >> 5;
        const int tok0 = b * SEQ + nb * 128;
        __syncthreads();
#pragma unroll
        for (int j = 0; j < 4; ++j) { const int id = F.tid + 512 * j, row = id >> 3, ch = id & 7;
            u32x4 kv = (u32x4){0u, 0u, 0u, 0u}, vv = (u32x4){0u, 0u, 0u, 0u};
            if (nb > 0 || row >= 128) { const size_t tok = (size_t)(tok0 - 128 + row); const bf16_t* src = PROJ + tok * NPROJ + kvh * 64 + ch * 8;
                vv = *(const u32x4*)(src + PC_VA);
                const u32x4 ko = *(const u32x4*)(src + PC_KA), kp = *(const u32x4*)(src + PC_KA + ((ch & 4) ? -32 : 32));
                const float* cs = CS + tok * 64 + 8 * (ch & 3);
                const f32x4 c0 = *(const f32x4*)cs, c1 = *(const f32x4*)(cs + 4), s0 = *(const f32x4*)(cs + 32), s1 = *(const f32x4*)(cs + 36);
                const float sg = (ch & 4) ? 1.0f : -1.0f;
                const unsigned kow[4] = {ko.x, ko.y, ko.z, ko.w}, kpw[4] = {kp.x, kp.y, kp.z, kp.w}; unsigned ow[4];
#pragma unroll
                for (int e = 0; e < 4; ++e) { const float cl = e < 2 ? c0[2 * e] : c1[2 * e - 4], ch_ = e < 2 ? c0[2 * e + 1] : c1[2 * e - 3], sl = e < 2 ? s0[2 * e] : s1[2 * e - 4], sh = e < 2 ? s0[2 * e + 1] : s1[2 * e - 3];
                    ow[e] = cvt_pk_bf16(bf_lo(kow[e]) * cl + sg * bf_lo(kpw[e]) * sl, bf_hi(kow[e]) * ch_ + sg * bf_hi(kpw[e]) * sh); }
                kv = (u32x4){ow[0], ow[1], ow[2], ow[3]}; }
            *(LAS u32x4*)(Kl + row * SWA_KRS + ch * 16) = kv;
            *(LAS u32x4*)(Vl + ((row >> 3) * 2 + (ch >> 2)) * 512 + (row & 7) * 64 + (ch & 3) * 16) = vv; }
        __syncthreads();
        const int hq = kvh * 8 + w; const float sink = F.sinks[hq];
        for (int i = 0; i < 4; ++i) {
            const size_t row0 = (size_t)tok0 + 32 * i;
            bf16x8 Qf[4];
            { const char* qp = (const char*)PROJ + (row0 * NPROJ + hq * 64) * 2; const unsigned qo = (unsigned)(l31 * (NPROJ * 2) + 16 * h);
#pragma unroll
              for (int ks = 0; ks < 4; ++ks) Qf[ks] = *(const bf16x8*)(qp + qo + 32 * ks);
              const float* cs = (const float*)((const char*)CS + row0 * 256 + (unsigned)(l31 * 256));
              rope_frag(Qf[0], Qf[2], cs, 8 * h, 0.125f * 1.4426950408889634f); rope_frag(Qf[1], Qf[3], cs, 16 + 8 * h, 0.125f * 1.4426950408889634f); }
            f32x16 O[2];
#pragma unroll
            for (int db = 0; db < 2; ++db)
#pragma unroll
                for (int r = 0; r < 16; ++r) O[db][r] = 0.f;
            const float sinkl = sink * 1.4426950408889634f;
            float mrun = sinkl, lrun = 0.f;
            const int tcmp = l31 - 4 * h;
#pragma unroll 1
            for (int kb = 0; kb < 5; ++kb) {
                if (nb == 0 && i + kb < 4) continue;
                const int kk0 = 32 * (i + kb);
                f32x16 Sx;
#pragma unroll
                for (int r = 0; r < 16; ++r) Sx[r] = 0.f;
                const LAS unsigned char* kp = Kl + kk0 * SWA_KRS + l31 * SWA_KRS + 16 * h;
#pragma unroll
                for (int ks = 0; ks < 4; ++ks) Sx = __builtin_amdgcn_mfma_f32_32x32x16_bf16(*(const LAS bf16x8*)(kp + 32 * ks), Qf[ks], Sx, 0, 0, 0);
                const LAS unsigned char* vb = Vl + (kk0 >> 3) * 1024 + vlane;
                bf16x8 vf[4];
#pragma unroll
                for (int db = 0; db < 2; ++db) { vf[2 * db] = tr2(vb + db * 512, vb + db * 512 + 1024); vf[2 * db + 1] = tr2(vb + db * 512 + 2048, vb + db * 512 + 3072); }
                __builtin_amdgcn_sched_barrier(0);
                if (kb == 0) {
#pragma unroll
                    for (int r = 0; r < 16; ++r) if (!((r & 3) + 8 * (r >> 2) > tcmp)) Sx[r] = -1e30f;
                } else if (kb == 4) {
#pragma unroll
                    for (int r = 0; r < 16; ++r) if ((r & 3) + 8 * (r >> 2) > tcmp) Sx[r] = -1e30f;
                }
                float mx = Sx[0];
#pragma unroll
                for (int r = 1; r < 16; ++r) mx = fmaxf(mx, Sx[r]);
                mx = fmaxf(mx, __shfl_xor(mx, 32));
                if (__builtin_amdgcn_ballot_w64(mx > mrun + 8.f) != 0) {
                    const float mn = fmaxf(mrun, mx);
                    const float alpha = __builtin_amdgcn_exp2f(mrun - mn);
                    mrun = mn; lrun *= alpha;
#pragma unroll
                    for (int db = 0; db < 2; ++db)
#pragma unroll
                        for (int r = 0; r < 16; ++r) O[db][r] *= alpha;
                }
                float ps = 0.f;
#pragma unroll
                for (int r = 0; r < 16; ++r) { const float p = __builtin_amdgcn_exp2f(Sx[r] - mrun); Sx[r] = p; ps += p; }
                lrun += ps;
                const bf16x8 P0 = pack_p(Sx, 0), P1 = pack_p(Sx, 1);
                __builtin_amdgcn_sched_barrier(0);
#pragma unroll
                for (int db = 0; db < 2; ++db) {
                    O[db] = __builtin_amdgcn_mfma_f32_32x32x16_bf16(vf[2 * db], P0, O[db], 0, 0, 0);
                    O[db] = __builtin_amdgcn_mfma_f32_32x32x16_bf16(vf[2 * db + 1], P1, O[db], 0, 0, 0);
                }
            }
            const float ltot = lrun + __shfl_xor(lrun, 32) + __builtin_amdgcn_exp2f(sinkl - mrun);
            const float inv = 1.0f / ltot;
            char* op = (char*)OUTA + (row0 * 2048 + hq * 64); const unsigned oo = (unsigned)(l31 * 2048 + 4 * h);
            const float inv16 = inv * 16.0f;
#pragma unroll
            for (int db = 0; db < 2; ++db)
#pragma unroll
                for (int g4 = 0; g4 < 4; ++g4) { int wv = __builtin_amdgcn_cvt_pk_fp8_f32(O[db][4 * g4] * inv16, O[db][4 * g4 + 1] * inv16, 0, false); wv = __builtin_amdgcn_cvt_pk_fp8_f32(O[db][4 * g4 + 2] * inv16, O[db][4 * g4 + 3] * inv16, wv, true);
                    *(unsigned*)(op + oo + 32 * db + 8 * g4) = (unsigned)wv; }
        }
    }
    __syncthreads();
}

constexpr int MLA_KRS = 400, MLA_KB = 64 * MLA_KRS, MLA_VB = 64 * 256, MLA_BUF = MLA_KB + MLA_VB;
typedef float f32x2m __attribute__((ext_vector_type(2)));
__device__ __forceinline__ void mla_phase(Frame& F) {
    const char* QBc = (const char*)(F.ws + WS_QB); const char* KMLA = (const char*)(F.ws + WS_KMLA); const char* VMLA = (const char*)(F.ws + WS_VMLA);
    const char* CSc = (const char*)(F.ws + WS_CS); char* OUTBc = (char*)(F.ws + WS_OUTA) + 1024;
    int lane = F.lane; asm volatile("" : "+v"(lane));
    const int w = F.wave, l31 = lane & 31, h = lane >> 5;
    const int vq = (lane & 15) >> 2, vp = lane & 3, vg = (lane >> 4) & 1;
    const int vlane = (4 * h + vq) * 64 + (16 * vg + 4 * vp) * 2;
    const int klane = l31 * MLA_KRS + 16 * h;
    constexpr float C2 = 0.07216878364870322f * 1.4426950408889634f;
    for (int it0 = F.bx; it0 < BATCH * 8 * 4; it0 += F.G) {
        const int it = (F.G == 256) ? ((it0 & 7) * 64 + ((it0 >> 3) & 31) + 32 * (it0 >> 8)) : it0;
        const int pr = it & 3, hh = (it >> 2) & 7, b = it >> 5;
        for (int half = 0; half < 2; ++half) {
            const int qb = half ? pr : (7 - pr);
            const int nkt = 4 * (qb + 1);
            const size_t row0 = (size_t)b * SEQ + 256 * qb + 32 * w;
            const int qpos = 256 * qb + 32 * w + l31;
            f32x16 O[4];
#pragma unroll
            for (int db = 0; db < 4; ++db)
#pragma unroll
                for (int r = 0; r < 16; ++r) O[db][r] = 0.f;
            float mrun = -1e30f, lrun = 0.f;
            const size_t hrow0 = ((size_t)b * 8 + hh) * SEQ;
#define MLA_DMAK(kt, bufp) do { const char* kb_ = KMLA + (hrow0 + 64 * (kt)) * 384; \
              _Pragma("unroll") for (int j = 0; j < 4; ++j) { const int q = w + 8 * j; \
                if (q < 25) { const int s_ = 64 * q + lane, row = s_ / 25, ch = s_ - 25 * row; const unsigned off = (unsigned)(row * 384 + ch * 16); \
                    glds16_asm(kb_, off, (unsigned)(size_t)((bufp) + q * 1024)); } } } while (0)
#define MLA_DMAV(kt, bufp) do { const char* vb_ = VMLA + (hrow0 + 64 * (kt)) * 256; \
              _Pragma("unroll") for (int j = 0; j < 2; ++j) { const int q = w + 8 * j; \
                const int s_ = 64 * q + lane, sub = s_ >> 5, row = (sub >> 2) * 8 + ((s_ >> 2) & 7), ch = (sub & 3) * 4 + (s_ & 3); const unsigned off = (unsigned)(row * 256 + ch * 16); \
                glds16_asm(vb_, off, (unsigned)(size_t)((bufp) + q * 1024)); } } while (0)
#define MLA_SB() __builtin_amdgcn_sched_barrier(0)
#define MLA_LDK(p) (*(const LAS bf16x8*)(p))
#define MLA_E(SP, r) do { const float p_ = __builtin_amdgcn_exp2f(SP[r] - mrun); SP[r] = p_; ps += p_; } while (0)
#define MLA_E2(SP, r) do { f32x2m t_ = (f32x2m){SP[r], SP[(r) + 1]} - mrun; t_[0] = __builtin_amdgcn_exp2f(t_[0]); t_[1] = __builtin_amdgcn_exp2f(t_[1]); SP[r] = t_[0]; SP[(r) + 1] = t_[1]; ps2 += t_; } while (0)
#define MLA_QKM(SN, f, ks) SN = __builtin_amdgcn_mfma_f32_32x32x16_bf16(f, Qf[ks], SN, 0, 0, 0)
#define MLA_PEND_PLAIN(SP, vbp) do { float ps = 0.f; \
                _Pragma("unroll") for (int r = 0; r < 16; ++r) MLA_E(SP, r); \
                lrun += ps; \
                const bf16x8 P0 = pack_p(SP, 0), P1 = pack_p(SP, 1); \
                const LAS unsigned char* vb = (vbp); \
                _Pragma("unroll") for (int db = 0; db < 4; ++db) { \
                    O[db] = __builtin_amdgcn_mfma_f32_32x32x16_bf16(tr2(vb + db * 512, vb + db * 512 + 4 * 512), P0, O[db], 0, 0, 0); \
                    O[db] = __builtin_amdgcn_mfma_f32_32x32x16_bf16(tr2(vb + db * 512 + 8 * 512, vb + db * 512 + 12 * 512), P1, O[db], 0, 0, 0); } } while (0)
#define MLA_STAGE(SN, SP, kpp, vbp, NIDX) do { const int n_ = (NIDX); \
                if (n_ <= nlast + 1) {                                    \
                    const LAS unsigned char* kp = (kpp); const LAS unsigned char* vb = (vbp); \
                    bf16x8 kfA[4], kfB[4], vf[8], P0, P1; f32x2m ps2 = {0.f, 0.f}; \
                    _Pragma("unroll") for (int j = 0; j < 4; ++j) kfA[j] = MLA_LDK(kp + 32 * j); \
                    _Pragma("unroll") for (int j = 0; j < 4; ++j) kfB[j] = MLA_LDK(kp + 32 * (4 + j)); \
                    _Pragma("unroll") for (int r = 0; r < 16; ++r) SN[r] = 0.f; \
                    MLA_SB(); \
                    MLA_E2(SP, 0); MLA_SB(); \
                    MLA_QKM(SN, kfA[0], 0); MLA_E2(SP, 2); MLA_SB(); \
                    MLA_QKM(SN, kfA[1], 1); MLA_SB(); \
                    MLA_QKM(SN, kfA[2], 2); MLA_E2(SP, 4); MLA_SB(); \
                    MLA_QKM(SN, kfA[3], 3); MLA_SB(); \
                    _Pragma("unroll") for (int j = 0; j < 4; ++j) kfA[j] = MLA_LDK(kp + 32 * (8 + j)); \
                    MLA_SB(); \
                    MLA_QKM(SN, kfB[0], 4); MLA_E2(SP, 6); MLA_SB(); \
                    MLA_QKM(SN, kfB[1], 5); P0 = pack_p(SP, 0); MLA_SB(); \
                    MLA_QKM(SN, kfB[2], 6); MLA_E2(SP, 8); MLA_SB(); \
                    MLA_QKM(SN, kfB[3], 7); MLA_E2(SP, 10); MLA_SB(); \
                    _Pragma("unroll") for (int db = 0; db < 2; ++db) { vf[2 * db] = tr2(vb + db * 512, vb + db * 512 + 4 * 512); vf[2 * db + 1] = tr2(vb + db * 512 + 8 * 512, vb + db * 512 + 12 * 512); } \
                    MLA_SB(); \
                    MLA_QKM(SN, kfA[0], 8); MLA_E2(SP, 12); MLA_SB(); \
                    MLA_QKM(SN, kfA[1], 9); MLA_SB(); \
                    MLA_QKM(SN, kfA[2], 10); MLA_E2(SP, 14); MLA_SB(); \
                    MLA_QKM(SN, kfA[3], 11); lrun += ps2[0] + ps2[1]; P1 = pack_p(SP, 1); MLA_SB(); \
                    _Pragma("unroll") for (int db = 2; db < 4; ++db) { vf[2 * db] = tr2(vb + db * 512, vb + db * 512 + 4 * 512); vf[2 * db + 1] = tr2(vb + db * 512 + 8 * 512, vb + db * 512 + 12 * 512); } \
                    MLA_SB(); \
                    if (n_ >= nlast) {                                    \
                        _Pragma("unroll") for (int r = 0; r < 16; ++r) { const int key = 32 * n_ + crow(r, h); if (key > qpos) SN[r] = -1e30f; } \
                    } \
                    float mx; \
                    O[0] = __builtin_amdgcn_mfma_f32_32x32x16_bf16(vf[0], P0, O[0], 0, 0, 0); MLA_SB(); \
                    O[0] = __builtin_amdgcn_mfma_f32_32x32x16_bf16(vf[1], P1, O[0], 0, 0, 0); MLA_SB(); \
                    O[1] = __builtin_amdgcn_mfma_f32_32x32x16_bf16(vf[2], P0, O[1], 0, 0, 0); mx = fmaxf(fmaxf(SN[0], SN[1]), SN[2]); MLA_SB(); \
                    O[1] = __builtin_amdgcn_mfma_f32_32x32x16_bf16(vf[3], P1, O[1], 0, 0, 0); mx = fmaxf(fmaxf(mx, SN[3]), SN[4]); mx = fmaxf(fmaxf(mx, SN[5]), SN[6]); MLA_SB(); \
                    O[2] = __builtin_amdgcn_mfma_f32_32x32x16_bf16(vf[4], P0, O[2], 0, 0, 0); mx = fmaxf(fmaxf(mx, SN[7]), SN[8]); mx = fmaxf(fmaxf(mx, SN[9]), SN[10]); MLA_SB(); \
                    O[2] = __builtin_amdgcn_mfma_f32_32x32x16_bf16(vf[5], P1, O[2], 0, 0, 0); mx = fmaxf(fmaxf(mx, SN[11]), SN[12]); mx = fmaxf(fmaxf(mx, SN[13]), SN[14]); MLA_SB(); \
                    O[3] = __builtin_amdgcn_mfma_f32_32x32x16_bf16(vf[6], P0, O[3], 0, 0, 0); mx = fmaxf(mx, SN[15]); MLA_SB(); \
                    O[3] = __builtin_amdgcn_mfma_f32_32x32x16_bf16(vf[7], P1, O[3], 0, 0, 0); MLA_SB(); \
                    mx = fmaxf(mx, __shfl_xor(mx, 32)); \
                      \
                    if (__builtin_amdgcn_ballot_w64(mx > mrun + 8.f) != 0) { \
                        const float mn = fmaxf(mrun, mx); \
                        const float alpha = __builtin_amdgcn_exp2f(mrun - mn); \
                        mrun = mn; lrun *= alpha; \
                        _Pragma("unroll") for (int db = 0; db < 4; ++db) _Pragma("unroll") for (int r = 0; r < 16; ++r) O[db][r] *= alpha; \
                    } \
                } } while (0)
#define MLA_KB_(i) (F.lds + (i) * MLA_KB)
#define MLA_VB_(i) (F.lds + 3 * MLA_KB + (i) * MLA_VB)
#define MLA_TILE(KT, BI) do { const int kt_ = (KT); \
                  \
                if (kt_ + 1 < nkt) asm volatile("s_waitcnt vmcnt(3) lgkmcnt(0)" ::: "memory"); else asm volatile("s_waitcnt vmcnt(0) lgkmcnt(0)" ::: "memory"); \
                __builtin_amdgcn_s_barrier(); asm volatile("" ::: "memory");     \
                  \
                  \
                if (w < 4) { if (kt_ + 1 < nkt) MLA_DMAV(kt_ + 1, MLA_VB_(((BI) + 1) % 3)); if (kt_ + 2 < nkt) MLA_DMAK(kt_ + 2, MLA_KB_(((BI) + 2) % 3)); } \
                  \
                const LAS unsigned char* vprev = (kt_ == 0) ? (MLA_VB_(BI) + vlane) : (MLA_VB_(((BI) + 2) % 3) + 16 * 512 + vlane); \
                MLA_STAGE(Sa, Sb, MLA_KB_(BI) + klane, vprev, 2 * kt_); \
                if (w >= 4) { if (kt_ + 1 < nkt) MLA_DMAV(kt_ + 1, MLA_VB_(((BI) + 1) % 3)); if (kt_ + 2 < nkt) MLA_DMAK(kt_ + 2, MLA_KB_(((BI) + 2) % 3)); } \
                MLA_STAGE(Sb, Sa, MLA_KB_(BI) + 32 * MLA_KRS + klane, MLA_VB_(BI) + vlane, 2 * kt_ + 1); \
                } while (0)
            const int nlast = 8 * qb + w;
            f32x16 Sa, Sb;
#pragma unroll
            for (int r = 0; r < 16; ++r) { Sa[r] = 0.f; Sb[r] = -__builtin_inff(); }
            __syncthreads();
            MLA_DMAK(0, MLA_KB_(0)); MLA_DMAV(0, MLA_VB_(0));
            if (nkt > 1) MLA_DMAK(1, MLA_KB_(1));
            bf16x8 Qf[12];
            { const char* qp = QBc + (row0 * 1536 + hh * 192) * 2; const unsigned qo = (unsigned)(l31 * 3072 + 16 * h);
#pragma unroll
              for (int ks = 0; ks < 12; ++ks) Qf[ks] = *(const bf16x8*)(qp + qo + 32 * ks);
              const float* cs = (const float*)(CSc + row0 * 256 + (unsigned)(l31 * 256));
              rope_frag(Qf[8], Qf[10], cs, 8 * h); rope_frag(Qf[9], Qf[11], cs, 16 + 8 * h); }
#pragma unroll 1
            for (int kt = 0; kt < nkt; kt += 3) {
                MLA_TILE(kt, 0);
                if (kt + 1 < nkt) MLA_TILE(kt + 1, 1);
                if (kt + 2 < nkt) MLA_TILE(kt + 2, 2);
            }
            if (w == 7) { MLA_PEND_PLAIN(Sb, MLA_VB_((nkt - 1) % 3) + 16 * 512 + vlane); }
#undef MLA_TILE
#undef MLA_STAGE
#undef MLA_PEND_PLAIN
#undef MLA_DMAK
#undef MLA_DMAV
            const float ltot = lrun + __shfl_xor(lrun, 32);
            const float inv = 1.0f / ltot;
            char* op = OUTBc + (row0 * 2048 + hh * 128); const unsigned oo = (unsigned)(l31 * 2048 + 4 * h);
            const float inv16 = inv * 16.0f;
#pragma unroll
            for (int db = 0; db < 4; ++db)
#pragma unroll
                for (int g4 = 0; g4 < 4; ++g4) { int wv = __builtin_amdgcn_cvt_pk_fp8_f32(O[db][4 * g4] * inv16, O[db][4 * g4 + 1] * inv16, 0, false); wv = __builtin_amdgcn_cvt_pk_fp8_f32(O[db][4 * g4 + 2] * inv16, O[db][4 * g4 + 3] * inv16, wv, true);
                    *(unsigned*)(op + oo + 32 * db + 8 * g4) = (unsigned)wv; }
        }
    }
    __syncthreads();
}

__device__ __forceinline__ void p7_router(Frame& F) {
    const char* Hc = (const char*)(F.ws + WS_H);
    const bf16_t* WRH = (const bf16_t*)(F.ws + WS_WRT); const bf16_t* WRL = WRH + NEXP * DM;
    int* TOPE = (int*)(F.ws + WS_TOPE); float* TOPW = (float*)(F.ws + WS_TOPW); int* CNT = (int*)(F.ws + WS_CNT);
    const float* SSQH = (const float*)(F.ws + WS_CKV); unsigned char* HN8 = (unsigned char*)(F.ws + WS_XN);
    constexpr int A_BYTES = 32 * 4096, LG_OFF = A_BYTES, HIST_OFF = LG_OFF + 32 * 33 * 4, RS_OFF = HIST_OFF + 128;
    LAS float* red = (LAS float*)F.lds; LAS float* lg = (LAS float*)(F.lds + LG_OFF); LAS int* hist = (LAS int*)(F.lds + HIST_OFF); LAS float* rsl = (LAS float*)(F.lds + RS_OFF);
    int lane = F.lane; asm volatile("" : "+v"(lane));
    const int w = F.wave, l31 = lane & 31, h = lane >> 5;
    bf16x8 bh[16];
#pragma unroll
    for (int ks = 0; ks < 16; ++ks) { const size_t bo = (size_t)l31 * DM + 256 * w + 16 * ks + 8 * h; bh[ks] = *(const bf16x8*)(WRH + bo); }
    for (int c = F.bx; c < NTOK / 128; c += F.G) {
        __syncthreads();
        if (F.tid < NEXP) hist[F.tid] = 0;
        for (int tt = 0; tt < 4; ++tt) {
            const int r0 = 128 * c + 32 * tt;
            __syncthreads();
            { const char* hb = Hc + (size_t)r0 * 4096;
#pragma unroll
              for (int j = 0; j < 16; ++j) { const int p = w + 8 * j, s_ = 64 * p + lane, row = s_ >> 8, pos = s_ & 255;
                  glds16_asm(hb, (unsigned)(row * 4096 + ((pos ^ (row & 15)) << 4)), (unsigned)(size_t)(F.lds + p * 1024)); } }
            if (F.tid < 32) { const float* sp = SSQH + (size_t)(r0 + F.tid) * 32; float ssum = 0.f;
#pragma unroll
                for (int q4 = 0; q4 < 8; ++q4) { const f32x4 v = *(const f32x4*)(sp + 4 * q4); ssum += (v[0] + v[1]) + (v[2] + v[3]); }
                const float rs = 1.0f / sqrtf(ssum * (1.0f / DM) + EPS); rsl[F.tid] = rs; }
            asm volatile("s_waitcnt vmcnt(0)" ::: "memory");
            __syncthreads();
            f32x16 acc;
#pragma unroll
            for (int r = 0; r < 16; ++r) acc[r] = 0.f;
#pragma unroll
            for (int ks = 0; ks < 16; ++ks) { const int ch = 32 * w + 2 * ks + h;
                const bf16x8 ah = *(const LAS bf16x8*)(F.lds + l31 * 4096 + ((ch ^ (l31 & 15)) << 4));
                const bf16x8 blk = *(const bf16x8*)(WRL + (size_t)l31 * DM + 256 * w + 16 * ks + 8 * h);
                acc = __builtin_amdgcn_mfma_f32_32x32x16_bf16(ah, bh[ks], acc, 0, 0, 0);
                acc = __builtin_amdgcn_mfma_f32_32x32x16_bf16(ah, blk, acc, 0, 0, 0); }
#pragma unroll 4
            for (int j = 0; j < 16; ++j) { const int s_ = F.tid + 512 * j, row = s_ >> 8, g = (s_ & 255) ^ (row & 15); const float rs = rsl[row];
                const u32x4 hw = *(const LAS u32x4*)(F.lds + s_ * 16);
                int y0 = __builtin_amdgcn_cvt_pk_fp8_f32(bf_lo(hw.x) * rs, bf_hi(hw.x) * rs, 0, false); y0 = __builtin_amdgcn_cvt_pk_fp8_f32(bf_lo(hw.y) * rs, bf_hi(hw.y) * rs, y0, true);
                int y1 = __builtin_amdgcn_cvt_pk_fp8_f32(bf_lo(hw.z) * rs, bf_hi(hw.z) * rs, 0, false); y1 = __builtin_amdgcn_cvt_pk_fp8_f32(bf_lo(hw.w) * rs, bf_hi(hw.w) * rs, y1, true);
                *(u32x2*)(HN8 + (size_t)(r0 + row) * DM + g * 8) = (u32x2){(unsigned)y0, (unsigned)y1}; }
            __syncthreads();
#pragma unroll
            for (int r = 0; r < 16; ++r) red[(w * 32 + crow(r, h)) * 32 + l31] = acc[r];
            __syncthreads();
#pragma unroll
            for (int q = 0; q < 2; ++q) { const int idx = F.tid + 512 * q, row = idx >> 5, e = idx & 31; float sum = 0.f;
#pragma unroll
                for (int ww = 0; ww < 8; ++ww) sum += red[(ww * 32 + row) * 32 + e];
                lg[row * 33 + e] = sum * rsl[row] + F.b_router[e]; }
            __syncthreads();
#pragma unroll
            for (int rr = 0; rr < 4; ++rr) {
                float lv = (lane < 32) ? lg[(4 * w + rr) * 33 + l31] : -1e30f; float tv[4]; int te[4];
#pragma unroll
                for (int k = 0; k < 4; ++k) {
                    float bv = lv; int bi = lane;
#pragma unroll
                    for (int o = 1; o < 64; o <<= 1) { const float ov = __shfl_xor(bv, o); const int oi = __shfl_xor(bi, o); if (ov > bv || (ov == bv && oi < bi)) { bv = ov; bi = oi; } }
                    tv[k] = bv; te[k] = bi; if (lane == bi) lv = -3e38f;
                }
                const float e1 = __expf(tv[1] - tv[0]), e2 = __expf(tv[2] - tv[0]), e3 = __expf(tv[3] - tv[0]); const float inv = 1.0f / (1.0f + e1 + e2 + e3);
                if (lane == 0) { const int row = r0 + 4 * w + rr;
                    *(int4*)(TOPE + (size_t)row * 4) = make_int4(te[0], te[1], te[2], te[3]);
                    *(float4*)(TOPW + (size_t)row * 4) = make_float4(inv, e1 * inv, e2 * inv, e3 * inv);
                    atomicAdd((int*)hist + te[0], 1); atomicAdd((int*)hist + te[1], 1); atomicAdd((int*)hist + te[2], 1); atomicAdd((int*)hist + te[3], 1); }
            }
        }
        __syncthreads();
        if (F.tid < NEXP) CNT[c * NEXP + F.tid] = hist[F.tid];
    }
    __syncthreads();
}

__device__ __forceinline__ void p8_slots(Frame& F) {
    const int* CNT = (const int*)(F.ws + WS_CNT); const int* TOPE = (const int*)(F.ws + WS_TOPE);
    int* SLOT = (int*)(F.ws + WS_SLOT); int* ROWTOK = (int*)(F.ws + WS_ROWTOK); int* TILEE = (int*)(F.ws + WS_TILEE);
    LAS int* red_all = (LAS int*)F.lds;
    LAS int* red_pre = red_all + 512;
    LAS int* tot = red_pre + 512;
    LAS int* pre = tot + 32;
    LAS int* pstart = pre + 32;
    LAS int* le = pstart + 64;
    LAS int* ls = le + 512;
    constexpr int NCH = NTOK / 128;
    for (int c = F.bx; c < NCH; c += F.G) {
        __syncthreads();
        { const int e = F.tid & 31, part = F.tid >> 5; int sa = 0, sp = 0;
          for (int cc = part; cc < NCH; cc += 16) { const int v = CNT[cc * NEXP + e]; sa += v; if (cc < c) sp += v; }
          red_all[part * 32 + e] = sa; red_pre[part * 32 + e] = sp; }
        le[F.tid] = TOPE[(size_t)c * 512 + F.tid];
        __syncthreads();
        if (F.tid < 32) { int sa = 0, sp = 0;
#pragma unroll
            for (int p = 0; p < 16; ++p) { sa += red_all[p * 32 + F.tid]; sp += red_pre[p * 32 + F.tid]; }
            tot[F.tid] = sa; pre[F.tid] = sp; }
        __syncthreads();
        if (F.tid == 0) { int a = 0; for (int e = 0; e < NEXP; ++e) { pstart[e] = a; a += (tot[e] + 255) / 256 * 256; } pstart[32] = a; }
        __syncthreads();
        { const int a = F.tid, e = le[a], lane_ = a & 63, w_ = a >> 6; int rank = 0;
#pragma unroll 4
          for (int q = 0; q < NEXP; ++q) { const unsigned long long m = __builtin_amdgcn_ballot_w64(e == q);
              if (e == q) rank = __builtin_popcountll(m & ((1ull << lane_) - 1ull));
              if (lane_ == 0) red_all[w_ * 32 + q] = __builtin_popcountll(m); }
          __syncthreads();
          int base = pstart[e] + pre[e];
          for (int ww = 0; ww < w_; ++ww) base += red_all[ww * 32 + e];
          ls[a] = base + rank; }
        __syncthreads();
        { const int a = F.tid, token = 128 * c + (a >> 2), slot = ls[a]; SLOT[(size_t)c * 512 + a] = slot; ROWTOK[slot] = token; }
        if (c < NEXP) { const int e = c; for (int r = pstart[e] + tot[e] + F.tid; r < pstart[e + 1]; r += NTHREADS) ROWTOK[r] = 0; }
        if (c == 0) { const int ntl = pstart[32] / 256;
            for (int t = F.tid; t < ntl; t += NTHREADS) { int e = 0; for (int q = 1; q < NEXP; ++q) if (t * 256 >= pstart[q]) e = q; TILEE[t] = e; }
            if (F.tid == 0) F.ctl[CW_NT] = (unsigned)ntl; }
    }
    __syncthreads();
}

__device__ __forceinline__ void p11_final(Frame& F) {
    const int gw = F.bx * NWAVES + F.wave, NGW = F.G * NWAVES, lane = F.lane;
    const bf16_t* YB = (const bf16_t*)(F.ws + WS_YBUF); const int* SLOT = (const int*)(F.ws + WS_SLOT); const float* TOPW = (const float*)(F.ws + WS_TOPW);
#ifdef DBG_DUMP
    for (int m = gw; m < NTOK; m += NGW) {
        const bf16_t* src = (const bf16_t*)(F.ws + DBG_DUMP_OFF) + (size_t)((m + DBG_DUMP_SHIFT) % NTOK) * DBG_DUMP_PITCH + DBG_DUMP_COL;
        #ifdef DBG_TWICE
        const bf16_t* src2 = (const bf16_t*)(F.ws + WS_ACT) + (size_t)m * DBG_DUMP_PITCH + DBG_DUMP_COL;
        for (int d = lane; d < DM; d += 64) F.out[(size_t)m * DM + d] = (bf_lo((unsigned)src[d]) - bf_lo((unsigned)src2[d])) * 1000.f + 1.0f;
#else
        for (int d = lane; d < DM; d += 64) F.out[(size_t)m * DM + d] = (d < DBG_DUMP_N) ? bf_lo((unsigned)src[d]) : 0.f;
#endif
    }
    return;
#endif
    constexpr int R11 = 2;
    typedef float f32x2_ __attribute__((ext_vector_type(2)));
    int4 sl[R11]; float4 tw[R11];
#pragma unroll
    for (int q = 0; q < R11; ++q) { const int m = gw + q * NGW; sl[q] = make_int4(0, 0, 0, 0); tw[q] = make_float4(0.f, 0.f, 0.f, 0.f);
        if (m < NTOK) { sl[q] = *(const int4*)(SLOT + (size_t)m * 4); tw[q] = *(const float4*)(TOPW + (size_t)m * 4); } }
    for (int m0 = gw; m0 < NTOK; m0 += R11 * NGW) {
        u32x2 hw[R11][8]; unsigned ya[R11][8], yb[R11][8], yc[R11][8], yd[R11][8];
#pragma unroll
        for (int q = 0; q < R11; ++q) { const int m = m0 + q * NGW; if (m < NTOK) {
            const u32x2* hb = (const u32x2*)((const bf16_t*)(F.ws + WS_H) + (size_t)m * DM) + lane;
            const unsigned* y0 = (const unsigned*)((const unsigned char*)YB + (size_t)sl[q].x * DM) + lane; const unsigned* y1 = (const unsigned*)((const unsigned char*)YB + (size_t)sl[q].y * DM) + lane;
            const unsigned* y2 = (const unsigned*)((const unsigned char*)YB + (size_t)sl[q].z * DM) + lane; const unsigned* y3 = (const unsigned*)((const unsigned char*)YB + (size_t)sl[q].w * DM) + lane;
#pragma unroll
            for (int j = 0; j < 8; ++j) { hw[q][j] = hb[64 * j]; ya[q][j] = y0[64 * j]; yb[q][j] = y1[64 * j]; yc[q][j] = y2[64 * j]; yd[q][j] = y3[64 * j]; } } }
        float4 twc[R11];
#pragma unroll
        for (int q = 0; q < R11; ++q) { twc[q] = tw[q]; const int mn = m0 + (R11 + q) * NGW;
            if (mn < NTOK) { sl[q] = *(const int4*)(SLOT + (size_t)mn * 4); tw[q] = *(const float4*)(TOPW + (size_t)mn * 4); } }
#pragma unroll
        for (int q = 0; q < R11; ++q) { const int m = m0 + q * NGW; if (m < NTOK) {
            f32x4* hr = (f32x4*)(F.out + (size_t)m * DM) + lane;
            f32x4 v[8]; float s = 0.f;
#pragma unroll
            for (int j = 0; j < 8; ++j) { v[j] = (f32x4){bf_lo(hw[q][j].x), bf_hi(hw[q][j].x), bf_lo(hw[q][j].y), bf_hi(hw[q][j].y)};
                const unsigned a = ya[q][j], b = yb[q][j], c = yc[q][j], d = yd[q][j];
                const f32x2_ a0 = __builtin_amdgcn_cvt_pk_f32_fp8((int)a, false), a1 = __builtin_amdgcn_cvt_pk_f32_fp8((int)a, true), b0 = __builtin_amdgcn_cvt_pk_f32_fp8((int)b, false), b1 = __builtin_amdgcn_cvt_pk_f32_fp8((int)b, true);
                const f32x2_ c0 = __builtin_amdgcn_cvt_pk_f32_fp8((int)c, false), c1 = __builtin_amdgcn_cvt_pk_f32_fp8((int)c, true), d0 = __builtin_amdgcn_cvt_pk_f32_fp8((int)d, false), d1 = __builtin_amdgcn_cvt_pk_f32_fp8((int)d, true);
                v[j].x += twc[q].x * a0[0] + twc[q].y * b0[0] + twc[q].z * c0[0] + twc[q].w * d0[0];
                v[j].y += twc[q].x * a0[1] + twc[q].y * b0[1] + twc[q].z * c0[1] + twc[q].w * d0[1];
                v[j].z += twc[q].x * a1[0] + twc[q].y * b1[0] + twc[q].z * c1[0] + twc[q].w * d1[0];
                v[j].w += twc[q].x * a1[1] + twc[q].y * b1[1] + twc[q].z * c1[1] + twc[q].w * d1[1];
                s += (v[j].x * v[j].x + v[j].y * v[j].y) + (v[j].z * v[j].z + v[j].w * v[j].w); }
            const float rstd = 1.0f / sqrtf(wave_sum(s) * (1.0f / DM) + EPS);
#pragma unroll
            for (int j = 0; j < 8; ++j) { const f32x4 gg = ((const f32x4*)F.g_final)[lane + 64 * j]; hr[64 * j] = v[j] * rstd * gg; } } }
    }
}

__global__ void __launch_bounds__(NTHREADS, 2) fwd_kernel(Args args) {
    __shared__ __attribute__((aligned(16))) unsigned char lds_raw[LDS_BYTES];
    Frame F;
    F.lds = (LAS unsigned char*)lds_raw; F.ws = args.ws; F.ctl = (unsigned*)(args.ws + WS_CTL);
    F.tid = threadIdx.x; F.lane = F.tid & 63; F.wave = __builtin_amdgcn_readfirstlane(F.tid >> 6); F.G = gridDim.x; F.bx = blockIdx.x;
    F.x = (const float*)args.in[0]; F.positions = (const int*)args.in[1]; F.g_attn = (const float*)args.in[2]; F.w_in = (const float*)args.in[3]; F.b_gate = (const float*)args.in[4];
    F.sinks = (const float*)args.in[5]; F.g_q = (const float*)args.in[6]; F.w_uq = (const float*)args.in[7]; F.g_kv = (const float*)args.in[8]; F.w_ukv = (const float*)args.in[9];
    F.w_o_swa = (const float*)args.in[10]; F.w_o_mla = (const float*)args.in[11]; F.w_out = (const float*)args.in[12]; F.g_ffn = (const float*)args.in[13]; F.w_router = (const float*)args.in[14];
    F.b_router = (const float*)args.in[15]; F.w_gate_up = (const float*)args.in[16]; F.b_gate_up = (const float*)args.in[17]; F.w_down = (const float*)args.in[18]; F.b_down = (const float*)args.in[19];
    F.g_final = (const float*)args.in[20]; F.out = args.out;
    volatile LAS unsigned* MISC = (volatile LAS unsigned*)(F.lds + MISC_OFF);
#ifdef DBG_ZERO_LDS
    for (int u = F.tid; u < RING_BYTES / 4; u += NTHREADS) ((LAS unsigned*)(F.lds))[u] = 0u;
#endif
    for (int u = F.tid; u < (LDS_BYTES - MISC_OFF) / 4; u += NTHREADS) ((LAS unsigned*)(F.lds + MISC_OFF))[u] = 0u;
    __syncthreads();
    const int lo = args.ph_lo, hi = args.ph_hi;
    const bool multi = (hi - lo) > 1;
    XcdBarrier bar; bar.bar = F.ctl + CW_BAR; bar.x = 0; bar.st = nullptr;
    if (multi) bar = xcd_barrier_post(F.ctl + CW_BAR, MISC + 8);
#ifndef PHMASK
#ifdef DBG_NOMOE
#define PHMASK 0x87F
#else
#define PHMASK 0xFFF
#endif
#endif
#define IN(k) (((PHMASK >> (k)) & 1) && lo <= (k) && (k) < hi)
#define SEAM(k) do { if (IN(k) && IN((k) + 1)) xcd_barrier(bar); } while (0)
    unsigned char* ws = args.ws;
    bf16_t* XN = (bf16_t*)(ws + WS_XN); bf16_t* PROJ = (bf16_t*)(ws + WS_PROJ); unsigned char* GATES = (unsigned char*)(ws + WS_GATES);
    const int* TILEE = (const int*)(ws + WS_TILEE); const int* ROWTOK = (const int*)(ws + WS_ROWTOK);

#ifndef REPMASK
#define REPMASK 0
#endif
#define NREP(k) (((REPMASK >> (k)) & 1) + 1)
    if (IN(0)) { for (int rep = 0; rep < NREP(0); ++rep) p0_prologue(F); SEAM(0); }
    if (IN(1)) {
        { pg8::Gemm8 g{(const unsigned char*)(ws + WS_XN8), (const unsigned char*)(ws + WS_WIN), DM, DM, nullptr, 0, (const int*)(ws + WS_IDROW)}; pg8::StaticOrder S; S.init(NTOK / 256, NPROJ / 256, F.G, F.bx);
          pg8::EpiProj8 E{PROJ, (float*)(ws + WS_CQ)};
          for (int rep = 0; rep < NREP(1); ++rep) pg8::gemm_phase_f8<pg8::EpiProj8>(F.lds, g, S, E); }
        { pg8::Gemm8 g{(const unsigned char*)(ws + WS_XN8), (const unsigned char*)(ws + WS_WIN + WIN_GATES_OFF), DM, DM, nullptr, 0, (const int*)(ws + WS_IDROW)}; pg8::StaticOrder S; S.init(NTOK / 256, NGATE / 256, F.G, F.bx);
          pg8::EpiGates8 E{GATES, F.b_gate};
          for (int rep = 0; rep < NREP(1); ++rep) pg8::gemm_phase_f8<pg8::EpiGates8>(F.lds, g, S, E); }
        SEAM(1);
    }
#ifdef DBG_TWICE
    if (IN(2)) {
        pg8::Gemm g{XN, (const bf16_t*)(ws + WS_WIN), DM, DM, nullptr, 0, nullptr}; pg8::StaticOrder S; S.init(NTOK / 256, NIN_PHYS / 256, F.G, F.bx);
        pg8::EpiProj E{(bf16_t*)(ws + WS_YBUF), (bf16_t*)(ws + WS_ACT), F.b_gate};
        pg8::gemm_phase<pg8::EpiProj, false, false>(F.lds, g, S, E);
    }
#else
#endif
    if (IN(3)) {
#ifndef P3_SKIP_GEMM
        { pg8::Gemm g{PROJ + PC_DQ, (const bf16_t*)(ws + WS_WUQ), NPROJ, 512, nullptr, 0, nullptr}; pg8::StaticOrder S; S.init(NTOK / 256, 1536 / 256, F.G, F.bx);
          pg8::EpiQn E{(bf16_t*)(ws + WS_QB), (const float*)(ws + WS_CQ), 0.07216878364870322f * 1.4426950408889634f};
          for (int rep = 0; rep < NREP(12); ++rep) pg8::gemm_phase<pg8::EpiQn, false, false>(F.lds, g, S, E); }
        { pg8::Gemm g{PROJ + PC_DKV, (const bf16_t*)(ws + WS_WUKV), NPROJ, 256, nullptr, 0, nullptr}; pg8::StaticOrder S; S.init(NTOK / 256, 2048 / 256, F.G, F.bx);
          pg8::EpiKVn E{(bf16_t*)(ws + WS_KMLA), (bf16_t*)(ws + WS_VMLA), (const float*)(ws + WS_CQ), PROJ, (const float*)(ws + WS_CS)};
          for (int rep = 0; rep < NREP(12); ++rep) pg8::gemm_phase<pg8::EpiKVn, false, false>(F.lds, g, S, E); }
#endif
#ifndef P3_SKIP_SWA
        for (int rep = 0; rep < NREP(3); ++rep) swa_phase(F);
#endif
        SEAM(3);
    }
    if (IN(4)) { for (int rep = 0; rep < NREP(4); ++rep) mla_phase(F); SEAM(4); }
    if (IN(5)) {
        pg8::Gemm8 g{(const unsigned char*)(ws + WS_OUTA), (const unsigned char*)(ws + WS_WOA), DM, DM, nullptr, 0, (const int*)(ws + WS_IDROW)}; pg8::StaticOrder S; S.init(NTOK / 256, DM / 256, F.G, F.bx);
        pg8::EpiGateMerge8 E{(unsigned char*)(ws + WS_MIX), GATES};
        for (int rep = 0; rep < NREP(5); ++rep) pg8::gemm_phase_f8<pg8::EpiGateMerge8, true>(F.lds, g, S, E);
        SEAM(5);
    }
    if (IN(6)) {
        pg8::Gemm8 g{(const unsigned char*)(ws + WS_MIX), (const unsigned char*)(ws + WS_WOUT), DM, DM, nullptr, 0, (const int*)(ws + WS_IDROW)}; pg8::StaticOrder S; S.init(NTOK / 256, DM / 256, F.G, F.bx);
        pg8::EpiRes8 E{F.x, (bf16_t*)(ws + WS_H), (float*)(ws + WS_CKV)};
        for (int rep = 0; rep < NREP(6); ++rep) pg8::gemm_phase_f8<pg8::EpiRes8>(F.lds, g, S, E);
        SEAM(6);
    }
    if (IN(7)) { for (int rep = 0; rep < NREP(7); ++rep) p7_router(F); SEAM(7); }
    if (IN(8)) { p8_slots(F); SEAM(8); }
    if (IN(9)) {
        const int ntl = (int)__hip_atomic_load(F.ctl + CW_NT, __ATOMIC_RELAXED, __HIP_MEMORY_SCOPE_AGENT);
        pg8::Gemm8 g{(const unsigned char*)XN, (const unsigned char*)(ws + WS_WGU), DM, DM, TILEE, (size_t)2 * DM * DM, ROWTOK}; pg8::StaticOrder S; S.init(ntl, 2 * DM / 256, F.G, F.bx);
        pg8::EpiSwiglu8 E{(unsigned char*)(ws + WS_ACT), F.b_gate_up, TILEE};
        for (int rep = 0; rep < NREP(9); ++rep) pg8::gemm_phase_f8<pg8::EpiSwiglu8>(F.lds, g, S, E);
        SEAM(9);
    }
#ifdef DBG_TWICE
    if (IN(10)) {
        const int gw = F.bx * NWAVES + F.wave, NGW = F.G * NWAVES; unsigned cnt = 0;
        for (int m = gw; m < NTOK; m += NGW) {
            const bf16_t* s1 = (const bf16_t*)(ws + DBG_CMP_OFF1) + (size_t)m * DBG_CMP_PITCH; const bf16_t* s2 = (const bf16_t*)(ws + DBG_CMP_OFF2) + (size_t)m * DBG_CMP_PITCH;
            for (int d = F.lane; d < 2048; d += 64) cnt += (s1[d] != s2[d]) ? 1u : 0u;
        }
        if (cnt) atomicAdd(F.ctl + 32, cnt);
    }
    if (IN(11)) {
        const unsigned c = __hip_atomic_load(F.ctl + 32, __ATOMIC_RELAXED, __HIP_MEMORY_SCOPE_AGENT);
        const float v = c == 0 ? 1.0f : (c < 1000u ? 2.0f : (c < 100000u ? 3.0f : (c < 10000000u ? 4.0f : 5.0f)));
        for (size_t i = (size_t)F.bx * NTHREADS + F.tid; i < (size_t)NTOK * DM; i += (size_t)F.G * NTHREADS) F.out[i] = v;
        return;
    }
#endif
    if (IN(10)) {
        const int ntl = (int)__hip_atomic_load(F.ctl + CW_NT, __ATOMIC_RELAXED, __HIP_MEMORY_SCOPE_AGENT);
        pg8::Gemm8 g{(const unsigned char*)(ws + WS_ACT), (const unsigned char*)(ws + WS_WD), DM, DM, TILEE, (size_t)DM * DM, (const int*)(ws + WS_IDROW)}; pg8::StaticOrder S; S.init(ntl, DM / 256, F.G, F.bx);
        pg8::EpiDown8 E{(unsigned char*)(ws + WS_YBUF), F.b_down, TILEE};
        for (int rep = 0; rep < NREP(10); ++rep) pg8::gemm_phase_f8<pg8::EpiDown8>(F.lds, g, S, E);
        SEAM(10);
    }
    if (IN(11)) { p11_final(F); }
#undef IN
#undef SEAM
}

extern "C" void kernel_launch(void* const* d_in, const int* in_sizes, int n_in, void* d_out, int out_size, void* d_ws, size_t ws_size, hipStream_t stream) {
    static int grid = 0;
    if (grid == 0) {
        if (n_in != 21 || out_size != NTOK * DM || ws_size < WS_END) { fprintf(stderr, "kernel_launch: unexpected problem (n_in %d, out %d, ws %zu)\n", n_in, out_size, ws_size); grid = -1; return; }
        int dev = 0, cus = 0, per_cu = 0;
        if (hipGetDevice(&dev) != hipSuccess || hipDeviceGetAttribute(&cus, hipDeviceAttributeMultiprocessorCount, dev) != hipSuccess) { grid = -1; return; }
        if (hipOccupancyMaxActiveBlocksPerMultiprocessor(&per_cu, (const void*)fwd_kernel, NTHREADS, 0) != hipSuccess || per_cu < 1) { fprintf(stderr, "kernel_launch: occupancy query says %d\n", per_cu); }
        (void)hipGetLastError();
        grid = cus;
    }
    if (grid < 0) return;
    if (hipMemsetAsync((char*)d_ws + WS_CTL, 0, CTL_ZERO_BYTES, stream) != hipSuccess) return;
    Args a{};
    for (int i = 0; i < 21; ++i) a.in[i] = d_in[i];
    a.out = (float*)d_out; a.ws = (unsigned char*)d_ws;
#if MK_ONE_LAUNCH
    a.ph_lo = 0; a.ph_hi = 12;
    hipLaunchKernelGGL(fwd_kernel, dim3(grid), dim3(NTHREADS), 0, stream, a);
#else
    for (int p = 0; p < 12; ++p) { a.ph_lo = p; a.ph_hi = p + 1; hipLaunchKernelGGL(fwd_kernel, dim3(grid), dim3(NTHREADS), 0, stream, a); }
#endif
}
```

```cpp
#include <hip/hip_runtime.h>
#include <cstdio>
#include <cstdint>

#ifndef MK_ONE_LAUNCH
#define MK_ONE_LAUNCH 1
#endif

#define LAS __attribute__((address_space(3)))
#define GAS __attribute__((address_space(1)))
typedef unsigned short bf16_t;
typedef short bf16x8 __attribute__((ext_vector_type(8)));
typedef short s16x4 __attribute__((ext_vector_type(4)));
typedef float f32x4 __attribute__((ext_vector_type(4)));
typedef float f32x16 __attribute__((ext_vector_type(16)));
typedef unsigned u32x4 __attribute__((ext_vector_type(4)));
typedef unsigned u32x2 __attribute__((ext_vector_type(2)));
typedef short v4i16_t __attribute__((ext_vector_type(4)));

constexpr int DM = 2048, BATCH = 16, SEQ = 2048, NTOK = BATCH * SEQ;
constexpr int NPROJ = 2304;
constexpr int PC_KA = 1024, PC_VA = 1152, PC_DQ = 1280, PC_DKV = 1792, PC_KR = 2048;
constexpr int NGATE = 4096, NIN_PHYS = 6400, NIN_LOG = 6208, NLOW = 2112;
constexpr int NEXP = 32, TOPK = 4, MAXTILES = 544, PROWS = MAXTILES * 256;
constexpr float EPS = 1e-6f;

constexpr size_t MiB = 1ull << 20;
constexpr size_t WS_CTL = 0, CTL_ZERO_BYTES = 1 * MiB;
constexpr size_t WS_CS = 1 * MiB, WS_WRT = 9 * MiB, WS_WIN = 10 * MiB, WS_WUQ = 36 * MiB, WS_WUKV = 38 * MiB, WS_WOA = 40 * MiB, WS_WOB = 45 * MiB, WS_WOUT = 50 * MiB;
constexpr size_t WS_WGU = 64 * MiB, WS_WD = 580 * MiB, WS_XN = 840 * MiB, WS_PROJ = 968 * MiB, WS_GATES = 1112 * MiB, WS_CQ = 1368 * MiB, WS_CKV = 1400 * MiB;
constexpr size_t WS_QB = 1416 * MiB, WS_KMLA = 1512 * MiB  , WS_VMLA = 1610 * MiB  ;
constexpr size_t WS_OUTA = 1676 * MiB, WS_OUTB = 1740 * MiB, WS_MIX = 1804 * MiB;
constexpr size_t WS_TOPE = 1932 * MiB, WS_TOPW = 1933 * MiB, WS_SLOT = 1934 * MiB, WS_ROWTOK = 1935 * MiB, WS_TILEE = 1936 * MiB, WS_CNT = 1937 * MiB;
constexpr size_t WS_ACT = 1940 * MiB, WS_YBUF = 2484 * MiB, WS_END = 3028 * MiB;
constexpr size_t WS_H = WS_OUTA;
constexpr size_t WS_XN8 = WS_YBUF  , WS_IDROW = 60 * MiB, WIN_GATES_OFF = 16 * MiB;
constexpr int LDPAD = 16;
constexpr int CW_NT = 16, CW_BAR = 4096;

constexpr int RING_BYTES = 131072, LDS_BYTES = 147456, MISC_OFF = LDS_BYTES - 256;
constexpr int NWAVES = 8, NTHREADS = 512;

__device__ __forceinline__ unsigned cvt_pk_bf16(float lo, float hi) { unsigned r; asm volatile("v_cvt_pk_bf16_f32 %0, %1, %2" : "=v"(r) : "v"(lo), "v"(hi)); return r; }
__device__ __forceinline__ unsigned cvt_pk_bf16_t(float lo, float hi) { unsigned r; asm volatile("s_nop 0\n\tv_cvt_pk_bf16_f32 %0, %1, %2" : "=v"(r) : "v"(lo), "v"(hi)); return r; }
__device__ __forceinline__ float bf_lo(unsigned w) { return __uint_as_float(w << 16); }
__device__ __forceinline__ float bf_hi(unsigned w) { return __uint_as_float(w & 0xffff0000u); }
__device__ __forceinline__ float wave_sum(float v) {
#pragma unroll
    for (int o = 1; o < 64; o <<= 1) v += __shfl_xor(v, o);
    return v;
}
__device__ __forceinline__ float fast_sigmoid(float x) { return __builtin_amdgcn_rcpf(1.0f + __builtin_amdgcn_exp2f(-1.4426950408889634f * x)); }
__device__ __forceinline__ const char* uni_ptr(const char* p) { const unsigned long long v = (unsigned long long)p; const unsigned lo = __builtin_amdgcn_readfirstlane((unsigned)v), hi = __builtin_amdgcn_readfirstlane((unsigned)(v >> 32)); return (const char*)(((unsigned long long)hi << 32) | lo); }
__device__ __forceinline__ void glds16_asm(const char* sbase, unsigned voff, unsigned lds_dst) {
    unsigned keep;
    asm volatile("s_mov_b32 %0, m0\n\ts_mov_b32 m0, %3\n\ts_nop 0\n\tglobal_load_lds_dwordx4 %1, %2\n\ts_mov_b32 m0, %0" : "=&s"(keep) : "v"(voff), "s"(sbase), "s"(lds_dst) : "memory");
}
#define LDS_WAIT() asm volatile("s_waitcnt lgkmcnt(0)" ::: "memory")

#define XB_TMO      128
#define XB_XCNT(j)  (256  + 64 * (j))
#define XB_XSUB(j)  (1280 + 64 * (j))
#define XB_XGEN(j)  (2304 + 64 * (j))
#define XB_TOP      3328
#define XB_TOPGEN   3392
#define XCD_BAR_WORDS 3456
#define XB_SPIN_CAP (1u << 18)
__device__ __forceinline__ unsigned xb_ld(unsigned* p)              { return __hip_atomic_load(p, __ATOMIC_RELAXED, __HIP_MEMORY_SCOPE_AGENT); }
__device__ __forceinline__ unsigned xb_add(unsigned* p, unsigned v) { return __hip_atomic_fetch_add(p, v, __ATOMIC_RELAXED, __HIP_MEMORY_SCOPE_AGENT); }
__device__ __forceinline__ unsigned xb_xcc_id() { return (unsigned)__builtin_amdgcn_s_getreg((3 << 11) | 20) & 0xFu; }
#define XB_SPIN(cond, bar) do { unsigned _sp = 0; while (cond) { __builtin_amdgcn_s_sleep(1); \
    if ((++_sp & 255u) == 0u) { if (xb_ld(&(bar)[XB_TMO])) break; if (_sp > XB_SPIN_CAP) { atomicAdd(&(bar)[XB_TMO], 1u); break; } } } } while (0)
struct XcdBarrier { unsigned* bar; unsigned x; volatile LAS unsigned* st; };
__device__ __forceinline__ XcdBarrier xcd_barrier_post(unsigned* bar, volatile LAS unsigned* st) {
    XcdBarrier b; b.bar = bar; b.x = xb_xcc_id(); b.st = st;
    if (threadIdx.x == 0) (void)xb_add(&bar[XB_XCNT(b.x)], 1u);
    return b;
}
__device__ __forceinline__ void xcd_barrier_complete(unsigned* bar, unsigned x, unsigned& nloc, unsigned& nx) {
    const unsigned G = gridDim.x * gridDim.y * gridDim.z;
    unsigned sum, cnt, mine, sp = 0u;
    for (;;) {
        sum = 0u; cnt = 0u; mine = 0u;
#pragma unroll
        for (unsigned j = 0; j < 16; ++j) { const unsigned c = xb_ld(&bar[XB_XCNT(j)]); sum += c; cnt += (c > 0u) ? 1u : 0u; mine = (j == x) ? c : mine; }
        if (sum == G) break;
        __builtin_amdgcn_s_sleep(1);
        if ((++sp & 255u) == 0u) { if (xb_ld(&bar[XB_TMO])) break; if (sp > XB_SPIN_CAP) { atomicAdd(&bar[XB_TMO], 1u); break; } }
    }
    nloc = mine > 0u ? mine : 1u; nx = cnt > 0u ? cnt : 1u;
}
__device__ __forceinline__ void xcd_barrier(const XcdBarrier& b) {
    asm volatile("s_waitcnt vmcnt(0)" ::: "memory");
    __syncthreads();
    if (threadIdx.x == 0) {
        unsigned* bar = b.bar;
        __builtin_amdgcn_s_waitcnt(0);
        unsigned nloc = b.st[0], nx = b.st[1];
        if (nloc == 0u) { xcd_barrier_complete(bar, b.x, nloc, nx); b.st[0] = nloc; b.st[1] = nx; }
        const unsigned old = xb_add(&bar[XB_XSUB(b.x)], 1u);
        const unsigned gen = old / nloc;
        if (old + 1u == (gen + 1u) * nloc) {
            __builtin_amdgcn_fence(__ATOMIC_RELEASE, "agent");
            asm volatile("s_waitcnt vmcnt(0)" ::: "memory");
            const unsigned og = xb_add(&bar[XB_TOP], 1u);
            const unsigned tg = og / nx;
            if (og + 1u == (tg + 1u) * nx) xb_add(&bar[XB_TOPGEN], 1u);
            else XB_SPIN(xb_ld(&bar[XB_TOPGEN]) == tg, bar);
            __builtin_amdgcn_fence(__ATOMIC_ACQUIRE, "agent");
            xb_add(&bar[XB_XGEN(b.x)], 1u);
            asm volatile("s_waitcnt vmcnt(0)" ::: "memory");
        } else {
            XB_SPIN(xb_ld(&bar[XB_XGEN(b.x)]) == gen, bar);
            __builtin_amdgcn_fence(__ATOMIC_ACQUIRE, "agent");
            asm volatile("s_waitcnt vmcnt(0)" ::: "memory");
        }
    }
    __syncthreads();
}

namespace pg8 {
constexpr int BM = 256, BK = 64, HALF = 128, HTB = HALF * BK * 2, STAGE_BYTES = 8 * HTB, NXCD = 8, WGM = 8;
__host__ __device__ __forceinline__ int lds_byte(int r, int c) { const int st = (r >> 4) * 2 + (c >> 5), rr = r & 15, cc = c & 31, ob = rr * 64 + cc * 2; return st * 1024 + (ob ^ (((ob >> 9) & 1) << 5)); }
__host__ __device__ __forceinline__ void stage_rc(int b, int& R, int& C) { const int st = b / 1024, sb = b % 1024, swz = sb ^ (((sb >> 9) & 1) << 5); R = (st >> 1) * 16 + swz / 64; C = (st & 1) * 32 + (swz % 64) / 2; }
__host__ __device__ __forceinline__ int perm32(int rho) { const int n = rho >> 4, i = rho & 15; return 8 * (i >> 2) + 4 * n + (i & 3); }
struct Unit { int pm, pn; };
struct Gemm { const bf16_t* A; const bf16_t* Bt; int lda, K; const int* tile_e; size_t estride; const int* rowtok; };
struct StaticOrder {
    int nM, nN, nwg, G, c;
    __device__ void init(int nM_, int nN_, int G_, int c_) { nM = nM_; nN = nN_; nwg = nM * nN; G = G_; c = c_; }
    __device__ bool next(int i, Unit& u) const {
        const long L = (long)i * G + c; if (L >= nwg) return false;
        int wgid = (int)L; { const int q = nwg / NXCD, r = nwg % NXCD, xcd = wgid % NXCD, off = wgid / NXCD; wgid = (xcd < r ? xcd * (q + 1) : r * (q + 1) + (xcd - r) * q) + off; }
        const int nig = WGM * nN, gid = wgid / nig, fm = gid * WGM, gsz = (nM - fm) < WGM ? (nM - fm) : WGM;
        u.pm = fm + ((wgid % nig) % gsz); u.pn = (wgid % nig) / gsz; return true;
    }
};
template <class Epi, bool GROUPED, bool GATHER, bool MIDHOOK = false>
__device__ __forceinline__ void gemm_phase(LAS unsigned char* lds, const Gemm g, const StaticOrder& S, const Epi& E) {
    int tid = threadIdx.x; asm volatile("" : "+v"(tid));
    const int wid = __builtin_amdgcn_readfirstlane(tid >> 6), lane = tid & 63, wr = wid >> 2, wc = wid & 3, fr = lane & 15, fq = lane >> 4;
    int K = g.K; asm volatile("" : "+s"(K));
    const int nt = K / BK, lda = g.lda;
    unsigned voffB[2];
#pragma unroll
    for (int i = 0; i < 2; ++i) { int R, C; stage_rc(tid * 16 + i * 8192, R, C); const int Rb = Epi::PERM ? ((R & ~31) + perm32(R & 31)) : R;
        (void)Rb; voffB[i] = (unsigned)(tid * 16 + i * 8192); }
    const size_t kstep = (size_t)(BK * 2);
    const size_t kstepB = 32768, hstepB = 16384, tstepB = (size_t)nt * 32768;
    const unsigned ldsw = (unsigned)wid * 1024u;
    const int aoff = lds_byte(wr * 64 + fr, fq * 8), boff = lds_byte(wc * 32 + fr, fq * 8);
#define PG8_SA(b, h) (((b) * 2 + (h)) * HTB)
#define PG8_SB(b, h) ((4 + (b) * 2 + (h)) * HTB)
#define PG8_STAGE(bufoff, gbase, voff) do { _Pragma("unroll") for (int _i = 0; _i < 2; ++_i) \
        __builtin_amdgcn_global_load_lds((const unsigned*)((const char*)(gbase) + (voff)[_i]), (LAS unsigned*)(lds + (bufoff) + ldsw + _i * 8192), 16, 0, 0); } while (0)
#define PG8_LDA(dst, b, h) do { _Pragma("unroll") for (int m = 0; m < 4; ++m) _Pragma("unroll") for (int k = 0; k < 2; ++k) dst[m][k] = *(const LAS bf16x8*)(lds + PG8_SA(b, h) + aoff + m * 2048 + k * 1024); } while (0)
#define PG8_LDB(dst, b, h) do { _Pragma("unroll") for (int n = 0; n < 2; ++n) _Pragma("unroll") for (int k = 0; k < 2; ++k) dst[n][k] = *(const LAS bf16x8*)(lds + PG8_SB(b, h) + boff + n * 2048 + k * 1024); } while (0)
#define PG8_MMA(ai, bj, At, Bt) do { __builtin_amdgcn_s_setprio(1); _Pragma("unroll") for (int m = 0; m < 4; ++m) _Pragma("unroll") for (int n = 0; n < 2; ++n) _Pragma("unroll") for (int k = 0; k < 2; ++k) \
        acc[ai][bj][m][n] = __builtin_amdgcn_mfma_f32_16x16x32_bf16(Bt[n][k], At[m][k], acc[ai][bj][m][n], 0, 0, 0); __builtin_amdgcn_s_setprio(0); } while (0)
#ifdef DBG_SAFE_GEMM
#define PG8_WAIT_V(n) asm volatile("s_waitcnt vmcnt(0)" ::: "memory")
#else
#define PG8_WAIT_V(n) asm volatile("s_waitcnt vmcnt(" #n ")" ::: "memory")
#endif
#define PG8_WAIT_L(n) asm volatile("s_waitcnt lgkmcnt(" #n ")" ::: "memory")
#define PG8_BAR __builtin_amdgcn_s_barrier()
#define PG8_SCHED __builtin_amdgcn_sched_barrier(0)
#define PG8_AOFF(vo, u) do { int _t = tid; asm volatile("" : "+v"(_t));     \
        _Pragma("unroll") for (int _i = 0; _i < 2; ++_i) { int _R, _C; stage_rc(_t * 16 + _i * 8192, _R, _C); \
        _Pragma("unroll") for (int _h = 0; _h < 2; ++_h) { \
        const int _r = (u).pm * BM + _h * HALF + _R; (vo)[_h][_i] = (unsigned)(g.rowtok[_r] * lda + _C) * 2u; } } } while (0)
#define PG8_STGA(bufoff, aptr, gptr, h, vo) do { if constexpr (GATHER) PG8_STAGE(bufoff, gptr, (vo)[h]); else PG8_STAGE(bufoff, (aptr) + (h) * hstepA, voffA); } while (0)
#define PF8_AOFF_LDS(vo, rt) do { int _t = tid; asm volatile("" : "+v"(_t)); \
        _Pragma("unroll") for (int _i = 0; _i < 2; ++_i) { const int _p = _t + 512 * _i, _R = _p >> 3, _C = ((_p & 7) ^ sw8(_R)) << 4; \
        _Pragma("unroll") for (int _h = 0; _h < 2; ++_h) (vo)[_h][_i] = (unsigned)((rt)[_h * HALF + _R] * lda + _C); } } while (0)
    Unit cur, nxt; int ui = 0;
    if (!S.next(0, cur)) return;
    f32x4 acc[2][2][4][2];
#pragma unroll
    for (int a = 0; a < 2; ++a)
#pragma unroll
        for (int b = 0; b < 2; ++b)
#pragma unroll
            for (int m = 0; m < 4; ++m)
#pragma unroll
                for (int n = 0; n < 2; ++n) acc[a][b][m][n] = (f32x4){0.f, 0.f, 0.f, 0.f};
    bf16x8 At[4][2], B0[2][2], B1[2][2];
    unsigned voC[2][2], voffA[2];
    LAS u32x4* const gslot = (LAS u32x4*)(lds + STAGE_BYTES) + tid;
    const size_t hstepA = (size_t)HALF * lda * 2, tstepA = 2 * hstepA;
    if constexpr (GATHER) { PG8_AOFF(voC, cur); voffA[0] = 0; voffA[1] = 0; }
    else {
#pragma unroll
        for (int i = 0; i < 2; ++i) { int R, C; stage_rc(tid * 16 + i * 8192, R, C); voffA[i] = (unsigned)(R * lda + C) * 2u; }
#pragma unroll
        for (int h = 0; h < 2; ++h)
#pragma unroll
            for (int i = 0; i < 2; ++i) voC[h][i] = 0;
    }
    const char* const Abase = (const char*)g.A;
    const char* cA = GATHER ? Abase : Abase + (size_t)cur.pm * tstepA;
    const char* cB = (const char*)g.Bt + (GROUPED ? (size_t)g.tile_e[cur.pm] * g.estride * 2 : (size_t)0) + (size_t)cur.pn * tstepB;
    PG8_STAGE(PG8_SB(0, 0), cB, voffB); PG8_STAGE(PG8_SB(0, 1), cB + hstepB, voffB); PG8_STGA(PG8_SA(0, 0), cA, Abase, 0, voC); PG8_STGA(PG8_SA(0, 1), cA, Abase, 1, voC);
    if (wr == 1) PG8_BAR;
    PG8_WAIT_V(2); PG8_BAR;
    PG8_STAGE(PG8_SB(1, 0), cB + kstepB, voffB); PG8_STGA(PG8_SA(1, 0), cA + kstep, Abase + kstep, 0, voC); PG8_STAGE(PG8_SB(1, 1), cB + hstepB + kstepB, voffB);
    PG8_WAIT_V(6); PG8_BAR;
    for (;;) {
        const bool has_next = S.next(ui + 1, nxt);
        const char* nB = cB; const char* nA = cA;
        if (has_next) { nB = (const char*)g.Bt + (GROUPED ? (size_t)g.tile_e[nxt.pm] * g.estride * 2 : (size_t)0) + (size_t)nxt.pn * tstepB;
            if constexpr (GATHER) { unsigned vt[2][2]; PG8_AOFF(vt, nxt); *gslot = (u32x4){vt[0][0], vt[0][1], vt[1][0], vt[1][1]}; } else nA = Abase + (size_t)nxt.pm * tstepA; }
        else if constexpr (GATHER) *gslot = (u32x4){voC[0][0], voC[0][1], voC[1][0], voC[1][1]};
#pragma unroll 1
        for (int t = 0; t < nt; t += 2) {
            const bool last = (t == nt - 2);
            const char* a1 = cA + (size_t)(t + 1) * kstep;
            const char* a2 = last ? nA : cA + (size_t)(t + 2) * kstep; const char* b2 = last ? nB : cB + (size_t)(t + 2) * kstepB;
            const char* a3 = a2 + kstep; const char* b3 = b2 + kstepB;
            if constexpr (MIDHOOK) { if (t == nt / 2) { int ln_ = lane; asm volatile("" : "+v"(ln_)); E.mid(acc, cur, wr, wc, ln_ & 15, ln_ >> 4); } }
            PG8_LDB(B0, 0, 0); PG8_LDB(B1, 0, 1); PG8_SCHED; PG8_LDA(At, 0, 0); PG8_STGA(PG8_SA(1, 1), a1, a1, 1, voC);
            if constexpr (GATHER) { if (last) { const u32x4 q = *gslot; voC[0][0] = q.x; voC[0][1] = q.y; voC[1][0] = q.z; voC[1][1] = q.w; } }
            PG8_WAIT_V(8); PG8_WAIT_L(0); PG8_BAR; PG8_MMA(0, 0, At, B0); PG8_MMA(0, 1, At, B1); PG8_BAR; PG8_SCHED;
            PG8_LDA(At, 0, 1); PG8_STAGE(PG8_SB(0, 0), b2, voffB); PG8_STAGE(PG8_SB(0, 1), b2 + hstepB, voffB); PG8_STGA(PG8_SA(0, 0), a2, a2, 0, voC);
            PG8_WAIT_V(8); PG8_WAIT_L(0); PG8_BAR; PG8_MMA(1, 0, At, B0); PG8_MMA(1, 1, At, B1); PG8_BAR; PG8_SCHED;
            PG8_LDB(B0, 1, 0); PG8_LDB(B1, 1, 1); PG8_SCHED; PG8_LDA(At, 1, 0); PG8_STGA(PG8_SA(0, 1), a2, a2, 1, voC);
            PG8_WAIT_V(8); PG8_WAIT_L(0); PG8_BAR; PG8_MMA(0, 0, At, B0); PG8_MMA(0, 1, At, B1); PG8_BAR; PG8_SCHED;
            PG8_LDA(At, 1, 1); PG8_STAGE(PG8_SB(1, 0), b3, voffB); PG8_STAGE(PG8_SB(1, 1), b3 + hstepB, voffB); PG8_STGA(PG8_SA(1, 0), a3, a3, 0, voC);
            PG8_WAIT_V(8); PG8_WAIT_L(0); PG8_BAR; PG8_MMA(1, 0, At, B0); PG8_MMA(1, 1, At, B1); PG8_BAR; PG8_SCHED;
        }
        if (wr == 0) PG8_BAR;
        { int ln_ = lane; asm volatile("" : "+v"(ln_)); E(acc, cur, wr, wc, ln_ & 15, ln_ >> 4); }
        if (!has_next) break;
#pragma unroll
        for (int a = 0; a < 2; ++a)
#pragma unroll
            for (int b = 0; b < 2; ++b)
#pragma unroll
                for (int m = 0; m < 4; ++m)
#pragma unroll
                    for (int n = 0; n < 2; ++n) acc[a][b][m][n] = (f32x4){0.f, 0.f, 0.f, 0.f};
        cur = nxt; cB = nB; cA = nA; ++ui;
        if (wr == 1) PG8_BAR;
    }
    PG8_WAIT_V(0);
    PG8_BAR;
#undef PG8_SA
#undef PG8_SB
#undef PG8_STAGE
#undef PG8_LDA
#undef PG8_LDB
#undef PG8_MMA
#undef PG8_WAIT_V
#undef PG8_WAIT_L
#undef PG8_BAR
#undef PG8_SCHED
#undef PG8_AOFF
#undef PG8_STGA
}

struct GemmO { const bf16_t* A; const bf16_t* Bt; int M, N, K; };
template <class Epi, class Sched, bool ALIGN_EPI = false, bool SP2 = false>
__device__ __forceinline__ void gemm_phase_orig(LAS unsigned char* lds, const GemmO g, const Sched& S, const Epi& E) {
    const int tid = threadIdx.x, wid = __builtin_amdgcn_readfirstlane(tid >> 6), lane = tid & 63, wr = wid >> 2, wc = wid & 3, fr = lane & 15, fq = lane >> 4;
    const int K = g.K, nt = K / BK;
    unsigned voffA[2], voffB[2];
#pragma unroll
    for (int i = 0; i < 2; ++i) { int R, C; stage_rc(tid * 16 + i * 8192, R, C); const int Rb = Epi::PERM ? ((R & ~31) + perm32(R & 31)) : R;
        voffA[i] = (unsigned)(R * K + C) * 2u; voffB[i] = (unsigned)(Rb * K + C) * 2u; }
    const size_t kstep = (size_t)(BK * 2);
    const size_t hstep = (size_t)HALF * K * 2;
    const size_t tstep = 2 * hstep;
    const unsigned ldsw = (unsigned)wid * 1024u;
    const int aoff = lds_byte(wr * 64 + fr, fq * 8), boff = lds_byte(wc * 32 + fr, fq * 8);
#define PG8_SA(b, h) (((b) * 2 + (h)) * HTB)
#define PG8_SB(b, h) ((4 + (b) * 2 + (h)) * HTB)
#define PG8_STAGE(bufoff, gbase, voff) do { _Pragma("unroll") for (int _i = 0; _i < 2; ++_i) \
        __builtin_amdgcn_global_load_lds((const unsigned*)((const char*)(gbase) + (voff)[_i]), (LAS unsigned*)(lds + (bufoff) + ldsw + _i * 8192), 16, 0, 0); } while (0)
#define PG8_LDA(dst, b, h) do { _Pragma("unroll") for (int m = 0; m < 4; ++m) _Pragma("unroll") for (int k = 0; k < 2; ++k) dst[m][k] = *(const LAS bf16x8*)(lds + PG8_SA(b, h) + aoff + m * 2048 + k * 1024); } while (0)
#define PG8_LDB(dst, b, h) do { _Pragma("unroll") for (int n = 0; n < 2; ++n) _Pragma("unroll") for (int k = 0; k < 2; ++k) dst[n][k] = *(const LAS bf16x8*)(lds + PG8_SB(b, h) + boff + n * 2048 + k * 1024); } while (0)
#define PG8_MMA(ai, bj, At, Bt) do { __builtin_amdgcn_s_setprio(1); _Pragma("unroll") for (int m = 0; m < 4; ++m) _Pragma("unroll") for (int n = 0; n < 2; ++n) _Pragma("unroll") for (int k = 0; k < 2; ++k) \
        acc[ai][bj][m][n] = __builtin_amdgcn_mfma_f32_16x16x32_bf16(Bt[n][k], At[m][k], acc[ai][bj][m][n], 0, 0, 0); __builtin_amdgcn_s_setprio(0); } while (0)
#define PG8_WAIT_V(n) asm volatile("s_waitcnt vmcnt(" #n ")" ::: "memory")
#define PG8_WAIT_L(n) asm volatile("s_waitcnt lgkmcnt(" #n ")" ::: "memory")
#define PG8_BAR __builtin_amdgcn_s_barrier()
#define PG8_SCHED __builtin_amdgcn_sched_barrier(0)
    Unit cur, nxt; int ui = 0;
    if (!S.next(0, cur)) return;
    f32x4 acc[2][2][4][2];
#pragma unroll
    for (int a = 0; a < 2; ++a)
#pragma unroll
        for (int b = 0; b < 2; ++b)
#pragma unroll
            for (int m = 0; m < 4; ++m)
#pragma unroll
                for (int n = 0; n < 2; ++n) acc[a][b][m][n] = (f32x4){0.f, 0.f, 0.f, 0.f};
    bf16x8 At[4][2], B0[2][2], B1[2][2];
    const char* cA = (const char*)g.A + (size_t)cur.pm * tstep; const char* cB = (const char*)g.Bt + (size_t)cur.pn * tstep;

    if constexpr (SP2) {
        PG8_STAGE(PG8_SB(0, 0), cB, voffB); PG8_STAGE(PG8_SB(0, 1), cB + hstep, voffB); PG8_STAGE(PG8_SA(0, 0), cA, voffA); PG8_STAGE(PG8_SA(0, 1), cA + hstep, voffA);
        if (wr == 1) PG8_BAR;
        PG8_WAIT_V(2); PG8_BAR;
        PG8_STAGE(PG8_SB(1, 0), cB + kstep, voffB); PG8_STAGE(PG8_SA(1, 0), cA + kstep, voffA); PG8_STAGE(PG8_SB(1, 1), cB + hstep + kstep, voffB);
        PG8_WAIT_V(6); PG8_BAR;
    } else {
        PG8_STAGE(PG8_SB(0, 0), cB, voffB); PG8_STAGE(PG8_SA(0, 0), cA, voffA); PG8_STAGE(PG8_SB(0, 1), cB + hstep, voffB); PG8_STAGE(PG8_SA(0, 1), cA + hstep, voffA);
        if (wr == 1) PG8_BAR;
        PG8_WAIT_V(4); PG8_BAR;
        PG8_STAGE(PG8_SB(1, 0), cB + kstep, voffB); PG8_STAGE(PG8_SA(1, 0), cA + kstep, voffA); PG8_STAGE(PG8_SB(1, 1), cB + hstep + kstep, voffB);
        PG8_WAIT_V(6); PG8_BAR;
    }
    for (;;) {
        const bool has_next = S.next(ui + 1, nxt);
        const char* nA = has_next ? (const char*)g.A + (size_t)nxt.pm * tstep : cA; const char* nB = has_next ? (const char*)g.Bt + (size_t)nxt.pn * tstep : cB;
        for (int t = 0; t < nt; t += 2) {
            const bool last = (t == nt - 2);
            const char* a1 = cA + (size_t)(t + 1) * kstep;
            const char* a2 = last ? nA : cA + (size_t)(t + 2) * kstep; const char* b2 = last ? nB : cB + (size_t)(t + 2) * kstep;
            const char* a3 = a2 + kstep; const char* b3 = b2 + kstep;

            if constexpr (SP2) {
            PG8_LDB(B0, 0, 0); PG8_LDB(B1, 0, 1); PG8_SCHED; PG8_LDA(At, 0, 0); PG8_STAGE(PG8_SA(1, 1), a1 + hstep, voffA);
            PG8_WAIT_V(8); PG8_WAIT_L(0); PG8_BAR; PG8_MMA(0, 0, At, B0); PG8_MMA(0, 1, At, B1); PG8_BAR; PG8_SCHED;
            PG8_LDA(At, 0, 1); PG8_STAGE(PG8_SB(0, 0), b2, voffB); PG8_STAGE(PG8_SB(0, 1), b2 + hstep, voffB); PG8_STAGE(PG8_SA(0, 0), a2, voffA);
            PG8_WAIT_V(8); PG8_WAIT_L(0); PG8_BAR; PG8_MMA(1, 0, At, B0); PG8_MMA(1, 1, At, B1); PG8_BAR; PG8_SCHED;
            PG8_LDB(B0, 1, 0); PG8_LDB(B1, 1, 1); PG8_SCHED; PG8_LDA(At, 1, 0); PG8_STAGE(PG8_SA(0, 1), a2 + hstep, voffA);
            PG8_WAIT_V(8); PG8_WAIT_L(0); PG8_BAR; PG8_MMA(0, 0, At, B0); PG8_MMA(0, 1, At, B1); PG8_BAR; PG8_SCHED;
            PG8_LDA(At, 1, 1); PG8_STAGE(PG8_SB(1, 0), b3, voffB); PG8_STAGE(PG8_SB(1, 1), b3 + hstep, voffB); PG8_STAGE(PG8_SA(1, 0), a3, voffA);
            PG8_WAIT_V(8); PG8_WAIT_L(0); PG8_BAR; PG8_MMA(1, 0, At, B0); PG8_MMA(1, 1, At, B1); PG8_BAR; PG8_SCHED;
            } else {
            PG8_LDB(B0, 0, 0); PG8_SCHED; PG8_LDA(At, 0, 0); PG8_STAGE(PG8_SA(1, 1), a1 + hstep, voffA);
            PG8_WAIT_L(8); PG8_BAR; PG8_WAIT_L(0); PG8_MMA(0, 0, At, B0); PG8_BAR; PG8_SCHED;
            PG8_LDB(B1, 0, 1); PG8_STAGE(PG8_SB(0, 0), b2, voffB);
            PG8_BAR; PG8_WAIT_L(0); PG8_MMA(0, 1, At, B1); PG8_BAR;
            PG8_LDA(At, 0, 1); PG8_STAGE(PG8_SA(0, 0), a2, voffA);
            PG8_BAR; PG8_WAIT_L(0); PG8_MMA(1, 0, At, B0); PG8_BAR; PG8_SCHED;
            PG8_STAGE(PG8_SB(0, 1), b2 + hstep, voffB);
            PG8_WAIT_V(6); PG8_BAR; PG8_MMA(1, 1, At, B1); PG8_BAR;
            PG8_LDB(B0, 1, 0); PG8_SCHED; PG8_LDA(At, 1, 0); PG8_STAGE(PG8_SA(0, 1), a2 + hstep, voffA);
            PG8_WAIT_L(8); PG8_BAR; PG8_WAIT_L(0); PG8_MMA(0, 0, At, B0); PG8_BAR; PG8_SCHED;
            PG8_LDB(B1, 1, 1); PG8_STAGE(PG8_SB(1, 0), b3, voffB);
            PG8_BAR; PG8_WAIT_L(0); PG8_MMA(0, 1, At, B1); PG8_BAR;
            PG8_LDA(At, 1, 1); PG8_STAGE(PG8_SA(1, 0), a3, voffA);
            PG8_BAR; PG8_WAIT_L(0); PG8_MMA(1, 0, At, B0); PG8_BAR; PG8_SCHED;
            PG8_STAGE(PG8_SB(1, 1), b3 + hstep, voffB);
            PG8_WAIT_V(6); PG8_BAR; PG8_MMA(1, 1, At, B1); PG8_BAR;
            }
        }
        if constexpr (ALIGN_EPI) { if (wr == 0) PG8_BAR; }
        E(acc, cur, wr, wc, fr, fq);
        if (!has_next) break;
#pragma unroll
        for (int a = 0; a < 2; ++a)
#pragma unroll
            for (int b = 0; b < 2; ++b)
#pragma unroll
                for (int m = 0; m < 4; ++m)
#pragma unroll
                    for (int n = 0; n < 2; ++n) acc[a][b][m][n] = (f32x4){0.f, 0.f, 0.f, 0.f};
        cur = nxt; cA = nA; cB = nB; ++ui;
        if constexpr (ALIGN_EPI) { if (wr == 1) PG8_BAR; }
    }
    PG8_WAIT_V(0);
    if constexpr (!ALIGN_EPI) { if (wr == 0) PG8_BAR; }
    PG8_BAR;
#undef PG8_SA
#undef PG8_SB
#undef PG8_STAGE
#undef PG8_LDA
#undef PG8_LDB
#undef PG8_MMA
#undef PG8_WAIT_V
#undef PG8_WAIT_L
#undef PG8_BAR
#undef PG8_SCHED
}

typedef const f32x4 (&AccRef)[2][2][4][2];
__device__ __forceinline__ u32x4 pack8(f32x4 v0, f32x4 v1) { u32x4 w; w.x = cvt_pk_bf16(v0[0], v0[1]); w.y = cvt_pk_bf16(v0[2], v0[3]); w.z = cvt_pk_bf16(v1[0], v1[1]); w.w = cvt_pk_bf16(v1[2], v1[3]); return w; }

struct EpiProj { static constexpr bool PERM = true;
    bf16_t* proj; bf16_t* gates; const float* b_gate;
    __device__ __forceinline__ void operator()(AccRef acc, const Unit& u, int wr, int wc, int fr, int fq) const {
        const int row0 = u.pm * BM + wr * 64 + fr;
        if (u.pn < 9) {
            const int col0 = u.pn * BM + wc * 64 + 16 * fq;
#pragma unroll
            for (int ai = 0; ai < 2; ++ai)
#pragma unroll
                for (int m = 0; m < 4; ++m) { bf16_t* rowp = proj + (size_t)(row0 + ai * HALF + m * 16) * NPROJ + col0;
#pragma unroll
                    for (int bj = 0; bj < 2; ++bj) *(u32x4*)(rowp + bj * 8) = pack8(acc[ai][bj][m][0], acc[ai][bj][m][1]); }
        } else {
            const int col0 = (u.pn - 9) * BM + wc * 64 + 16 * fq;
            f32x4 bv[2][2];
#pragma unroll
            for (int bj = 0; bj < 2; ++bj)
#pragma unroll
                for (int n = 0; n < 2; ++n) bv[bj][n] = *(const f32x4*)(b_gate + col0 + bj * 8 + 4 * n);
#pragma unroll
            for (int ai = 0; ai < 2; ++ai)
#pragma unroll
                for (int m = 0; m < 4; ++m) { bf16_t* rowp = gates + (size_t)(row0 + ai * HALF + m * 16) * NGATE + col0;
#pragma unroll
                    for (int bj = 0; bj < 2; ++bj) { f32x4 v0 = acc[ai][bj][m][0] + bv[bj][0], v1 = acc[ai][bj][m][1] + bv[bj][1];
#pragma unroll
                        for (int j = 0; j < 4; ++j) { v0[j] = fast_sigmoid(v0[j]); v1[j] = fast_sigmoid(v1[j]); }
                        u32x4 w; w.x = cvt_pk_bf16_t(v0[0], v0[1]); w.y = cvt_pk_bf16_t(v0[2], v0[3]); w.z = cvt_pk_bf16_t(v1[0], v1[1]); w.w = cvt_pk_bf16_t(v1[2], v1[3]);
                        *(u32x4*)(rowp + bj * 8) = w; } }
        }
    }
};
template <bool BIAS> struct EpiBf16 { static constexpr bool PERM = true;
    bf16_t* O; int ldc; const float* bias; const int* tile_e; int bstride; float scl;
    __device__ __forceinline__ void operator()(AccRef acc, const Unit& u, int wr, int wc, int fr, int fq) const {
        const int row0 = u.pm * BM + wr * 64 + fr, col0 = u.pn * BM + wc * 64 + 16 * fq;
        f32x4 bv[2][2];
#pragma unroll
        for (int bj = 0; bj < 2; ++bj)
#pragma unroll
            for (int n = 0; n < 2; ++n) bv[bj][n] = (f32x4){0.f, 0.f, 0.f, 0.f};
        if constexpr (BIAS) { const float* bp = bias + (size_t)tile_e[u.pm] * bstride + col0;
#pragma unroll
            for (int bj = 0; bj < 2; ++bj)
#pragma unroll
                for (int n = 0; n < 2; ++n) bv[bj][n] = *(const f32x4*)(bp + bj * 8 + 4 * n); }
#pragma unroll
        for (int ai = 0; ai < 2; ++ai)
#pragma unroll
            for (int m = 0; m < 4; ++m) { bf16_t* rowp = O + (size_t)(row0 + ai * HALF + m * 16) * ldc + col0;
#pragma unroll
                for (int bj = 0; bj < 2; ++bj) *(u32x4*)(rowp + bj * 8) = pack8((acc[ai][bj][m][0] + bv[bj][0]) * scl, (acc[ai][bj][m][1] + bv[bj][1]) * scl); }
    }
};
struct EpiKV { static constexpr bool PERM = true;
    bf16_t* kmla; bf16_t* vmla;
    __device__ __forceinline__ void operator()(AccRef acc, const Unit& u, int wr, int wc, int fr, int fq) const {
        const int row0 = u.pm * BM + wr * 64 + fr, c0 = wc * 32 + 8 * fq;
#pragma unroll
        for (int ai = 0; ai < 2; ++ai)
#pragma unroll
            for (int m = 0; m < 4; ++m) { const size_t row = (size_t)(row0 + ai * HALF + m * 16);
                const size_t hrow = ((row >> 11) * 8 + u.pn) * 2048 + (row & 2047);
                *(u32x4*)(kmla + hrow * 192 + c0) = pack8(acc[ai][0][m][0], acc[ai][0][m][1]);
                *(u32x4*)(vmla + hrow * 128 + c0) = pack8(acc[ai][1][m][0], acc[ai][1][m][1]); }
    }
};
template <bool ADD> struct EpiGateMix { static constexpr bool PERM = true;
    bf16_t* O; const unsigned char* gates; int goff;
    __device__ __forceinline__ void operator()(AccRef acc, const Unit& u, int wr, int wc, int fr, int fq) const {
        const int row0 = u.pm * BM + wr * 64 + fr, col0 = u.pn * BM + wc * 32 + 8 * fq;
        constexpr float I255 = 1.0f / 255.0f;
#pragma unroll
        for (int ai = 0; ai < 2; ++ai) {
            u32x2 gw[4][2]; u32x4 pw[4][2];
#pragma unroll
            for (int m = 0; m < 4; ++m)
#pragma unroll
                for (int bj = 0; bj < 2; ++bj) { const size_t row = (size_t)(row0 + ai * HALF + m * 16);
                    gw[m][bj] = *(const u32x2*)(gates + row * NGATE + goff + col0 + bj * HALF);
                    if constexpr (ADD) pw[m][bj] = *(const u32x4*)(O + row * DM + col0 + bj * HALF); }
            asm volatile("s_waitcnt vmcnt(0)" ::: "memory");
#pragma unroll
            for (int m = 0; m < 4; ++m)
#pragma unroll
                for (int bj = 0; bj < 2; ++bj) { const size_t row = (size_t)(row0 + ai * HALF + m * 16); const u32x2 g2 = gw[m][bj];
                    f32x4 v0 = acc[ai][bj][m][0], v1 = acc[ai][bj][m][1];
                    v0[0] *= (float)(g2.x & 0xffu) * I255; v0[1] *= (float)((g2.x >> 8) & 0xffu) * I255; v0[2] *= (float)((g2.x >> 16) & 0xffu) * I255; v0[3] *= (float)(g2.x >> 24) * I255;
                    v1[0] *= (float)(g2.y & 0xffu) * I255; v1[1] *= (float)((g2.y >> 8) & 0xffu) * I255; v1[2] *= (float)((g2.y >> 16) & 0xffu) * I255; v1[3] *= (float)(g2.y >> 24) * I255;
                    if constexpr (ADD) { const u32x4 p4 = pw[m][bj];
                        v0[0] += bf_lo(p4.x); v0[1] += bf_hi(p4.x); v0[2] += bf_lo(p4.y); v0[3] += bf_hi(p4.y);
                        v1[0] += bf_lo(p4.z); v1[1] += bf_hi(p4.z); v1[2] += bf_lo(p4.w); v1[3] += bf_hi(p4.w); }
                    *(u32x4*)(O + row * DM + col0 + bj * HALF) = pack8(v0, v1); }
            asm volatile("" ::: "memory");
        }
    }
};
struct EpiGateMerge { static constexpr bool PERM = true;
    unsigned char* O; const unsigned char* gates;
    template <bool FINAL, class AccT> __device__ __forceinline__ void scale(AccT& acc, const Unit& u, int wr, int wc, int fr, int fq) const {
        const int row0 = u.pm * BM + wr * 64 + fr, col0 = u.pn * BM + wc * 64 + 16 * fq;
#pragma unroll
        for (int ai = 0; ai < 2; ++ai) {
            u32x2 ga[4][2], gb[4][2];
#pragma unroll
            for (int m = 0; m < 4; ++m)
#pragma unroll
                for (int bj = 0; bj < 2; ++bj) { const size_t row = (size_t)(row0 + ai * HALF + m * 16);
                    if constexpr (!FINAL) ga[m][bj] = *(const u32x2*)(gates + row * NGATE + col0 + bj * 8);
                    gb[m][bj] = *(const u32x2*)(gates + row * NGATE + DM + col0 + bj * 8); }
            asm volatile("s_waitcnt vmcnt(0)" ::: "memory");
#pragma unroll
            for (int m = 0; m < 4; ++m)
#pragma unroll
                for (int bj = 0; bj < 2; ++bj) { const size_t row = (size_t)(row0 + ai * HALF + m * 16);
                    float f[8];
#pragma unroll
                    for (int j = 0; j < 8; ++j) { const unsigned wb = j < 4 ? gb[m][bj].x : gb[m][bj].y; const float b = fmaxf((float)((wb >> (8 * (j & 3))) & 0xffu), 1.0f);
                        if constexpr (FINAL) f[j] = b * (1.0f / 255.0f);
                        else { const unsigned wa = j < 4 ? ga[m][bj].x : ga[m][bj].y; f[j] = (float)((wa >> (8 * (j & 3))) & 0xffu) * __builtin_amdgcn_rcpf(b); } }
                    f32x4 v0 = acc[ai][bj][m][0], v1 = acc[ai][bj][m][1];
                    v0[0] *= f[0]; v0[1] *= f[1]; v0[2] *= f[2]; v0[3] *= f[3]; v1[0] *= f[4]; v1[1] *= f[5]; v1[2] *= f[6]; v1[3] *= f[7];
                    if constexpr (FINAL) { int w0 = __builtin_amdgcn_cvt_pk_fp8_f32(v0[0] * 16.0f, v0[1] * 16.0f, 0, false); w0 = __builtin_amdgcn_cvt_pk_fp8_f32(v0[2] * 16.0f, v0[3] * 16.0f, w0, true);
                        int w1 = __builtin_amdgcn_cvt_pk_fp8_f32(v1[0] * 16.0f, v1[1] * 16.0f, 0, false); w1 = __builtin_amdgcn_cvt_pk_fp8_f32(v1[2] * 16.0f, v1[3] * 16.0f, w1, true);
                        *(u32x2*)(O + row * DM + col0 + bj * 8) = (u32x2){(unsigned)w0, (unsigned)w1}; }
                    else { acc[ai][bj][m][0] = v0; acc[ai][bj][m][1] = v1; } }
            asm volatile("" ::: "memory");
        }
    }
    __device__ __forceinline__ void mid(f32x4 (&acc)[2][2][4][2], const Unit& u, int wr, int wc, int fr, int fq) const { scale<false>(acc, u, wr, wc, fr, fq); }
    __device__ __forceinline__ void operator()(AccRef acc, const Unit& u, int wr, int wc, int fr, int fq) const { scale<true>(acc, u, wr, wc, fr, fq); }
};
struct EpiResF32 { static constexpr bool PERM = false;
    const float* x; float* out;
    __device__ __forceinline__ void operator()(AccRef acc, const Unit& u, int wr, int wc, int fr, int fq) const {
        const int row0 = u.pm * BM + wr * 64 + fr, col0 = u.pn * BM + wc * 32 + 4 * fq;
#pragma unroll
        for (int ai = 0; ai < 2; ++ai) {
            f32x4 xv[4][2][2];
#pragma unroll
            for (int m = 0; m < 4; ++m) { const size_t off = (size_t)(row0 + ai * HALF + m * 16) * DM + col0;
#pragma unroll
                for (int bj = 0; bj < 2; ++bj)
#pragma unroll
                    for (int n = 0; n < 2; ++n) xv[m][bj][n] = *(const f32x4*)(x + off + bj * HALF + n * 16); }
            asm volatile("s_waitcnt vmcnt(0)" ::: "memory");
#pragma unroll
            for (int m = 0; m < 4; ++m) { const size_t off = (size_t)(row0 + ai * HALF + m * 16) * DM + col0;
#pragma unroll
                for (int bj = 0; bj < 2; ++bj)
#pragma unroll
                    for (int n = 0; n < 2; ++n) *(f32x4*)(out + off + bj * HALF + n * 16) = xv[m][bj][n] + acc[ai][bj][m][n]; }
            asm volatile("" ::: "memory");
        }
    }
};
struct EpiResBf16 { static constexpr bool PERM = true;
    const float* x; bf16_t* out;
    __device__ __forceinline__ void operator()(AccRef acc, const Unit& u, int wr, int wc, int fr, int fq) const {
        const int row0 = u.pm * BM + wr * 64 + fr, col0 = u.pn * BM + wc * 64 + 16 * fq;
#pragma unroll
        for (int ai = 0; ai < 2; ++ai) {
            f32x4 xv[4][2][2];
#pragma unroll
            for (int m = 0; m < 4; ++m) { const size_t off = (size_t)(row0 + ai * HALF + m * 16) * DM + col0;
#pragma unroll
                for (int bj = 0; bj < 2; ++bj)
#pragma unroll
                    for (int n = 0; n < 2; ++n) xv[m][bj][n] = *(const f32x4*)(x + off + bj * 8 + n * 4); }
            asm volatile("s_waitcnt vmcnt(0)" ::: "memory");
#pragma unroll
            for (int m = 0; m < 4; ++m) { const size_t off = (size_t)(row0 + ai * HALF + m * 16) * DM + col0;
#pragma unroll
                for (int bj = 0; bj < 2; ++bj) *(u32x4*)(out + off + bj * 8) = pack8(xv[m][bj][0] + acc[ai][bj][m][0], xv[m][bj][1] + acc[ai][bj][m][1]); }
            asm volatile("" ::: "memory");
        }
    }
};
struct EpiSwiglu { static constexpr bool PERM = true;
    bf16_t* act; const float* bgu; const int* tile_e;
    __device__ __forceinline__ void operator()(AccRef acc, const Unit& u, int wr, int wc, int fr, int fq) const {
        const int row0 = u.pm * BM + wr * 64 + fr, p0 = u.pn * BM + wc * 32 + 8 * fq;
        const float* bp = bgu + (size_t)tile_e[u.pm] * (2 * DM) + p0;
        f32x4 bg[2], bu[2];
#pragma unroll
        for (int bj = 0; bj < 2; ++bj) { const f32x4 a = *(const f32x4*)(bp + bj * HALF), b = *(const f32x4*)(bp + bj * HALF + 4);
            bg[bj] = (f32x4){a[0], a[2], b[0], b[2]}; bu[bj] = (f32x4){a[1], a[3], b[1], b[3]}; }
#pragma unroll
        for (int ai = 0; ai < 2; ++ai)
#pragma unroll
            for (int m = 0; m < 4; ++m) { bf16_t* rowp = act + (size_t)(row0 + ai * HALF + m * 16) * DM + (p0 >> 1);
#pragma unroll
                for (int bj = 0; bj < 2; ++bj) { const f32x4 gt = acc[ai][bj][m][0] + bg[bj], up = acc[ai][bj][m][1] + bu[bj]; float o[4];
#pragma unroll
                    for (int j = 0; j < 4; ++j) { const float gg = fminf(gt[j], 7.0f), uu = fminf(fmaxf(up[j], -7.0f), 7.0f); o[j] = gg * fast_sigmoid(1.702f * gg) * (uu + 1.0f); }
                    u32x2 w; w.x = cvt_pk_bf16(o[0], o[1]); w.y = cvt_pk_bf16(o[2], o[3]);
                    *(u32x2*)(rowp + bj * (HALF / 2)) = w; } }
    }
};

typedef int v8i32 __attribute__((ext_vector_type(8)));
__host__ __device__ __forceinline__ int sw8(int row) { return ((row >> 1) & 7) ^ ((((row >> 2) ^ (row >> 3)) & 1) << 1); }
__host__ __device__ __forceinline__ int img8(int row, int c) { return row * 128 + ((c ^ sw8(row)) << 4); }
struct Gemm8 { const unsigned char* A; const unsigned char* Bt; int lda, K; const int* tile_e; size_t estride; const int* rowtok; };
typedef const f32x4 (&AccRef8)[2][2][4][2];
template <class Epi, bool MIDHOOK = false>
__device__ __forceinline__ void gemm_phase_f8(LAS unsigned char* lds, const Gemm8 g, const StaticOrder& S, const Epi& E) {
    int tid = threadIdx.x; asm volatile("" : "+v"(tid));
    const int wid = __builtin_amdgcn_readfirstlane(tid >> 6), lane = tid & 63, wr = wid >> 2, wc = wid & 3, r15 = lane & 15, kq = lane >> 4;
    int K = g.K; asm volatile("" : "+s"(K));
    const int nt = K / 128, lda = g.lda;
    unsigned voffB[2];
#pragma unroll
    for (int i = 0; i < 2; ++i) voffB[i] = (unsigned)(tid * 16 + i * 8192);
    const size_t kstep = 128;
    const size_t kstepB = 32768, hstepB = 16384, tstepB = (size_t)nt * 32768;
    const unsigned ldsw = (unsigned)wid * 1024u;
    const int sw = sw8(r15);
    int aadr[2], badr[2];
#pragma unroll
    for (int x = 0; x < 2; ++x) { const int c = 2 * kq + x; aadr[x] = (wr * 64 + r15) * 128 + ((c ^ sw) << 4); badr[x] = (wc * 32 + r15) * 128 + ((c ^ sw) << 4); }
#define PF8_SA(b, h) (((b) * 2 + (h)) * HTB)
#define PF8_SB(b, h) ((4 + (b) * 2 + (h)) * HTB)
#define PF8_STAGE(bufoff, gbase, voff) do { _Pragma("unroll") for (int _i = 0; _i < 2; ++_i) \
        __builtin_amdgcn_global_load_lds((const unsigned*)((const char*)(gbase) + (voff)[_i]), (LAS unsigned*)(lds + (bufoff) + ldsw + _i * 8192), 16, 0, 0); } while (0)
#define PF8_LD(dst, off) do { const u32x4 _a = *(const LAS u32x4*)(lds + (off)[0]), _b = *(const LAS u32x4*)(lds + (off)[1]); \
        dst = (v8i32){(int)_a.x, (int)_a.y, (int)_a.z, (int)_a.w, (int)_b.x, (int)_b.y, (int)_b.z, (int)_b.w}; } while (0)
#define PF8_LDA(dst, b, h) do { _Pragma("unroll") for (int tb = 0; tb < 4; ++tb) { const int _o[2] = {PF8_SA(b, h) + aadr[0] + tb * 2048, PF8_SA(b, h) + aadr[1] + tb * 2048}; PF8_LD(dst[tb], _o); } } while (0)
#define PF8_LDB(dst, b, h) do { _Pragma("unroll") for (int pb = 0; pb < 2; ++pb) { const int _o[2] = {PF8_SB(b, h) + badr[0] + pb * 2048, PF8_SB(b, h) + badr[1] + pb * 2048}; PF8_LD(dst[pb], _o); } } while (0)
#define PF8_MMA(ai, bj, At, Bt) do { __builtin_amdgcn_s_setprio(1); _Pragma("unroll") for (int tb = 0; tb < 4; ++tb) _Pragma("unroll") for (int pb = 0; pb < 2; ++pb) \
        acc[ai][bj][tb][pb] = __builtin_amdgcn_mfma_scale_f32_16x16x128_f8f6f4(Bt[pb], At[tb], acc[ai][bj][tb][pb], 0, 0, 0, 0, 0, 0); __builtin_amdgcn_s_setprio(0); } while (0)
#define PF8_WAIT_V(n) asm volatile("s_waitcnt vmcnt(" #n ")" ::: "memory")
#define PF8_WAIT_L(n) asm volatile("s_waitcnt lgkmcnt(" #n ")" ::: "memory")
#define PF8_BAR __builtin_amdgcn_s_barrier()
#define PF8_SCHED __builtin_amdgcn_sched_barrier(0)
#define PF8_AOFF(vo, u) do { int _t = tid; asm volatile("" : "+v"(_t)); \
        _Pragma("unroll") for (int _i = 0; _i < 2; ++_i) { const int _p = _t + 512 * _i, _R = _p >> 3, _C = ((_p & 7) ^ sw8(_R)) << 4; \
        _Pragma("unroll") for (int _h = 0; _h < 2; ++_h) { const int _r = (u).pm * BM + _h * HALF + _R; (vo)[_h][_i] = (unsigned)(g.rowtok[_r] * lda + _C); } } } while (0)
    Unit cur, nxt; int ui = 0;
    LAS int* const te_l = (LAS int*)(lds + STAGE_BYTES + 2048);
    if (g.tile_e) { for (int i = tid; i < S.nM; i += NTHREADS) te_l[i] = g.tile_e[i]; }
    __syncthreads();
    if (!S.next(0, cur)) return;
    f32x4 acc[2][2][4][2];
#pragma unroll
    for (int a = 0; a < 2; ++a)
#pragma unroll
        for (int b = 0; b < 2; ++b)
#pragma unroll
            for (int m = 0; m < 4; ++m)
#pragma unroll
                for (int r = 0; r < 2; ++r) acc[a][b][m][r] = (f32x4){0.f, 0.f, 0.f, 0.f};
    v8i32 At[4], B0[2], B1[2];
    unsigned voC[2][2];
    LAS u32x4* const gslot = (LAS u32x4*)(lds + STAGE_BYTES) + tid;
    PF8_AOFF(voC, cur);
    const char* const Abase = (const char*)g.A;
    const char* cB = (const char*)g.Bt + (g.tile_e ? (size_t)g.tile_e[cur.pm] * g.estride : (size_t)0) + (size_t)cur.pn * tstepB;
    PF8_STAGE(PF8_SB(0, 0), cB, voffB); PF8_STAGE(PF8_SB(0, 1), cB + hstepB, voffB); PF8_STAGE(PF8_SA(0, 0), Abase, voC[0]); PF8_STAGE(PF8_SA(0, 1), Abase, voC[1]);
    if (wr == 1) PF8_BAR;
    PF8_WAIT_V(2); PF8_BAR;
    PF8_STAGE(PF8_SB(1, 0), cB + kstepB, voffB); PF8_STAGE(PF8_SA(1, 0), Abase + kstep, voC[0]); PF8_STAGE(PF8_SB(1, 1), cB + hstepB + kstepB, voffB);
    PF8_WAIT_V(6); PF8_BAR;
    for (;;) {
        const bool has_next = S.next(ui + 1, nxt);
        const char* nB = cB;
        if (has_next) { const int npm = __builtin_amdgcn_readfirstlane(nxt.pm);
            nB = (const char*)g.Bt + (g.tile_e ? (size_t)te_l[npm] * g.estride : (size_t)0) + (size_t)nxt.pn * tstepB;
            if (wid == 0) glds16_asm((const char*)(g.rowtok + (size_t)npm * BM), (unsigned)(lane * 16), (unsigned)(size_t)(lds + STAGE_BYTES + ((ui + 1) & 1) * 1024)); }
#pragma unroll 1
        for (int t = 0; t < nt; t += 2) {
            const bool last = (t == nt - 2);
            if constexpr (MIDHOOK) { if (t == nt / 2) { int ln_ = lane; asm volatile("" : "+v"(ln_)); E.mid(acc, cur, wr, wc, ln_ & 15, ln_ >> 4); } }
            const char* a1 = Abase + (size_t)(t + 1) * kstep;
            const char* a2 = last ? Abase : Abase + (size_t)(t + 2) * kstep; const char* b2 = last ? nB : cB + (size_t)(t + 2) * kstepB;
            const char* a3 = a2 + kstep; const char* b3 = b2 + kstepB;
            PF8_LDB(B0, 0, 0); PF8_LDB(B1, 0, 1); PF8_SCHED; PF8_LDA(At, 0, 0); PF8_STAGE(PF8_SA(1, 1), a1, voC[1]);
            if (last && has_next) { const LAS int* rt = (const LAS int*)(lds + STAGE_BYTES + ((ui + 1) & 1) * 1024); PF8_AOFF_LDS(voC, rt); }
            PF8_WAIT_V(8); PF8_WAIT_L(0); PF8_BAR; PF8_MMA(0, 0, At, B0); PF8_MMA(0, 1, At, B1); PF8_BAR; PF8_SCHED;
            PF8_LDA(At, 0, 1); PF8_STAGE(PF8_SB(0, 0), b2, voffB); PF8_STAGE(PF8_SB(0, 1), b2 + hstepB, voffB); PF8_STAGE(PF8_SA(0, 0), a2, voC[0]);
            PF8_WAIT_V(8); PF8_WAIT_L(0); PF8_BAR; PF8_MMA(1, 0, At, B0); PF8_MMA(1, 1, At, B1); PF8_BAR; PF8_SCHED;
            PF8_LDB(B0, 1, 0); PF8_LDB(B1, 1, 1); PF8_SCHED; PF8_LDA(At, 1, 0); PF8_STAGE(PF8_SA(0, 1), a2, voC[1]);
            PF8_WAIT_V(8); PF8_WAIT_L(0); PF8_BAR; PF8_MMA(0, 0, At, B0); PF8_MMA(0, 1, At, B1); PF8_BAR; PF8_SCHED;
            PF8_LDA(At, 1, 1); PF8_STAGE(PF8_SB(1, 0), b3, voffB); PF8_STAGE(PF8_SB(1, 1), b3 + hstepB, voffB); PF8_STAGE(PF8_SA(1, 0), a3, voC[0]);
            PF8_WAIT_V(8); PF8_WAIT_L(0); PF8_BAR; PF8_MMA(1, 0, At, B0); PF8_MMA(1, 1, At, B1); PF8_BAR; PF8_SCHED;
        }
        if (wr == 0) PF8_BAR;
        { int ln_ = lane; asm volatile("" : "+v"(ln_)); E(acc, cur, wr, wc, ln_ & 15, ln_ >> 4); }
        if (!has_next) break;
#pragma unroll
        for (int a = 0; a < 2; ++a)
#pragma unroll
            for (int b = 0; b < 2; ++b)
#pragma unroll
                for (int m = 0; m < 4; ++m)
#pragma unroll
                    for (int r = 0; r < 2; ++r) acc[a][b][m][r] = (f32x4){0.f, 0.f, 0.f, 0.f};
        cur = nxt; cB = nB; ++ui;
        if (wr == 1) PF8_BAR;
    }
    PF8_WAIT_V(0);
    PF8_BAR;
#undef PF8_SA
#undef PF8_SB
#undef PF8_STAGE
#undef PF8_LD
#undef PF8_LDA
#undef PF8_LDB
#undef PF8_MMA
#undef PF8_WAIT_V
#undef PF8_WAIT_L
#undef PF8_BAR
#undef PF8_SCHED
#undef PF8_AOFF
}
struct EpiSwiglu8 {
    unsigned char* act; const float* bgu; const int* tile_e;
    __device__ __forceinline__ void operator()(AccRef8 acc, const Unit& u, int wr, int wc, int t15, int q) const {
        const int row0 = u.pm * BM + wr * 64 + t15;
        const float* bp = bgu + (size_t)tile_e[u.pm] * (2 * DM);
        const int ja = u.pn * 128 + 32 * wc + 8 * q;
        const f32x4 b0 = *(const f32x4*)(bp + 2 * ja), b1 = *(const f32x4*)(bp + 2 * ja + 4), b2 = *(const f32x4*)(bp + 2 * ja + 8), b3 = *(const f32x4*)(bp + 2 * ja + 12);
        const float bg[8] = {b0[0], b0[2], b1[0], b1[2], b2[0], b2[2], b3[0], b3[2]}, bu[8] = {b0[1], b0[3], b1[1], b1[3], b2[1], b2[3], b3[1], b3[3]};
#pragma unroll
        for (int ai = 0; ai < 2; ++ai)
#pragma unroll
            for (int tb = 0; tb < 4; ++tb) { float o[8];
#pragma unroll
                for (int bj = 0; bj < 2; ++bj)
#pragma unroll
                    for (int j = 0; j < 4; j += 2) {
                        typedef float f32x2_ __attribute__((ext_vector_type(2)));
                        const f32x2_ a0 = {acc[ai][bj][tb][0][j], acc[ai][bj][tb][0][j + 1]}, a1 = {acc[ai][bj][tb][1][j], acc[ai][bj][tb][1][j + 1]};
                        const f32x2_ bg2 = {bg[4 * bj + j], bg[4 * bj + j + 1]}, bu2 = {bu[4 * bj + j], bu[4 * bj + j + 1]};
                        f32x2_ gt = a0 * 0.015625f + bg2, up = a1 * 0.015625f + bu2;
                        gt[0] = fminf(gt[0], 7.0f); gt[1] = fminf(gt[1], 7.0f); up[0] = fminf(fmaxf(up[0], -7.0f), 7.0f); up[1] = fminf(fmaxf(up[1], -7.0f), 7.0f);
                        f32x2_ e = gt * (-1.702f * 1.4426950408889634f); e[0] = __builtin_amdgcn_exp2f(e[0]); e[1] = __builtin_amdgcn_exp2f(e[1]);
                        f32x2_ d = e + 1.0f; d[0] = __builtin_amdgcn_rcpf(d[0]); d[1] = __builtin_amdgcn_rcpf(d[1]);
                        const f32x2_ r = gt * d * (up + 1.0f); o[4 * bj + j] = r[0]; o[4 * bj + j + 1] = r[1]; }
                int w0 = __builtin_amdgcn_cvt_pk_fp8_f32(o[0], o[1], 0, false); w0 = __builtin_amdgcn_cvt_pk_fp8_f32(o[2], o[3], w0, true);
                int w1 = __builtin_amdgcn_cvt_pk_fp8_f32(o[4], o[5], 0, false); w1 = __builtin_amdgcn_cvt_pk_fp8_f32(o[6], o[7], w1, true);
                *(u32x2*)(act + (size_t)(row0 + ai * HALF + tb * 16) * DM + ja) = (u32x2){(unsigned)w0, (unsigned)w1}; }
    }
};
struct EpiDown8 {
    unsigned char* y; const float* bd; const int* tile_e;
    __device__ __forceinline__ void operator()(AccRef8 acc, const Unit& u, int wr, int wc, int t15, int q) const {
        const int row0 = u.pm * BM + wr * 64 + t15;
        const float* bp = bd + (size_t)tile_e[u.pm] * DM;
        const int c0 = u.pn * BM + 64 * wc + 16 * q;
        f32x4 bb[2][2];
#pragma unroll
        for (int bj = 0; bj < 2; ++bj)
#pragma unroll
            for (int pb = 0; pb < 2; ++pb) bb[bj][pb] = *(const f32x4*)(bp + c0 + 8 * bj + 4 * pb);
#pragma unroll
        for (int ai = 0; ai < 2; ++ai)
#pragma unroll
            for (int tb = 0; tb < 4; ++tb) { int w4[4];
#pragma unroll
                for (int bj = 0; bj < 2; ++bj)
#pragma unroll
                    for (int pb = 0; pb < 2; ++pb) { const f32x4 o = acc[ai][bj][tb][pb] * 0.015625f + bb[bj][pb];
                        const int x = __builtin_amdgcn_cvt_pk_fp8_f32(o[0], o[1], 0, false); w4[2 * bj + pb] = __builtin_amdgcn_cvt_pk_fp8_f32(o[2], o[3], x, true); }
                *(u32x4*)(y + (size_t)(row0 + ai * HALF + tb * 16) * DM + c0) = (u32x4){(unsigned)w4[0], (unsigned)w4[1], (unsigned)w4[2], (unsigned)w4[3]}; }
    }
};
struct EpiGateMerge8 {
    unsigned char* O; const unsigned char* gates;
    template <bool FINAL, class AccT> __device__ __forceinline__ void scale(AccT& acc, const Unit& u, int wr, int wc, int t15, int q) const {
        const int row0 = u.pm * BM + wr * 64 + t15, c0 = u.pn * BM + 64 * wc + 16 * q;
#pragma unroll
        for (int ai = 0; ai < 2; ++ai) {
            u32x4 ga[4], gb[4];
#pragma unroll
            for (int tb = 0; tb < 4; ++tb) { const size_t row = (size_t)(row0 + ai * HALF + tb * 16);
                if constexpr (!FINAL) ga[tb] = *(const u32x4*)(gates + row * NGATE + c0);
                gb[tb] = *(const u32x4*)(gates + row * NGATE + DM + c0); }
            asm volatile("s_waitcnt vmcnt(0)" ::: "memory");
#pragma unroll
            for (int tb = 0; tb < 4; ++tb) { const size_t row = (size_t)(row0 + ai * HALF + tb * 16); int w4[4];
#pragma unroll
                for (int bj = 0; bj < 2; ++bj)
#pragma unroll
                    for (int pb = 0; pb < 2; ++pb) { const unsigned wb = gb[tb][2 * bj + pb]; f32x4 v = acc[ai][bj][tb][pb];
#pragma unroll
                        for (int j = 0; j < 4; ++j) { const float b = fmaxf((float)((wb >> (8 * j)) & 0xffu), 1.0f);
                            if constexpr (FINAL) v[j] *= b * (1.0f / (255.0f * 64.0f));
                            else { const unsigned wa = ga[tb][2 * bj + pb]; v[j] *= (float)((wa >> (8 * j)) & 0xffu) * __builtin_amdgcn_rcpf(b); } }
                        if constexpr (FINAL) { const int x = __builtin_amdgcn_cvt_pk_fp8_f32(v[0], v[1], 0, false); w4[2 * bj + pb] = __builtin_amdgcn_cvt_pk_fp8_f32(v[2], v[3], x, true); }
                        else acc[ai][bj][tb][pb] = v; }
                if constexpr (FINAL) *(u32x4*)(O + row * DM + c0) = (u32x4){(unsigned)w4[0], (unsigned)w4[1], (unsigned)w4[2], (unsigned)w4[3]}; }
            asm volatile("" ::: "memory");
        }
    }
    __device__ __forceinline__ void mid(f32x4 (&acc)[2][2][4][2], const Unit& u, int wr, int wc, int t15, int q) const { scale<false>(acc, u, wr, wc, t15, q); }
    __device__ __forceinline__ void operator()(AccRef8 acc, const Unit& u, int wr, int wc, int t15, int q) const { scale<true>(acc, u, wr, wc, t15, q); }
};
struct EpiProj8 {
    bf16_t* proj; float* ssqp;
    __device__ __forceinline__ void operator()(AccRef8 acc, const Unit& u, int wr, int wc, int t15, int q) const {
        const int row0 = u.pm * BM + wr * 64 + t15, c0 = u.pn * BM + 64 * wc + 16 * q;
        const bool lat = (u.pn >= 5) && (u.pn <= 7);
#pragma unroll
        for (int ai = 0; ai < 2; ++ai)
#pragma unroll
            for (int tb = 0; tb < 4; ++tb) { const size_t row = (size_t)(row0 + ai * HALF + tb * 16); bf16_t* rowp = proj + row * NPROJ + c0;
#pragma unroll
                for (int bj = 0; bj < 2; ++bj) *(u32x4*)(rowp + 8 * bj) = pack8(acc[ai][bj][tb][0] * 0.015625f, acc[ai][bj][tb][1] * 0.015625f);
                if (lat) { f32x4 sq = {0.f, 0.f, 0.f, 0.f};
#pragma unroll
                    for (int bj = 0; bj < 2; ++bj)
#pragma unroll
                        for (int pb = 0; pb < 2; ++pb) { const f32x4 v = acc[ai][bj][tb][pb] * 0.015625f; sq += v * v; }
                    float ss = (sq[0] + sq[1]) + (sq[2] + sq[3]);
                    ss += __shfl_xor(ss, 16); ss += __shfl_xor(ss, 32);
                    if (q == 0) ssqp[row * 12 + 4 * (u.pn - 5) + wc] = ss; } }
    }
};
struct EpiRes8 {
    const float* x; bf16_t* out; float* ssqh;
    __device__ __forceinline__ void operator()(AccRef8 acc, const Unit& u, int wr, int wc, int t15, int q) const {
        const int row0 = u.pm * BM + wr * 64 + t15, c0 = u.pn * BM + 64 * wc + 16 * q;
#pragma unroll
        for (int ai = 0; ai < 2; ++ai) {
            f32x4 xv[4][2][2];
#pragma unroll
            for (int tb = 0; tb < 4; ++tb) { const size_t off = (size_t)(row0 + ai * HALF + tb * 16) * DM + c0;
#pragma unroll
                for (int bj = 0; bj < 2; ++bj)
#pragma unroll
                    for (int pb = 0; pb < 2; ++pb) xv[tb][bj][pb] = *(const f32x4*)(x + off + 8 * bj + 4 * pb); }
            asm volatile("s_waitcnt vmcnt(0)" ::: "memory");
#pragma unroll
            for (int tb = 0; tb < 4; ++tb) { const size_t row = (size_t)(row0 + ai * HALF + tb * 16), off = row * DM + c0; f32x4 sq = {0.f, 0.f, 0.f, 0.f};
#pragma unroll
                for (int bj = 0; bj < 2; ++bj) { const f32x4 h0 = xv[tb][bj][0] + acc[ai][bj][tb][0] * (1.0f / 1024.0f), h1 = xv[tb][bj][1] + acc[ai][bj][tb][1] * (1.0f / 1024.0f);
                    *(u32x4*)(out + off + 8 * bj) = pack8(h0, h1); sq += h0 * h0 + h1 * h1; }
                float ss = (sq[0] + sq[1]) + (sq[2] + sq[3]); ss += __shfl_xor(ss, 16); ss += __shfl_xor(ss, 32);
                if (q == 0) ssqh[row * 32 + 4 * u.pn + wc] = ss; }
            asm volatile("" ::: "memory");
        }
    }
};
struct EpiGates8 {
    unsigned char* gates; const float* b_gate;
    __device__ __forceinline__ void operator()(AccRef8 acc, const Unit& u, int wr, int wc, int t15, int q) const {
        const int row0 = u.pm * BM + wr * 64 + t15;
        const int c0 = u.pn * BM + 64 * wc + 16 * q;
        f32x4 bb[2][2];
#pragma unroll
        for (int bj = 0; bj < 2; ++bj)
#pragma unroll
            for (int pb = 0; pb < 2; ++pb) bb[bj][pb] = *(const f32x4*)(b_gate + c0 + 8 * bj + 4 * pb);
#pragma unroll
        for (int ai = 0; ai < 2; ++ai)
#pragma unroll
            for (int tb = 0; tb < 4; ++tb) { unsigned qq[4];
#pragma unroll
                for (int bj = 0; bj < 2; ++bj)
#pragma unroll
                    for (int pb = 0; pb < 2; ++pb) { float o[4];
#pragma unroll
                        for (int j = 0; j < 4; j += 2) {
                            typedef float f32x2_ __attribute__((ext_vector_type(2)));
                            const f32x2_ a = {acc[ai][bj][tb][pb][j], acc[ai][bj][tb][pb][j + 1]}, b2 = {bb[bj][pb][j], bb[bj][pb][j + 1]};
                            f32x2_ e = (a * 0.015625f + b2) * -1.4426950408889634f; e[0] = __builtin_amdgcn_exp2f(e[0]); e[1] = __builtin_amdgcn_exp2f(e[1]);
                            f32x2_ d = e + 1.0f; d[0] = __builtin_amdgcn_rcpf(d[0]); d[1] = __builtin_amdgcn_rcpf(d[1]);
                            const f32x2_ r = d * 255.0f + 0.5f; o[j] = r[0]; o[j + 1] = r[1]; }
                        qq[2 * bj + pb] = (unsigned)o[0] | ((unsigned)o[1] << 8) | ((unsigned)o[2] << 16) | ((unsigned)o[3] << 24); }
                *(u32x4*)(gates + (size_t)(row0 + ai * HALF + tb * 16) * NGATE + c0) = (u32x4){qq[0], qq[1], qq[2], qq[3]}; }
    }
};
}

struct Args { const void* in[21]; float* out; unsigned char* ws; int ph_lo, ph_hi; };

struct Frame {
    LAS unsigned char* lds; unsigned char* ws; unsigned* ctl;
    int tid, lane, wave, G, bx;
    const float *x, *g_attn, *w_in, *b_gate, *sinks, *g_q, *w_uq, *g_kv, *w_ukv, *w_o_swa, *w_o_mla, *w_out, *g_ffn, *w_router, *b_router, *w_gate_up, *b_gate_up, *w_down, *b_down, *g_final;
    const int* positions; float* out;
};

template <int MODE> __device__ __forceinline__ int rowmap(int n) {
    if (MODE == 1) return n < NLOW ? n : n + (NPROJ - NLOW);
    if (MODE == 2) { const int j = n >> 1, t = n & 1; return 8 * (j >> 2) + 4 * t + (j & 3); }
    return n;
}
__device__ __forceinline__ int perm32_inv(int x) { return 16 * ((x >> 2) & 1) + 4 * (x >> 3) + (x & 3); }
__host__ __device__ __forceinline__ int wide_map(int c) { return 128 * ((c >> 3) & 1) + 32 * (c >> 6) + 8 * ((c >> 4) & 3) + (c & 7); }
template <int MODE, bool PERM, bool WIDE = false> __device__ __forceinline__ void p0_convert_item(const float* W, int K, int N, bf16_t* WB, int item, int lane, int ldw = 0, int nkt_img = 0, int kt_off = 0, const float* kgain = nullptr) {
    if (ldw == 0) ldw = N;
    const int nblk = (N + 255) / 256, kb = item / nblk, nb = item % nblk, k0 = 32 * kb, n = 256 * nb + 4 * lane;
    if (n >= N) return;
    const f32x4* src = (const f32x4*)(W + (size_t)k0 * ldw + n);
    f32x4 v[32];
#pragma unroll
    for (int r = 0; r < 32; ++r) v[r] = src[(size_t)r * (ldw / 4)];
    if (kgain) {
#pragma unroll
        for (int r = 0; r < 32; ++r) v[r] = v[r] * kgain[k0 + r]; }
    const int nkt = nkt_img ? nkt_img : K / 64;
#pragma unroll
    for (int cmp = 0; cmp < 4; ++cmp) {
        const int p0_ = rowmap<MODE>(n + cmp), p = WIDE ? (p0_ & ~255) + wide_map(p0_ & 255) : p0_, q = p & 127, R = PERM ? ((q & ~31) + perm32_inv(q & 31)) : q;
        char* tile = (char*)WB + ((size_t)(p >> 8) * nkt + kt_off + (kb >> 1)) * 32768 + ((p >> 7) & 1) * 16384;
#pragma unroll
        for (int g8 = 0; g8 < 4; ++g8) { u32x4 o;
            o.x = cvt_pk_bf16(v[8 * g8 + 0][cmp], v[8 * g8 + 1][cmp]); o.y = cvt_pk_bf16(v[8 * g8 + 2][cmp], v[8 * g8 + 3][cmp]);
            o.z = cvt_pk_bf16(v[8 * g8 + 4][cmp], v[8 * g8 + 5][cmp]); o.w = cvt_pk_bf16(v[8 * g8 + 6][cmp], v[8 * g8 + 7][cmp]);
            *(u32x4*)(tile + pg8::lds_byte(R, 32 * (kb & 1) + 8 * g8)) = o; }
    }
}
template <bool GU> __device__ __forceinline__ void p0_convert_item_f8(const float* W, int K, int N, unsigned char* WB, int item, int lane, int ldw = 0, int nkt_img = 0, int kt_off = 0) {
    if (ldw == 0) ldw = N;
    const int nblk = (N + 255) / 256, kb = item / nblk, nb = item % nblk, k0 = 32 * kb, n = 256 * nb + 4 * lane;
    if (n >= N) return;
    const f32x4* src = (const f32x4*)(W + (size_t)k0 * ldw + n);
    f32x4 v[32];
#pragma unroll
    for (int r = 0; r < 32; ++r) v[r] = src[(size_t)r * (ldw / 4)];
    const int nkt = nkt_img ? nkt_img : K / 128, kt = kt_off + (k0 >> 7), c0 = (k0 & 127) >> 4;
#pragma unroll
    for (int cmp = 0; cmp < 4; ++cmp) {
        const int nl = n + cmp, j = (nl & 255) >> 1, t = nl & 1;
        const int P = (nl & ~255) + (GU ? 128 * ((j >> 2) & 1) + 32 * (j >> 5) + 16 * t + 4 * ((j >> 3) & 3) + (j & 3) : 128 * ((nl >> 3) & 1) + 32 * ((nl >> 6) & 3) + 16 * ((nl >> 2) & 1) + 4 * ((nl >> 4) & 3) + (nl & 3));
        const int q = P & 127, row = q;
        unsigned char* tile = WB + ((size_t)(P >> 8) * nkt + kt) * 32768 + ((P >> 7) & 1) * 16384;
#pragma unroll
        for (int g = 0; g < 2; ++g) { int w[4];
#pragma unroll
            for (int d = 0; d < 4; ++d) { int x = __builtin_amdgcn_cvt_pk_fp8_f32(v[16 * g + 4 * d + 0][cmp] * 64.0f, v[16 * g + 4 * d + 1][cmp] * 64.0f, 0, false);
                w[d] = __builtin_amdgcn_cvt_pk_fp8_f32(v[16 * g + 4 * d + 2][cmp] * 64.0f, v[16 * g + 4 * d + 3][cmp] * 64.0f, x, true); }
            *(u32x4*)(tile + pg8::img8(row, c0 + g)) = (u32x4){(unsigned)w[0], (unsigned)w[1], (unsigned)w[2], (unsigned)w[3]}; }
    }
}
__device__ __forceinline__ void p0_moe_convert_block(Frame& F) {
    constexpr int NI_GU = NEXP * 16 * 16, NI_D = NEXP * 16 * 8, NIT = NI_GU + NI_D;
    const int lane = F.lane, w = F.wave, tid = F.tid;
    unsigned char* WGU = (unsigned char*)(F.ws + WS_WGU); unsigned char* WD = (unsigned char*)(F.ws + WS_WD);
#define MC_SRC(it, srcp, ldw_, dstp, gu_, gk_) do { int r_ = (it); const float* W_; int N_; unsigned char* D_; \
        if (r_ < NI_GU) { const int e_ = r_ >> 8, rem_ = r_ & 255, kt_ = rem_ >> 4, pn_ = rem_ & 15; W_ = F.w_gate_up + (size_t)e_ * DM * 2 * DM + (size_t)(128 * kt_) * (2 * DM) + 256 * pn_; N_ = 2 * DM; \
            D_ = WGU + (size_t)e_ * 2 * DM * DM + ((size_t)pn_ * 16 + kt_) * 32768; gu_ = true; gk_ = F.g_ffn + 128 * kt_ + 16 * w; }     \
        else { r_ -= NI_GU; const int e_ = r_ >> 7, rem_ = r_ & 127, kt_ = rem_ >> 3, pn_ = rem_ & 7; W_ = F.w_down + (size_t)e_ * DM * DM + (size_t)(128 * kt_) * DM + 256 * pn_; N_ = DM; \
            D_ = WD + (size_t)e_ * DM * DM + ((size_t)pn_ * 16 + kt_) * 32768; gu_ = false; } \
        srcp = (const f32x4*)(W_ + (size_t)(16 * w) * N_ + 4 * lane); ldw_ = N_ / 4; dstp = D_; } while (0)
#define MC_LOAD(v, srcp, ldw_) do { _Pragma("unroll") for (int r = 0; r < 16; ++r) v[r] = srcp[(size_t)r * ldw_]; } while (0)
#define MC_STEP(v, buf, dstp, gu_, gk_) do { float gs_[16]; _Pragma("unroll") for (int r = 0; r < 16; ++r) gs_[r] = gu_ ? gk_[r] * 64.0f : 64.0f; \
        _Pragma("unroll") for (int cmp = 0; cmp < 4; ++cmp) { const int nl = 4 * lane + cmp, j = nl >> 1, t = nl & 1, P = gu_ ? 128 * ((j >> 2) & 1) + 32 * (j >> 5) + 16 * t + 4 * ((j >> 3) & 3) + (j & 3) : 128 * ((nl >> 3) & 1) + 32 * ((nl >> 6) & 3) + 16 * ((nl >> 2) & 1) + 4 * ((nl >> 4) & 3) + (nl & 3); \
            const int q = P & 127, row = q; int wq[4]; \
            _Pragma("unroll") for (int d = 0; d < 4; ++d) { const int x = __builtin_amdgcn_cvt_pk_fp8_f32(v[4 * d + 0][cmp] * gs_[4 * d + 0], v[4 * d + 1][cmp] * gs_[4 * d + 1], 0, false); \
                wq[d] = __builtin_amdgcn_cvt_pk_fp8_f32(v[4 * d + 2][cmp] * gs_[4 * d + 2], v[4 * d + 3][cmp] * gs_[4 * d + 3], x, true); } \
            *(LAS u32x4*)((buf) + ((P >> 7) & 1) * 16384 + pg8::img8(row, w)) = (u32x4){(unsigned)wq[0], (unsigned)wq[1], (unsigned)wq[2], (unsigned)wq[3]}; } \
        __syncthreads(); \
        _Pragma("unroll") for (int q4 = 0; q4 < 4; ++q4) *(u32x4*)((dstp) + tid * 16 + q4 * 8192) = *(const LAS u32x4*)((buf) + tid * 16 + q4 * 8192); } while (0)
    f32x4 va[16], vb[16];
    const f32x4* sa; const f32x4* sb; int la = 0, lb = 0; unsigned char* da = nullptr; unsigned char* db = nullptr; bool ga = false, gb = false; const float* gka = F.g_ffn; const float* gkb = F.g_ffn;
    int it = F.bx;
    if (it < NIT) { MC_SRC(it, sa, la, da, ga, gka); MC_LOAD(va, sa, la); }
    __syncthreads();
    for (; it < NIT; it += 2 * F.G) {
        const int it1 = it + F.G, it2 = it + 2 * F.G;
        if (it1 < NIT) { MC_SRC(it1, sb, lb, db, gb, gkb); MC_LOAD(vb, sb, lb); }
        MC_STEP(va, F.lds, da, ga, gka);
        if (it1 < NIT) {
            if (it2 < NIT) { MC_SRC(it2, sa, la, da, ga, gka); MC_LOAD(va, sa, la); }
            MC_STEP(vb, F.lds + 32768, db, gb, gkb);
        }
    }
    __syncthreads();
#undef MC_SRC
#undef MC_LOAD
#undef MC_STEP
}
__device__ __forceinline__ void p0_prologue(Frame& F) {
    const int gw = F.bx * NWAVES + F.wave, NGW = F.G * NWAVES;
    bf16_t* WIN = (bf16_t*)(F.ws + WS_WIN); bf16_t* WUQ = (bf16_t*)(F.ws + WS_WUQ); bf16_t* WUKV = (bf16_t*)(F.ws + WS_WUKV);
    bf16_t* WOA = (bf16_t*)(F.ws + WS_WOA); bf16_t* WOB = (bf16_t*)(F.ws + WS_WOB); bf16_t* WOUT = (bf16_t*)(F.ws + WS_WOUT);
    bf16_t* WGU = (bf16_t*)(F.ws + WS_WGU); bf16_t* WD = (bf16_t*)(F.ws + WS_WD);
    constexpr int I_IN = (DM / 32) * ((NLOW + 255) / 256), I_ING = (DM / 32) * (NGATE / 256), I_UQ = (512 / 32) * (1536 / 256), I_UKV = (256 / 32) * (2048 / 256), I_OA = (1024 / 32) * (DM / 256), I_OUT = (DM / 32) * (DM / 256);
    constexpr int I_GU1 = (DM / 32) * (2 * DM / 256), I_D1 = (DM / 32) * (DM / 256);
    (void)WGU; (void)WD; (void)I_GU1; (void)I_D1;
    constexpr int NITEMS = I_IN + I_ING + I_UQ + I_UKV + 2 * I_OA + I_OUT;
    for (int it = gw; it < NITEMS; it += NGW) {
        int r = it;
        if (r < I_IN) { p0_convert_item_f8<false>(F.w_in, DM, NLOW, (unsigned char*)WIN, r, F.lane, NIN_LOG); continue; } r -= I_IN;
        if (r < I_ING) { p0_convert_item_f8<false>(F.w_in + NLOW, DM, NGATE, (unsigned char*)WIN + WIN_GATES_OFF, r, F.lane, NIN_LOG); continue; } r -= I_ING;
        if (r < I_UQ) { p0_convert_item<0, true, true>(F.w_uq, 512, 1536, WUQ, r, F.lane, 0, 0, 0, F.g_q); continue; } r -= I_UQ;
        if (r < I_UKV) { p0_convert_item<0, true>(F.w_ukv, 256, 2048, WUKV, r, F.lane, 0, 0, 0, F.g_kv); continue; } r -= I_UKV;
        if (r < I_OA) { p0_convert_item_f8<false>(F.w_o_swa, 1024, DM, (unsigned char*)WOA, r, F.lane, 0, 16, 0); continue; } r -= I_OA;
        if (r < I_OA) { (void)WOB; p0_convert_item_f8<false>(F.w_o_mla, 1024, DM, (unsigned char*)WOA, r, F.lane, 0, 16, 8); continue; } r -= I_OA;
        { p0_convert_item_f8<false>(F.w_out, DM, DM, (unsigned char*)WOUT, r, F.lane); }
    }
    p0_moe_convert_block(F);
    { constexpr int NPAD = NPROJ - NLOW, nz = (DM / 128) * NPAD * 8;
      for (int i = F.bx * NTHREADS + F.tid; i < nz; i += F.G * NTHREADS) { const int c = i & 7, col = (i >> 3) % NPAD, kt = (i >> 3) / NPAD, p0_ = NLOW + col, nl = p0_ & 255;
          const int P = (p0_ & ~255) + 128 * ((nl >> 3) & 1) + 32 * ((nl >> 6) & 3) + 16 * ((nl >> 2) & 1) + 4 * ((nl >> 4) & 3) + (nl & 3), q = P & 127;
          *(u32x4*)((unsigned char*)WIN + ((size_t)(P >> 8) * (DM / 128) + kt) * 32768 + ((P >> 7) & 1) * 16384 + pg8::img8(q, c)) = (u32x4){0u, 0u, 0u, 0u}; } }
    { int* idr = (int*)(F.ws + WS_IDROW); for (int i = F.bx * NTHREADS + F.tid; i < PROWS; i += F.G * NTHREADS) idr[i] = i; }
    { bf16_t* wrh = (bf16_t*)(F.ws + WS_WRT); bf16_t* wrl = wrh + NEXP * DM;
      for (int i = F.bx * NTHREADS + F.tid; i < DM * NEXP; i += F.G * NTHREADS) { const int d = i >> 5, e = i & 31; const float wv = F.w_router[i] * F.g_ffn[d];
          const unsigned hb = cvt_pk_bf16(wv, 0.f) & 0xffffu; const unsigned lb = cvt_pk_bf16(wv - bf_lo(hb), 0.f) & 0xffffu; wrh[e * DM + d] = (bf16_t)hb; wrl[e * DM + d] = (bf16_t)lb; } }
    float* CS = (float*)(F.ws + WS_CS);
#ifndef P0B_REP
#define P0B_REP 1
#endif
    for (int rep_ = 0; rep_ < P0B_REP; ++rep_)
    for (int m = gw; m < NTOK; m += NGW) {
        const f32x4* xr = (const f32x4*)(F.x + (size_t)m * DM) + F.lane; const f32x4* gr = (const f32x4*)F.g_attn + F.lane;
        f32x4 v[8]; float s = 0.f;
#pragma unroll
        for (int j = 0; j < 8; ++j) { v[j] = xr[64 * j]; s += (v[j].x * v[j].x + v[j].y * v[j].y) + (v[j].z * v[j].z + v[j].w * v[j].w); }
        const float rstd = 1.0f / sqrtf(wave_sum(s) * (1.0f / DM) + EPS);
#pragma unroll
        for (int j = 0; j < 8; ++j) { const f32x4 gg = gr[64 * j]; const float y0 = v[j].x * rstd * gg.x, y1 = v[j].y * rstd * gg.y, y2 = v[j].z * rstd * gg.z, y3 = v[j].w * rstd * gg.w;
            int w8 = __builtin_amdgcn_cvt_pk_fp8_f32(y0, y1, 0, false); w8 = __builtin_amdgcn_cvt_pk_fp8_f32(y2, y3, w8, true); ((unsigned*)(F.ws + WS_XN8 + (size_t)m * DM))[F.lane + 64 * j] = (unsigned)w8; }
        { const int i = F.lane & 31; const float inv_freq = powf(10000.0f, -(float)i * 2.0f / 64.0f); const float ang = (float)F.positions[m] * inv_freq;
          CS[(size_t)m * 64 + F.lane] = (F.lane < 32) ? cosf(ang) : sinf(ang); }
    }
}

__device__ __forceinline__ void rope4(u32x2& a, u32x2& b, f32x4 c, f32x4 s) {
    const float x1[4] = {bf_lo(a.x), bf_hi(a.x), bf_lo(a.y), bf_hi(a.y)}, x2[4] = {bf_lo(b.x), bf_hi(b.x), bf_lo(b.y), bf_hi(b.y)};
    float o1[4], o2[4];
#pragma unroll
    for (int j = 0; j < 4; ++j) { o1[j] = x1[j] * c[j] - x2[j] * s[j]; o2[j] = x2[j] * c[j] + x1[j] * s[j]; }
    a.x = cvt_pk_bf16(o1[0], o1[1]); a.y = cvt_pk_bf16(o1[2], o1[3]); b.x = cvt_pk_bf16(o2[0], o2[1]); b.y = cvt_pk_bf16(o2[2], o2[3]);
}
namespace pg8 {
__device__ __forceinline__ float row_rstd_q(const float* ssqp, size_t row) { const f32x4 a = *(const f32x4*)(ssqp + row * 12), b = *(const f32x4*)(ssqp + row * 12 + 4);
    return 1.0f / sqrtf((((a[0] + a[1]) + (a[2] + a[3])) + ((b[0] + b[1]) + (b[2] + b[3]))) * (1.0f / 512.0f) + EPS); }
__device__ __forceinline__ float row_rstd_kv(const float* ssqp, size_t row) { const f32x4 a = *(const f32x4*)(ssqp + row * 12 + 8);
    return 1.0f / sqrtf(((a[0] + a[1]) + (a[2] + a[3])) * (1.0f / 256.0f) + EPS); }
struct EpiQn { static constexpr bool PERM = true;
    bf16_t* O; const float* ssqp; float scl;
    __device__ __forceinline__ void operator()(AccRef acc, const Unit& u, int wr, int wc, int fr, int fq) const {
        const int row0 = u.pm * BM + wr * 64 + fr, col0 = u.pn * BM + wc * 64 + 16 * fq;
#pragma unroll
        for (int ai = 0; ai < 2; ++ai)
#pragma unroll
            for (int m = 0; m < 4; ++m) { const size_t row = (size_t)(row0 + ai * HALF + m * 16); const float sc = row_rstd_q(ssqp, row) * scl; bf16_t* rowp = O + row * 1536 + col0;
#pragma unroll
                for (int bj = 0; bj < 2; ++bj) *(u32x4*)(rowp + bj * 8) = pack8(acc[ai][bj][m][0] * sc, acc[ai][bj][m][1] * sc); }
    }
};
struct EpiKVn { static constexpr bool PERM = true;
    bf16_t* kmla; bf16_t* vmla; const float* ssqp; const bf16_t* proj; const float* cs;
    __device__ __forceinline__ void operator()(AccRef acc, const Unit& u, int wr, int wc, int fr, int fq) const {
        const int row0 = u.pm * BM + wr * 64 + fr, c0 = wc * 32 + 8 * fq;
#pragma unroll
        for (int ai = 0; ai < 2; ++ai)
#pragma unroll
            for (int m = 0; m < 4; ++m) { const size_t row = (size_t)(row0 + ai * HALF + m * 16); const float sc = row_rstd_kv(ssqp, row);
                const size_t hrow = ((row >> 11) * 8 + u.pn) * 2048 + (row & 2047);
                *(u32x4*)(kmla + hrow * 192 + c0) = pack8(acc[ai][0][m][0] * sc, acc[ai][0][m][1] * sc);
                *(u32x4*)(vmla + hrow * 128 + c0) = pack8(acc[ai][1][m][0] * sc, acc[ai][1][m][1] * sc); }
        const int tid_ = (wr * 4 + wc) * 64 + fq * 16 + fr;
#pragma unroll
        for (int it = 0; it < 4; ++it) { const int idx = tid_ + 512 * it, i0 = 4 * (idx & 7); const size_t row = (size_t)(u.pm * BM + (idx >> 3));
            const bf16_t* pr = proj + row * NPROJ + PC_KR;
            u32x2 a = *(const u32x2*)(pr + i0), b = *(const u32x2*)(pr + 32 + i0);
            const f32x4 c = *(const f32x4*)(cs + row * 64 + i0), sn = *(const f32x4*)(cs + row * 64 + 32 + i0);
            rope4(a, b, c, sn);
            bf16_t* kp = kmla + (((row >> 11) * 8 + u.pn) * 2048 + (row & 2047)) * 192 + 128 + i0;
            *(u32x2*)kp = a; *(u32x2*)(kp + 32) = b; }
    }
};
}
__device__ __forceinline__ void p2_postproj(Frame& F) {
    const int gw = F.bx * NWAVES + F.wave, NGW = F.G * NWAVES, lane = F.lane;
    bf16_t* PROJ = (bf16_t*)(F.ws + WS_PROJ); const float* CS = (const float*)(F.ws + WS_CS);
    bf16_t* CQ = (bf16_t*)(F.ws + WS_CQ); bf16_t* CKV = (bf16_t*)(F.ws + WS_CKV); bf16_t* KMLA = (bf16_t*)(F.ws + WS_KMLA);
    constexpr int R2 = 4;
    const int hd = lane >> 3, i0 = 4 * (lane & 7); const int base = (hd < 2) ? PC_KA + hd * 64 : PC_KR;
    const f32x4 gq0 = *(const f32x4*)(F.g_q + 8 * lane), gq1 = *(const f32x4*)(F.g_q + 8 * lane + 4), gk0 = *(const f32x4*)(F.g_kv + 4 * lane);
    for (int m0 = gw; m0 < NTOK; m0 += R2 * NGW) {
        f32x4 rc[R2], rs[R2]; u32x2 ra[R2], rb[R2], wkv[R2]; u32x4 wq[R2];
#pragma unroll
        for (int j = 0; j < R2; ++j) { const int m = m0 + j * NGW; if (m < NTOK) { bf16_t* pr = PROJ + (size_t)m * NPROJ;
            if (lane < 24) { rc[j] = *(const f32x4*)(CS + (size_t)m * 64 + i0); rs[j] = *(const f32x4*)(CS + (size_t)m * 64 + 32 + i0);
                ra[j] = *(u32x2*)(pr + base + i0); rb[j] = *(u32x2*)(pr + base + 32 + i0); }
            wq[j] = *(const u32x4*)(pr + PC_DQ + 8 * lane); wkv[j] = *(const u32x2*)(pr + PC_DKV + 4 * lane); } }
#pragma unroll
        for (int j = 0; j < R2; ++j) { const int m = m0 + j * NGW; if (m < NTOK) { bf16_t* pr = PROJ + (size_t)m * NPROJ;
            if (lane < 24) { u32x2 a = ra[j], b = rb[j];
                rope4(a, b, rc[j], rs[j]);
                if (hd < 2) { *(u32x2*)(pr + base + i0) = a; *(u32x2*)(pr + base + 32 + i0) = b; }
                else { bf16_t* kp = KMLA + ((size_t)(m >> 11) * (8 * 2048) + (m & 2047)) * 192 + 128 + i0;
#pragma unroll
                    for (int hh = 0; hh < 8; ++hh) { *(u32x2*)(kp + (size_t)hh * (2048 * 192)) = a; *(u32x2*)(kp + (size_t)hh * (2048 * 192) + 32) = b; } } }
            { const u32x4 w = wq[j];
              float v[8] = {bf_lo(w.x), bf_hi(w.x), bf_lo(w.y), bf_hi(w.y), bf_lo(w.z), bf_hi(w.z), bf_lo(w.w), bf_hi(w.w)}; float sq = 0.f;
#pragma unroll
              for (int t = 0; t < 8; ++t) sq += v[t] * v[t];
              const float rstd = 1.0f / sqrtf(wave_sum(sq) * (1.0f / 512.0f) + EPS);
              u32x4 o; o.x = cvt_pk_bf16(v[0] * rstd * gq0[0], v[1] * rstd * gq0[1]); o.y = cvt_pk_bf16(v[2] * rstd * gq0[2], v[3] * rstd * gq0[3]);
              o.z = cvt_pk_bf16(v[4] * rstd * gq1[0], v[5] * rstd * gq1[1]); o.w = cvt_pk_bf16(v[6] * rstd * gq1[2], v[7] * rstd * gq1[3]);
              *(u32x4*)(CQ + (size_t)m * 512 + 8 * lane) = o; }
            { const u32x2 w = wkv[j];
              float v[4] = {bf_lo(w.x), bf_hi(w.x), bf_lo(w.y), bf_hi(w.y)}; float sq = (v[0] * v[0] + v[1] * v[1]) + (v[2] * v[2] + v[3] * v[3]);
              const float rstd = 1.0f / sqrtf(wave_sum(sq) * (1.0f / 256.0f) + EPS);
              u32x2 o; o.x = cvt_pk_bf16(v[0] * rstd * gk0[0], v[1] * rstd * gk0[1]); o.y = cvt_pk_bf16(v[2] * rstd * gk0[2], v[3] * rstd * gk0[3]);
              *(u32x2*)(CKV + (size_t)m * 256 + 4 * lane) = o; } } }
    }
}

__device__ __forceinline__ int crow(int r, int hi) { return (r & 3) + 8 * (r >> 2) + 4 * hi; }
__device__ __forceinline__ bf16x8 tr2(const LAS unsigned char* p0, const LAS unsigned char* p1) {
    const v4i16_t a = __builtin_amdgcn_ds_read_tr16_b64_v4i16((LAS v4i16_t*)p0), b = __builtin_amdgcn_ds_read_tr16_b64_v4i16((LAS v4i16_t*)p1);
    bf16x8 r; r[0] = a[0]; r[1] = a[1]; r[2] = a[2]; r[3] = a[3]; r[4] = b[0]; r[5] = b[1]; r[6] = b[2]; r[7] = b[3]; return r;
}
__device__ __forceinline__ void rope_frag(bf16x8& f1, bf16x8& f2, const float* cs, int i0, float scl = 1.0f) {
    const f32x4 c0 = *(const f32x4*)(cs + i0) * scl, c1 = *(const f32x4*)(cs + i0 + 4) * scl, s0 = *(const f32x4*)(cs + 32 + i0) * scl, s1 = *(const f32x4*)(cs + 32 + i0 + 4) * scl;
    u32x4 a = __builtin_bit_cast(u32x4, f1), b = __builtin_bit_cast(u32x4, f2);
    u32x2 a0 = {a.x, a.y}, b0 = {b.x, b.y}, a1 = {a.z, a.w}, b1 = {b.z, b.w};
    rope4(a0, b0, c0, s0); rope4(a1, b1, c1, s1);
    f1 = __builtin_bit_cast(bf16x8, (u32x4){a0.x, a0.y, a1.x, a1.y}); f2 = __builtin_bit_cast(bf16x8, (u32x4){b0.x, b0.y, b1.x, b1.y});
}
__device__ __forceinline__ void rope_frag_v(bf16x8& f1, bf16x8& f2, f32x4 c0, f32x4 c1, f32x4 s0, f32x4 s1, float scl) {
    c0 = c0 * scl; c1 = c1 * scl; s0 = s0 * scl; s1 = s1 * scl;
    u32x4 a = __builtin_bit_cast(u32x4, f1), b = __builtin_bit_cast(u32x4, f2);
    u32x2 a0 = {a.x, a.y}, b0 = {b.x, b.y}, a1 = {a.z, a.w}, b1 = {b.z, b.w};
    rope4(a0, b0, c0, s0); rope4(a1, b1, c1, s1);
    f1 = __builtin_bit_cast(bf16x8, (u32x4){a0.x, a0.y, a1.x, a1.y}); f2 = __builtin_bit_cast(bf16x8, (u32x4){b0.x, b0.y, b1.x, b1.y});
}
__device__ __forceinline__ bf16x8 pack_p(const f32x16& p, int s2) {
    u32x4 w;
    asm volatile("s_nop 0\n\tv_cvt_pk_bf16_f32 %0, %4, %5\n\tv_cvt_pk_bf16_f32 %1, %6, %7\n\tv_cvt_pk_bf16_f32 %2, %8, %9\n\tv_cvt_pk_bf16_f32 %3, %10, %11"
                 : "=&v"(w.x), "=&v"(w.y), "=&v"(w.z), "=&v"(w.w)
                 : "v"(p[8 * s2 + 0]), "v"(p[8 * s2 + 1]), "v"(p[8 * s2 + 2]), "v"(p[8 * s2 + 3]), "v"(p[8 * s2 + 4]), "v"(p[8 * s2 + 5]), "v"(p[8 * s2 + 6]), "v"(p[8 * s2 + 7]));
    return __builtin_bit_cast(bf16x8, w);
}

constexpr int SWA_KRS = 144;
constexpr int SWA_LDS_K = 0, SWA_LDS_V = 256 * SWA_KRS;
__device__ __forceinline__ void swa_phase(Frame& F) {
    const bf16_t* PROJ = (const bf16_t*)(F.ws + WS_PROJ); const float* CS = (const float*)(F.ws + WS_CS); bf16_t* OUTA = (bf16_t*)(F.ws + WS_OUTA);
    LAS unsigned char* Kl = F.lds + SWA_LDS_K; LAS unsigned char* Vl = F.lds + SWA_LDS_V;
    int lane = F.lane; asm volatile("" : "+v"(lane));
    const int w = F.wave, l31 = lane & 31, h = lane >> 5;
    const int vq = (lane & 15) >> 2, vp = lane & 3, vg = (lane >> 4) & 1;
    const int vlane = (4 * h + vq) * 64 + (16 * vg + 4 * vp) * 2;
    for (int u = F.bx; u < BATCH * 16 * 2; u += F.G) {
        const int kvh = u & 1, nb = (u >> 1) & 15, b = u >> 5;
        const int tok0 = b * SEQ + nb * 128;
        __syncthreads();
#pragma unroll
        for (int j = 0; j < 4; ++j) { const int id = F.tid + 512 * j, row = id >> 3, ch = id & 7;
            u32x4 kv = (u32x4){0u, 0u, 0u, 0u}, vv = (u32x4){0u, 0u, 0u, 0u};
            if (nb > 0 || row >= 128) { const size_t tok = (size_t)(tok0 - 128 + row); const bf16_t* src = PROJ + tok * NPROJ + kvh * 64 + ch * 8;
                vv = *(const u32x4*)(src + PC_VA);
                const u32x4 ko = *(const u32x4*)(src + PC_KA), kp = *(const u32x4*)(src + PC_KA + ((ch & 4) ? -32 : 32));
                const float* cs = CS + tok * 64 + 8 * (ch & 3);
                const f32x4 c0 = *(const f32x4*)cs, c1 = *(const f32x4*)(cs + 4), s0 = *(const f32x4*)(cs + 32), s1 = *(const f32x4*)(cs + 36);
                const float sg = (ch & 4) ? 1.0f : -1.0f;
                const unsigned kow[4] = {ko.x, ko.y, ko.z, ko.w}, kpw[4] = {kp.x, kp.y, kp.z, kp.w}; unsigned ow[4];
#pragma unroll
                for (int e = 0; e < 4; ++e) { const float cl = e < 2 ? c0[2 * e] : c1[2 * e - 4], ch_ = e < 2 ? c0[2 * e + 1] : c1[2 * e - 3], sl = e < 2 ? s0[2 * e] : s1[2 * e - 4], sh = e < 2 ? s0[2 * e + 1] : s1[2 * e - 3];
                    ow[e] = cvt_pk_bf16(bf_lo(kow[e]) * cl + sg * bf_lo(kpw[e]) * sl, bf_hi(kow[e]) * ch_ + sg * bf_hi(kpw[e]) * sh); }
                kv = (u32x4){ow[0], ow[1], ow[2], ow[3]}; }
            *(LAS u32x4*)(Kl + row * SWA_KRS + ch * 16) = kv;
            *(LAS u32x4*)(Vl + ((row >> 3) * 2 + (ch >> 2)) * 512 + (row & 7) * 64 + (ch & 3) * 16) = vv; }
        __syncthreads();
        const int hq = kvh * 8 + w; const float sink = F.sinks[hq];
        bf16x8 qraw[4]; f32x4 qcs[8];
#define SWA_QREQ(I) do { const size_t r_ = (size_t)tok0 + 32 * (I); const char* qp = (const char*)PROJ + (r_ * NPROJ + hq * 64) * 2; const unsigned qo = (unsigned)(l31 * (NPROJ * 2) + 16 * h); \
            _Pragma("unroll") for (int ks = 0; ks < 4; ++ks) qraw[ks] = *(const bf16x8*)(qp + qo + 32 * ks); \
            const float* cs = (const float*)((const char*)CS + r_ * 256 + (unsigned)(l31 * 256)); \
            _Pragma("unroll") for (int t_ = 0; t_ < 2; ++t_) { const int i0 = 16 * t_ + 8 * h; qcs[4 * t_] = *(const f32x4*)(cs + i0); qcs[4 * t_ + 1] = *(const f32x4*)(cs + i0 + 4); qcs[4 * t_ + 2] = *(const f32x4*)(cs + 32 + i0); qcs[4 * t_ + 3] = *(const f32x4*)(cs + 32 + i0 + 4); } } while (0)
        SWA_QREQ(0);
        for (int i = 0; i < 4; ++i) {
            const size_t row0 = (size_t)tok0 + 32 * i;
            bf16x8 Qf[4];
#pragma unroll
            for (int ks = 0; ks < 4; ++ks) Qf[ks] = qraw[ks];
            rope_frag_v(Qf[0], Qf[2], qcs[0], qcs[1], qcs[2], qcs[3], 0.125f * 1.4426950408889634f); rope_frag_v(Qf[1], Qf[3], qcs[4], qcs[5], qcs[6], qcs[7], 0.125f * 1.4426950408889634f);
            if (i < 3) SWA_QREQ(i + 1);
            f32x16 O[2];
#pragma unroll
            for (int db = 0; db < 2; ++db)
#pragma unroll
                for (int r = 0; r < 16; ++r) O[db][r] = 0.f;
            const float sinkl = sink * 1.4426950408889634f;
            float mrun = sinkl, lrun = 0.f;
            const int tcmp = l31 - 4 * h;
#pragma unroll 1
            for (int kb = 0; kb < 5; ++kb) {
                if (nb == 0 && i + kb < 4) continue;
                const int kk0 = 32 * (i + kb);
                f32x16 Sx;
#pragma unroll
                for (int r = 0; r < 16; ++r) Sx[r] = 0.f;
                const LAS unsigned char* kp = Kl + kk0 * SWA_KRS + l31 * SWA_KRS + 16 * h;
#pragma unroll
                for (int ks = 0; ks < 4; ++ks) Sx = __builtin_amdgcn_mfma_f32_32x32x16_bf16(*(const LAS bf16x8*)(kp + 32 * ks), Qf[ks], Sx, 0, 0, 0);
                const LAS unsigned char* vb = Vl + (kk0 >> 3) * 1024 + vlane;
                bf16x8 vf[4];
#pragma unroll
                for (int db = 0; db < 2; ++db) { vf[2 * db] = tr2(vb + db * 512, vb + db * 512 + 1024); vf[2 * db + 1] = tr2(vb + db * 512 + 2048, vb + db * 512 + 3072); }
                __builtin_amdgcn_sched_barrier(0);
                if (kb == 0) {
#pragma unroll
                    for (int r = 0; r < 16; ++r) if (!((r & 3) + 8 * (r >> 2) > tcmp)) Sx[r] = -1e30f;
                } else if (kb == 4) {
#pragma unroll
                    for (int r = 0; r < 16; ++r) if ((r & 3) + 8 * (r >> 2) > tcmp) Sx[r] = -1e30f;
                }
                float mx = Sx[0];
#pragma unroll
                for (int r = 1; r < 16; ++r) mx = fmaxf(mx, Sx[r]);
                mx = fmaxf(mx, __shfl_xor(mx, 32));
                if (__builtin_amdgcn_ballot_w64(mx > mrun + 8.f) != 0) {
                    const float mn = fmaxf(mrun, mx);
                    const float alpha = __builtin_amdgcn_exp2f(mrun - mn);
                    mrun = mn; lrun *= alpha;
#pragma unroll
                    for (int db = 0; db < 2; ++db)
#pragma unroll
                        for (int r = 0; r < 16; ++r) O[db][r] *= alpha;
                }
                float ps = 0.f;
#pragma unroll
                for (int r = 0; r < 16; ++r) { const float p = __builtin_amdgcn_exp2f(Sx[r] - mrun); Sx[r] = p; ps += p; }
                lrun += ps;
                const bf16x8 P0 = pack_p(Sx, 0), P1 = pack_p(Sx, 1);
                __builtin_amdgcn_sched_barrier(0);
#pragma unroll
                for (int db = 0; db < 2; ++db) {
                    O[db] = __builtin_amdgcn_mfma_f32_32x32x16_bf16(vf[2 * db], P0, O[db], 0, 0, 0);
                    O[db] = __builtin_amdgcn_mfma_f32_32x32x16_bf16(vf[2 * db + 1], P1, O[db], 0, 0, 0);
                }
            }
            const float ltot = lrun + __shfl_xor(lrun, 32) + __builtin_amdgcn_exp2f(sinkl - mrun);
            const float inv = 1.0f / ltot;
            char* op = (char*)OUTA + (row0 * 2048 + hq * 64); const unsigned oo = (unsigned)(l31 * 2048 + 4 * h);
            const float inv16 = inv * 16.0f;
#pragma unroll
            for (int db = 0; db < 2; ++db)
#pragma unroll
                for (int g4 = 0; g4 < 4; ++g4) { int wv = __builtin_amdgcn_cvt_pk_fp8_f32(O[db][4 * g4] * inv16, O[db][4 * g4 + 1] * inv16, 0, false); wv = __builtin_amdgcn_cvt_pk_fp8_f32(O[db][4 * g4 + 2] * inv16, O[db][4 * g4 + 3] * inv16, wv, true);
                    *(unsigned*)(op + oo + 32 * db + 8 * g4) = (unsigned)wv; }
        }
    }
    __syncthreads();
}

constexpr int MLA_KRS = 400, MLA_KB = 64 * MLA_KRS, MLA_VB = 64 * 256, MLA_BUF = MLA_KB + MLA_VB;
typedef float f32x2m __attribute__((ext_vector_type(2)));
__device__ __forceinline__ void mla_phase(Frame& F) {
    const char* QBc = (const char*)(F.ws + WS_QB); const char* KMLA = (const char*)(F.ws + WS_KMLA); const char* VMLA = (const char*)(F.ws + WS_VMLA);
    const char* CSc = (const char*)(F.ws + WS_CS); char* OUTBc = (char*)(F.ws + WS_OUTA) + 1024;
    int lane = F.lane; asm volatile("" : "+v"(lane));
    const int w = F.wave, l31 = lane & 31, h = lane >> 5;
    const int vq = (lane & 15) >> 2, vp = lane & 3, vg = (lane >> 4) & 1;
    const int vlane = (4 * h + vq) * 64 + (16 * vg + 4 * vp) * 2;
    const int klane = l31 * MLA_KRS + 16 * h;
    constexpr float C2 = 0.07216878364870322f * 1.4426950408889634f;
    for (int it0 = F.bx; it0 < BATCH * 8 * 4; it0 += F.G) {
        const int it = (F.G == 256) ? ((it0 & 7) * 64 + ((it0 >> 3) & 31) + 32 * (it0 >> 8)) : it0;
        const int pr = it & 3, hh = (it >> 2) & 7, b = it >> 5;
        for (int half = 0; half < 2; ++half) {
            const int qb = half ? pr : (7 - pr);
            const int nkt = 4 * (qb + 1);
            const size_t row0 = (size_t)b * SEQ + 256 * qb + 32 * w;
            const int qpos = 256 * qb + 32 * w + l31;
            f32x16 O[4];
#pragma unroll
            for (int db = 0; db < 4; ++db)
#pragma unroll
                for (int r = 0; r < 16; ++r) O[db][r] = 0.f;
            float mrun = -1e30f, lrun = 0.f;
            const size_t hrow0 = ((size_t)b * 8 + hh) * SEQ;
#define MLA_DMAK(kt, bufp) do { const char* kb_ = KMLA + (hrow0 + 64 * (kt)) * 384; \
              _Pragma("unroll") for (int j = 0; j < 4; ++j) { const int q = w + 8 * j; \
                if (q < 25) { const int s_ = 64 * q + lane, row = s_ / 25, ch = s_ - 25 * row; const unsigned off = (unsigned)(row * 384 + ch * 16); \
                    glds16_asm(kb_, off, (unsigned)(size_t)((bufp) + q * 1024)); } } } while (0)
#define MLA_DMAV(kt, bufp) do { const char* vb_ = VMLA + (hrow0 + 64 * (kt)) * 256; \
              _Pragma("unroll") for (int j = 0; j < 2; ++j) { const int q = w + 8 * j; \
                const int s_ = 64 * q + lane, sub = s_ >> 5, row = (sub >> 2) * 8 + ((s_ >> 2) & 7), ch = (sub & 3) * 4 + (s_ & 3); const unsigned off = (unsigned)(row * 256 + ch * 16); \
                glds16_asm(vb_, off, (unsigned)(size_t)((bufp) + q * 1024)); } } while (0)
#define MLA_SB() __builtin_amdgcn_sched_barrier(0)
#define MLA_LDK(p) (*(const LAS bf16x8*)(p))
#define MLA_E(SP, r) do { const float p_ = __builtin_amdgcn_exp2f(SP[r] - mrun); SP[r] = p_; ps += p_; } while (0)
#define MLA_E2(SP, r) do { f32x2m t_ = (f32x2m){SP[r], SP[(r) + 1]} - mrun; t_[0] = __builtin_amdgcn_exp2f(t_[0]); t_[1] = __builtin_amdgcn_exp2f(t_[1]); SP[r] = t_[0]; SP[(r) + 1] = t_[1]; ps2 += t_; } while (0)
#define MLA_QKM(SN, f, ks) SN = __builtin_amdgcn_mfma_f32_32x32x16_bf16(f, Qf[ks], SN, 0, 0, 0)
#define MLA_PEND_PLAIN(SP, vbp) do { float ps = 0.f; \
                _Pragma("unroll") for (int r = 0; r < 16; ++r) MLA_E(SP, r); \
                lrun += ps; \
                const bf16x8 P0 = pack_p(SP, 0), P1 = pack_p(SP, 1); \
                const LAS unsigned char* vb = (vbp); \
                _Pragma("unroll") for (int db = 0; db < 4; ++db) { \
                    O[db] = __builtin_amdgcn_mfma_f32_32x32x16_bf16(tr2(vb + db * 512, vb + db * 512 + 4 * 512), P0, O[db], 0, 0, 0); \
                    O[db] = __builtin_amdgcn_mfma_f32_32x32x16_bf16(tr2(vb + db * 512 + 8 * 512, vb + db * 512 + 12 * 512), P1, O[db], 0, 0, 0); } } while (0)
#define MLA_STAGE(SN, SP, kpp, vbp, NIDX) do { const int n_ = (NIDX); \
                if (n_ <= nlast + 1) {                                    \
                    const LAS unsigned char* kp = (kpp); const LAS unsigned char* vb = (vbp); \
                    bf16x8 kfA[4], kfB[4], vf[8], P0, P1; f32x2m ps2 = {0.f, 0.f}; \
                    _Pragma("unroll") for (int j = 0; j < 4; ++j) kfA[j] = MLA_LDK(kp + 32 * j); \
                    _Pragma("unroll") for (int j = 0; j < 4; ++j) kfB[j] = MLA_LDK(kp + 32 * (4 + j)); \
                    _Pragma("unroll") for (int r = 0; r < 16; ++r) SN[r] = 0.f; \
                    MLA_SB(); \
                    MLA_E2(SP, 0); MLA_SB(); \
                    MLA_QKM(SN, kfA[0], 0); MLA_E2(SP, 2); MLA_SB(); \
                    MLA_QKM(SN, kfA[1], 1); MLA_SB(); \
                    MLA_QKM(SN, kfA[2], 2); MLA_E2(SP, 4); MLA_SB(); \
                    MLA_QKM(SN, kfA[3], 3); MLA_SB(); \
                    _Pragma("unroll") for (int j = 0; j < 4; ++j) kfA[j] = MLA_LDK(kp + 32 * (8 + j)); \
                    MLA_SB(); \
                    MLA_QKM(SN, kfB[0], 4); MLA_E2(SP, 6); MLA_SB(); \
                    MLA_QKM(SN, kfB[1], 5); P0 = pack_p(SP, 0); MLA_SB(); \
                    MLA_QKM(SN, kfB[2], 6); MLA_E2(SP, 8); MLA_SB(); \
                    MLA_QKM(SN, kfB[3], 7); MLA_E2(SP, 10); MLA_SB(); \
                    _Pragma("unroll") for (int db = 0; db < 2; ++db) { vf[2 * db] = tr2(vb + db * 512, vb + db * 512 + 4 * 512); vf[2 * db + 1] = tr2(vb + db * 512 + 8 * 512, vb + db * 512 + 12 * 512); } \
                    MLA_SB(); \
                    MLA_QKM(SN, kfA[0], 8); MLA_E2(SP, 12); MLA_SB(); \
                    MLA_QKM(SN, kfA[1], 9); MLA_SB(); \
                    MLA_QKM(SN, kfA[2], 10); MLA_E2(SP, 14); MLA_SB(); \
                    MLA_QKM(SN, kfA[3], 11); lrun += ps2[0] + ps2[1]; P1 = pack_p(SP, 1); MLA_SB(); \
                    _Pragma("unroll") for (int db = 2; db < 4; ++db) { vf[2 * db] = tr2(vb + db * 512, vb + db * 512 + 4 * 512); vf[2 * db + 1] = tr2(vb + db * 512 + 8 * 512, vb + db * 512 + 12 * 512); } \
                    MLA_SB(); \
                    if (n_ >= nlast) {                                    \
                        _Pragma("unroll") for (int r = 0; r < 16; ++r) { const int key = 32 * n_ + crow(r, h); if (key > qpos) SN[r] = -1e30f; } \
                    } \
                    float mx; \
                    O[0] = __builtin_amdgcn_mfma_f32_32x32x16_bf16(vf[0], P0, O[0], 0, 0, 0); MLA_SB(); \
                    O[0] = __builtin_amdgcn_mfma_f32_32x32x16_bf16(vf[1], P1, O[0], 0, 0, 0); MLA_SB(); \
                    O[1] = __builtin_amdgcn_mfma_f32_32x32x16_bf16(vf[2], P0, O[1], 0, 0, 0); mx = fmaxf(fmaxf(SN[0], SN[1]), SN[2]); MLA_SB(); \
                    O[1] = __builtin_amdgcn_mfma_f32_32x32x16_bf16(vf[3], P1, O[1], 0, 0, 0); mx = fmaxf(fmaxf(mx, SN[3]), SN[4]); mx = fmaxf(fmaxf(mx, SN[5]), SN[6]); MLA_SB(); \
                    O[2] = __builtin_amdgcn_mfma_f32_32x32x16_bf16(vf[4], P0, O[2], 0, 0, 0); mx = fmaxf(fmaxf(mx, SN[7]), SN[8]); mx = fmaxf(fmaxf(mx, SN[9]), SN[10]); MLA_SB(); \
                    O[2] = __builtin_amdgcn_mfma_f32_32x32x16_bf16(vf[5], P1, O[2], 0, 0, 0); mx = fmaxf(fmaxf(mx, SN[11]), SN[12]); mx = fmaxf(fmaxf(mx, SN[13]), SN[14]); MLA_SB(); \
                    O[3] = __builtin_amdgcn_mfma_f32_32x32x16_bf16(vf[6], P0, O[3], 0, 0, 0); mx = fmaxf(mx, SN[15]); MLA_SB(); \
                    O[3] = __builtin_amdgcn_mfma_f32_32x32x16_bf16(vf[7], P1, O[3], 0, 0, 0); MLA_SB(); \
                    mx = fmaxf(mx, __shfl_xor(mx, 32)); \
                      \
                    if (__builtin_amdgcn_ballot_w64(mx > mrun + 8.f) != 0) { \
                        const float mn = fmaxf(mrun, mx); \
                        const float alpha = __builtin_amdgcn_exp2f(mrun - mn); \
                        mrun = mn; lrun *= alpha; \
                        _Pragma("unroll") for (int db = 0; db < 4; ++db) _Pragma("unroll") for (int r = 0; r < 16; ++r) O[db][r] *= alpha; \
                    } \
                } } while (0)
#define MLA_KB_(i) (F.lds + (i) * MLA_KB)
#define MLA_VB_(i) (F.lds + 3 * MLA_KB + (i) * MLA_VB)
#define MLA_TILE(KT, BI) do { const int kt_ = (KT); \
                  \
                if (kt_ + 1 < nkt) asm volatile("s_waitcnt vmcnt(3) lgkmcnt(0)" ::: "memory"); else asm volatile("s_waitcnt vmcnt(0) lgkmcnt(0)" ::: "memory"); \
                __builtin_amdgcn_s_barrier(); asm volatile("" ::: "memory");     \
                  \
                  \
                if (w < 4) { if (kt_ + 1 < nkt) MLA_DMAV(kt_ + 1, MLA_VB_(((BI) + 1) % 3)); if (kt_ + 2 < nkt) MLA_DMAK(kt_ + 2, MLA_KB_(((BI) + 2) % 3)); } \
                  \
                const LAS unsigned char* vprev = (kt_ == 0) ? (MLA_VB_(BI) + vlane) : (MLA_VB_(((BI) + 2) % 3) + 16 * 512 + vlane); \
                MLA_STAGE(Sa, Sb, MLA_KB_(BI) + klane, vprev, 2 * kt_); \
                if (w >= 4) { if (kt_ + 1 < nkt) MLA_DMAV(kt_ + 1, MLA_VB_(((BI) + 1) % 3)); if (kt_ + 2 < nkt) MLA_DMAK(kt_ + 2, MLA_KB_(((BI) + 2) % 3)); } \
                MLA_STAGE(Sb, Sa, MLA_KB_(BI) + 32 * MLA_KRS + klane, MLA_VB_(BI) + vlane, 2 * kt_ + 1); \
                } while (0)
            const int nlast = 8 * qb + w;
            f32x16 Sa, Sb;
#pragma unroll
            for (int r = 0; r < 16; ++r) { Sa[r] = 0.f; Sb[r] = -__builtin_inff(); }
            __syncthreads();
            MLA_DMAK(0, MLA_KB_(0)); MLA_DMAV(0, MLA_VB_(0));
            if (nkt > 1) MLA_DMAK(1, MLA_KB_(1));
            bf16x8 Qf[12];
            { const char* qp = QBc + (row0 * 1536 + hh * 192) * 2; const unsigned qo = (unsigned)(l31 * 3072 + 16 * h);
#pragma unroll
              for (int ks = 0; ks < 12; ++ks) Qf[ks] = *(const bf16x8*)(qp + qo + 32 * ks);
              const float* cs = (const float*)(CSc + row0 * 256 + (unsigned)(l31 * 256));
              rope_frag(Qf[8], Qf[10], cs, 8 * h); rope_frag(Qf[9], Qf[11], cs, 16 + 8 * h); }
#pragma unroll 1
            for (int kt = 0; kt < nkt; kt += 3) {
                MLA_TILE(kt, 0);
                if (kt + 1 < nkt) MLA_TILE(kt + 1, 1);
                if (kt + 2 < nkt) MLA_TILE(kt + 2, 2);
            }
            if (w == 7) { MLA_PEND_PLAIN(Sb, MLA_VB_((nkt - 1) % 3) + 16 * 512 + vlane); }
#undef MLA_TILE
#undef MLA_STAGE
#undef MLA_PEND_PLAIN
#undef MLA_DMAK
#undef MLA_DMAV
            const float ltot = lrun + __shfl_xor(lrun, 32);
            const float inv = 1.0f / ltot;
            char* op = OUTBc + (row0 * 2048 + hh * 128); const unsigned oo = (unsigned)(l31 * 2048 + 4 * h);
            const float inv16 = inv * 16.0f;
#pragma unroll
            for (int db = 0; db < 4; ++db)
#pragma unroll
                for (int g4 = 0; g4 < 4; ++g4) { int wv = __builtin_amdgcn_cvt_pk_fp8_f32(O[db][4 * g4] * inv16, O[db][4 * g4 + 1] * inv16, 0, false); wv = __builtin_amdgcn_cvt_pk_fp8_f32(O[db][4 * g4 + 2] * inv16, O[db][4 * g4 + 3] * inv16, wv, true);
                    *(unsigned*)(op + oo + 32 * db + 8 * g4) = (unsigned)wv; }
        }
    }
    __syncthreads();
}

__device__ __forceinline__ void p7_router(Frame& F) {
    const char* Hc = (const char*)(F.ws + WS_H);
    const bf16_t* WRH = (const bf16_t*)(F.ws + WS_WRT); const bf16_t* WRL = WRH + NEXP * DM;
    int* TOPE = (int*)(F.ws + WS_TOPE); float* TOPW = (float*)(F.ws + WS_TOPW); int* CNT = (int*)(F.ws + WS_CNT);
    const float* SSQH = (const float*)(F.ws + WS_CKV); unsigned char* HN8 = (unsigned char*)(F.ws + WS_XN);
    constexpr int A_BYTES = 32 * 4096, LG_OFF = A_BYTES, HIST_OFF = LG_OFF + 32 * 33 * 4, RS_OFF = HIST_OFF + 128;
    LAS float* red = (LAS float*)F.lds; LAS float* lg = (LAS float*)(F.lds + LG_OFF); LAS int* hist = (LAS int*)(F.lds + HIST_OFF); LAS float* rsl = (LAS float*)(F.lds + RS_OFF);
    int lane = F.lane; asm volatile("" : "+v"(lane));
    const int w = F.wave, l31 = lane & 31, h = lane >> 5;
    bf16x8 bh[16];
#pragma unroll
    for (int ks = 0; ks < 16; ++ks) { const size_t bo = (size_t)l31 * DM + 256 * w + 16 * ks + 8 * h; bh[ks] = *(const bf16x8*)(WRH + bo); }
    for (int c = F.bx; c < NTOK / 128; c += F.G) {
        __syncthreads();
        if (F.tid < NEXP) hist[F.tid] = 0;
        for (int tt = 0; tt < 4; ++tt) {
            const int r0 = 128 * c + 32 * tt;
            __syncthreads();
            { const char* hb = Hc + (size_t)r0 * 4096;
#pragma unroll
              for (int j = 0; j < 16; ++j) { const int p = w + 8 * j, s_ = 64 * p + lane, row = s_ >> 8, pos = s_ & 255;
                  glds16_asm(hb, (unsigned)(row * 4096 + ((pos ^ (row & 15)) << 4)), (unsigned)(size_t)(F.lds + p * 1024)); } }
            if (F.tid < 32) { const float* sp = SSQH + (size_t)(r0 + F.tid) * 32; float ssum = 0.f;
#pragma unroll
                for (int q4 = 0; q4 < 8; ++q4) { const f32x4 v = *(const f32x4*)(sp + 4 * q4); ssum += (v[0] + v[1]) + (v[2] + v[3]); }
                const float rs = 1.0f / sqrtf(ssum * (1.0f / DM) + EPS); rsl[F.tid] = rs; }
            asm volatile("s_waitcnt vmcnt(0)" ::: "memory");
            __syncthreads();
            f32x16 acc;
#pragma unroll
            for (int r = 0; r < 16; ++r) acc[r] = 0.f;
#pragma unroll
            for (int ks = 0; ks < 16; ++ks) { const int ch = 32 * w + 2 * ks + h;
                const bf16x8 ah = *(const LAS bf16x8*)(F.lds + l31 * 4096 + ((ch ^ (l31 & 15)) << 4));
                const bf16x8 blk = *(const bf16x8*)(WRL + (size_t)l31 * DM + 256 * w + 16 * ks + 8 * h);
                acc = __builtin_amdgcn_mfma_f32_32x32x16_bf16(ah, bh[ks], acc, 0, 0, 0);
                acc = __builtin_amdgcn_mfma_f32_32x32x16_bf16(ah, blk, acc, 0, 0, 0); }
#pragma unroll 4
            for (int j = 0; j < 16; ++j) { const int s_ = F.tid + 512 * j, row = s_ >> 8, g = (s_ & 255) ^ (row & 15); const float rs = rsl[row];
                const u32x4 hw = *(const LAS u32x4*)(F.lds + s_ * 16);
                int y0 = __builtin_amdgcn_cvt_pk_fp8_f32(bf_lo(hw.x) * rs, bf_hi(hw.x) * rs, 0, false); y0 = __builtin_amdgcn_cvt_pk_fp8_f32(bf_lo(hw.y) * rs, bf_hi(hw.y) * rs, y0, true);
                int y1 = __builtin_amdgcn_cvt_pk_fp8_f32(bf_lo(hw.z) * rs, bf_hi(hw.z) * rs, 0, false); y1 = __builtin_amdgcn_cvt_pk_fp8_f32(bf_lo(hw.w) * rs, bf_hi(hw.w) * rs, y1, true);
                *(u32x2*)(HN8 + (size_t)(r0 + row) * DM + g * 8) = (u32x2){(unsigned)y0, (unsigned)y1}; }
            __syncthreads();
#pragma unroll
            for (int r = 0; r < 16; ++r) red[(w * 32 + crow(r, h)) * 32 + l31] = acc[r];
            __syncthreads();
#pragma unroll
            for (int q = 0; q < 2; ++q) { const int idx = F.tid + 512 * q, row = idx >> 5, e = idx & 31; float sum = 0.f;
#pragma unroll
                for (int ww = 0; ww < 8; ++ww) sum += red[(ww * 32 + row) * 32 + e];
                lg[row * 33 + e] = sum * rsl[row] + F.b_router[e]; }
            __syncthreads();
#pragma unroll
            for (int rr = 0; rr < 4; ++rr) {
                float lv = (lane < 32) ? lg[(4 * w + rr) * 33 + l31] : -1e30f; float tv[4]; int te[4];
#pragma unroll
                for (int k = 0; k < 4; ++k) {
                    float bv = lv; int bi = lane;
#pragma unroll
                    for (int o = 1; o < 64; o <<= 1) { const float ov = __shfl_xor(bv, o); const int oi = __shfl_xor(bi, o); if (ov > bv || (ov == bv && oi < bi)) { bv = ov; bi = oi; } }
                    tv[k] = bv; te[k] = bi; if (lane == bi) lv = -3e38f;
                }
                const float e1 = __expf(tv[1] - tv[0]), e2 = __expf(tv[2] - tv[0]), e3 = __expf(tv[3] - tv[0]); const float inv = 1.0f / (1.0f + e1 + e2 + e3);
                if (lane == 0) { const int row = r0 + 4 * w + rr;
                    *(int4*)(TOPE + (size_t)row * 4) = make_int4(te[0], te[1], te[2], te[3]);
                    *(float4*)(TOPW + (size_t)row * 4) = make_float4(inv, e1 * inv, e2 * inv, e3 * inv);
                    atomicAdd((int*)hist + te[0], 1); atomicAdd((int*)hist + te[1], 1); atomicAdd((int*)hist + te[2], 1); atomicAdd((int*)hist + te[3], 1); }
            }
        }
        __syncthreads();
        if (F.tid < NEXP) CNT[c * NEXP + F.tid] = hist[F.tid];
    }
    __syncthreads();
}

__device__ __forceinline__ void p8_slots(Frame& F) {
    const int* CNT = (const int*)(F.ws + WS_CNT); const int* TOPE = (const int*)(F.ws + WS_TOPE);
    int* SLOT = (int*)(F.ws + WS_SLOT); int* ROWTOK = (int*)(F.ws + WS_ROWTOK); int* TILEE = (int*)(F.ws + WS_TILEE);
    LAS int* red_all = (LAS int*)F.lds;
    LAS int* red_pre = red_all + 512;
    LAS int* tot = red_pre + 512;
    LAS int* pre = tot + 32;
    LAS int* pstart = pre + 32;
    LAS int* le = pstart + 64;
    LAS int* ls = le + 512;
    constexpr int NCH = NTOK / 128;
    for (int c = F.bx; c < NCH; c += F.G) {
        __syncthreads();
        { const int e = F.tid & 31, part = F.tid >> 5; int sa = 0, sp = 0;
          for (int cc = part; cc < NCH; cc += 16) { const int v = CNT[cc * NEXP + e]; sa += v; if (cc < c) sp += v; }
          red_all[part * 32 + e] = sa; red_pre[part * 32 + e] = sp; }
        le[F.tid] = TOPE[(size_t)c * 512 + F.tid];
        __syncthreads();
        if (F.tid < 32) { int sa = 0, sp = 0;
#pragma unroll
            for (int p = 0; p < 16; ++p) { sa += red_all[p * 32 + F.tid]; sp += red_pre[p * 32 + F.tid]; }
            tot[F.tid] = sa; pre[F.tid] = sp; }
        __syncthreads();
        if (F.tid == 0) { int a = 0; for (int e = 0; e < NEXP; ++e) { pstart[e] = a; a += (tot[e] + 255) / 256 * 256; } pstart[32] = a; }
        __syncthreads();
        { const int a = F.tid, e = le[a], lane_ = a & 63, w_ = a >> 6; int rank = 0;
#pragma unroll 4
          for (int q = 0; q < NEXP; ++q) { const unsigned long long m = __builtin_amdgcn_ballot_w64(e == q);
              if (e == q) rank = __builtin_popcountll(m & ((1ull << lane_) - 1ull));
              if (lane_ == 0) red_all[w_ * 32 + q] = __builtin_popcountll(m); }
          __syncthreads();
          int base = pstart[e] + pre[e];
          for (int ww = 0; ww < w_; ++ww) base += red_all[ww * 32 + e];
          ls[a] = base + rank; }
        __syncthreads();
        { const int a = F.tid, token = 128 * c + (a >> 2), slot = ls[a]; SLOT[(size_t)c * 512 + a] = slot; ROWTOK[slot] = token; }
        if (c < NEXP) { const int e = c; for (int r = pstart[e] + tot[e] + F.tid; r < pstart[e + 1]; r += NTHREADS) ROWTOK[r] = 0; }
        if (c == 0) { const int ntl = pstart[32] / 256;
            for (int t = F.tid; t < ntl; t += NTHREADS) { int e = 0; for (int q = 1; q < NEXP; ++q) if (t * 256 >= pstart[q]) e = q; TILEE[t] = e; }
            if (F.tid == 0) F.ctl[CW_NT] = (unsigned)ntl; }
    }
    __syncthreads();
}

__device__ __forceinline__ void p11_final(Frame& F) {
    const int gw = F.bx * NWAVES + F.wave, NGW = F.G * NWAVES, lane = F.lane;
    const bf16_t* YB = (const bf16_t*)(F.ws + WS_YBUF); const int* SLOT = (const int*)(F.ws + WS_SLOT); const float* TOPW = (const float*)(F.ws + WS_TOPW);
#ifdef DBG_DUMP
    for (int m = gw; m < NTOK; m += NGW) {
        const bf16_t* src = (const bf16_t*)(F.ws + DBG_DUMP_OFF) + (size_t)((m + DBG_DUMP_SHIFT) % NTOK) * DBG_DUMP_PITCH + DBG_DUMP_COL;
        #ifdef DBG_TWICE
        const bf16_t* src2 = (const bf16_t*)(F.ws + WS_ACT) + (size_t)m * DBG_DUMP_PITCH + DBG_DUMP_COL;
        for (int d = lane; d < DM; d += 64) F.out[(size_t)m * DM + d] = (bf_lo((unsigned)src[d]) - bf_lo((unsigned)src2[d])) * 1000.f + 1.0f;
#else
        for (int d = lane; d < DM; d += 64) F.out[(size_t)m * DM + d] = (d < DBG_DUMP_N) ? bf_lo((unsigned)src[d]) : 0.f;
#endif
    }
    return;
#endif
    constexpr int R11 = 2;
    typedef float f32x2_ __attribute__((ext_vector_type(2)));
    int4 sl[R11]; float4 tw[R11];
#pragma unroll
    for (int q = 0; q < R11; ++q) { const int m = gw + q * NGW; sl[q] = make_int4(0, 0, 0, 0); tw[q] = make_float4(0.f, 0.f, 0.f, 0.f);
        if (m < NTOK) { sl[q] = *(const int4*)(SLOT + (size_t)m * 4); tw[q] = *(const float4*)(TOPW + (size_t)m * 4); } }
    for (int m0 = gw; m0 < NTOK; m0 += R11 * NGW) {
        u32x2 hw[R11][8]; unsigned ya[R11][8], yb[R11][8], yc[R11][8], yd[R11][8];
#pragma unroll
        for (int q = 0; q < R11; ++q) { const int m = m0 + q * NGW; if (m < NTOK) {
            const u32x2* hb = (const u32x2*)((const bf16_t*)(F.ws + WS_H) + (size_t)m * DM) + lane;
            const unsigned* y0 = (const unsigned*)((const unsigned char*)YB + (size_t)sl[q].x * DM) + lane; const unsigned* y1 = (const unsigned*)((const unsigned char*)YB + (size_t)sl[q].y * DM) + lane;
            const unsigned* y2 = (const unsigned*)((const unsigned char*)YB + (size_t)sl[q].z * DM) + lane; const unsigned* y3 = (const unsigned*)((const unsigned char*)YB + (size_t)sl[q].w * DM) + lane;
#pragma unroll
            for (int j = 0; j < 8; ++j) { hw[q][j] = hb[64 * j]; ya[q][j] = y0[64 * j]; yb[q][j] = y1[64 * j]; yc[q][j] = y2[64 * j]; yd[q][j] = y3[64 * j]; } } }
        float4 twc[R11];
#pragma unroll
        for (int q = 0; q < R11; ++q) { twc[q] = tw[q]; const int mn = m0 + (R11 + q) * NGW;
            if (mn < NTOK) { sl[q] = *(const int4*)(SLOT + (size_t)mn * 4); tw[q] = *(const float4*)(TOPW + (size_t)mn * 4); } }
#pragma unroll
        for (int q = 0; q < R11; ++q) { const int m = m0 + q * NGW; if (m < NTOK) {
            f32x4* hr = (f32x4*)(F.out + (size_t)m * DM) + lane;
            f32x4 v[8]; float s = 0.f;
#pragma unroll
            for (int j = 0; j < 8; ++j) { v[j] = (f32x4){bf_lo(hw[q][j].x), bf_hi(hw[q][j].x), bf_lo(hw[q][j].y), bf_hi(hw[q][j].y)};
                const unsigned a = ya[q][j], b = yb[q][j], c = yc[q][j], d = yd[q][j];
                const f32x2_ a0 = __builtin_amdgcn_cvt_pk_f32_fp8((int)a, false), a1 = __builtin_amdgcn_cvt_pk_f32_fp8((int)a, true), b0 = __builtin_amdgcn_cvt_pk_f32_fp8((int)b, false), b1 = __builtin_amdgcn_cvt_pk_f32_fp8((int)b, true);
                const f32x2_ c0 = __builtin_amdgcn_cvt_pk_f32_fp8((int)c, false), c1 = __builtin_amdgcn_cvt_pk_f32_fp8((int)c, true), d0 = __builtin_amdgcn_cvt_pk_f32_fp8((int)d, false), d1 = __builtin_amdgcn_cvt_pk_f32_fp8((int)d, true);
                v[j].x += twc[q].x * a0[0] + twc[q].y * b0[0] + twc[q].z * c0[0] + twc[q].w * d0[0];
                v[j].y += twc[q].x * a0[1] + twc[q].y * b0[1] + twc[q].z * c0[1] + twc[q].w * d0[1];
                v[j].z += twc[q].x * a1[0] + twc[q].y * b1[0] + twc[q].z * c1[0] + twc[q].w * d1[0];
                v[j].w += twc[q].x * a1[1] + twc[q].y * b1[1] + twc[q].z * c1[1] + twc[q].w * d1[1];
                s += (v[j].x * v[j].x + v[j].y * v[j].y) + (v[j].z * v[j].z + v[j].w * v[j].w); }
            const float rstd = 1.0f / sqrtf(wave_sum(s) * (1.0f / DM) + EPS);
#pragma unroll
            for (int j = 0; j < 8; ++j) { const f32x4 gg = ((const f32x4*)F.g_final)[lane + 64 * j]; hr[64 * j] = v[j] * rstd * gg; } } }
    }
}

__global__ void __launch_bounds__(NTHREADS, 2) fwd_kernel(Args args) {
    __shared__ __attribute__((aligned(16))) unsigned char lds_raw[LDS_BYTES];
    Frame F;
    F.lds = (LAS unsigned char*)lds_raw; F.ws = args.ws; F.ctl = (unsigned*)(args.ws + WS_CTL);
    F.tid = threadIdx.x; F.lane = F.tid & 63; F.wave = __builtin_amdgcn_readfirstlane(F.tid >> 6); F.G = gridDim.x; F.bx = blockIdx.x;
    F.x = (const float*)args.in[0]; F.positions = (const int*)args.in[1]; F.g_attn = (const float*)args.in[2]; F.w_in = (const float*)args.in[3]; F.b_gate = (const float*)args.in[4];
    F.sinks = (const float*)args.in[5]; F.g_q = (const float*)args.in[6]; F.w_uq = (const float*)args.in[7]; F.g_kv = (const float*)args.in[8]; F.w_ukv = (const float*)args.in[9];
    F.w_o_swa = (const float*)args.in[10]; F.w_o_mla = (const float*)args.in[11]; F.w_out = (const float*)args.in[12]; F.g_ffn = (const float*)args.in[13]; F.w_router = (const float*)args.in[14];
    F.b_router = (const float*)args.in[15]; F.w_gate_up = (const float*)args.in[16]; F.b_gate_up = (const float*)args.in[17]; F.w_down = (const float*)args.in[18]; F.b_down = (const float*)args.in[19];
    F.g_final = (const float*)args.in[20]; F.out = args.out;
    volatile LAS unsigned* MISC = (volatile LAS unsigned*)(F.lds + MISC_OFF);
#ifdef DBG_ZERO_LDS
    for (int u = F.tid; u < RING_BYTES / 4; u += NTHREADS) ((LAS unsigned*)(F.lds))[u] = 0u;
#endif
    for (int u = F.tid; u < (LDS_BYTES - MISC_OFF) / 4; u += NTHREADS) ((LAS unsigned*)(F.lds + MISC_OFF))[u] = 0u;
    __syncthreads();
    const int lo = args.ph_lo, hi = args.ph_hi;
    const bool multi = (hi - lo) > 1;
    XcdBarrier bar; bar.bar = F.ctl + CW_BAR; bar.x = 0; bar.st = nullptr;
    if (multi) bar = xcd_barrier_post(F.ctl + CW_BAR, MISC + 8);
#ifndef PHMASK
#ifdef DBG_NOMOE
#define PHMASK 0x87F
#else
#define PHMASK 0xFFF
#endif
#endif
#define IN(k) (((PHMASK >> (k)) & 1) && lo <= (k) && (k) < hi)
#define SEAM(k) do { if (IN(k) && IN((k) + 1)) xcd_barrier(bar); } while (0)
    unsigned char* ws = args.ws;
    bf16_t* XN = (bf16_t*)(ws + WS_XN); bf16_t* PROJ = (bf16_t*)(ws + WS_PROJ); unsigned char* GATES = (unsigned char*)(ws + WS_GATES);
    const int* TILEE = (const int*)(ws + WS_TILEE); const int* ROWTOK = (const int*)(ws + WS_ROWTOK);

#ifndef REPMASK
#define REPMASK 0
#endif
#define NREP(k) (((REPMASK >> (k)) & 1) + 1)
    if (IN(0)) { for (int rep = 0; rep < NREP(0); ++rep) p0_prologue(F); SEAM(0); }
    if (IN(1)) {
        { pg8::Gemm8 g{(const unsigned char*)(ws + WS_XN8), (const unsigned char*)(ws + WS_WIN), DM, DM, nullptr, 0, (const int*)(ws + WS_IDROW)}; pg8::StaticOrder S; S.init(NTOK / 256, NPROJ / 256, F.G, F.bx);
          pg8::EpiProj8 E{PROJ, (float*)(ws + WS_CQ)};
          for (int rep = 0; rep < NREP(1); ++rep) pg8::gemm_phase_f8<pg8::EpiProj8>(F.lds, g, S, E); }
        { pg8::Gemm8 g{(const unsigned char*)(ws + WS_XN8), (const unsigned char*)(ws + WS_WIN + WIN_GATES_OFF), DM, DM, nullptr, 0, (const int*)(ws + WS_IDROW)}; pg8::StaticOrder S; S.init(NTOK / 256, NGATE / 256, F.G, F.bx);
          pg8::EpiGates8 E{GATES, F.b_gate};
          for (int rep = 0; rep < NREP(1); ++rep) pg8::gemm_phase_f8<pg8::EpiGates8>(F.lds, g, S, E); }
        SEAM(1);
    }
#ifdef DBG_TWICE
    if (IN(2)) {
        pg8::Gemm g{XN, (const bf16_t*)(ws + WS_WIN), DM, DM, nullptr, 0, nullptr}; pg8::StaticOrder S; S.init(NTOK / 256, NIN_PHYS / 256, F.G, F.bx);
        pg8::EpiProj E{(bf16_t*)(ws + WS_YBUF), (bf16_t*)(ws + WS_ACT), F.b_gate};
        pg8::gemm_phase<pg8::EpiProj, false, false>(F.lds, g, S, E);
    }
#else
#endif
    if (IN(3)) {
#ifndef P3_SKIP_GEMM
        { pg8::Gemm g{PROJ + PC_DQ, (const bf16_t*)(ws + WS_WUQ), NPROJ, 512, nullptr, 0, nullptr}; pg8::StaticOrder S; S.init(NTOK / 256, 1536 / 256, F.G, F.bx);
          pg8::EpiQn E{(bf16_t*)(ws + WS_QB), (const float*)(ws + WS_CQ), 0.07216878364870322f * 1.4426950408889634f};
          for (int rep = 0; rep < NREP(12); ++rep) pg8::gemm_phase<pg8::EpiQn, false, false>(F.lds, g, S, E); }
        { pg8::Gemm g{PROJ + PC_DKV, (const bf16_t*)(ws + WS_WUKV), NPROJ, 256, nullptr, 0, nullptr}; pg8::StaticOrder S; S.init(NTOK / 256, 2048 / 256, F.G, F.bx);
          pg8::EpiKVn E{(bf16_t*)(ws + WS_KMLA), (bf16_t*)(ws + WS_VMLA), (const float*)(ws + WS_CQ), PROJ, (const float*)(ws + WS_CS)};
          for (int rep = 0; rep < NREP(12); ++rep) pg8::gemm_phase<pg8::EpiKVn, false, false>(F.lds, g, S, E); }
#endif
#ifndef P3_SKIP_SWA
        for (int rep = 0; rep < NREP(3); ++rep) swa_phase(F);
#endif
        SEAM(3);
    }
    if (IN(4)) { for (int rep = 0; rep < NREP(4); ++rep) mla_phase(F); SEAM(4); }
    if (IN(5)) {
        pg8::Gemm8 g{(const unsigned char*)(ws + WS_OUTA), (const unsigned char*)(ws + WS_WOA), DM, DM, nullptr, 0, (const int*)(ws + WS_IDROW)}; pg8::StaticOrder S; S.init(NTOK / 256, DM / 256, F.G, F.bx);
        pg8::EpiGateMerge8 E{(unsigned char*)(ws + WS_MIX), GATES};
        for (int rep = 0; rep < NREP(5); ++rep) pg8::gemm_phase_f8<pg8::EpiGateMerge8, true>(F.lds, g, S, E);
        SEAM(5);
    }
    if (IN(6)) {
        pg8::Gemm8 g{(const unsigned char*)(ws + WS_MIX), (const unsigned char*)(ws + WS_WOUT), DM, DM, nullptr, 0, (const int*)(ws + WS_IDROW)}; pg8::StaticOrder S; S.init(NTOK / 256, DM / 256, F.G, F.bx);
        pg8::EpiRes8 E{F.x, (bf16_t*)(ws + WS_H), (float*)(ws + WS_CKV)};
        for (int rep = 0; rep < NREP(6); ++rep) pg8::gemm_phase_f8<pg8::EpiRes8>(F.lds, g, S, E);
        SEAM(6);
    }
    if (IN(7)) { for (int rep = 0; rep < NREP(7); ++rep) p7_router(F); SEAM(7); }
    if (IN(8)) { p8_slots(F); SEAM(8); }
    if (IN(9)) {
        const int ntl = (int)__hip_atomic_load(F.ctl + CW_NT, __ATOMIC_RELAXED, __HIP_MEMORY_SCOPE_AGENT);
        pg8::Gemm8 g{(const unsigned char*)XN, (const unsigned char*)(ws + WS_WGU), DM, DM, TILEE, (size_t)2 * DM * DM, ROWTOK}; pg8::StaticOrder S; S.init(ntl, 2 * DM / 256, F.G, F.bx);
        pg8::EpiSwiglu8 E{(unsigned char*)(ws + WS_ACT), F.b_gate_up, TILEE};
        for (int rep = 0; rep < NREP(9); ++rep) pg8::gemm_phase_f8<pg8::EpiSwiglu8>(F.lds, g, S, E);
        SEAM(9);
    }
#ifdef DBG_TWICE
    if (IN(10)) {
        const int gw = F.bx * NWAVES + F.wave, NGW = F.G * NWAVES; unsigned cnt = 0;
        for (int m = gw; m < NTOK; m += NGW) {
            const bf16_t* s1 = (const bf16_t*)(ws + DBG_CMP_OFF1) + (size_t)m * DBG_CMP_PITCH; const bf16_t* s2 = (const bf16_t*)(ws + DBG_CMP_OFF2) + (size_t)m * DBG_CMP_PITCH;
            for (int d = F.lane; d < 2048; d += 64) cnt += (s1[d] != s2[d]) ? 1u : 0u;
        }
        if (cnt) atomicAdd(F.ctl + 32, cnt);
    }
    if (IN(11)) {
        const unsigned c = __hip_atomic_load(F.ctl + 32, __ATOMIC_RELAXED, __HIP_MEMORY_SCOPE_AGENT);
        const float v = c == 0 ? 1.0f : (c < 1000u ? 2.0f : (c < 100000u ? 3.0f : (c < 10000000u ? 4.0f : 5.0f)));
        for (size_t i = (size_t)F.bx * NTHREADS + F.tid; i < (size_t)NTOK * DM; i += (size_t)F.G * NTHREADS) F.out[i] = v;
        return;
    }
#endif
    if (IN(10)) {
        const int ntl = (int)__hip_atomic_load(F.ctl + CW_NT, __ATOMIC_RELAXED, __HIP_MEMORY_SCOPE_AGENT);
        pg8::Gemm8 g{(const unsigned char*)(ws + WS_ACT), (const unsigned char*)(ws + WS_WD), DM, DM, TILEE, (size_t)DM * DM, (const int*)(ws + WS_IDROW)}; pg8::StaticOrder S; S.init(ntl, DM / 256, F.G, F.bx);
        pg8::EpiDown8 E{(unsigned char*)(ws + WS_YBUF), F.b_down, TILEE};
        for (int rep = 0; rep < NREP(10); ++rep) pg8::gemm_phase_f8<pg8::EpiDown8>(F.lds, g, S, E);
        SEAM(10);
    }
    if (IN(11)) { p11_final(F); }
#undef IN
#undef SEAM
}

extern "C" void kernel_launch(void* const* d_in, const int* in_sizes, int n_in, void* d_out, int out_size, void* d_ws, size_t ws_size, hipStream_t stream) {
    static int grid = 0;
    if (grid == 0) {
        if (n_in != 21 || out_size != NTOK * DM || ws_size < WS_END) { fprintf(stderr, "kernel_launch: unexpected problem (n_in %d, out %d, ws %zu)\n", n_in, out_size, ws_size); grid = -1; return; }
        int dev = 0, cus = 0, per_cu = 0;
        if (hipGetDevice(&dev) != hipSuccess || hipDeviceGetAttribute(&cus, hipDeviceAttributeMultiprocessorCount, dev) != hipSuccess) { grid = -1; return; }
        if (hipOccupancyMaxActiveBlocksPerMultiprocessor(&per_cu, (const void*)fwd_kernel, NTHREADS, 0) != hipSuccess || per_cu < 1) { fprintf(stderr, "kernel_launch: occupancy query says %d\n", per_cu); }
        (void)hipGetLastError();
        grid = cus;
    }
    if (grid < 0) return;
    if (hipMemsetAsync((char*)d_ws + WS_CTL, 0, CTL_ZERO_BYTES, stream) != hipSuccess) return;
    Args a{};
    for (int i = 0; i < 21; ++i) a.in[i] = d_in[i];
    a.out = (float*)d_out; a.ws = (unsigned char*)d_ws;
#if MK_ONE_LAUNCH
    a.ph_lo = 0; a.ph_hi = 12;
    hipLaunchKernelGGL(fwd_kernel, dim3(grid), dim3(NTHREADS), 0, stream, a);
#else
    for (int p = 0; p < 12; ++p) { a.ph_lo = p; a.ph_hi = p + 1; hipLaunchKernelGGL(fwd_kernel, dim3(grid), dim3(NTHREADS), 0, stream, a); }
#endif
}
```
